# Optimizing an MI355X kernel written in HIP

```python
import jax, jax.numpy as jnp
from jax import lax
import numpy as np

D_MODEL = 1024
BATCH = 1
SEQ = 16384
DEPTH = 1

GRID_W = 64
CTX_LEN = 256
RET_HEADS = 4
RET_DK = 256
RET_DV = 512
RET_CHUNK = 128
FOURIER_GROUPS = 4
FOURIER_DG = 256
D_FF = 2816
ROPE_BASE = 10000.0
EPS = 1e-6
N_MOD = 9

RET_QK = RET_HEADS * RET_DK
RET_V = RET_HEADS * RET_DV
FOURIER_W = FOURIER_GROUPS * FOURIER_DG
IN_COLS = 2 * RET_QK + 2 * RET_V + FOURIER_W + 2 * D_MODEL
SPLITS = (RET_QK, 2 * RET_QK, 2 * RET_QK + RET_V, 2 * RET_QK + 2 * RET_V,
          2 * RET_QK + 2 * RET_V + FOURIER_W, 2 * RET_QK + 2 * RET_V + FOURIER_W + D_MODEL)

kernel_name = "hybrid_retention_fnet_macaron_dit_block"


def rmsnorm(x, w):
    xf = x.astype(jnp.float32)
    y = xf * lax.rsqrt(jnp.mean(xf * xf, axis=-1, keepdims=True) + EPS)
    return (y * w.astype(jnp.float32)).astype(x.dtype)


def modulate(h, shift, scale):
    return h * (1 + scale) + shift


def swiglu(h, w13, w2):
    a, b = jnp.split(h @ w13, 2, axis=-1)
    return (jax.nn.silu(a) * b) @ w2


def heads(a, dh):
    B, L, _ = a.shape
    return a.reshape(B, L, -1, dh).transpose(0, 2, 1, 3)


def project(h, w_in):
    u = h @ w_in
    q, k, v, g, f, ga, gf = jnp.split(u, SPLITS, axis=-1)
    q = heads(q, RET_DK).astype(jnp.float32) * (RET_DK ** -0.5)
    k = heads(k, RET_DK).astype(jnp.float32)
    v = heads(v, RET_DV).astype(jnp.float32)
    return q, k, v, g, f, ga, gf


def rope_2d(a, rows):
    row = jnp.repeat(jnp.arange(rows, dtype=jnp.float32), GRID_W)
    col = jnp.tile(jnp.arange(GRID_W, dtype=jnp.float32), rows)
    n_freq = RET_DK // 4
    inv = ROPE_BASE ** (-jnp.arange(n_freq, dtype=jnp.float32) / n_freq)
    ang = jnp.concatenate([row[:, None] * inv, col[:, None] * inv], axis=-1)
    cos, sin = jnp.cos(ang), jnp.sin(ang)
    a1, a2 = a[..., 0::2], a[..., 1::2]
    return jnp.stack([a1 * cos - a2 * sin, a1 * sin + a2 * cos], axis=-1).reshape(a.shape)


def retention_scan(q, k, v, log_gamma, s0):
    B, H, L, dk = q.shape
    dv = v.shape[-1]
    C = RET_CHUNK
    n = L // C
    idx = jnp.arange(C, dtype=jnp.float32)
    lg = log_gamma[:, None]
    diff = idx[:, None] - idx[None, :]
    decay_intra = jnp.where(diff >= 0, jnp.exp(lg[:, :, None] * jnp.maximum(diff, 0.0)), 0.0)
    xi = jnp.exp(lg * (idx + 1.0))
    zeta = jnp.exp(lg * (C - 1.0 - idx))
    g_chunk = jnp.exp(log_gamma * C)

    def to_chunks(a):
        return jnp.moveaxis(a.reshape(B, H, n, C, a.shape[-1]), 2, 0)

    def step(s, qkv):
        qc, kc, vc = qkv
        sc = jnp.einsum('bhid,bhjd->bhij', qc, kc) * decay_intra
        o = (jnp.einsum('bhij,bhjv->bhiv', sc, vc)
             + jnp.einsum('bhid,bhdv->bhiv', qc, s) * xi[None, :, :, None])
        s = s * g_chunk[None, :, None, None] + jnp.einsum('bhjd,bhjv->bhdv', kc * zeta[None, :, :, None], vc)
        return s, o

    s, o = lax.scan(step, s0, (to_chunks(q), to_chunks(k), to_chunks(v)))
    o = jnp.moveaxis(o, 0, 2).reshape(B, H, L, dv)
    return o, s


def bidir_retention(q, k, v, lg_f, lg_b, s_f0, s_b0):
    o_f, s_f = retention_scan(q, k, v, lg_f, s_f0)
    flip = lambda a: jnp.flip(a, axis=2)
    o_b, s_b = retention_scan(flip(q), flip(k), flip(v), lg_b, s_b0)
    return o_f + flip(o_b), s_f, s_b


def retention_out(o, g, gn_w, p_ret):
    mu = jnp.mean(o, axis=-1, keepdims=True)
    var = jnp.mean(jnp.square(o - mu), axis=-1, keepdims=True)
    on = (o - mu) * lax.rsqrt(var + EPS)
    B, H, L, dv = o.shape
    on = on.transpose(0, 2, 1, 3).reshape(B, L, H * dv).astype(g.dtype) * gn_w
    return (jax.nn.silu(g) * on) @ p_ret


def fourier_branch(f, p_four):
    B, L, _ = f.shape
    fg = f.reshape(B, L, FOURIER_GROUPS, FOURIER_DG).astype(jnp.float32)
    mixed = jnp.fft.fft2(fg, axes=(1, 3), norm="ortho").real
    return mixed.reshape(B, L, FOURIER_W).astype(f.dtype) @ p_four


def merge(r, fo, ga, gf, w_out):
    return (jax.nn.sigmoid(ga) * r + jax.nn.sigmoid(gf) * fo) @ w_out


def setup_inputs(seed: int = 0) -> dict:
    key = jax.random.key(seed)
    ks = jax.random.split(key, 24)

    def w(k, shape, fan_in, scale=1.0):
        return jax.random.normal(k, shape, jnp.float32) * (scale * fan_in ** -0.5)

    def gain(k, shape):
        return 1.0 + 0.02 * jax.random.normal(k, shape, jnp.float32)

    decay_base = jnp.asarray(np.log(2.0 ** (5 + np.arange(RET_HEADS)) - 1.0).astype(np.float32))
    return {
        "x": jax.random.normal(ks[0], (BATCH, SEQ, D_MODEL), jnp.float32),
        "c": jax.random.normal(ks[1], (BATCH, D_MODEL), jnp.float32),
        "ctx": jax.random.normal(ks[2], (BATCH, CTX_LEN, D_MODEL), jnp.float32),
        "c_ctx": 0.5 * jax.random.normal(ks[3], (D_MODEL,), jnp.float32),
        "w_ada": w(ks[4], (DEPTH, D_MODEL, N_MOD * D_MODEL), D_MODEL, 0.5),
        "b_ada": 0.02 * jax.random.normal(ks[5], (DEPTH, N_MOD * D_MODEL), jnp.float32),
        "norm_ffn1": gain(ks[6], (DEPTH, D_MODEL)),
        "w13_ffn1": w(ks[7], (DEPTH, D_MODEL, 2 * D_FF), D_MODEL),
        "w2_ffn1": w(ks[8], (DEPTH, D_FF, D_MODEL), D_FF),
        "norm_mix": gain(ks[9], (DEPTH, D_MODEL)),
        "w_in": w(ks[10], (DEPTH, D_MODEL, IN_COLS), D_MODEL),
        "decay_fwd": decay_base[None, :] + 0.05 * jax.random.normal(ks[11], (DEPTH, RET_HEADS), jnp.float32),
        "decay_bwd": decay_base[None, :] + 0.05 * jax.random.normal(ks[12], (DEPTH, RET_HEADS), jnp.float32),
        "ret_gn_w": gain(ks[13], (DEPTH, RET_V)),
        "p_ret": w(ks[14], (DEPTH, RET_V, D_MODEL), RET_V),
        "p_four": w(ks[15], (DEPTH, FOURIER_W, D_MODEL), FOURIER_W),
        "w_out": w(ks[16], (DEPTH, D_MODEL, D_MODEL), D_MODEL),
        "norm_ffn2": gain(ks[17], (DEPTH, D_MODEL)),
        "w13_ffn2": w(ks[18], (DEPTH, D_MODEL, 2 * D_FF), D_MODEL),
        "w2_ffn2": w(ks[19], (DEPTH, D_FF, D_MODEL), D_FF),
        "norm_final": gain(ks[20], (D_MODEL,)),
    }


def reference(x, c, ctx, c_ctx, w_ada, b_ada, norm_ffn1, w13_ffn1, w2_ffn1, norm_mix, w_in,
              decay_fwd, decay_bwd, ret_gn_w, p_ret, p_four, w_out, norm_ffn2, w13_ffn2, w2_ffn2,
              norm_final):
    B, L, _ = x.shape
    rows = L // GRID_W
    for l in range(DEPTH):
        last = l == DEPTH - 1
        mod_x = (jax.nn.silu(c) @ w_ada[l] + b_ada[l])[:, None, :]
        mod_c = (jax.nn.silu(c_ctx) @ w_ada[l] + b_ada[l])[None, None, :]
        sh1x, sc1x, g1x, sh2x, sc2x, g2x, sh3x, sc3x, g3x = jnp.split(mod_x, N_MOD, axis=-1)
        sh1c, sc1c, g1c, sh2c, sc2c, g2c, sh3c, sc3c, g3c = jnp.split(mod_c, N_MOD, axis=-1)

        x = x + 0.5 * g1x * swiglu(modulate(rmsnorm(x, norm_ffn1[l]), sh1x, sc1x), w13_ffn1[l], w2_ffn1[l])
        ctx = ctx + 0.5 * g1c * swiglu(modulate(rmsnorm(ctx, norm_ffn1[l]), sh1c, sc1c), w13_ffn1[l], w2_ffn1[l])

        lg_f = jax.nn.log_sigmoid(decay_fwd[l].astype(jnp.float32))
        lg_b = jax.nn.log_sigmoid(decay_bwd[l].astype(jnp.float32))

        qc, kc, vc, gc, fc, gac, gfc = project(modulate(rmsnorm(ctx, norm_mix[l]), sh2c, sc2c), w_in[l])
        zero = jnp.zeros((ctx.shape[0], RET_HEADS, RET_DK, RET_DV), jnp.float32)
        o_c, s_f, s_b = bidir_retention(qc, kc, vc, lg_f, lg_b, zero, zero)

        qx, kx, vx, gx, fx, gax, gfx = project(modulate(rmsnorm(x, norm_mix[l]), sh2x, sc2x), w_in[l])
        qx = rope_2d(qx, rows)
        kx = rope_2d(kx, rows)
        o_x, _, _ = bidir_retention(qx, kx, vx, lg_f, lg_b, s_f, s_b)
        y_x = merge(retention_out(o_x, gx, ret_gn_w[l], p_ret[l]), fourier_branch(fx, p_four[l]), gax, gfx, w_out[l])
        x = x + g2x * y_x

        x = x + 0.5 * g3x * swiglu(modulate(rmsnorm(x, norm_ffn2[l]), sh3x, sc3x), w13_ffn2[l], w2_ffn2[l])

        if not last:
            y_c = merge(retention_out(o_c, gc, ret_gn_w[l], p_ret[l]), fourier_branch(fc, p_four[l]), gac, gfc, w_out[l])
            ctx = ctx + g2c * y_c
            ctx = ctx + 0.5 * g3c * swiglu(modulate(rmsnorm(ctx, norm_ffn2[l]), sh3c, sc3c), w13_ffn2[l], w2_ffn2[l])
    return rmsnorm(x, norm_final)
```

```cpp
#include <hip/hip_runtime.h>
#include <cstdio>
#include <cstdint>

#ifndef DBG_NOFOUR
#define DBG_NOFOUR 0
#endif
#ifndef DBG_NORET
#define DBG_NORET 0
#endif
#ifndef DBG_PROBE
#define DBG_PROBE 0
#endif
#ifndef DBG_COUNT
#define DBG_COUNT 0
#ifndef DBG_COL
#define DBG_COL 736
#endif
#ifndef DBG_VAR
#define DBG_VAR 2
#endif
#ifndef DBG_SH
#define DBG_SH 0
#endif
#ifndef DBG_GF
#define DBG_GF 1
#endif
#ifndef DBG_S0
#define DBG_S0 4
#endif
#endif
#ifndef STOP_AFTER
#define STOP_AFTER 99
#endif

#define LAS __attribute__((address_space(3)))
typedef unsigned short bf16_t;
typedef short bf16x8 __attribute__((ext_vector_type(8)));
typedef float f32x4 __attribute__((ext_vector_type(4)));
typedef float f32x2 __attribute__((ext_vector_type(2)));
typedef unsigned u32x4 __attribute__((ext_vector_type(4)));
typedef unsigned u32x2 __attribute__((ext_vector_type(2)));

constexpr int DM = 1024, SEQ = 16384, CTX = 256, DFF = 2816;
constexpr float EPS = 1e-6f;
constexpr int LS = 512, NSEG = SEQ / LS;

constexpr size_t MiB = 1u << 20;
constexpr size_t WS_CTL = 0, CTL_ZERO_BYTES = 1 * MiB;
constexpr size_t WS_MOD = 1 * MiB;
constexpr size_t WS_TAB = 2 * MiB;
constexpr size_t WS_STATS = 3 * MiB;
constexpr size_t WS_S0 = 4 * MiB;
constexpr size_t WS_KC = 8 * MiB;
constexpr size_t WS_VC = 9 * MiB;
constexpr size_t WS_DC = 10 * MiB;
constexpr size_t WS_HC = 12 * MiB;
constexpr size_t WS_WIN = 14 * MiB;
constexpr size_t WS_WN = 34 * MiB;
constexpr size_t WS_WB = 36 * MiB;
constexpr size_t WS_H = 54 * MiB;
constexpr size_t WS_Q = 54 * MiB, WS_KN = 70 * MiB, WS_KT = 86 * MiB, WS_B4 = 118 * MiB;
constexpr size_t WS_O = 182 * MiB;
constexpr size_t WS_END = 246 * MiB;
constexpr size_t WS_WT = 118 * MiB, WS_BT = 54 * MiB, WS_MIX = 118 * MiB, WS_GA = 54 * MiB, WS_GF = 86 * MiB;
constexpr size_t DO_AX = 32 * MiB;
constexpr int WR_G = 4096, WR_F = 6144, WR_GA = 8192, WR_GF = 9216;
constexpr size_t WB_W13 = 0, WB_W2 = 11 * MiB;
constexpr size_t WB_BZ = 0, WB_WO = 6 * MiB;
constexpr size_t TB_ROPE = 0, TB_TW = 128 * 1024, TB_FM = 256 * 1024, TB_GM = 384 * 1024, TB_T256 = 512 * 1024;

typedef __bf16 bf16x2_t __attribute__((ext_vector_type(2)));
__device__ __forceinline__ unsigned cvt_pk_bf16(float lo, float hi) { const f32x2 v = {lo, hi}; return __builtin_bit_cast(unsigned, __builtin_convertvector(v, bf16x2_t)); }
__device__ __forceinline__ unsigned short f2bf(float f) { unsigned u = __builtin_bit_cast(unsigned, f); return (unsigned short)((u + 0x7fffu + ((u >> 16) & 1u)) >> 16); }
__device__ __forceinline__ float bflo(unsigned u) { return __builtin_bit_cast(float, u << 16); }
__device__ __forceinline__ float bfhi(unsigned u) { return __builtin_bit_cast(float, u & 0xffff0000u); }
__device__ __forceinline__ u32x4 pack8(const f32x4 a, const f32x4 b) { u32x4 w; w.x = cvt_pk_bf16(a[0], a[1]); w.y = cvt_pk_bf16(a[2], a[3]); w.z = cvt_pk_bf16(b[0], b[1]); w.w = cvt_pk_bf16(b[2], b[3]); return w; }
__device__ __forceinline__ void unpack8(const u32x4 w, f32x4& a, f32x4& b) { a = (f32x4){bflo(w.x), bfhi(w.x), bflo(w.y), bfhi(w.y)}; b = (f32x4){bflo(w.z), bfhi(w.z), bflo(w.w), bfhi(w.w)}; }
__device__ __forceinline__ float fsigmoid(float a) { return __builtin_amdgcn_rcpf(1.0f + __expf(-a)); }
__device__ __forceinline__ float fsilu(float a) { return a * fsigmoid(a); }
__device__ __forceinline__ float wave_sum(float v) {
#pragma unroll
    for (int o = 1; o < 64; o <<= 1) v += __shfl_xor(v, o);
    return v;
}

namespace pg {
constexpr int BM = 256, BK = 64, HALF = 128, HTB = HALF * BK * 2, STAGE_BYTES = 8 * HTB, NXCD = 8, WGM = 8;
__device__ __forceinline__ int lds_byte(int r, int c) { const int st = (r >> 4) * 2 + (c >> 5), rr = r & 15, cc = c & 31, ob = rr * 64 + cc * 2; return st * 1024 + (ob ^ (((ob >> 9) & 1) << 5)); }
__device__ __forceinline__ void stage_rc(int b, int& R, int& C) { const int st = b / 1024, sb = b % 1024, swz = sb ^ (((sb >> 9) & 1) << 5); R = (st >> 1) * 16 + swz / 64; C = (st & 1) * 32 + (swz % 64) / 2; }
__device__ __forceinline__ int perm32(int rho) { const int n = rho >> 4, i = rho & 15; return 8 * (i >> 2) + 4 * n + (i & 3); }

struct Unit { const char* a0; const char* a1; const char* b; char* d; int i0, i1, i2, i3; };
struct Geo { unsigned lda0, lda1, ldb;
             unsigned hsA0, hsA1, hsB;
             int nt, c0, rep0; };

__device__ __forceinline__ void tile_pm_pn(int L, int nM, int nN, int& pm, int& pn) {
    const int nwg = nM * nN; int wgid = L;
    { const int q = nwg / NXCD, r = nwg % NXCD, xcd = wgid % NXCD, off = wgid / NXCD; wgid = (xcd < r ? xcd * (q + 1) : r * (q + 1) + (xcd - r) * q) + off; }
    const int nig = WGM * nN, gid = wgid / nig, fm = gid * WGM, gsz = (nM - fm) < WGM ? (nM - fm) : WGM;
    pm = fm + ((wgid % nig) % gsz); pn = (wgid % nig) / gsz;
}
__device__ __forceinline__ int xcd_contig(int L, int n) { return (L % NXCD) * (n / NXCD) + L / NXCD; }

template <class Job> struct Sched {
    Job j; int n, G, c;
    __device__ __forceinline__ bool next(int i, Unit& u) const { const long L = (long)i * G + c; if (L >= n) return false; j.fill((int)L, u); return true; }
};

template <class Epi, class Sch, int ASEG>
__device__ __forceinline__ void gemm_phase(LAS unsigned char* lds, const Geo g, const Sch& S, const Epi& E) {
    int tid = threadIdx.x; asm volatile("" : "+v"(tid));
    const int wid = __builtin_amdgcn_readfirstlane(tid >> 6), lane = tid & 63, wr = wid >> 2, wc = wid & 3, fr = lane & 15, fq = lane >> 4;
    int nt = g.nt; asm volatile("" : "+s"(nt));
    unsigned voffA0[2], voffA1[2], voffB[2];
#pragma unroll
    for (int i = 0; i < 2; ++i) { int R, C; stage_rc(tid * 16 + i * 8192, R, C); const int Rb = (R & ~31) + perm32(R & 31);
        voffA0[i] = (unsigned)(R * g.lda0 + C) * 2u; voffA1[i] = (ASEG == 2) ? (unsigned)(R * g.lda1 + C) * 2u : 0u; voffB[i] = (unsigned)(Rb * g.ldb + C) * 2u; }
    const unsigned ldsw = (unsigned)wid * 1024u;
    const int aoff = lds_byte(wr * 64 + fr, fq * 8), boff = lds_byte(wc * 32 + fr, fq * 8);
#define PG_SA(b, h) (((b) * 2 + (h)) * HTB)
#define PG_SB(b, h) ((4 + (b) * 2 + (h)) * HTB)
#define PG_GLDS(gp, lp) __builtin_amdgcn_global_load_lds((const unsigned*)(gp), (LAS unsigned*)(lp), 16, 0, 0)
#define PG_ASEL(T) (ASEG == 2 && (T) >= g.c0)
#define PG_APTR(U, T) (PG_ASEL(T) ? (U).a1 + (size_t)((T) - g.c0) * 128 : (U).a0 + (size_t)((T) & (g.rep0 - 1)) * 128)
#define PG_STAGE_A(bufoff, gbase, h, sel) do { const bool _s = (sel); const unsigned _v0 = _s ? voffA1[0] : voffA0[0], _v1 = _s ? voffA1[1] : voffA0[1]; \
        const char* _p = (gbase) + ((h) ? (size_t)(_s ? g.hsA1 : g.hsA0) : (size_t)0); \
        PG_GLDS(_p + _v0, lds + (bufoff) + ldsw); PG_GLDS(_p + _v1, lds + (bufoff) + ldsw + 8192); } while (0)
#define PG_STAGE_B(bufoff, gbase, h) do { const char* _p = (gbase) + ((h) ? (size_t)g.hsB : (size_t)0); \
        PG_GLDS(_p + voffB[0], lds + (bufoff) + ldsw); PG_GLDS(_p + voffB[1], lds + (bufoff) + ldsw + 8192); } while (0)
#define PG_LDA(dst, b, h) do { _Pragma("unroll") for (int m = 0; m < 4; ++m) _Pragma("unroll") for (int k = 0; k < 2; ++k) dst[m][k] = *(const LAS bf16x8*)(lds + PG_SA(b, h) + aoff + m * 2048 + k * 1024); } while (0)
#define PG_LDB(dst, b, h) do { _Pragma("unroll") for (int n = 0; n < 2; ++n) _Pragma("unroll") for (int k = 0; k < 2; ++k) dst[n][k] = *(const LAS bf16x8*)(lds + PG_SB(b, h) + boff + n * 2048 + k * 1024); } while (0)
#define PG_MMA(ai, bj, At, Bt) do { __builtin_amdgcn_s_setprio(1); _Pragma("unroll") for (int m = 0; m < 4; ++m) _Pragma("unroll") for (int n = 0; n < 2; ++n) _Pragma("unroll") for (int k = 0; k < 2; ++k) \
        acc[ai][bj][m][n] = __builtin_amdgcn_mfma_f32_16x16x32_bf16(Bt[n][k], At[m][k], acc[ai][bj][m][n], 0, 0, 0); __builtin_amdgcn_s_setprio(0); } while (0)
#define PG_WAIT_V(n) asm volatile("s_waitcnt vmcnt(" #n ")" ::: "memory")
#define PG_WAIT_L(n) asm volatile("s_waitcnt lgkmcnt(" #n ")" ::: "memory")
#define PG_BAR __builtin_amdgcn_s_barrier()
#define PG_SCHED __builtin_amdgcn_sched_barrier(0)
    Unit cur, nxt; int ui = 0;
    if (!S.next(0, cur)) return;
    f32x4 acc[2][2][4][2];
#pragma unroll
    for (int a = 0; a < 2; ++a)
#pragma unroll
        for (int b = 0; b < 2; ++b)
#pragma unroll
            for (int m = 0; m < 4; ++m)
#pragma unroll
                for (int n = 0; n < 2; ++n) acc[a][b][m][n] = (f32x4){0.f, 0.f, 0.f, 0.f};
    bf16x8 At[4][2], B0[2][2], B1[2][2];
    { const char* p0 = PG_APTR(cur, 0); const char* p1 = PG_APTR(cur, 1);
      PG_STAGE_B(PG_SB(0, 0), cur.b, 0); PG_STAGE_B(PG_SB(0, 1), cur.b, 1); PG_STAGE_A(PG_SA(0, 0), p0, 0, PG_ASEL(0)); PG_STAGE_A(PG_SA(0, 1), p0, 1, PG_ASEL(0));
      if (wr == 1) PG_BAR;
      PG_WAIT_V(2); PG_BAR;
      PG_STAGE_B(PG_SB(1, 0), cur.b + 128, 0); PG_STAGE_A(PG_SA(1, 0), p1, 0, PG_ASEL(1)); PG_STAGE_B(PG_SB(1, 1), cur.b + 128, 1);
      PG_WAIT_V(6); PG_BAR; }
    for (;;) {
        const bool has_next = S.next(ui + 1, nxt);
        const char* nA0 = has_next ? PG_APTR(nxt, 0) : PG_APTR(cur, 0); const char* nA1 = has_next ? PG_APTR(nxt, 1) : PG_APTR(cur, 1); const char* nB = has_next ? nxt.b : cur.b;
        for (int t = 0; t < nt; t += 2) {
            const bool last = (t == nt - 2);
            if constexpr (Epi::NHOOK >= 1) { if (t == E.h0) { int t2 = threadIdx.x; asm volatile("" : "+v"(t2)); E.hook(acc, cur, 0, wr, wc, t2 & 15, (t2 >> 4) & 3); } }
            if constexpr (Epi::NHOOK >= 2) { if (t == E.h1) { int t2 = threadIdx.x; asm volatile("" : "+v"(t2)); E.hook(acc, cur, 1, wr, wc, t2 & 15, (t2 >> 4) & 3); } }
            const char* a1 = PG_APTR(cur, t + 1); const bool s1 = PG_ASEL(t + 1);
            const char* a2 = last ? nA0 : PG_APTR(cur, t + 2); const char* a3 = last ? nA1 : PG_APTR(cur, t + 3);
            const char* b2 = last ? nB : cur.b + (size_t)(t + 2) * 128; const char* b3 = b2 + 128;
            const bool s2 = last ? PG_ASEL(0) : PG_ASEL(t + 2), s3 = last ? PG_ASEL(1) : PG_ASEL(t + 3);
            PG_LDB(B0, 0, 0); PG_LDB(B1, 0, 1); PG_SCHED; PG_LDA(At, 0, 0); PG_STAGE_A(PG_SA(1, 1), a1, 1, s1);
            PG_WAIT_V(8); PG_WAIT_L(0); PG_BAR; PG_MMA(0, 0, At, B0); PG_MMA(0, 1, At, B1); PG_BAR; PG_SCHED;
            PG_LDA(At, 0, 1); PG_STAGE_B(PG_SB(0, 0), b2, 0); PG_STAGE_B(PG_SB(0, 1), b2, 1); PG_STAGE_A(PG_SA(0, 0), a2, 0, s2);
            PG_WAIT_V(8); PG_WAIT_L(0); PG_BAR; PG_MMA(1, 0, At, B0); PG_MMA(1, 1, At, B1); PG_BAR; PG_SCHED;
            PG_LDB(B0, 1, 0); PG_LDB(B1, 1, 1); PG_SCHED; PG_LDA(At, 1, 0); PG_STAGE_A(PG_SA(0, 1), a2, 1, s2);
            PG_WAIT_V(8); PG_WAIT_L(0); PG_BAR; PG_MMA(0, 0, At, B0); PG_MMA(0, 1, At, B1); PG_BAR; PG_SCHED;
            PG_LDA(At, 1, 1); PG_STAGE_B(PG_SB(1, 0), b3, 0); PG_STAGE_B(PG_SB(1, 1), b3, 1); PG_STAGE_A(PG_SA(1, 0), a3, 0, s3);
            PG_WAIT_V(8); PG_WAIT_L(0); PG_BAR; PG_MMA(1, 0, At, B0); PG_MMA(1, 1, At, B1); PG_BAR; PG_SCHED;
        }
        if (wr == 0) PG_BAR;
        { int t2 = threadIdx.x; asm volatile("" : "+v"(t2)); E(acc, cur, wr, wc, t2 & 15, (t2 >> 4) & 3); }
        if (!has_next) break;
#pragma unroll
        for (int a = 0; a < 2; ++a)
#pragma unroll
            for (int b = 0; b < 2; ++b)
#pragma unroll
                for (int m = 0; m < 4; ++m)
#pragma unroll
                    for (int n = 0; n < 2; ++n) acc[a][b][m][n] = (f32x4){0.f, 0.f, 0.f, 0.f};
        cur = nxt; ++ui;
        if (wr == 1) PG_BAR;
    }
    PG_WAIT_V(0);
    PG_BAR;
#undef PG_SA
#undef PG_SB
#undef PG_GLDS
#undef PG_ASEL
#undef PG_APTR
#undef PG_STAGE_A
#undef PG_STAGE_B
#undef PG_LDA
#undef PG_LDB
#undef PG_MMA
#undef PG_WAIT_V
#undef PG_WAIT_L
#undef PG_BAR
#undef PG_SCHED
}
}
using pg::Unit; using pg::Geo;

#define EPI_ROWS _Pragma("unroll") for (int ai = 0; ai < 2; ++ai) _Pragma("unroll") for (int m = 0; m < 4; ++m)
#define EPI_ROW (128 * ai + 64 * wr + 16 * m + fr)
#define EPI_COLS _Pragma("unroll") for (int bj = 0; bj < 2; ++bj)
#define EPI_COL0 (128 * bj + 32 * wc + 8 * fq)
typedef f32x4 acc_t[2][2][4][2];

struct Base { unsigned char* ws; unsigned char* dout; };
#define modx ((float*)(F.ws + WS_MOD))
#define modc (modx + 9216)
#define lgp (modx + 2 * 9216)
#define Ax ((bf16_t*)(F.dout + DO_AX))
#define Ac ((bf16_t*)(F.ws + WS_DC + 512 * 1024))
#define Dx ((bf16_t*)F.dout)
#define Dc ((bf16_t*)(F.ws + WS_DC))
#define Hb ((bf16_t*)(F.ws + WS_H))
#define Hc ((bf16_t*)(F.ws + WS_HC))
#define W13t ((bf16_t*)(F.ws + WS_WB + WB_W13))
#define W2t ((bf16_t*)(F.ws + WS_WB + WB_W2))
#define ropeT ((float*)(F.ws + WS_TAB + TB_ROPE))
#define twT ((float*)(F.ws + WS_TAB + TB_TW))
#define FmT ((bf16_t*)(F.ws + WS_TAB + TB_FM))
#define GmT ((bf16_t*)(F.ws + WS_TAB + TB_GM))
#define T256 ((bf16_t*)(F.ws + WS_TAB + TB_T256))
#define Win ((bf16_t*)(F.ws + WS_WIN))
#define Wn ((bf16_t*)(F.ws + WS_WN))
#define Bz ((bf16_t*)(F.ws + WS_WB + WB_BZ))
#define WoT ((bf16_t*)(F.ws + WS_WB + WB_WO))
#define Qb ((bf16_t*)(F.ws + WS_Q))
#define Knb ((bf16_t*)(F.ws + WS_KN))
#define Ktb_ ((bf16_t*)(F.ws + WS_KT))
#define Pb Ktb_
#define B4 ((bf16_t*)(F.ws + WS_B4))
#define Ob ((bf16_t*)(F.ws + WS_O))
#define S0 ((float*)(F.ws + WS_S0))
#define stats ((float*)(F.ws + WS_STATS))
#define KcT ((bf16_t*)(F.ws + WS_KC))
#define VcT ((bf16_t*)(F.ws + WS_VC))
#define Wt ((bf16_t*)(F.ws + WS_WT))
#define Bt ((bf16_t*)(F.ws + WS_BT))
#define MIXb ((bf16_t*)(F.ws + WS_MIX))
#define GAb ((bf16_t*)(F.ws + WS_GA))
#define GFb ((bf16_t*)(F.ws + WS_GF))
#define Zb Ax

struct EpiSwiglu {
    static constexpr int NHOOK = 0; int h0, h1;
    Base F;
    __device__ __forceinline__ void hook(acc_t&, const Unit&, int, int, int, int, int) const {}
    __device__ __forceinline__ void operator()(const acc_t& acc, const Unit& u, int wr, int wc, int fr, int fq) const {
        bf16_t* base = u.i0 < 64 ? Hb + (size_t)u.i0 * 256 * DFF : Hc;
        EPI_ROWS { bf16_t* rowp = base + (size_t)EPI_ROW * DFF + u.i1 * 128;
            EPI_COLS { const f32x4 a = acc[ai][bj][m][0], b = acc[ai][bj][m][1]; u32x2 w;
                w.x = cvt_pk_bf16(fsilu(a[0]) * b[0], fsilu(a[1]) * b[1]); w.y = cvt_pk_bf16(fsilu(a[2]) * b[2], fsilu(a[3]) * b[3]);
                *(u32x2*)(rowp + EPI_COL0 / 2) = w; }  asm volatile("" ::: "memory"); }
    }
};
struct EpiResid {
    static constexpr int NHOOK = 0; int h0, h1;
    Base F; int mode;
    __device__ __forceinline__ void hook(acc_t&, const Unit&, int, int, int, int, int) const {}
    __device__ __forceinline__ void operator()(const acc_t& acc, const Unit& u, int wr, int wc, int fr, int fq) const {
        const bool isx = u.i0 < 64; const int has_old = mode != 0; const float scale = mode == 1 ? 1.0f : 0.5f;
        const bf16_t* din = Dx + (size_t)u.i0 * 256 * DM; bf16_t* dout = isx ? (mode == 2 ? Ob : Dx) + (size_t)u.i0 * 256 * DM : Dc;
        const float* coef = (isx ? modx : modc) + (mode == 0 ? 2 : (mode == 1 ? 5 : 8)) * DM + u.i1 * 256;
        EPI_COLS { const int c = EPI_COL0; const f32x4 c0 = *(const f32x4*)(coef + c) * scale, c1 = *(const f32x4*)(coef + c + 4) * scale;
#pragma unroll
            for (int ai = 0; ai < 2; ++ai)
#pragma unroll
                for (int m = 0; m < 4; ++m) { const size_t off = (size_t)EPI_ROW * DM + u.i1 * 256 + c;
                    f32x4 v0 = acc[ai][bj][m][0] * c0, v1 = acc[ai][bj][m][1] * c1;
                    if (has_old) { f32x4 o0, o1; unpack8(*(const u32x4*)(din + off), o0, o1); v0 += o0; v1 += o1; }
                    *(u32x4*)(dout + off) = pack8(v0, v1); if (m & 1) asm volatile("" ::: "memory"); } }
    }
};

struct JobFfn1 {
    Base F; int nM;
    __device__ __forceinline__ void fill(int L, Unit& u) const { int pm, pn; pg::tile_pm_pn(L, nM, 22, pm, pn);
        u.a0 = (const char*)(pm < 64 ? Ax + (size_t)pm * 256 * DM : Ac); u.a1 = u.a0; u.b = (const char*)(W13t + (size_t)pn * 256 * DM); u.d = nullptr; u.i0 = pm; u.i1 = pn; u.i2 = 0; u.i3 = 0; }
};
struct JobFfn2 {
    Base F; int nM;
    __device__ __forceinline__ void fill(int L, Unit& u) const { int pm, pn; pg::tile_pm_pn(L, nM, 4, pm, pn);
        u.a0 = (const char*)(pm < 64 ? Hb + (size_t)pm * 256 * DFF : Hc); u.a1 = u.a0; u.b = (const char*)(W2t + (size_t)pn * 256 * DFF); u.d = nullptr; u.i0 = pm; u.i1 = pn; u.i2 = 0; u.i3 = 0; }
};

struct EpiStore {
    static constexpr int NHOOK = 0; int h0, h1; int ldd;
    __device__ __forceinline__ void hook(acc_t&, const Unit&, int, int, int, int, int) const {}
    __device__ __forceinline__ void operator()(const acc_t& acc, const Unit& u, int wr, int wc, int fr, int fq) const {
        bf16_t* d = (bf16_t*)u.d;
        EPI_ROWS { EPI_COLS { *(u32x4*)(d + (size_t)EPI_ROW * ldd + EPI_COL0) = pack8(acc[ai][bj][m][0], acc[ai][bj][m][1]); }  asm volatile("" ::: "memory"); }
    }
};
struct EpiQK {
    static constexpr int NHOOK = 0; int h0, h1;
    Base F; int pair;
    __device__ __forceinline__ void hook(acc_t&, const Unit&, int, int, int, int, int) const {}
    __device__ __forceinline__ void operator()(const acc_t& acc, const Unit& u, int wr, int wc, int fr, int fq) const {
        const int pm = u.i0, pn = u.i1, hl = pn & 1, h = 2 * pair + hl; const bool isk = pn >= 2; const float lgf = lgp[h], lgb = lgp[4 + h]; const float* rope = ropeT; bf16_t* Ktf = Ktb_; bf16_t* Ktb = Ktb_ + (size_t)512 * SEQ;
        EPI_ROWS { const int pos = pm * 256 + EPI_ROW, prow = pos >> 6, pcol = pos & 63, jl = pos & (LS - 1);
            const float zf = __expf(lgf * (float)(LS - 1 - jl)), zb = __expf(lgb * (float)jl);
            EPI_COLS { const int d0 = EPI_COL0, i0 = d0 >> 1, p = i0 < 64 ? prow : pcol, f0 = i0 & 63;
                const f32x4 t0 = *(const f32x4*)(rope + (size_t)(p * 64 + f0) * 2), t1 = *(const f32x4*)(rope + (size_t)(p * 64 + f0) * 2 + 4);
                f32x4 a = acc[ai][bj][m][0], b = acc[ai][bj][m][1];
                if (!isk) { a *= 0.0625f; b *= 0.0625f; }
                const f32x4 ra = {a[0] * t0[0] - a[1] * t0[1], a[0] * t0[1] + a[1] * t0[0], a[2] * t0[2] - a[3] * t0[3], a[2] * t0[3] + a[3] * t0[2]};
                const f32x4 rb = {b[0] * t1[0] - b[1] * t1[1], b[0] * t1[1] + b[1] * t1[0], b[2] * t1[2] - b[3] * t1[3], b[2] * t1[3] + b[3] * t1[2]};
                if (!isk) *(u32x4*)(Qb + (size_t)pos * 512 + hl * 256 + d0) = pack8(ra, rb);
                else { *(u32x4*)(Knb + (size_t)pos * 512 + hl * 256 + d0) = pack8(ra, rb);
#pragma unroll
                    for (int e = 0; e < 8; ++e) { const float v = e < 4 ? ra[e & 3] : rb[e & 3]; const size_t o = (size_t)(hl * 256 + d0 + e) * SEQ + pos;
                        Ktf[o] = f2bf(v * zf); Ktb[o] = f2bf(v * zb); } } }  asm volatile("" ::: "memory"); }
    }
};
struct EpiVT {
    static constexpr int NHOOK = 0; int h0, h1; Base F;
    __device__ __forceinline__ void hook(acc_t&, const Unit&, int, int, int, int, int) const {}
    __device__ __forceinline__ void operator()(const acc_t& acc, const Unit& u, int wr, int wc, int fr, int fq) const {
        const int hl = u.i0 >> 1, vt = u.i0 & 1, pn = u.i1;
        EPI_ROWS { const int v = vt * 256 + EPI_ROW;
            EPI_COLS { const int pos = pn * 256 + EPI_COL0, seg = pos >> 9, jl = pos & (LS - 1);
                *(u32x4*)(B4 + ((size_t)((hl * NSEG + seg) * 512 + v)) * 1024 + 512 + jl) = pack8(acc[ai][bj][m][0], acc[ai][bj][m][1]); }  asm volatile("" ::: "memory"); }
    }
};
struct EpiKc {
    static constexpr int NHOOK = 0; int h0, h1; Base F;
    __device__ __forceinline__ void hook(acc_t&, const Unit&, int, int, int, int, int) const {}
    __device__ __forceinline__ void operator()(const acc_t& acc, const Unit& u, int wr, int wc, int fr, int fq) const {
        const int h = u.i1; const float lgf = lgp[h], lgb = lgp[4 + h]; bf16_t* Kcf = KcT; bf16_t* Kcb = KcT + (size_t)1024 * CTX;
        EPI_ROWS { const int j = EPI_ROW; const float zf = __expf(lgf * (float)(CTX - 1 - j)), zb = __expf(lgb * (float)j);
            EPI_COLS { const int d0 = EPI_COL0;
#pragma unroll
                for (int e = 0; e < 8; ++e) { const float v = acc[ai][bj][m][e >> 2][e & 3]; const size_t o = (size_t)(h * 256 + d0 + e) * CTX + j;
                    Kcf[o] = f2bf(v * zf); Kcb[o] = f2bf(v * zb); } }  asm volatile("" ::: "memory"); }
    }
};
struct EpiVc {
    static constexpr int NHOOK = 0; int h0, h1; Base F;
    __device__ __forceinline__ void hook(acc_t&, const Unit&, int, int, int, int, int) const {}
    __device__ __forceinline__ void operator()(const acc_t& acc, const Unit& u, int wr, int wc, int fr, int fq) const {
        const int h = u.i0 >> 1, vt = u.i0 & 1;
        EPI_ROWS { const int v = vt * 256 + EPI_ROW;
            EPI_COLS { *(u32x4*)(VcT + (size_t)(h * 512 + v) * CTX + EPI_COL0) = pack8(acc[ai][bj][m][0], acc[ai][bj][m][1]); }  asm volatile("" ::: "memory"); }
    }
};
struct EpiS0 {
    static constexpr int NHOOK = 0; int h0, h1; Base F;
    __device__ __forceinline__ void hook(acc_t&, const Unit&, int, int, int, int, int) const {}
    __device__ __forceinline__ void operator()(const acc_t& acc, const Unit& u, int wr, int wc, int fr, int fq) const {
        EPI_ROWS { float* rowp = S0 + ((size_t)((u.i0 * 2 + u.i1) * 512 + u.i3 * 256 + EPI_ROW)) * 256;
            EPI_COLS { *(f32x4*)(rowp + EPI_COL0) = acc[ai][bj][m][0]; *(f32x4*)(rowp + EPI_COL0 + 4) = acc[ai][bj][m][1]; }  asm volatile("" ::: "memory"); }
    }
};
struct EpiU {
    static constexpr int NHOOK = 0; int h0, h1; Base F;
    __device__ __forceinline__ void hook(acc_t&, const Unit&, int, int, int, int, int) const {}
    __device__ __forceinline__ void operator()(const acc_t& acc, const Unit& u, int wr, int wc, int fr, int fq) const {
        EPI_ROWS { bf16_t* rowp = B4 + ((size_t)((u.i0 * NSEG + u.i2) * 512 + u.i3 * 256 + EPI_ROW)) * 1024 + u.i1 * 256;
            EPI_COLS { *(u32x4*)(rowp + EPI_COL0) = pack8(acc[ai][bj][m][0], acc[ai][bj][m][1]); }  asm volatile("" ::: "memory"); }
    }
};
struct EpiP {
    static constexpr int NHOOK = 0; int h0, h1; Base F; int pair;
    __device__ __forceinline__ void hook(acc_t&, const Unit&, int, int, int, int, int) const {}
    __device__ __forceinline__ void operator()(const acc_t& acc, const Unit& u, int wr, int wc, int fr, int fq) const {
        const int hl = u.i0, seg = u.i1, it = u.i2, jt = u.i3, h = 2 * pair + hl; const float l2f = lgp[h] * 1.44269504f, l2b = lgp[4 + h] * 1.44269504f;
        EPI_ROWS { const int il = it * 256 + EPI_ROW; bf16_t* rowp = Pb + (size_t)(seg * LS + il) * 1024 + hl * 512 + jt * 256;
            EPI_COLS { const int j0 = jt * 256 + EPI_COL0; f32x4 v[2];
#pragma unroll
                for (int e = 0; e < 8; ++e) { const int dl = il - (j0 + e); const float w = dl > 0 ? __builtin_amdgcn_exp2f((float)dl * l2f) : (dl < 0 ? __builtin_amdgcn_exp2f((float)(-dl) * l2b) : 2.0f);
                    v[e >> 2][e & 3] = acc[ai][bj][m][e >> 2][e & 3] * w; }
                *(u32x4*)(rowp + EPI_COL0) = pack8(v[0], v[1]); }  asm volatile("" ::: "memory"); }
    }
};
struct EpiO {
    static constexpr int NHOOK = 2; int h0, h1; Base F; int pair;
    __device__ __forceinline__ void hook(acc_t& acc, const Unit& u, int k, int wr, int wc, int fr, int fq) const {
        const int h = 2 * pair + u.i0; const float lgf = lgp[h], lgb = lgp[4 + h];
        EPI_ROWS { const int il = u.i2 * 256 + EPI_ROW; const float eb = lgb * (float)(LS - il);
            const float f = k == 0 ? __expf(lgf * (float)(il + 1) - eb) : __expf(eb);
#pragma unroll
            for (int bj = 0; bj < 2; ++bj) { acc[ai][bj][m][0] *= f; acc[ai][bj][m][1] *= f; }  asm volatile("" ::: "memory"); }
    }
    __device__ __forceinline__ void operator()(const acc_t& acc, const Unit& u, int wr, int wc, int fr, int fq) const {
        const int h = 2 * pair + u.i0;
        EPI_ROWS { bf16_t* rowp = Ob + (size_t)(u.i1 * LS + u.i2 * 256 + EPI_ROW) * 2048 + h * 512 + u.i3 * 256;
            EPI_COLS { *(u32x4*)(rowp + EPI_COL0) = pack8(acc[ai][bj][m][0], acc[ai][bj][m][1]); }  asm volatile("" ::: "memory"); }
    }
};
struct EpiG {
    static constexpr int NHOOK = 0; int h0, h1; Base F; const float* gnw;
    __device__ __forceinline__ void hook(acc_t&, const Unit&, int, int, int, int, int) const {}
    __device__ __forceinline__ void operator()(const acc_t& acc, const Unit& u, int wr, int wc, int fr, int fq) const {
        const int pm = u.i0, pn = u.i1, h = pn >> 1;
        EPI_ROWS { const int pos = pm * 256 + EPI_ROW; const f32x2 st = *(const f32x2*)(stats + (size_t)(pos * 4 + h) * 2);
            EPI_COLS { const int col = pn * 256 + EPI_COL0; bf16_t* p = Ob + (size_t)pos * 2048 + col; f32x4 o0, o1; unpack8(*(const u32x4*)p, o0, o1);
                const f32x4 w0 = *(const f32x4*)(gnw + col), w1 = *(const f32x4*)(gnw + col + 4); const f32x4 g0 = acc[ai][bj][m][0], g1 = acc[ai][bj][m][1]; f32x4 r0, r1;
#pragma unroll
                for (int e = 0; e < 4; ++e) { r0[e] = DBG_NORET ? 0.f : fsilu(g0[e]) * ((o0[e] - st.x) * st.y) * w0[e]; r1[e] = DBG_NORET ? 0.f : fsilu(g1[e]) * ((o1[e] - st.x) * st.y) * w1[e]; }
                *(u32x4*)p = pack8(r0, r1); }  asm volatile("" ::: "memory"); }
    }
};
struct EpiF {
    static constexpr int NHOOK = 0; int h0, h1; Base F;
    __device__ __forceinline__ void hook(acc_t&, const Unit&, int, int, int, int, int) const {}
    __device__ __forceinline__ void operator()(const acc_t& acc, const Unit& u, int wr, int wc, int fr, int fq) const {
        EPI_ROWS { const int mrow = u.i0 * 256 + EPI_ROW, ri = mrow >> 10, ch = mrow & 1023;
            EPI_COLS { const int c0 = EPI_COL0, l2 = 2 * u.i1 + (c0 >> 7), l1 = c0 & 127;
                *(u32x4*)(Wt + (size_t)(ch * 128 + l2) * 256 + ri * 128 + l1) = pack8(acc[ai][bj][m][0], acc[ai][bj][m][1]); }  asm volatile("" ::: "memory"); }
    }
};
struct EpiF1 {
    static constexpr int NHOOK = 0; int h0, h1; Base F;
    __device__ __forceinline__ void hook(acc_t&, const Unit&, int, int, int, int, int) const {}
    __device__ __forceinline__ void operator()(const acc_t& acc, const Unit& u, int wr, int wc, int fr, int fq) const {
        EPI_ROWS { const int r = EPI_ROW, k1 = r >> 1, ri = r & 1; const float sg = ri ? -1.0f : 1.0f;
            EPI_COLS { const int n = u.i1 * 256 + EPI_COL0, ch = n >> 7, l2 = n & 127; const float* tp = twT + (size_t)(k1 * 128 + l2) * 2; f32x4 v[2];
#pragma unroll
                for (int q = 0; q < 4; ++q) { const f32x4 t = *(const f32x4*)(tp + 4 * q);
#pragma unroll
                    for (int z = 0; z < 2; ++z) { const int e = 2 * q + z; const float mine = acc[ai][bj][m][e >> 2][e & 3], other = __shfl_xor(mine, 1);
                        v[e >> 2][e & 3] = mine * t[2 * z] + sg * other * t[2 * z + 1]; } }
                *(u32x4*)(Bt + (size_t)(k1 * 1024 + ch) * 256 + ri * 128 + l2) = pack8(v[0], v[1]); }  asm volatile("" ::: "memory"); }
    }
};
struct EpiF2 {
    static constexpr int NHOOK = 0; int h0, h1; Base F;
    __device__ __forceinline__ void hook(acc_t&, const Unit&, int, int, int, int, int) const {}
    __device__ __forceinline__ void operator()(const acc_t& acc, const Unit& u, int wr, int wc, int fr, int fq) const {
        const int k1 = u.i0 >> 2;
        EPI_ROWS { const int ch = (u.i0 & 3) * 256 + EPI_ROW; const int k20 = 32 * wc + 8 * fq;
#pragma unroll
            for (int e = 0; e < 8; ++e) MIXb[(size_t)(k1 + 128 * (k20 + e)) * 2048 + ch] = f2bf(acc[ai][0][m][e >> 2][e & 3]);  asm volatile("" ::: "memory"); }
    }
};
struct EpiGate {
    static constexpr int NHOOK = 0; int h0, h1; Base F;
    __device__ __forceinline__ void hook(acc_t&, const Unit&, int, int, int, int, int) const {}
    __device__ __forceinline__ void operator()(const acc_t& acc, const Unit& u, int wr, int wc, int fr, int fq) const {
        bf16_t* dst = (u.i1 >> 2) ? GFb : GAb; const int cb = (u.i1 & 3) * 256;
        EPI_ROWS { bf16_t* rowp = dst + (size_t)(u.i0 * 256 + EPI_ROW) * DM + cb;
            EPI_COLS { f32x4 s0, s1;
#pragma unroll
                for (int e = 0; e < 4; ++e) { s0[e] = fsigmoid(acc[ai][bj][m][0][e]); s1[e] = fsigmoid(acc[ai][bj][m][1][e]); }
                *(u32x4*)(rowp + EPI_COL0) = pack8(s0, s1); }  asm volatile("" ::: "memory"); }
    }
};
struct EpiZ {
    static constexpr int NHOOK = 1; int h0, h1; Base F;
    __device__ __forceinline__ void hook(acc_t& acc, const Unit& u, int, int wr, int wc, int fr, int fq) const {
        EPI_ROWS { const size_t ro = (size_t)(u.i0 * 256 + EPI_ROW) * DM + u.i1 * 256;
            EPI_COLS { f32x4 a0, a1, f0, f1; unpack8(*(const u32x4*)(GAb + ro + EPI_COL0), a0, a1); unpack8(*(const u32x4*)(GFb + ro + EPI_COL0), f0, f1);
#pragma unroll
                for (int e = 0; e < 4; ++e) { acc[ai][bj][m][0][e] *= DBG_NOFOUR ? 0.f : f0[e] * __builtin_amdgcn_rcpf(fmaxf(a0[e], 1e-30f)); acc[ai][bj][m][1][e] *= DBG_NOFOUR ? 0.f : f1[e] * __builtin_amdgcn_rcpf(fmaxf(a1[e], 1e-30f)); } }  asm volatile("" ::: "memory"); }
    }
    __device__ __forceinline__ void operator()(const acc_t& acc, const Unit& u, int wr, int wc, int fr, int fq) const {
        EPI_ROWS { const size_t ro = (size_t)(u.i0 * 256 + EPI_ROW) * DM + u.i1 * 256;
            EPI_COLS { f32x4 a0, a1; unpack8(*(const u32x4*)(GAb + ro + EPI_COL0), a0, a1); f32x4 v0, v1;
#pragma unroll
                for (int e = 0; e < 4; ++e) { v0[e] = acc[ai][bj][m][0][e] * fmaxf(a0[e], 1e-30f); v1[e] = acc[ai][bj][m][1][e] * fmaxf(a1[e], 1e-30f); }
                *(u32x4*)(Zb + ro + EPI_COL0) = pack8(v0, v1); }  asm volatile("" ::: "memory"); }
    }
};

struct JobFold {
    Base F;
    __device__ __forceinline__ void fill(int L, Unit& u) const { const int pn = L & 3, pm = (L >> 2) & 1, g = L >> 3;
        u.a0 = (const char*)(T256 + (size_t)pm * 256 * 256); u.a1 = u.a0; u.b = (const char*)(Wn + (size_t)pn * 256 * DM + g * 256);
        u.d = (char*)(Win + (size_t)(WR_F + pm * 1024 + g * 256) * DM + pn * 256); u.i0 = pm; u.i1 = pn; u.i2 = g; u.i3 = 0; }
};
struct JobRowCol {
    Base F; int sel, nM, nN; size_t aoff0, boff0, astep, bstep;
    __device__ __forceinline__ void fill(int L, Unit& u) const { int pm, pn; pg::tile_pm_pn(L, nM, nN, pm, pn);
        const bf16_t* A = sel == 0 ? Ax : (sel == 1 ? Win : Zb); const bf16_t* B = sel == 0 ? Win : (sel == 1 ? Ax : WoT);
        u.a0 = (const char*)(A + aoff0 + (size_t)pm * astep); u.a1 = u.a0; u.b = (const char*)(B + boff0 + (size_t)pn * bstep); u.d = nullptr; u.i0 = pm; u.i1 = pn; u.i2 = 0; u.i3 = 0; }
};
struct JobKc {
    Base F;
    __device__ __forceinline__ void fill(int L, Unit& u) const { const int h = L; u.a0 = (const char*)Ac; u.a1 = u.a0;
        u.b = (const char*)(Win + (size_t)((h >> 1) * 2048 + 512 + (h & 1) * 256) * DM); u.d = nullptr; u.i0 = 0; u.i1 = h; u.i2 = 0; u.i3 = 0; }
};
struct JobVc {
    Base F;
    __device__ __forceinline__ void fill(int L, Unit& u) const { const int t = L, h = t >> 1; u.a0 = (const char*)(Win + (size_t)((h >> 1) * 2048 + 1024 + (h & 1) * 512 + (t & 1) * 256) * DM); u.a1 = u.a0;
        u.b = (const char*)Ac; u.d = nullptr; u.i0 = t; u.i1 = 0; u.i2 = 0; u.i3 = 0; }
};
struct JobS0 {
    Base F;
    __device__ __forceinline__ void fill(int L, Unit& u) const { const int h = L >> 2, dir = (L >> 1) & 1, vt = L & 1;
        u.a0 = (const char*)(VcT + (size_t)(h * 512 + vt * 256) * CTX); u.a1 = u.a0; u.b = (const char*)(KcT + (size_t)dir * 1024 * CTX + (size_t)(h * 256) * CTX);
        u.d = nullptr; u.i0 = h; u.i1 = dir; u.i2 = 0; u.i3 = vt; }
};
struct JobR1 {
    Base F;
    __device__ __forceinline__ void fill(int L, Unit& u) const { const int w = pg::xcd_contig(L, 256), vt = w & 1, dir = (w >> 1) & 1, seg = (w >> 2) & 31, hl = w >> 7;
        u.a0 = (const char*)(B4 + ((size_t)((hl * NSEG + seg) * 512 + vt * 256)) * 1024 + 512); u.a1 = u.a0;
        u.b = (const char*)(Ktb_ + (size_t)dir * 512 * SEQ + (size_t)(hl * 256) * SEQ + seg * LS); u.d = nullptr; u.i0 = hl; u.i1 = dir; u.i2 = seg; u.i3 = vt; }
};
struct JobR3 {
    Base F;
    __device__ __forceinline__ void fill(int L, Unit& u) const { const int w = pg::xcd_contig(L, 256), jt = w & 1, it = (w >> 1) & 1, seg = (w >> 2) & 31, hl = w >> 7;
        u.a0 = (const char*)(Qb + (size_t)(seg * LS + it * 256) * 512 + hl * 256); u.a1 = u.a0; u.b = (const char*)(Knb + (size_t)(seg * LS + jt * 256) * 512 + hl * 256);
        u.d = nullptr; u.i0 = hl; u.i1 = seg; u.i2 = it; u.i3 = jt; }
};
struct JobR4 {
    Base F;
    __device__ __forceinline__ void fill(int L, Unit& u) const { const int w = pg::xcd_contig(L, 256), vt = w & 1, it = (w >> 1) & 1, seg = (w >> 2) & 31, hl = w >> 7;
        u.a0 = (const char*)(Qb + (size_t)(seg * LS + it * 256) * 512 + hl * 256); u.a1 = (const char*)(Pb + (size_t)(seg * LS + it * 256) * 1024 + hl * 512);
        u.b = (const char*)(B4 + ((size_t)((hl * NSEG + seg) * 512 + vt * 256)) * 1024); u.d = nullptr; u.i0 = hl; u.i1 = seg; u.i2 = it; u.i3 = vt; }
};
struct JobF1 {
    Base F;
    __device__ __forceinline__ void fill(int L, Unit& u) const { u.a0 = (const char*)FmT; u.a1 = u.a0; u.b = (const char*)(Wt + (size_t)L * 256 * 256); u.d = nullptr; u.i0 = 0; u.i1 = L; u.i2 = 0; u.i3 = 0; }
};
struct JobF2 {
    Base F;
    __device__ __forceinline__ void fill(int L, Unit& u) const { u.a0 = (const char*)(Bt + (size_t)L * 256 * 256); u.a1 = u.a0; u.b = (const char*)GmT; u.d = nullptr; u.i0 = L; u.i1 = 0; u.i2 = 0; u.i3 = 0; }
};
struct JobZ {
    Base F;
    __device__ __forceinline__ void fill(int L, Unit& u) const { int pm, pn; pg::tile_pm_pn(L, 64, 4, pm, pn);
        u.a0 = (const char*)(MIXb + (size_t)pm * 256 * 2048); u.a1 = (const char*)(Ob + (size_t)pm * 256 * 2048); u.b = (const char*)(Bz + (size_t)pn * 256 * 3072); u.d = nullptr; u.i0 = pm; u.i1 = pn; u.i2 = 0; u.i3 = 0; }
};

#define XB_TMO      128
#define XB_XCNT(j)  (256  + 64 * (j))
#define XB_XSUB(j)  (1280 + 64 * (j))
#define XB_XGEN(j)  (2304 + 64 * (j))
#define XB_TOP      3328
#define XB_TOPGEN   3392
#define XCD_BAR_WORDS 3456
#define XB_SPIN_CAP (1u << 22)
__device__ __forceinline__ unsigned xb_ld(unsigned* p)              { return __hip_atomic_load(p, __ATOMIC_RELAXED, __HIP_MEMORY_SCOPE_AGENT); }
__device__ __forceinline__ unsigned xb_add(unsigned* p, unsigned v) { return __hip_atomic_fetch_add(p, v, __ATOMIC_RELAXED, __HIP_MEMORY_SCOPE_AGENT); }
__device__ __forceinline__ unsigned xb_xcc_id() { return (unsigned)__builtin_amdgcn_s_getreg((3 << 11) | 20) & 0xFu; }
#define XB_SPIN(cond, bar) do { unsigned _sp = 0; while (cond) { __builtin_amdgcn_s_sleep(1); \
    if ((++_sp & 255u) == 0u) { if (xb_ld(&(bar)[XB_TMO])) break; if (_sp > XB_SPIN_CAP) { atomicAdd(&(bar)[XB_TMO], 1u); break; } } } } while (0)
struct XcdBarrier { unsigned* bar; unsigned x; volatile LAS unsigned* st; };
__device__ __forceinline__ XcdBarrier xcd_barrier_post(unsigned* bar, volatile LAS unsigned* st) {
    XcdBarrier b; b.bar = bar; b.x = xb_xcc_id(); b.st = st;
    if (threadIdx.x == 0) (void)xb_add(&bar[XB_XCNT(b.x)], 1u);
    return b;
}
__device__ __forceinline__ void xcd_barrier_complete(unsigned* bar, unsigned x, unsigned& nloc, unsigned& nx) {
    const unsigned G = gridDim.x * gridDim.y * gridDim.z;
    unsigned sum, cnt, mine, sp = 0u;
    for (;;) {
        sum = 0u; cnt = 0u; mine = 0u;
#pragma unroll
        for (unsigned j = 0; j < 16; ++j) { const unsigned c = xb_ld(&bar[XB_XCNT(j)]); sum += c; cnt += (c > 0u) ? 1u : 0u; mine = (j == x) ? c : mine; }
        if (sum == G) break;
        __builtin_amdgcn_s_sleep(1);
        if ((++sp & 255u) == 0u) { if (xb_ld(&bar[XB_TMO])) break; if (sp > XB_SPIN_CAP) { atomicAdd(&bar[XB_TMO], 1u); break; } }
    }
    nloc = mine > 0u ? mine : 1u; nx = cnt > 0u ? cnt : 1u;
}
__device__ __attribute__((noinline)) void xcd_barrier(unsigned* bar_, unsigned bx_, volatile LAS unsigned* st_) {
    XcdBarrier b; b.bar = bar_; b.x = bx_; b.st = st_;
    asm volatile("s_waitcnt vmcnt(0)" ::: "memory");
    __syncthreads();
    if (threadIdx.x == 0) {
        unsigned* bar = b.bar;
        __builtin_amdgcn_s_waitcnt(0);
        unsigned nloc = b.st[0], nx = b.st[1];
        if (nloc == 0u) { xcd_barrier_complete(bar, b.x, nloc, nx); b.st[0] = nloc; b.st[1] = nx; }
        const unsigned old = xb_add(&bar[XB_XSUB(b.x)], 1u);
        const unsigned gen = old / nloc;
        if (old + 1u == (gen + 1u) * nloc) {
            __builtin_amdgcn_fence(__ATOMIC_RELEASE, "agent");
            asm volatile("s_waitcnt vmcnt(0)" ::: "memory");
            const unsigned og = xb_add(&bar[XB_TOP], 1u);
            const unsigned tg = og / nx;
            if (og + 1u == (tg + 1u) * nx) xb_add(&bar[XB_TOPGEN], 1u);
            else XB_SPIN(xb_ld(&bar[XB_TOPGEN]) == tg, bar);
            __builtin_amdgcn_fence(__ATOMIC_ACQUIRE, "agent");
            xb_add(&bar[XB_XGEN(b.x)], 1u);
            asm volatile("s_waitcnt vmcnt(0)" ::: "memory");
        } else {
            XB_SPIN(xb_ld(&bar[XB_XGEN(b.x)]) == gen, bar);
            __builtin_amdgcn_fence(__ATOMIC_ACQUIRE, "agent");
            asm volatile("s_waitcnt vmcnt(0)" ::: "memory");
        }
    }
    __syncthreads();
}

constexpr int NWAVES = 8, NTHREADS = 512;
constexpr int RING_BYTES = 131072, MISC_OFF = RING_BYTES + 320, LDS_BYTES = 147456;
constexpr int CW_BAR = 4096;

struct Args { const float* in[21]; float* out; unsigned char* ws; int ph_lo, ph_hi; };

struct Ctx {
    LAS unsigned char* lds; int tid, lane, wave, G, vcu;
    unsigned char* ws; unsigned char* dout;
};
#define F_WS (F.ws)
#define F_DOUT (F.dout)

__device__ __forceinline__ void gemv_item(const Ctx& F, int item, const float* W, const float* b, const float* c, const float* cc) {
    LAS float* scr = (LAS float*)F.lds;
    const int cg = F.tid & 7, rg = F.tid >> 3, n0 = item * 32 + cg * 4;
    f32x4 ax = {0.f, 0.f, 0.f, 0.f}, ac = {0.f, 0.f, 0.f, 0.f};
#pragma unroll 4
    for (int k = rg; k < DM; k += 64) { const f32x4 w = *(const f32x4*)(W + (size_t)k * 9216 + n0); const float sx = c[k], sc = cc[k];
        ax += w * (sx / (1.f + expf(-sx))); ac += w * (sc / (1.f + expf(-sc))); }
    __syncthreads();
#pragma unroll
    for (int e = 0; e < 4; ++e) { scr[(rg * 8 + cg) * 8 + e] = ax[e]; scr[(rg * 8 + cg) * 8 + 4 + e] = ac[e]; }
    __syncthreads();
    if (F.tid < 64) { const int which = F.tid >> 5, col = F.tid & 31, g = col >> 2, e = col & 3; float s = 0.f;
        for (int r = 0; r < 64; ++r) s += scr[(r * 8 + g) * 8 + which * 4 + e];
        (which ? modc : modx)[item * 32 + col] = s + b[item * 32 + col]; }
    __syncthreads();
}
struct TrDesc { const float* W; int K, N; bf16_t* dst; int ld, coloff, kind; };
__device__ __forceinline__ int tr_dest_row(int kind, int n) {
    switch (kind) {
    case 0: { const int isb = n >= DFF, j = isb ? n - DFF : n; return 8 * (j >> 2) + 4 * isb + (j & 3); }
    case 2: {
        if (n < 1024) { const int h = n >> 8, d = n & 255; return (h >> 1) * 2048 + (h & 1) * 256 + d; }
        if (n < 2048) { const int h = (n - 1024) >> 8, d = n & 255; return (h >> 1) * 2048 + 512 + (h & 1) * 256 + d; }
        if (n < 4096) { const int h = (n - 2048) >> 9, v = (n - 2048) & 511; return (h >> 1) * 2048 + 1024 + (h & 1) * 512 + v; }
        if (n < 6144) return WR_G + (n - 4096);
        if (n < 7168) return -1;
        if (n < 8192) return WR_GA + (n - 7168);
        return WR_GF + (n - 8192); }
    default: return n; }
}
__device__ __forceinline__ void tr_item(const TrDesc& t, LAS float* scr, int item, int lane) {
    const int nblk = t.N / 32, kb = item / nblk, nb = item % nblk, k0 = 64 * kb, n0 = 32 * nb;
    if (t.kind == 2 && n0 >= 6144 && n0 < 7168) return;
#pragma unroll 8
    for (int i = 0; i < 32; ++i) { const int kk = 2 * i + (lane >> 5); scr[kk * 33 + (lane & 31)] = t.W[(size_t)(k0 + kk) * t.N + n0 + (lane & 31)]; }
    asm volatile("s_waitcnt lgkmcnt(0)" ::: "memory");
    const int c = lane & 7;
#pragma unroll
    for (int j = 0; j < 4; ++j) { const int n = (lane >> 3) + 8 * j; const LAS float* s = scr + (8 * c) * 33 + n;
        u32x4 o; o.x = cvt_pk_bf16(s[0 * 33], s[1 * 33]); o.y = cvt_pk_bf16(s[2 * 33], s[3 * 33]); o.z = cvt_pk_bf16(s[4 * 33], s[5 * 33]); o.w = cvt_pk_bf16(s[6 * 33], s[7 * 33]);
        const int dr = tr_dest_row(t.kind, n0 + n);
        *(u32x4*)(t.dst + (size_t)dr * t.ld + t.coloff + k0 + 8 * c) = o; }
    asm volatile("s_waitcnt lgkmcnt(0)" ::: "memory");
}
__device__ __forceinline__ void tr_all(const Ctx& F, const TrDesc& t) {
    LAS float* scr = (LAS float*)(F.lds + F.wave * 16384);
    const int gw = F.vcu * NWAVES + F.wave, NGW = F.G * NWAVES, nitems = (t.K / 64) * (t.N / 32);
    for (int it = gw; it < nitems; it += NGW) tr_item(t, scr, it, F.lane);
}
__device__ __forceinline__ void norm_rows(const Ctx& F, const float* xin, const float* cin, const float* nw, int modoff, const bf16_t* dx, const bf16_t* dc, bool has_delta, int nrows) {
    const int gw = F.vcu * NWAVES + F.wave, NGW = F.G * NWAVES;
    for (int r = gw; r < nrows; r += NGW) {
        const bool isx = r < SEQ; const int rr = isx ? r : r - SEQ;
        const float* xr = (isx ? xin : cin) + (size_t)rr * DM; const bf16_t* dr = (isx ? dx : dc) + (size_t)rr * DM;
        const float* md = (isx ? modx : modc) + modoff; bf16_t* orow = (isx ? Ax : Ac) + (size_t)rr * DM;
        f32x4 v[4]; float ss = 0.f;
#pragma unroll
        for (int j = 0; j < 4; ++j) { v[j] = *(const f32x4*)(xr + 256 * j + 4 * F.lane);
            if (has_delta) { const u32x2 d = *(const u32x2*)(dr + 256 * j + 4 * F.lane); v[j] += (f32x4){bflo(d.x), bfhi(d.x), bflo(d.y), bfhi(d.y)}; }
            ss += (v[j][0] * v[j][0] + v[j][1] * v[j][1]) + (v[j][2] * v[j][2] + v[j][3] * v[j][3]); }
        const float rinv = 1.0f / sqrtf(wave_sum(ss) * (1.f / DM) + EPS);
#pragma unroll
        for (int j = 0; j < 4; ++j) { const int c = 256 * j + 4 * F.lane; const f32x4 w = *(const f32x4*)(nw + c), sh = *(const f32x4*)(md + c), sc = *(const f32x4*)(md + 1024 + c);
            const f32x4 y = (v[j] * rinv) * w * (sc + 1.0f) + sh; u32x2 o; o.x = cvt_pk_bf16(y[0], y[1]); o.y = cvt_pk_bf16(y[2], y[3]);
            *(u32x2*)(orow + c) = o; }
    }
}
__device__ __forceinline__ void final_norm(const Ctx& F, const float* xin, const float* nw, const bf16_t* dx) {
    float* out = (float*)F_DOUT;
    const int gw = F.vcu * NWAVES + F.wave, NGW = F.G * NWAVES;
    for (int r = gw; r < SEQ; r += NGW) {
        const float* xr = xin + (size_t)r * DM; const bf16_t* dr = dx + (size_t)r * DM;
        f32x4 v[4]; float ss = 0.f;
#pragma unroll
        for (int j = 0; j < 4; ++j) { v[j] = *(const f32x4*)(xr + 256 * j + 4 * F.lane);
            const u32x2 d = *(const u32x2*)(dr + 256 * j + 4 * F.lane); v[j] += (f32x4){bflo(d.x), bfhi(d.x), bflo(d.y), bfhi(d.y)};
            ss += (v[j][0] * v[j][0] + v[j][1] * v[j][1]) + (v[j][2] * v[j][2] + v[j][3] * v[j][3]); }
        const float rinv = 1.0f / sqrtf(wave_sum(ss) * (1.f / DM) + EPS);
#pragma unroll
        for (int j = 0; j < 4; ++j) { const int c = 256 * j + 4 * F.lane; *(f32x4*)(out + (size_t)r * DM + c) = (v[j] * rinv) * *(const f32x4*)(nw + c); }
    }
}
__device__ __forceinline__ void copy_delta(const Ctx& F, const bf16_t* src, bf16_t* dst) {
    const size_t n16 = (size_t)SEQ * DM * 2 / 16; const u32x4* s = (const u32x4*)src; u32x4* d = (u32x4*)dst;
    for (size_t i = (size_t)F.vcu * NTHREADS + F.tid; i < n16; i += (size_t)F.G * NTHREADS) d[i] = s[i];
}


__device__ __forceinline__ float block_sum(LAS float* scr, float v, int tid) {
    v = wave_sum(v); __syncthreads(); if ((tid & 63) == 0) scr[tid >> 6] = v; __syncthreads();
    float s = 0.f; for (int i = 0; i < NWAVES; ++i) s += scr[i]; __syncthreads(); return s;
}
__device__ __forceinline__ void dbg_report(unsigned* word, float ref, float got, float floor_) {
    const float e = fabsf(got - ref) / fmaxf(fabsf(ref), floor_); atomicMax(word, __builtin_bit_cast(unsigned, e)); if (e > 0.05f) atomicAdd(word + 64, 1u);
}
__device__ __forceinline__ float bf2f(bf16_t b) { return __builtin_bit_cast(float, (unsigned)b << 16); }

__global__ void __launch_bounds__(NTHREADS, 2) fwd_kernel(Args args) {
    extern __shared__ __attribute__((aligned(16))) unsigned char lds_raw[];
    Ctx F;
    F.lds = (LAS unsigned char*)lds_raw;
    F.tid = threadIdx.x; F.lane = F.tid & 63; F.wave = __builtin_amdgcn_readfirstlane(F.tid >> 6);
    F.G = gridDim.x; { const int bx = blockIdx.x; F.vcu = (F.G % 8 == 0) ? (bx % 8) * (F.G / 8) + bx / 8 : bx; }
    F.ws = args.ws; F.dout = (unsigned char*)args.out;
    volatile LAS unsigned* MISC = (volatile LAS unsigned*)(F.lds + MISC_OFF);
    for (int u = F.tid; u < (LDS_BYTES - RING_BYTES) / 4; u += NTHREADS) ((LAS unsigned*)(F.lds + RING_BYTES))[u] = 0u;
    __syncthreads();
    unsigned* ctl = (unsigned*)(F_WS + WS_CTL);
    XcdBarrier bar = xcd_barrier_post(ctl + CW_BAR, MISC + 8);
    const int lo = args.ph_lo, hi = args.ph_hi;
    int phase = 0;
#define PHASE_BEGIN if (phase >= lo && phase < hi) { asm volatile("; MARK %0" :: "i"(__LINE__)); { unsigned char* _w = args.ws; unsigned char* _o = (unsigned char*)args.out; int _t = threadIdx.x; asm volatile("" : "+s"(_w), "+s"(_o), "+v"(_t)); F.ws = _w; F.dout = _o; F.tid = _t; F.lane = _t & 63; }
#define PHASE_END   if (phase + 1 < hi) xcd_barrier((unsigned*)(F.ws + WS_CTL) + CW_BAR, bar.x, MISC + 8); } ++phase;
    const int bx = (int)blockIdx.x;

#define gtid ((size_t)F.vcu * NTHREADS + F.tid)
#define gthreads ((size_t)F.G * NTHREADS)
#define FB (Base{F.ws, F.dout})
    const Geo gK1024{DM, DM, DM, 128u * DM * 2u, 128u * DM * 2u, 128u * DM * 2u, DM / 64, 1 << 20, 1 << 20};
    const Geo gFfn2{DFF, DFF, DFF, 128u * DFF * 2u, 128u * DFF * 2u, 128u * DFF * 2u, DFF / 64, 1 << 20, 1 << 20};

    PHASE_BEGIN
        for (int it = F.vcu; it < 288; it += F.G) gemv_item(F, it, args.in[4], args.in[5], args.in[1], args.in[3]);
        __syncthreads();
        if (gtid == 0) { ((unsigned*)(F.ws + WS_CTL))[32768 + 192] = 255u; ((unsigned*)(F.ws + WS_CTL))[32768 + 193] = 255u; }
        if (gtid < 8) { const float x = (gtid < 4 ? args.in[11] : args.in[12])[gtid & 3]; modx[2 * 9216 + gtid] = -log1pf(expf(-x)); }
        for (size_t i = gtid; i < 256 * 64; i += gthreads) { const int p = (int)(i >> 6), f = (int)(i & 63); const float inv = powf(10000.0f, -(float)f / 64.0f), ang = (float)p * inv;
            ropeT[2 * i] = cosf(ang); ropeT[2 * i + 1] = sinf(ang); }
        for (size_t i = gtid; i < 128 * 128; i += gthreads) { const int k1 = (int)(i >> 7), l2 = (int)(i & 127); const float a = (float)((k1 * l2) & 16383) * (1.0f / 8192.0f);
            twT[2 * i] = cospif(a); twT[2 * i + 1] = sinpif(a); }
        for (size_t i = gtid; i < 256 * 256; i += gthreads) { const int r = (int)(i >> 8), cc = (int)(i & 255), rin = cc >> 7, l = cc & 127;
            { const int k1 = r >> 1, ri = r & 1; const float a = (float)((k1 * l) & 127) * (1.0f / 64.0f), c = cospif(a), s = sinpif(a);
              FmT[i] = f2bf(ri == 0 ? (rin == 0 ? c : s) : (rin == 0 ? -s : c)); }
            { const float a = (float)((r * l) & 127) * (1.0f / 64.0f), c = cospif(a), s = sinpif(a);
              GmT[i] = r < 128 ? f2bf((rin == 0 ? c : s) * (1.0f / 2048.0f)) : (bf16_t)0; } }
        for (size_t i = gtid; i < 512 * 256; i += gthreads) { const int r = (int)(i >> 8), c = (int)(i & 255), ri = r >> 8, cp = r & 255; const float a = (float)((c * cp) & 255) * (1.0f / 128.0f);
            T256[i] = f2bf(ri == 0 ? cospif(a) : -sinpif(a)); }
        for (size_t i = gtid; i < (size_t)DM * DM / 4; i += gthreads) { const int k = (int)(i >> 8), c4 = (int)(i & 255) * 4; const f32x4 w = *(const f32x4*)(args.in[10] + (size_t)k * 9216 + 6144 + c4);
            u32x2 o; o.x = cvt_pk_bf16(w[0], w[1]); o.y = cvt_pk_bf16(w[2], w[3]); *(u32x2*)(Wn + (size_t)k * DM + c4) = o; }
        { TrDesc t{args.in[7], DM, 2 * DFF, W13t, DM, 0, 0}; tr_all(F, t); }
        { TrDesc t{args.in[8], DFF, DM, W2t, DFF, 0, 1}; tr_all(F, t); }
        { TrDesc t{args.in[10], DM, 9216, Win, DM, 0, 2}; tr_all(F, t); }
        __syncthreads();
    PHASE_END
    PHASE_BEGIN
        norm_rows(F, args.in[0], args.in[2], args.in[6], 0, nullptr, nullptr, false, SEQ + CTX);
        { Geo g{256, 256, DM, 128u * 256 * 2u, 128u * 256 * 2u, 128u * DM * 2u, 4, 1 << 20, 1 << 20};
          pg::Sched<JobFold> S{{FB}, 32, F.G, bx}; EpiStore E{0, 0, DM};
          pg::gemm_phase<EpiStore, pg::Sched<JobFold>, 1>(F.lds, g, S, E); }
    PHASE_END
    if constexpr (DBG_PROBE == 11) {
    PHASE_BEGIN
        unsigned* dw = (unsigned*)(F.ws + WS_CTL) + 32768;
        for (size_t idx = gtid; idx < (size_t)DM * 9216; idx += gthreads) { const int k = (int)(idx / 9216), n = (int)(idx % 9216); const int dr = tr_dest_row(2, n);
            if (dr >= 0) { const float a = args.in[10][idx]; const float b = bf2f(Win[(size_t)dr * DM + k]); if (fabsf(a - b) > 0.01f * fabsf(a) + 1e-6f) { atomicAdd(dw + 64, 1u); atomicMin(dw + 192, (unsigned)(dr >> 8)); } } }
    PHASE_END
    }
    PHASE_BEGIN
        pg::Sched<JobFfn1> S{{FB, 65}, 65 * 22, F.G, bx};
        EpiSwiglu E{0, 0, FB};
        pg::gemm_phase<EpiSwiglu, pg::Sched<JobFfn1>, 1>(F.lds, gK1024, S, E);
    PHASE_END
    PHASE_BEGIN
        pg::Sched<JobFfn2> S{{FB, 65}, 65 * 4, F.G, bx};
        EpiResid E{0, 0, FB, 0};
        pg::gemm_phase<EpiResid, pg::Sched<JobFfn2>, 1>(F.lds, gFfn2, S, E);
    PHASE_END
    if constexpr (STOP_AFTER >= 3) {
    PHASE_BEGIN
        norm_rows(F, args.in[0], args.in[2], args.in[9], 3 * DM, Dx, Dc, true, SEQ + CTX);
        { TrDesc t{args.in[15], DM, DM, Bz, 3072, 0, 3}; tr_all(F, t); }
        { TrDesc t{args.in[14], 2048, DM, Bz, 3072, 1024, 4}; tr_all(F, t); }
        { TrDesc t{args.in[16], DM, DM, WoT, DM, 0, 5}; tr_all(F, t); }
        __syncthreads();
    PHASE_END
    for (int pair = 0; pair < 2; ++pair) {
        PHASE_BEGIN
            { pg::Sched<JobRowCol> S{{FB, 0, 64, 4, 0, (size_t)pair * 2048 * DM, (size_t)256 * DM, (size_t)256 * DM}, 256, F.G, bx};
              EpiQK E{0, 0, FB, pair};
              pg::gemm_phase<EpiQK, pg::Sched<JobRowCol>, 1>(F.lds, gK1024, S, E); }
            { pg::Sched<JobRowCol> S{{FB, 1, 4, 64, (size_t)(pair * 2048 + 1024) * DM, 0, (size_t)256 * DM, (size_t)256 * DM}, 256, F.G, bx};
              EpiVT E{0, 0, FB};
              pg::gemm_phase<EpiVT, pg::Sched<JobRowCol>, 1>(F.lds, gK1024, S, E); }
            if (pair == 0) {
                { pg::Sched<JobKc> S{{FB}, 4, F.G, bx}; EpiKc E{0, 0, FB};
                  pg::gemm_phase<EpiKc, pg::Sched<JobKc>, 1>(F.lds, gK1024, S, E); }
                { pg::Sched<JobVc> S{{FB}, 8, F.G, (bx + F.G - 8) % F.G}; EpiVc E{0, 0, FB};
                  pg::gemm_phase<EpiVc, pg::Sched<JobVc>, 1>(F.lds, gK1024, S, E); }
            }
        PHASE_END
        if constexpr (DBG_PROBE == 5) {
        PHASE_BEGIN
            LAS float* scr = (LAS float*)F.lds; unsigned* dw = (unsigned*)(F.ws + WS_CTL) + 32768;
            const int s = bx; const int i = (int)(((unsigned)s * 2654435761u) >> 18) & 16383, hl = s & 1, h = 2 * pair + hl, pp = (s * 29 + 3) & 127, v = (s * 37 + 11) & 511;
            const float* win = args.in[10]; float q1 = 0.f, q2 = 0.f, k1 = 0.f, k2 = 0.f, vv = 0.f;
            for (int a = F.tid; a < DM; a += NTHREADS) { const float x = bf2f(Ax[(size_t)i * DM + a]); const float* wr_ = win + (size_t)a * 9216;
                q1 += x * wr_[h * 256 + 2 * pp]; q2 += x * wr_[h * 256 + 2 * pp + 1]; k1 += x * wr_[1024 + h * 256 + 2 * pp]; k2 += x * wr_[1024 + h * 256 + 2 * pp + 1]; vv += x * wr_[2048 + h * 512 + v]; }
            q1 = block_sum(scr, q1, F.tid); q2 = block_sum(scr, q2, F.tid); k1 = block_sum(scr, k1, F.tid); k2 = block_sum(scr, k2, F.tid); vv = block_sum(scr, vv, F.tid);
            if (F.tid == 0) { const float inv = powf(10000.0f, -(float)(pp & 63) / 64.0f), ang = (float)(pp < 64 ? (i >> 6) : (i & 63)) * inv, cs = cosf(ang), sn = sinf(ang);
                const float rq1 = (q1 * cs - q2 * sn) * 0.0625f, rq2 = (q1 * sn + q2 * cs) * 0.0625f, rk1 = k1 * cs - k2 * sn, rk2 = k1 * sn + k2 * cs; const int jl = i & 511;
                dbg_report(dw, rq1, bf2f(Qb[(size_t)i * 512 + hl * 256 + 2 * pp]), 1000.0f); dbg_report(dw, rq2, bf2f(Qb[(size_t)i * 512 + hl * 256 + 2 * pp + 1]), 1000.0f);
                dbg_report(dw, rk1, bf2f(Knb[(size_t)i * 512 + hl * 256 + 2 * pp]), 1000.0f); dbg_report(dw, rk2, bf2f(Knb[(size_t)i * 512 + hl * 256 + 2 * pp + 1]), 1000.0f);
                dbg_report(dw, rk2 * expf(lgp[h] * (float)(511 - jl)), bf2f(Ktb_[(size_t)(hl * 256 + 2 * pp + 1) * SEQ + i]), 1000.0f);
                dbg_report(dw, rk1 * expf(lgp[4 + h] * (float)jl), bf2f(Ktb_[(size_t)512 * SEQ + (size_t)(hl * 256 + 2 * pp) * SEQ + i]), 1000.0f);
                dbg_report(dw, vv, bf2f(B4[((size_t)((hl * NSEG + (i >> 9)) * 512 + v)) * 1024 + 512 + jl]), 1000.0f); }
        PHASE_END
        }
        PHASE_BEGIN
            { Geo g{1024, 1024, SEQ, 128u * 1024 * 2u, 128u * 1024 * 2u, 128u * (unsigned)SEQ * 2u, LS / 64, 1 << 20, 1 << 20};
              pg::Sched<JobR1> S{{FB}, 256, F.G, bx}; EpiU E{0, 0, FB};
              pg::gemm_phase<EpiU, pg::Sched<JobR1>, 1>(F.lds, g, S, E); }
            if (pair == 0) { Geo g{CTX, CTX, CTX, 128u * CTX * 2u, 128u * CTX * 2u, 128u * CTX * 2u, CTX / 64, 1 << 20, 1 << 20};
              pg::Sched<JobS0> S{{FB}, 16, F.G, bx}; EpiS0 E{0, 0, FB};
              pg::gemm_phase<EpiS0, pg::Sched<JobS0>, 1>(F.lds, g, S, E); }
        PHASE_END
        if constexpr (DBG_PROBE == 6) {
        PHASE_BEGIN
            LAS float* scr = (LAS float*)F.lds; unsigned* dw = (unsigned*)(F.ws + WS_CTL) + 32768;
            const int s = bx, h = s & 3, dir = (s >> 2) & 1, d = (s * 29 + 3) & 255, v = (s * 37 + 11) & 511; const float* win = args.in[10];
            const int j = F.tid & 255, which = F.tid >> 8; const int col = which ? 2048 + h * 512 + v : 1024 + h * 256 + d; float dot = 0.f;
            for (int a = 0; a < DM; ++a) dot += bf2f(Ac[(size_t)j * DM + a]) * win[(size_t)a * 9216 + col];
            scr[16 + F.tid] = dot; __syncthreads();
            float term = 0.f; if (F.tid < 256) term = scr[16 + F.tid] * scr[16 + 256 + F.tid] * expf(lgp[dir * 4 + h] * (float)(dir ? j : 255 - j));
            __syncthreads();
            const float ref = block_sum(scr, term, F.tid);
            if (F.tid == 0) dbg_report(dw, ref, S0[((size_t)((h * 2 + dir) * 512 + v)) * 256 + d], 1000.0f);
        PHASE_END
        }
        PHASE_BEGIN
            { const int gw = F.vcu * NWAVES + F.wave, NGW = F.G * NWAVES;
              for (int rowid = gw; rowid < 1024; rowid += NGW) { const int hl = rowid >> 9, v = rowid & 511, h = 2 * pair + hl, dir = F.lane >> 5, d0 = (F.lane & 31) * 8;
                  const float* s0 = S0 + ((size_t)((h * 2 + dir) * 512 + v)) * 256 + d0; f32x4 c0 = *(const f32x4*)s0, c1 = *(const f32x4*)(s0 + 4);
                  const float dec = expf(lgp[dir * 4 + h] * (float)LS);
                  for (int it = 0; it < NSEG; ++it) { const int seg = dir ? NSEG - 1 - it : it; bf16_t* p = B4 + ((size_t)((hl * NSEG + seg) * 512 + v)) * 1024 + dir * 256 + d0;
                      f32x4 u0, u1; unpack8(*(const u32x4*)p, u0, u1); *(u32x4*)p = pack8(c0, c1); c0 = c0 * dec + u0; c1 = c1 * dec + u1; } } }
            { Geo g{512, 512, 512, 128u * 512 * 2u, 128u * 512 * 2u, 128u * 512 * 2u, 4, 1 << 20, 1 << 20};
              pg::Sched<JobR3> S{{FB}, 256, F.G, bx}; EpiP E{0, 0, FB, pair};
              pg::gemm_phase<EpiP, pg::Sched<JobR3>, 1>(F.lds, g, S, E); }
        PHASE_END
        PHASE_BEGIN
            Geo g{512, 1024, 1024, 128u * 512 * 2u, 128u * 1024 * 2u, 128u * 1024 * 2u, 16, 8, 4};
            pg::Sched<JobR4> S{{FB}, 256, F.G, bx}; EpiO E{4, 8, FB, pair};
            pg::gemm_phase<EpiO, pg::Sched<JobR4>, 2>(F.lds, g, S, E);
        PHASE_END
        if constexpr (DBG_PROBE == 1) {
        PHASE_BEGIN
            LAS float* scr = (LAS float*)F.lds; unsigned* dw = (unsigned*)(F.ws + WS_CTL) + 32768;
            const int s = bx; int i = (int)(((unsigned)s * 2654435761u) >> 18) & 16383; if (s < 8) { const int sp[8] = {0, 1, 511, 512, 513, 8191, 16382, 16383}; i = sp[s]; }
            const int hl = s & 1, h = 2 * pair + hl, v = (s * 37 + 11) & 511; const float lgf = lgp[h], lgb = lgp[4 + h];
            float part = 0.f;
            for (int j = F.tid; j < SEQ; j += NTHREADS) { float qk = 0.f;
                for (int d = 0; d < 256; ++d) qk += bf2f(Qb[(size_t)i * 512 + hl * 256 + d]) * bf2f(Knb[(size_t)j * 512 + hl * 256 + d]);
                const float D = j < i ? __expf(lgf * (float)(i - j)) : (j > i ? __expf(lgb * (float)(j - i)) : 2.0f);
                part += D * qk * bf2f(B4[((size_t)((hl * NSEG + (j >> 9)) * 512 + v)) * 1024 + 512 + (j & 511)]); }
            if (F.tid < 256) { const float q = bf2f(Qb[(size_t)i * 512 + hl * 256 + F.tid]);
                part += q * (__expf(lgf * (float)(i + 1)) * S0[((size_t)((h * 2 + 0) * 512 + v)) * 256 + F.tid] + __expf(lgb * (float)(SEQ - i)) * S0[((size_t)((h * 2 + 1) * 512 + v)) * 256 + F.tid]); }
            const float ref = block_sum(scr, part, F.tid);
            const float ov = bf2f(Ob[(size_t)i * 2048 + h * 512 + F.tid]); const float rms = sqrtf(block_sum(scr, ov * ov, F.tid) * (1.0f / 512.0f));
            if (F.tid == 0) dbg_report(dw, ref, bf2f(Ob[(size_t)i * 2048 + h * 512 + v]), rms * 1000.0f);
        PHASE_END
        }
    }
    PHASE_BEGIN
        const int gw = F.vcu * NWAVES + F.wave, NGW = F.G * NWAVES;
        for (int pos = gw; pos < SEQ; pos += NGW) {
#pragma unroll
            for (int h = 0; h < 4; ++h) { f32x4 a, b; unpack8(*(const u32x4*)(Ob + (size_t)pos * 2048 + h * 512 + F.lane * 8), a, b);
                const float mean = wave_sum((a[0] + a[1]) + (a[2] + a[3]) + (b[0] + b[1]) + (b[2] + b[3])) * (1.0f / 512.0f);
                a -= mean; b -= mean; const float q = wave_sum((a[0] * a[0] + a[1] * a[1]) + (a[2] * a[2] + a[3] * a[3]) + (b[0] * b[0] + b[1] * b[1]) + (b[2] * b[2] + b[3] * b[3]));
                if (F.lane == 0) *(f32x2*)(stats + (size_t)(pos * 4 + h) * 2) = (f32x2){mean, 1.0f / sqrtf(q * (1.0f / 512.0f) + EPS)}; } }
    PHASE_END
    if constexpr (DBG_PROBE == 7 || DBG_PROBE == 8) {
    PHASE_BEGIN
        LAS float* scr = (LAS float*)F.lds; unsigned* dw = (unsigned*)(F.ws + WS_CTL) + 32768; float* sav = (float*)(F.ws + WS_END);
        const int s = bx; const int i = s * 64 + 57, h = DBG_COL >> 9, v = DBG_COL & 511;
        const float ov = bf2f(Ob[(size_t)i * 2048 + h * 512 + F.tid]); const float mean = block_sum(scr, ov, F.tid) * (1.0f / 512.0f);
        const float var = block_sum(scr, (ov - mean) * (ov - mean), F.tid) * (1.0f / 512.0f); const float rstd = 1.0f / sqrtf(var + EPS);
        if (F.tid == 0) { if (DBG_PROBE == 7) { dbg_report(dw, mean, stats[(size_t)(i * 4 + h) * 2], 1000.0f); dbg_report(dw, rstd, stats[(size_t)(i * 4 + h) * 2 + 1], 1000.0f); }
            sav[s * 4 + 0] = (bf2f(Ob[(size_t)i * 2048 + h * 512 + v]) - mean) * rstd; }
    PHASE_END
    }
    PHASE_BEGIN
        { pg::Sched<JobRowCol> S{{FB, 0, 64, 8, 0, (size_t)WR_G * DM, (size_t)256 * DM, (size_t)256 * DM}, 512, F.G, bx};
          EpiG E{0, 0, FB, args.in[13]};
          pg::gemm_phase<EpiG, pg::Sched<JobRowCol>, 1>(F.lds, gK1024, S, E); }
        { Geo g{DM, DM, 128u * DM, 128u * DM * 2u, 128u * DM * 2u, (unsigned)DM * 2u, DM / 64, 1 << 20, 1 << 20};
          pg::Sched<JobRowCol> S{{FB, 1, 8, 64, (size_t)WR_F * DM, 0, (size_t)256 * DM, (size_t)2 * DM}, 512, F.G, bx};
          EpiF E{0, 0, FB};
          pg::gemm_phase<EpiF, pg::Sched<JobRowCol>, 1>(F.lds, g, S, E); }
    PHASE_END
    if constexpr (DBG_PROBE == 8) {
    PHASE_BEGIN
        LAS float* scr = (LAS float*)F.lds; unsigned* dw = (unsigned*)(F.ws + WS_CTL) + 32768; float* sav = (float*)(F.ws + WS_END);
        const int s = bx; const int i = s * 64 + 57, h = DBG_COL >> 9, v = DBG_COL & 511, col = h * 512 + v; float g = 0.f;
        for (int a = F.tid; a < DM; a += NTHREADS) g += bf2f(Ax[(size_t)i * DM + a]) * args.in[10][(size_t)a * 9216 + 4096 + col];
        g = block_sum(scr, g, F.tid);
        if (F.tid == 0) dbg_report(dw, g / (1.0f + expf(-g)) * sav[s * 4] * args.in[13][col], bf2f(Ob[(size_t)i * 2048 + col]), 1.0f);
    PHASE_END
    }
    PHASE_BEGIN
        Geo g{256, 256, 256, 128u * 256 * 2u, 128u * 256 * 2u, 128u * 256 * 2u, 4, 1 << 20, 1 << 20};
        pg::Sched<JobF1> S{{FB}, 512, F.G, bx}; EpiF1 E{0, 0, FB};
        pg::gemm_phase<EpiF1, pg::Sched<JobF1>, 1>(F.lds, g, S, E);
    PHASE_END
    if constexpr (DBG_PROBE == 2 || DBG_PROBE == 4) {
    PHASE_BEGIN
        LAS float* scr = (LAS float*)F.lds; unsigned* dw = (unsigned*)(F.ws + WS_CTL) + 32768;
        if (DBG_PROBE == 4) {
            const int s = bx; const int l = (int)(((unsigned)s * 2654435761u) >> 18) & 16383, ch = (s * 131 + 7) & 1023, g = ch >> 8, cp = ch & 255;
            const int c = F.tid & 255, hf = F.tid >> 8; float fpart = 0.f;
            for (int a = hf * 512; a < hf * 512 + 512; ++a) fpart += bf2f(Ax[(size_t)l * DM + a]) * args.in[10][(size_t)a * 9216 + 6144 + g * 256 + c];
            scr[16 + F.tid] = fpart; __syncthreads();
            float wr_ = 0.f, wi_ = 0.f;
            if (F.tid < 256) { const float fv = scr[16 + F.tid] + scr[16 + 256 + F.tid]; const float ang = (float)((c * cp) & 255) * (1.0f / 128.0f); wr_ = fv * cospif(ang); wi_ = -fv * sinpif(ang); }
            __syncthreads();
            const float Wr = block_sum(scr, wr_, F.tid), Wi = block_sum(scr, wi_, F.tid);
            const int l1 = l >> 7, l2 = l & 127;
            if (F.tid == 0) { dbg_report(dw, Wr, bf2f(Wt[(size_t)(ch * 128 + l2) * 256 + l1]), 16000.0f); dbg_report(dw, Wi, bf2f(Wt[(size_t)(ch * 128 + l2) * 256 + 128 + l1]), 16000.0f); }
        } else {
            const unsigned sid = (unsigned)(bx * NTHREADS + F.tid) * 2654435761u; const int k1 = (sid >> 8) & 127, l2 = (sid >> 15) & 127, ch = (sid >> 22) & 1023;
            float ar = 0.f, ai = 0.f;
            for (int l1 = 0; l1 < 128; ++l1) { const float wr_ = bf2f(Wt[(size_t)(ch * 128 + l2) * 256 + l1]), wi_ = bf2f(Wt[(size_t)(ch * 128 + l2) * 256 + 128 + l1]);
                const float a = (float)((k1 * l1) & 127) * (1.0f / 64.0f), cs = cospif(a), sn = sinpif(a); ar += cs * wr_ + sn * wi_; ai += cs * wi_ - sn * wr_; }
            const float t = (float)((k1 * l2) & 16383) * (1.0f / 8192.0f), ct = cospif(t), st = sinpif(t);
            const float br = ar * ct + ai * st, bi = ai * ct - ar * st;
            dbg_report(dw, br, bf2f(Bt[(size_t)(k1 * 1024 + ch) * 256 + l2]), 180000.0f); dbg_report(dw, bi, bf2f(Bt[(size_t)(k1 * 1024 + ch) * 256 + 128 + l2]), 180000.0f);
        }
    PHASE_END
    }
    PHASE_BEGIN
        Geo g{256, 256, 256, 128u * 256 * 2u, 128u * 256 * 2u, 128u * 256 * 2u, 4, 1 << 20, 1 << 20};
        pg::Sched<JobF2> S{{FB}, 512, F.G, bx}; EpiF2 E{0, 0, FB};
        pg::gemm_phase<EpiF2, pg::Sched<JobF2>, 1>(F.lds, g, S, E);
    PHASE_END
    if constexpr (DBG_PROBE == 3) {
    PHASE_BEGIN
        unsigned* dw = (unsigned*)(F.ws + WS_CTL) + 32768;
        const unsigned sid = (unsigned)(bx * NTHREADS + F.tid) * 2654435761u; const int k1 = (sid >> 8) & 127, k2 = (sid >> 15) & 127, ch = (sid >> 22) & 1023;
        float y = 0.f;
        for (int l2 = 0; l2 < 128; ++l2) { const float br = bf2f(Bt[(size_t)(k1 * 1024 + ch) * 256 + l2]), bi = bf2f(Bt[(size_t)(k1 * 1024 + ch) * 256 + 128 + l2]);
            const float a = (float)((k2 * l2) & 127) * (1.0f / 64.0f); y += br * cospif(a) + bi * sinpif(a); }
        dbg_report(dw, y * (1.0f / 2048.0f), bf2f(MIXb[(size_t)(k1 + 128 * k2) * 2048 + ch]), 1000.0f);
    PHASE_END
    }
    if constexpr (DBG_PROBE == 12) {
    PHASE_BEGIN
        unsigned* dw = (unsigned*)(F.ws + WS_CTL) + 32768;
        for (size_t idx = gtid; idx < (size_t)DM * 9216; idx += gthreads) { const int k = (int)(idx / 9216), n = (int)(idx % 9216); const int dr = tr_dest_row(2, n);
            if (dr >= 0) { const float a = args.in[10][idx]; const float b = bf2f(Win[(size_t)dr * DM + k]); if (fabsf(a - b) > 0.01f * fabsf(a) + 1e-6f) { atomicAdd(dw + 64, 1u); atomicMin(dw + 192, (unsigned)(dr >> 8)); } } }
    PHASE_END
    }
    PHASE_BEGIN
        pg::Sched<JobRowCol> S{{FB, 0, 64, 8, 0, (size_t)WR_GA * DM, (size_t)256 * DM, (size_t)256 * DM}, 512, F.G, bx};
        EpiGate E{0, 0, FB};
        pg::gemm_phase<EpiGate, pg::Sched<JobRowCol>, 1>(F.lds, gK1024, S, E);
    PHASE_END
    if constexpr (DBG_PROBE == 9) {
    PHASE_BEGIN
        LAS float* scr = (LAS float*)F.lds; unsigned* dw = (unsigned*)(F.ws + WS_CTL) + 32768;
        const int s = bx; const int i = DBG_VAR == 0 ? 1210 : (DBG_VAR == 1 ? 1024 + s : (DBG_VAR == 2 ? s * 64 + 57 : 1210 + 256 * (s & 63))), n = DBG_VAR == 0 ? 4 * s : 736; float ga = 0.f, gf = 0.f;
        for (int a = F.tid; a < DM; a += NTHREADS) { const float x = bf2f(Ax[(size_t)i * DM + a]); ga += x * args.in[10][(size_t)a * 9216 + 7168 + n]; gf += x * args.in[10][(size_t)a * 9216 + 8192 + n]; }
        ga = block_sum(scr, ga, F.tid); gf = block_sum(scr, gf, F.tid);
        if (F.tid == 0) { const float ea = fabsf(1.0f / (1.0f + expf(-ga)) - bf2f(GAb[(size_t)i * DM + n])), ef = fabsf(1.0f / (1.0f + expf(-gf)) - bf2f(GFb[(size_t)i * DM + n]));
            if (ea > 0.05f) { atomicMin(dw + 192, (unsigned)s); atomicAdd(dw + 64, 1u); dbg_report(dw, 0.f, DBG_GF ? ea : bf2f(GAb[(size_t)i * DM + n]), 1000.0f); } if (ef > 0.05f) atomicMin(dw + 193, (unsigned)s); }
    PHASE_END
    }
    PHASE_BEGIN
        Geo g{2048, 2048, 3072, 128u * 2048 * 2u, 128u * 2048 * 2u, 128u * 3072 * 2u, 48, 16, 16};
        pg::Sched<JobZ> S{{FB}, 256, F.G, bx}; EpiZ E{16, 0, FB};
        pg::gemm_phase<EpiZ, pg::Sched<JobZ>, 2>(F.lds, g, S, E);
    PHASE_END
    if constexpr (DBG_PROBE == 9 || DBG_PROBE == 10) {
    PHASE_BEGIN
        LAS float* scr = (LAS float*)F.lds; unsigned* dw = (unsigned*)(F.ws + WS_CTL) + 32768;
        const int s = bx; const int i = (int)(((unsigned)s * 2654435761u) >> 18) & 16383, n = (s * 131 + 7) & 1023;
        if (DBG_PROBE == 9) { float ga = 0.f, gf = 0.f;
            (void)ga; (void)gf;
        } else { float r = 0.f, fo = 0.f;
            for (int k = F.tid; k < 2048; k += NTHREADS) r += bf2f(Ob[(size_t)i * 2048 + k]) * args.in[14][(size_t)k * DM + n];
            for (int k = F.tid; k < 1024; k += NTHREADS) fo += bf2f(MIXb[(size_t)i * 2048 + k]) * args.in[15][(size_t)k * DM + n];
            r = block_sum(scr, r, F.tid); fo = block_sum(scr, fo, F.tid);
            if (F.tid == 0) dbg_report(dw, bf2f(GAb[(size_t)i * DM + n]) * r + bf2f(GFb[(size_t)i * DM + n]) * fo, bf2f(Zb[(size_t)i * DM + n]), 1000.0f); }
    PHASE_END
    }
    PHASE_BEGIN
        pg::Sched<JobRowCol> S{{FB, 2, 64, 4, 0, 0, (size_t)256 * DM, (size_t)256 * DM}, 256, F.G, bx};
        EpiResid E{0, 0, FB, 1};
        pg::gemm_phase<EpiResid, pg::Sched<JobRowCol>, 1>(F.lds, gK1024, S, E);
    PHASE_END
    }
    if constexpr (STOP_AFTER >= 2) {
    PHASE_BEGIN
        norm_rows(F, args.in[0], args.in[2], args.in[17], 6 * DM, Dx, nullptr, true, SEQ);
        { TrDesc t{args.in[18], DM, 2 * DFF, W13t, DM, 0, 0}; tr_all(F, t); }
        { TrDesc t{args.in[19], DFF, DM, W2t, DFF, 0, 1}; tr_all(F, t); }
        __syncthreads();
    PHASE_END
    PHASE_BEGIN
        pg::Sched<JobFfn1> S{{FB, 64}, 64 * 22, F.G, bx};
        EpiSwiglu E{0, 0, FB};
        pg::gemm_phase<EpiSwiglu, pg::Sched<JobFfn1>, 1>(F.lds, gK1024, S, E);
    PHASE_END
    PHASE_BEGIN
        pg::Sched<JobFfn2> S{{FB, 64}, 64 * 4, F.G, bx};
        EpiResid E{0, 0, FB, 2};
        pg::gemm_phase<EpiResid, pg::Sched<JobFfn2>, 1>(F.lds, gFfn2, S, E);
    PHASE_END
    } else {
    PHASE_BEGIN
        copy_delta(F, Dx, Ob);
    PHASE_END
    }
    PHASE_BEGIN
        final_norm(F, args.in[0], args.in[20], Ob);
    PHASE_END
    if constexpr (DBG_PROBE != 0) {
    PHASE_BEGIN
        if (bx == 0 && F.tid == 0) { const float e = __builtin_bit_cast(float, ((unsigned*)(F.ws + WS_CTL))[32768]); ((float*)F.dout)[0] = DBG_COUNT == 3 ? 100.0f * (float)(16u + ((((unsigned*)(F.ws + WS_CTL))[32768 + 192 + DBG_GF] + 0xC0000000u - 0xC0000000u) >> DBG_SH & 15u)) : DBG_COUNT == 2 ? 100.0f * (float)(16u + ((unsigned*)(F.ws + WS_CTL))[32768 + 128]) : DBG_COUNT ? 1000.0f + 10.0f * (float)((unsigned*)(F.ws + WS_CTL))[32768 + 64] : 1000.0f * (10.0f + log10f(e + 1e-10f)); }
    PHASE_END
    }
}

extern "C" void kernel_launch(void* const* d_in, const int* in_sizes, int n_in, void* d_out, int out_size, void* d_ws, size_t ws_size, hipStream_t stream) {
    static int grid = 0;
    if (grid == 0) {
        if (n_in != 21 || out_size != SEQ * DM || ws_size < WS_END) { fprintf(stderr, "kernel_launch: unexpected shapes (n_in %d out %d ws %zu)\n", n_in, out_size, ws_size); grid = -1; return; }
        int dev = 0, cus = 0, per_cu = 0;
        if (hipGetDevice(&dev) != hipSuccess || hipDeviceGetAttribute(&cus, hipDeviceAttributeMultiprocessorCount, dev) != hipSuccess) { grid = -1; return; }
        if (hipFuncSetAttribute((const void*)fwd_kernel, hipFuncAttributeMaxDynamicSharedMemorySize, LDS_BYTES) != hipSuccess) { fprintf(stderr, "kernel_launch: hipFuncSetAttribute failed\n"); grid = -1; return; }
        if (hipOccupancyMaxActiveBlocksPerMultiprocessor(&per_cu, (const void*)fwd_kernel, NTHREADS, LDS_BYTES) != hipSuccess || per_cu < 1) { fprintf(stderr, "kernel_launch: occupancy query says %d blocks/CU\n", per_cu); }
        (void)hipGetLastError();
        grid = cus;
    }
    if (grid < 0) return;
    (void)hipMemsetAsync((char*)d_ws + WS_CTL, 0, CTL_ZERO_BYTES, stream);
    Args a{};
    for (int i = 0; i < 21; ++i) a.in[i] = (const float*)d_in[i];
    a.out = (float*)d_out; a.ws = (unsigned char*)d_ws; a.ph_lo = 0; a.ph_hi = 1000;
    hipLaunchKernelGGL(fwd_kernel, dim3(grid), dim3(NTHREADS), LDS_BYTES, stream, a);
}
```

```cpp
#include <hip/hip_runtime.h>
#include <cstdio>
#include <cstdint>

#ifndef DBG_NOFOUR
#define DBG_NOFOUR 0
#endif
#ifndef DBG_NORET
#define DBG_NORET 0
#endif
#ifndef DBG_PROBE
#define DBG_PROBE 0
#endif
#ifndef DBG_COUNT
#define DBG_COUNT 0
#ifndef DBG_COL
#define DBG_COL 736
#endif
#ifndef DBG_VAR
#define DBG_VAR 2
#endif
#ifndef DBG_SH
#define DBG_SH 0
#endif
#ifndef DBG_GF
#define DBG_GF 1
#endif
#ifndef DBG_S0
#define DBG_S0 4
#endif
#endif
#ifndef DBG_XBAR
#define DBG_XBAR 0
#endif
#ifndef DBG_DUP
#define DBG_DUP -1
#endif
#ifndef DBG_TSEL
#define DBG_TSEL -1
#endif
#ifndef DBG_TSEL2
#define DBG_TSEL2 1
#endif
#ifndef PG_ALIGN
#define PG_ALIGN 1
#endif
#ifndef STOP_AFTER
#define STOP_AFTER 99
#endif

#define LAS __attribute__((address_space(3)))
typedef unsigned short bf16_t;
typedef short bf16x8 __attribute__((ext_vector_type(8)));
typedef float f32x4 __attribute__((ext_vector_type(4)));
typedef float f32x2 __attribute__((ext_vector_type(2)));
typedef unsigned u32x4 __attribute__((ext_vector_type(4)));
typedef unsigned u32x2 __attribute__((ext_vector_type(2)));

constexpr int DM = 1024, SEQ = 16384, CTX = 256, DFF = 2816;
constexpr float EPS = 1e-6f;
constexpr int LS = 512, NSEG = SEQ / LS;

constexpr size_t MiB = 1u << 20;
constexpr size_t WS_CTL = 0, CTL_ZERO_BYTES = 1 * MiB;
constexpr size_t WS_MOD = 1 * MiB;
constexpr size_t WS_TAB = 2 * MiB;
constexpr size_t WS_STATS = 3 * MiB;
constexpr size_t WS_S0 = 4 * MiB;
constexpr size_t WS_KC = 8 * MiB;
constexpr size_t WS_VC = 9 * MiB;
constexpr size_t WS_DC = 10 * MiB;
constexpr size_t WS_HC = 12 * MiB;
constexpr size_t WS_WIN = 14 * MiB;
constexpr size_t WS_WN = 34 * MiB;
constexpr size_t WS_WB = 36 * MiB;
constexpr size_t WS_H = 54 * MiB;
constexpr size_t WS_Q = 54 * MiB, WS_KN = 70 * MiB, WS_KT = 86 * MiB, WS_B4 = 118 * MiB;
constexpr size_t WS_O = 182 * MiB;
constexpr size_t WS_END = 246 * MiB;
constexpr size_t WS_XB = 11 * MiB;
constexpr size_t WS_OUTW = 246 * MiB;
constexpr size_t WS_XCSLAB = 150 * MiB;
constexpr size_t WS_WT = 118 * MiB, WS_BT = 54 * MiB, WS_MIX = 118 * MiB, WS_GA = 54 * MiB, WS_GF = 86 * MiB;
constexpr size_t DO_AX = 32 * MiB;
constexpr int WR_G = 4096, WR_F = 6144, WR_GA = 8192, WR_GF = 9216;
constexpr size_t WB_W13 = 0, WB_W2 = 11 * MiB;
constexpr size_t WB_BZ = 0, WB_WO = 6 * MiB;
constexpr size_t TB_ROPE = 0, TB_TW = 128 * 1024, TB_FM = 256 * 1024, TB_GM = 384 * 1024, TB_T256 = 512 * 1024;

typedef __bf16 bf16x2_t __attribute__((ext_vector_type(2)));
__device__ __forceinline__ unsigned cvt_pk_bf16(float lo, float hi) { const f32x2 v = {lo, hi}; return __builtin_bit_cast(unsigned, __builtin_convertvector(v, bf16x2_t)); }
__device__ __forceinline__ unsigned short f2bf(float f) { unsigned u = __builtin_bit_cast(unsigned, f); return (unsigned short)((u + 0x7fffu + ((u >> 16) & 1u)) >> 16); }
__device__ __forceinline__ float bflo(unsigned u) { return __builtin_bit_cast(float, u << 16); }
__device__ __forceinline__ float bfhi(unsigned u) { return __builtin_bit_cast(float, u & 0xffff0000u); }
__device__ __forceinline__ u32x4 pack8(const f32x4 a, const f32x4 b) { u32x4 w; w.x = cvt_pk_bf16(a[0], a[1]); w.y = cvt_pk_bf16(a[2], a[3]); w.z = cvt_pk_bf16(b[0], b[1]); w.w = cvt_pk_bf16(b[2], b[3]); return w; }
__device__ __forceinline__ void unpack8(const u32x4 w, f32x4& a, f32x4& b) { a = (f32x4){bflo(w.x), bfhi(w.x), bflo(w.y), bfhi(w.y)}; b = (f32x4){bflo(w.z), bfhi(w.z), bflo(w.w), bfhi(w.w)}; }
__device__ __forceinline__ float fsigmoid(float a) { return __builtin_amdgcn_rcpf(1.0f + __expf(-a)); }
__device__ __forceinline__ float fsilu(float a) { return a * fsigmoid(a); }
__device__ __forceinline__ float wave_sum(float v) {
#pragma unroll
    for (int o = 1; o < 64; o <<= 1) v += __shfl_xor(v, o);
    return v;
}

namespace pg {
constexpr int BM = 256, BK = 64, HALF = 128, HTB = HALF * BK * 2, STAGE_BYTES = 8 * HTB, NXCD = 8, WGM = 4;
__device__ __forceinline__ int lds_byte(int r, int c) { const int st = (r >> 4) * 2 + (c >> 5), rr = r & 15, cc = c & 31, ob = rr * 64 + cc * 2; return st * 1024 + (ob ^ (((ob >> 9) & 1) << 5)); }
__device__ __forceinline__ void stage_rc(int b, int& R, int& C) { const int st = b / 1024, sb = b % 1024, swz = sb ^ (((sb >> 9) & 1) << 5); R = (st >> 1) * 16 + swz / 64; C = (st & 1) * 32 + (swz % 64) / 2; }
__device__ __forceinline__ int perm32(int rho) { const int n = rho >> 4, i = rho & 15; return 8 * (i >> 2) + 4 * n + (i & 3); }

struct Unit { const char* a0; const char* a1; const char* b; char* d; int i0, i1, i2, i3; };
struct Geo { unsigned lda0, lda1, ldb;
             unsigned hsA0, hsA1, hsB;
             int nt, c0, rep0; };

__device__ __forceinline__ void tile_pm_pn(int L, int nM, int nN, int& pm, int& pn) {
    const int nwg = nM * nN; int wgid = L;
    { const int q = nwg / NXCD, r = nwg % NXCD, xcd = wgid % NXCD, off = wgid / NXCD; wgid = (xcd < r ? xcd * (q + 1) : r * (q + 1) + (xcd - r) * q) + off; }
    const int nig = WGM * nN, gid = wgid / nig, fm = gid * WGM, gsz = (nM - fm) < WGM ? (nM - fm) : WGM;
    pm = fm + ((wgid % nig) % gsz); pn = (wgid % nig) / gsz;
}
__device__ __forceinline__ int xcd_contig(int L, int n) { return (L % NXCD) * (n / NXCD) + L / NXCD; }

template <class Job> struct Sched {
    Job j; int n, G, c;
    __device__ __forceinline__ bool next(int i, Unit& u) const { const long L = (long)i * G + c; if (L >= n) return false; j.fill((int)L, u); return true; }
};

template <class Epi, class Sch, int ASEG>
__device__ __forceinline__ void gemm_phase(LAS unsigned char* lds, const Geo g, const Sch& S, const Epi& E) {
    int tid = threadIdx.x; asm volatile("" : "+v"(tid));
    const int wid = __builtin_amdgcn_readfirstlane(tid >> 6), lane = tid & 63, wr = wid >> 2, wc = wid & 3, fr = lane & 15, fq = lane >> 4;
    int nt = g.nt; asm volatile("" : "+s"(nt));
    unsigned voffA0[2], voffA1[2], voffB[2];
#pragma unroll
    for (int i = 0; i < 2; ++i) { int R, C; stage_rc(tid * 16 + i * 8192, R, C); const int Rb = (R & ~31) + perm32(R & 31);
        voffA0[i] = (unsigned)(R * g.lda0 + C) * 2u; voffA1[i] = (ASEG == 2) ? (unsigned)(R * g.lda1 + C) * 2u : 0u; voffB[i] = (unsigned)(Rb * g.ldb + C) * 2u; }
    const unsigned ldsw = (unsigned)wid * 1024u;
    const int aoff = lds_byte(wr * 64 + fr, fq * 8), boff = lds_byte(wc * 32 + fr, fq * 8);
#define PG_SA(b, h) (((b) * 2 + (h)) * HTB)
#define PG_SB(b, h) ((4 + (b) * 2 + (h)) * HTB)
#define PG_GLDS(gp, lp) __builtin_amdgcn_global_load_lds((const unsigned*)(gp), (LAS unsigned*)(lp), 16, 0, 0)
#define PG_ASEL(T) (ASEG == 2 && (T) >= g.c0)
#define PG_APTR(U, T) (PG_ASEL(T) ? (U).a1 + (size_t)((T) - g.c0) * 128 : (U).a0 + (size_t)((T) & (g.rep0 - 1)) * 128)
#define PG_STAGE_A(bufoff, gbase, h, sel) do { const bool _s = (sel); const unsigned _v0 = _s ? voffA1[0] : voffA0[0], _v1 = _s ? voffA1[1] : voffA0[1]; \
        const char* _p = (gbase) + ((h) ? (size_t)(_s ? g.hsA1 : g.hsA0) : (size_t)0); \
        PG_GLDS(_p + _v0, lds + (bufoff) + ldsw); PG_GLDS(_p + _v1, lds + (bufoff) + ldsw + 8192); } while (0)
#define PG_STAGE_B(bufoff, gbase, h) do { const char* _p = (gbase) + ((h) ? (size_t)g.hsB : (size_t)0); \
        PG_GLDS(_p + voffB[0], lds + (bufoff) + ldsw); PG_GLDS(_p + voffB[1], lds + (bufoff) + ldsw + 8192); } while (0)
#define PG_LDA(dst, b, h) do { _Pragma("unroll") for (int m = 0; m < 4; ++m) _Pragma("unroll") for (int k = 0; k < 2; ++k) dst[m][k] = *(const LAS bf16x8*)(lds + PG_SA(b, h) + aoff + m * 2048 + k * 1024); } while (0)
#define PG_LDB(dst, b, h) do { _Pragma("unroll") for (int n = 0; n < 2; ++n) _Pragma("unroll") for (int k = 0; k < 2; ++k) dst[n][k] = *(const LAS bf16x8*)(lds + PG_SB(b, h) + boff + n * 2048 + k * 1024); } while (0)
#define PG_MMA(ai, bj, At, Bt) do { __builtin_amdgcn_s_setprio(1); _Pragma("unroll") for (int m = 0; m < 4; ++m) _Pragma("unroll") for (int n = 0; n < 2; ++n) _Pragma("unroll") for (int k = 0; k < 2; ++k) \
        acc[ai][bj][m][n] = __builtin_amdgcn_mfma_f32_16x16x32_bf16(Bt[n][k], At[m][k], acc[ai][bj][m][n], 0, 0, 0); __builtin_amdgcn_s_setprio(0); } while (0)
#define PG_WAIT_V(n) asm volatile("s_waitcnt vmcnt(" #n ")" ::: "memory")
#define PG_WAIT_L(n) asm volatile("s_waitcnt lgkmcnt(" #n ")" ::: "memory")
#define PG_BAR __builtin_amdgcn_s_barrier()
#define PG_SCHED __builtin_amdgcn_sched_barrier(0)
    Unit cur, nxt; int ui = 0;
    if (!S.next(0, cur)) return;
    f32x4 acc[2][2][4][2];
#pragma unroll
    for (int a = 0; a < 2; ++a)
#pragma unroll
        for (int b = 0; b < 2; ++b)
#pragma unroll
            for (int m = 0; m < 4; ++m)
#pragma unroll
                for (int n = 0; n < 2; ++n) acc[a][b][m][n] = (f32x4){0.f, 0.f, 0.f, 0.f};
    bf16x8 At[4][2], B0[2][2], B1[2][2];
    { const char* p0 = PG_APTR(cur, 0); const char* p1 = PG_APTR(cur, 1);
      PG_STAGE_B(PG_SB(0, 0), cur.b, 0); PG_STAGE_B(PG_SB(0, 1), cur.b, 1); PG_STAGE_A(PG_SA(0, 0), p0, 0, PG_ASEL(0)); PG_STAGE_A(PG_SA(0, 1), p0, 1, PG_ASEL(0));
      if (wr == 1) PG_BAR;
      PG_WAIT_V(2); PG_BAR;
      PG_STAGE_B(PG_SB(1, 0), cur.b + 128, 0); PG_STAGE_A(PG_SA(1, 0), p1, 0, PG_ASEL(1)); PG_STAGE_B(PG_SB(1, 1), cur.b + 128, 1);
      PG_WAIT_V(6); PG_BAR; }
    for (;;) {
        const bool has_next = S.next(ui + 1, nxt);
        const char* nA0 = has_next ? PG_APTR(nxt, 0) : PG_APTR(cur, 0); const char* nA1 = has_next ? PG_APTR(nxt, 1) : PG_APTR(cur, 1); const char* nB = has_next ? nxt.b : cur.b;
        for (int t = 0; t < nt; t += 2) {
            const bool last = (t == nt - 2);
            if constexpr (Epi::NHOOK >= 1) { if (t == E.h0) { int t2 = threadIdx.x; asm volatile("" : "+v"(t2)); E.hook(acc, cur, 0, wr, wc, t2 & 15, (t2 >> 4) & 3); } }
            if constexpr (Epi::NHOOK >= 2) { if (t == E.h1) { int t2 = threadIdx.x; asm volatile("" : "+v"(t2)); E.hook(acc, cur, 1, wr, wc, t2 & 15, (t2 >> 4) & 3); } }
            const char* a1 = PG_APTR(cur, t + 1); const bool s1 = PG_ASEL(t + 1);
            const char* a2 = last ? nA0 : PG_APTR(cur, t + 2); const char* a3 = last ? nA1 : PG_APTR(cur, t + 3);
            const char* b2 = last ? nB : cur.b + (size_t)(t + 2) * 128; const char* b3 = b2 + 128;
            const bool s2 = last ? PG_ASEL(0) : PG_ASEL(t + 2), s3 = last ? PG_ASEL(1) : PG_ASEL(t + 3);
            PG_LDB(B0, 0, 0); PG_LDB(B1, 0, 1); PG_SCHED; PG_LDA(At, 0, 0); PG_STAGE_A(PG_SA(1, 1), a1, 1, s1);
            PG_WAIT_V(8); PG_WAIT_L(0); PG_BAR; PG_MMA(0, 0, At, B0); PG_MMA(0, 1, At, B1); PG_BAR; PG_SCHED;
            PG_LDA(At, 0, 1); PG_STAGE_B(PG_SB(0, 0), b2, 0); PG_STAGE_B(PG_SB(0, 1), b2, 1); PG_STAGE_A(PG_SA(0, 0), a2, 0, s2);
            PG_WAIT_V(8); PG_WAIT_L(0); PG_BAR; PG_MMA(1, 0, At, B0); PG_MMA(1, 1, At, B1); PG_BAR; PG_SCHED;
            PG_LDB(B0, 1, 0); PG_LDB(B1, 1, 1); PG_SCHED; PG_LDA(At, 1, 0); PG_STAGE_A(PG_SA(0, 1), a2, 1, s2);
            PG_WAIT_V(8); PG_WAIT_L(0); PG_BAR; PG_MMA(0, 0, At, B0); PG_MMA(0, 1, At, B1); PG_BAR; PG_SCHED;
            PG_LDA(At, 1, 1); PG_STAGE_B(PG_SB(1, 0), b3, 0); PG_STAGE_B(PG_SB(1, 1), b3, 1); PG_STAGE_A(PG_SA(1, 0), a3, 0, s3);
            PG_WAIT_V(8); PG_WAIT_L(0); PG_BAR; PG_MMA(1, 0, At, B0); PG_MMA(1, 1, At, B1); PG_BAR; PG_SCHED;
        }
        if (PG_ALIGN && wr == 0) PG_BAR;
        if constexpr (!Epi::AFTER_DRAIN) { int t2 = threadIdx.x; asm volatile("" : "+v"(t2)); E(acc, cur, wr, wc, t2 & 15, (t2 >> 4) & 3); }
        if (!has_next) break;
#pragma unroll
        for (int a = 0; a < 2; ++a)
#pragma unroll
            for (int b = 0; b < 2; ++b)
#pragma unroll
                for (int m = 0; m < 4; ++m)
#pragma unroll
                    for (int n = 0; n < 2; ++n) acc[a][b][m][n] = (f32x4){0.f, 0.f, 0.f, 0.f};
        cur = nxt; ++ui;
        if (PG_ALIGN && wr == 1) PG_BAR;
    }
    PG_WAIT_V(0);
    if (!PG_ALIGN && wr == 0) PG_BAR;
    PG_BAR;
    if constexpr (Epi::AFTER_DRAIN) { int t2 = threadIdx.x; asm volatile("" : "+v"(t2)); E.fused(acc, cur, wr, wc, t2 & 15, (t2 >> 4) & 3, lds, wid, t2 & 63); }
#undef PG_SA
#undef PG_SB
#undef PG_GLDS
#undef PG_ASEL
#undef PG_APTR
#undef PG_STAGE_A
#undef PG_STAGE_B
#undef PG_LDA
#undef PG_LDB
#undef PG_MMA
#undef PG_WAIT_V
#undef PG_WAIT_L
#undef PG_BAR
#undef PG_SCHED
}
}
using pg::Unit; using pg::Geo;

#define EPI_ROWS _Pragma("unroll") for (int ai = 0; ai < 2; ++ai) _Pragma("unroll") for (int m = 0; m < 4; ++m)
#define EPI_ROW (128 * ai + 64 * wr + 16 * m + fr)
#define EPI_COLS _Pragma("unroll") for (int bj = 0; bj < 2; ++bj)
#define EPI_COL0 (128 * bj + 32 * wc + 8 * fq)
typedef f32x4 acc_t[2][2][4][2];

struct Base { unsigned char* ws; unsigned char* dout; };
#define modx ((float*)(F.ws + WS_MOD))
#define modc (modx + 9216)
#define lgp (modx + 2 * 9216)
#define Ax ((bf16_t*)(F.dout + DO_AX))
#define Ac ((bf16_t*)(F.ws + WS_DC + 512 * 1024))
#define Dx ((bf16_t*)F.dout)
#define Dc ((bf16_t*)(F.ws + WS_DC))
#define Hb ((bf16_t*)(F.ws + WS_H))
#define Hc ((bf16_t*)(F.ws + WS_HC))
#define W13t ((bf16_t*)(F.ws + WS_WB + WB_W13))
#define W2t ((bf16_t*)(F.ws + WS_WB + WB_W2))
#define ropeT ((float*)(F.ws + WS_TAB + TB_ROPE))
#define twT ((float*)(F.ws + WS_TAB + TB_TW))
#define FmT ((bf16_t*)(F.ws + WS_TAB + TB_FM))
#define GmT ((bf16_t*)(F.ws + WS_TAB + TB_GM))
#define T256 ((bf16_t*)(F.ws + WS_TAB + TB_T256))
#define Win ((bf16_t*)(F.ws + WS_WIN))
#define Wn ((bf16_t*)(F.ws + WS_WN))
#define Bz ((bf16_t*)(F.ws + WS_OUTW))
#define WoT ((bf16_t*)(F.ws + WS_OUTW + 6 * MiB))
#define Qb ((bf16_t*)(F.ws + WS_Q))
#define Knb ((bf16_t*)(F.ws + WS_KN))
#define Ktb_ ((bf16_t*)(F.ws + WS_KT))
#define Pb Ktb_
#define B4 ((bf16_t*)(F.ws + WS_B4))
#define Ob ((bf16_t*)(F.ws + WS_O))
#define S0 ((float*)(F.ws + WS_S0))
#define stats ((float*)(F.ws + WS_STATS))
#define KcT ((bf16_t*)(F.ws + WS_KC))
#define VcT ((bf16_t*)(F.ws + WS_VC))
#define Wt ((bf16_t*)(F.ws + WS_WT))
#define Bt ((bf16_t*)(F.ws + WS_BT))
#define MIXb ((bf16_t*)(F.ws + WS_MIX))
#define GAb ((bf16_t*)(F.ws + WS_GA))
#define GFb ((bf16_t*)(F.ws + WS_GF))
#define Zb (MIXb + 1024)
#define XcSlab ((float*)(F.ws + WS_XCSLAB))

struct EpiSwiglu {
    static constexpr int NHOOK = 0; static constexpr int AFTER_DRAIN = 0; int h0, h1;
    Base F;
    __device__ __forceinline__ void hook(acc_t&, const Unit&, int, int, int, int, int) const {}
    __device__ __forceinline__ void operator()(const acc_t& acc, const Unit& u, int wr, int wc, int fr, int fq) const {
        bf16_t* base = u.i0 < 64 ? Hb + (size_t)u.i0 * 256 * DFF : Hc;
        EPI_ROWS { bf16_t* rowp = base + (size_t)EPI_ROW * DFF + u.i1 * 128 + 32 * wc + 8 * fq; f32x4 h[2];
#pragma unroll
            for (int n = 0; n < 2; ++n)
#pragma unroll
                for (int e = 0; e < 4; ++e) h[n][e] = fsilu(acc[ai][0][m][n][e]) * acc[ai][1][m][n][e];
            *(u32x4*)rowp = pack8(h[0], h[1]); if (m & 1) asm volatile("" ::: "memory"); }
    }
};
struct EpiResid {
    static constexpr int NHOOK = 0; static constexpr int AFTER_DRAIN = 0; int h0, h1;
    Base F; int mode;
    __device__ __forceinline__ void hook(acc_t&, const Unit&, int, int, int, int, int) const {}
    __device__ __forceinline__ void operator()(const acc_t& acc, const Unit& u, int wr, int wc, int fr, int fq) const {
        const bool isx = u.i0 < 64; const int has_old = mode != 0; const float scale = mode == 1 ? 1.0f : 0.5f;
        const bf16_t* din = Dx + (size_t)u.i0 * 256 * DM; bf16_t* dout = isx ? (mode == 2 ? Ob : Dx) + (size_t)u.i0 * 256 * DM : Dc;
        const float* coef = (isx ? modx : modc) + (mode == 0 ? 2 : (mode == 1 ? 5 : 8)) * DM + u.i1 * 256;
        EPI_COLS { const int c = EPI_COL0; const f32x4 c0 = *(const f32x4*)(coef + c) * scale, c1 = *(const f32x4*)(coef + c + 4) * scale;
#pragma unroll
            for (int ai = 0; ai < 2; ++ai)
#pragma unroll
                for (int m = 0; m < 4; ++m) { const size_t off = (size_t)EPI_ROW * DM + u.i1 * 256 + c;
                    f32x4 v0 = acc[ai][bj][m][0] * c0, v1 = acc[ai][bj][m][1] * c1;
                    if (has_old) { f32x4 o0, o1; unpack8(*(const u32x4*)(din + off), o0, o1); v0 += o0; v1 += o1; }
                    *(u32x4*)(dout + off) = pack8(v0, v1); if (m & 1) asm volatile("" ::: "memory"); } }
    }
};

struct EpiFuse {
    static constexpr int NHOOK = 0; static constexpr int AFTER_DRAIN = 1; int h0, h1; Base F; int mode; const float* x; const float* nw;
    __device__ __forceinline__ void hook(acc_t&, const Unit&, int, int, int, int, int) const {}
    __device__ __forceinline__ void operator()(const acc_t&, const Unit&, int, int, int, int) const {}
    __device__ __forceinline__ void fused(acc_t& acc, const Unit& u, int wr, int wc, int fr, int fq, LAS unsigned char* lds, int wid, int lane) const {
        const int pm = u.i0, pn = u.i1; const float scale = mode == 1 ? 1.0f : 0.5f;
        const float* coef = modx + (mode == 0 ? 2 : (mode == 1 ? 5 : 8)) * DM + pn * 256;
        const bf16_t* din = (mode == 2 ? Ob : Dx) + (size_t)pm * 256 * DM + pn * 256; bf16_t* dout = (mode == 1 ? Ob : Dx) + (size_t)pm * 256 * DM + pn * 256;
        const float* xt = x + (size_t)pm * 256 * DM + pn * 256;
        LAS float* P = (LAS float*)lds; LAS float* S = (LAS float*)(lds + 4096);
        f32x4 cf[2][2];
#pragma unroll
        for (int bj = 0; bj < 2; ++bj) { cf[bj][0] = *(const f32x4*)(coef + EPI_COL0) * scale; cf[bj][1] = *(const f32x4*)(coef + EPI_COL0 + 4) * scale; }
#pragma unroll
        for (int aim = 0; aim < 4; ++aim) { const int ai = aim >> 1; f32x4 xv[4][2][2]; u32x4 ov[4][2];
#pragma unroll
            for (int m = 2 * (aim & 1); m < 2 * (aim & 1) + 2; ++m) EPI_COLS { const size_t off = (size_t)EPI_ROW * DM + EPI_COL0; xv[m][bj][0] = *(const f32x4*)(xt + off); xv[m][bj][1] = *(const f32x4*)(xt + off + 4); if (mode != 0) ov[m][bj] = *(const u32x4*)(din + off); }
#pragma unroll
            for (int m = 2 * (aim & 1); m < 2 * (aim & 1) + 2; ++m) { const int row = EPI_ROW; float ss = 0.f;
                EPI_COLS { const size_t off = (size_t)row * DM + EPI_COL0; f32x4 d0 = acc[ai][bj][m][0] * cf[bj][0], d1 = acc[ai][bj][m][1] * cf[bj][1];
                    if (mode != 0) { f32x4 o0, o1; unpack8(ov[m][bj], o0, o1); d0 += o0; d1 += o1; }
                    if (mode != 2) *(u32x4*)(dout + off) = pack8(d0, d1);
                    const f32x4 v0 = xv[m][bj][0] + d0, v1 = xv[m][bj][1] + d1; acc[ai][bj][m][0] = v0; acc[ai][bj][m][1] = v1;
                    ss += (v0[0] * v0[0] + v0[1] * v0[1]) + (v0[2] * v0[2] + v0[3] * v0[3]) + (v1[0] * v1[0] + v1[1] * v1[1]) + (v1[2] * v1[2] + v1[3] * v1[3]); }
                ss += __shfl_xor(ss, 16); ss += __shfl_xor(ss, 32);
                if (fq == 0) P[row * 4 + wc] = ss; }
            asm volatile("" ::: "memory"); }
        asm volatile("s_waitcnt lgkmcnt(0)" ::: "memory"); __builtin_amdgcn_s_barrier(); asm volatile("" ::: "memory");
        float* xb = (float*)(F.ws + WS_XB) + (size_t)mode * 64 * 256 * 4; unsigned* cnt = (unsigned*)(F.ws + WS_CTL) + 8192 + mode * 4096 + 64 * pm;
        const int prow = wid * 32 + (lane & 31);
        if (lane < 32) { const float t = (P[prow * 4 + 0] + P[prow * 4 + 1]) + (P[prow * 4 + 2] + P[prow * 4 + 3]);
            __hip_atomic_store(xb + ((size_t)(pm * 256 + prow) * 4 + pn), t, __ATOMIC_RELAXED, __HIP_MEMORY_SCOPE_AGENT); }
        asm volatile("s_waitcnt vmcnt(0)" ::: "memory");
        if (lane == 0) __hip_atomic_fetch_add(cnt, 1u, __ATOMIC_RELAXED, __HIP_MEMORY_SCOPE_AGENT);
        if (wid == 0) { unsigned sp = 0;
            while ((unsigned)__builtin_amdgcn_readfirstlane(__hip_atomic_load(cnt, __ATOMIC_RELAXED, __HIP_MEMORY_SCOPE_AGENT)) < 32u) { __builtin_amdgcn_s_sleep(2); if (++sp > (1u << 22)) break; }
            __builtin_amdgcn_fence(__ATOMIC_ACQUIRE, "agent"); }
        asm volatile("s_waitcnt vmcnt(0) lgkmcnt(0)" ::: "memory"); __builtin_amdgcn_s_barrier(); asm volatile("" ::: "memory");
        if (lane < 32) { const float* sl = xb + (size_t)(pm * 256 + prow) * 4; float t = 0.f;
#pragma unroll
            for (int q = 0; q < 4; ++q) t += __hip_atomic_load(sl + q, __ATOMIC_RELAXED, __HIP_MEMORY_SCOPE_AGENT);
            S[prow] = 1.0f / sqrtf(t * (1.0f / DM) + EPS); }
        asm volatile("s_waitcnt lgkmcnt(0)" ::: "memory"); __builtin_amdgcn_s_barrier(); asm volatile("" ::: "memory");
        const float* md = modx + (mode == 0 ? 3 : 6) * DM + pn * 256; const float* nwp = nw + pn * 256;
        f32x4 wv[2][2], shv[2][2];
#pragma unroll
        for (int bj = 0; bj < 2; ++bj)
#pragma unroll
            for (int n = 0; n < 2; ++n) { const int c = EPI_COL0 + 4 * n; const f32x4 w = *(const f32x4*)(nwp + c);
                if (mode == 2) { wv[bj][n] = w; shv[bj][n] = (f32x4){0.f, 0.f, 0.f, 0.f}; } else { wv[bj][n] = w * (*(const f32x4*)(md + DM + c) + 1.0f); shv[bj][n] = *(const f32x4*)(md + c); } }
        EPI_ROWS { const int row = EPI_ROW; const float rinv = S[row];
            EPI_COLS { const size_t off = (size_t)row * DM + EPI_COL0;
                const f32x4 y0 = (acc[ai][bj][m][0] * rinv) * wv[bj][0] + shv[bj][0], y1 = (acc[ai][bj][m][1] * rinv) * wv[bj][1] + shv[bj][1];
                if (mode == 2) { float* o = (float*)F.dout + (size_t)pm * 256 * DM + pn * 256 + off; *(f32x4*)o = y0; *(f32x4*)(o + 4) = y1; }
                else *(u32x4*)(Ax + (size_t)pm * 256 * DM + pn * 256 + off) = pack8(y0, y1); } }
        asm volatile("s_waitcnt lgkmcnt(0)" ::: "memory"); __builtin_amdgcn_s_barrier(); asm volatile("" ::: "memory");
    }
};
struct JobFfn1 {
    Base F; int nM;
    __device__ __forceinline__ void fill(int L, Unit& u) const { int pm, pn; pg::tile_pm_pn(L, nM, 22, pm, pn);
        u.a0 = (const char*)(pm < 64 ? Ax + (size_t)pm * 256 * DM : Ac); u.a1 = u.a0; u.b = (const char*)(W13t + (size_t)pn * 256 * DM); u.d = nullptr; u.i0 = pm; u.i1 = pn; u.i2 = 0; u.i3 = 0; }
};
struct JobFfn2 {
    Base F; int nM;
    __device__ __forceinline__ void fill(int L, Unit& u) const { int pm, pn; pg::tile_pm_pn(L, nM, 4, pm, pn);
        u.a0 = (const char*)(pm < 64 ? Hb + (size_t)pm * 256 * DFF : Hc); u.a1 = u.a0; u.b = (const char*)(W2t + (size_t)pn * 256 * DFF); u.d = nullptr; u.i0 = pm; u.i1 = pn; u.i2 = 0; u.i3 = 0; }
};

struct EpiStore {
    static constexpr int NHOOK = 0; static constexpr int AFTER_DRAIN = 0; int h0, h1; int ldd;
    __device__ __forceinline__ void hook(acc_t&, const Unit&, int, int, int, int, int) const {}
    __device__ __forceinline__ void operator()(const acc_t& acc, const Unit& u, int wr, int wc, int fr, int fq) const {
        bf16_t* d = (bf16_t*)u.d;
        EPI_ROWS { EPI_COLS { *(u32x4*)(d + (size_t)EPI_ROW * ldd + EPI_COL0) = pack8(acc[ai][bj][m][0], acc[ai][bj][m][1]); }  asm volatile("" ::: "memory"); }
    }
};
struct EpiQK {
    static constexpr int NHOOK = 0; static constexpr int AFTER_DRAIN = 1; int h0, h1;
    Base F; int pair;
    __device__ __forceinline__ void hook(acc_t&, const Unit&, int, int, int, int, int) const {}
    __device__ __forceinline__ void operator()(const acc_t&, const Unit&, int, int, int, int) const {}
    __device__ __forceinline__ void fused(acc_t& acc, const Unit& u, int wr, int wc, int fr, int fq, LAS unsigned char* lds, int wid, int lane) const {
        const int pm = u.i0, pn = u.i1, hl = pn & 1, h = 2 * pair + hl; const bool isk = pn >= 2; const float lgf = lgp[h], lgb = lgp[4 + h]; const float* rope = ropeT;
        constexpr int PITCH = 528;
        const int tid = wid * 64 + lane, p8 = tid & 31;
        float zf[8], zb[8];
#pragma unroll
        for (int e = 0; e < 8; ++e) { const int jl = (pm * 256 + p8 * 8 + e) & (LS - 1); zf[e] = __expf(lgf * (float)(LS - 1 - jl)); zb[e] = __expf(lgb * (float)jl); }
#pragma unroll
        for (int bj = 0; bj < 2; ++bj) {
            EPI_ROWS { const int row = EPI_ROW, pos = pm * 256 + row, prow = pos >> 6, pcol = pos & 63;
                const int d0 = EPI_COL0, i0 = d0 >> 1, p = i0 < 64 ? prow : pcol, f0 = i0 & 63;
                const f32x4 t0 = *(const f32x4*)(rope + (size_t)(p * 64 + f0) * 2), t1 = *(const f32x4*)(rope + (size_t)(p * 64 + f0) * 2 + 4);
                f32x4 a = acc[ai][bj][m][0], b = acc[ai][bj][m][1];
                if (!isk) { a *= 0.0625f; b *= 0.0625f; }
                const f32x4 ra = {a[0] * t0[0] - a[1] * t0[1], a[0] * t0[1] + a[1] * t0[0], a[2] * t0[2] - a[3] * t0[3], a[2] * t0[3] + a[3] * t0[2]};
                const f32x4 rb = {b[0] * t1[0] - b[1] * t1[1], b[0] * t1[1] + b[1] * t1[0], b[2] * t1[2] - b[3] * t1[3], b[2] * t1[3] + b[3] * t1[2]};
                const u32x4 pk = pack8(ra, rb);
                if (!isk) *(u32x4*)(Qb + (size_t)pos * 512 + hl * 256 + d0) = pk;
                else { *(u32x4*)(Knb + (size_t)pos * 512 + hl * 256 + d0) = pk;
                    LAS unsigned short* tp = (LAS unsigned short*)(lds + (32 * wc + 8 * fq) * PITCH + row * 2);
                    tp[0 * PITCH / 2] = (unsigned short)pk.x; tp[1 * PITCH / 2] = (unsigned short)(pk.x >> 16); tp[2 * PITCH / 2] = (unsigned short)pk.y; tp[3 * PITCH / 2] = (unsigned short)(pk.y >> 16);
                    tp[4 * PITCH / 2] = (unsigned short)pk.z; tp[5 * PITCH / 2] = (unsigned short)(pk.z >> 16); tp[6 * PITCH / 2] = (unsigned short)pk.w; tp[7 * PITCH / 2] = (unsigned short)(pk.w >> 16); }
                if (m & 1) asm volatile("" ::: "memory"); }
            if (isk) {
                asm volatile("s_waitcnt lgkmcnt(0)" ::: "memory"); __builtin_amdgcn_s_barrier(); asm volatile("" ::: "memory");
#pragma unroll
                for (int k = 0; k < 8; ++k) { const int dl = (tid >> 5) + 16 * k;
                    f32x4 v0, v1; unpack8(*(const LAS u32x4*)(lds + dl * PITCH + p8 * 16), v0, v1);
                    const f32x4 f0v = {v0[0] * zf[0], v0[1] * zf[1], v0[2] * zf[2], v0[3] * zf[3]}, f1v = {v1[0] * zf[4], v1[1] * zf[5], v1[2] * zf[6], v1[3] * zf[7]};
                    const f32x4 b0v = {v0[0] * zb[0], v0[1] * zb[1], v0[2] * zb[2], v0[3] * zb[3]}, b1v = {v1[0] * zb[4], v1[1] * zb[5], v1[2] * zb[6], v1[3] * zb[7]};
                    const size_t o = (size_t)(hl * 256 + bj * 128 + dl) * SEQ + pm * 256 + p8 * 8;
                    *(u32x4*)(Ktb_ + o) = pack8(f0v, f1v); *(u32x4*)(Ktb_ + (size_t)512 * SEQ + o) = pack8(b0v, b1v); }
                asm volatile("s_waitcnt lgkmcnt(0)" ::: "memory"); __builtin_amdgcn_s_barrier(); asm volatile("" ::: "memory");
            }
        }
    }
};
struct EpiVT {
    static constexpr int NHOOK = 0; static constexpr int AFTER_DRAIN = 0; int h0, h1; Base F;
    __device__ __forceinline__ void hook(acc_t&, const Unit&, int, int, int, int, int) const {}
    __device__ __forceinline__ void operator()(const acc_t& acc, const Unit& u, int wr, int wc, int fr, int fq) const {
        const int hl = u.i0 >> 1, vt = u.i0 & 1, pn = u.i1;
        EPI_ROWS { const int v = vt * 256 + EPI_ROW;
            EPI_COLS { const int pos = pn * 256 + EPI_COL0, seg = pos >> 9, jl = pos & (LS - 1);
                *(u32x4*)(B4 + ((size_t)((hl * NSEG + seg) * 512 + v)) * 1024 + 512 + jl) = pack8(acc[ai][bj][m][0], acc[ai][bj][m][1]); }  asm volatile("" ::: "memory"); }
    }
};
struct EpiKc {
    static constexpr int NHOOK = 0; static constexpr int AFTER_DRAIN = 0; int h0, h1; Base F;
    __device__ __forceinline__ void hook(acc_t&, const Unit&, int, int, int, int, int) const {}
    __device__ __forceinline__ void operator()(const acc_t& acc, const Unit& u, int wr, int wc, int fr, int fq) const {
        const int h = u.i1; const float lgf = lgp[h], lgb = lgp[4 + h]; bf16_t* Kcf = KcT; bf16_t* Kcb = KcT + (size_t)1024 * CTX;
        EPI_ROWS { const int j = EPI_ROW; const float zf = __expf(lgf * (float)(CTX - 1 - j)), zb = __expf(lgb * (float)j);
            EPI_COLS { const int d0 = EPI_COL0;
#pragma unroll
                for (int e = 0; e < 8; ++e) { const float v = acc[ai][bj][m][e >> 2][e & 3]; const size_t o = (size_t)(h * 256 + d0 + e) * CTX + j;
                    Kcf[o] = f2bf(v * zf); Kcb[o] = f2bf(v * zb); } }  asm volatile("" ::: "memory"); }
    }
};
struct EpiVc {
    static constexpr int NHOOK = 0; static constexpr int AFTER_DRAIN = 0; int h0, h1; Base F;
    __device__ __forceinline__ void hook(acc_t&, const Unit&, int, int, int, int, int) const {}
    __device__ __forceinline__ void operator()(const acc_t& acc, const Unit& u, int wr, int wc, int fr, int fq) const {
        const int h = u.i0 >> 1, vt = u.i0 & 1;
        EPI_ROWS { const int v = vt * 256 + EPI_ROW;
            EPI_COLS { *(u32x4*)(VcT + (size_t)(h * 512 + v) * CTX + EPI_COL0) = pack8(acc[ai][bj][m][0], acc[ai][bj][m][1]); }  asm volatile("" ::: "memory"); }
    }
};
struct EpiS0 {
    static constexpr int NHOOK = 0; static constexpr int AFTER_DRAIN = 0; int h0, h1; Base F;
    __device__ __forceinline__ void hook(acc_t&, const Unit&, int, int, int, int, int) const {}
    __device__ __forceinline__ void operator()(const acc_t& acc, const Unit& u, int wr, int wc, int fr, int fq) const {
        EPI_ROWS { float* rowp = S0 + ((size_t)((u.i0 * 2 + u.i1) * 512 + u.i3 * 256 + EPI_ROW)) * 256;
            EPI_COLS { *(f32x4*)(rowp + EPI_COL0) = acc[ai][bj][m][0]; *(f32x4*)(rowp + EPI_COL0 + 4) = acc[ai][bj][m][1]; }  asm volatile("" ::: "memory"); }
    }
};
struct EpiU {
    static constexpr int NHOOK = 0; static constexpr int AFTER_DRAIN = 0; int h0, h1; Base F;
    __device__ __forceinline__ void hook(acc_t&, const Unit&, int, int, int, int, int) const {}
    __device__ __forceinline__ void operator()(const acc_t& acc, const Unit& u, int wr, int wc, int fr, int fq) const {
        EPI_ROWS { bf16_t* rowp = B4 + ((size_t)((u.i0 * NSEG + u.i2) * 512 + u.i3 * 256 + EPI_ROW)) * 1024 + u.i1 * 256;
            EPI_COLS { *(u32x4*)(rowp + EPI_COL0) = pack8(acc[ai][bj][m][0], acc[ai][bj][m][1]); }  asm volatile("" ::: "memory"); }
    }
};
struct EpiP {
    static constexpr int NHOOK = 0; static constexpr int AFTER_DRAIN = 0; int h0, h1; Base F; int pair;
    __device__ __forceinline__ void hook(acc_t&, const Unit&, int, int, int, int, int) const {}
    __device__ __forceinline__ void operator()(const acc_t& acc, const Unit& u, int wr, int wc, int fr, int fq) const {
        const int hl = u.i0, seg = u.i1, it = u.i2, jt = u.i3, h = 2 * pair + hl; const float l2f = lgp[h] * 1.44269504f, l2b = lgp[4 + h] * 1.44269504f;
        EPI_ROWS { const int il = it * 256 + EPI_ROW; bf16_t* rowp = Pb + (size_t)(seg * LS + il) * 1024 + hl * 512 + jt * 256;
            EPI_COLS { const int j0 = jt * 256 + EPI_COL0; f32x4 v[2];
#pragma unroll
                for (int e = 0; e < 8; ++e) { const int dl = il - (j0 + e); const float w = dl > 0 ? __builtin_amdgcn_exp2f((float)dl * l2f) : (dl < 0 ? __builtin_amdgcn_exp2f((float)(-dl) * l2b) : 2.0f);
                    v[e >> 2][e & 3] = acc[ai][bj][m][e >> 2][e & 3] * w; }
                *(u32x4*)(rowp + EPI_COL0) = pack8(v[0], v[1]); }  asm volatile("" ::: "memory"); }
    }
};
struct EpiO {
    static constexpr int NHOOK = 2; static constexpr int AFTER_DRAIN = 0; int h0, h1; Base F; int pair;
    __device__ __forceinline__ void hook(acc_t& acc, const Unit& u, int k, int wr, int wc, int fr, int fq) const {
        const int h = 2 * pair + u.i0; const float lgf = lgp[h], lgb = lgp[4 + h];
        EPI_ROWS { const int il = u.i2 * 256 + EPI_ROW; const float eb = lgb * (float)(LS - il);
            const float f = k == 0 ? __expf(lgf * (float)(il + 1) - eb) : __expf(eb);
#pragma unroll
            for (int bj = 0; bj < 2; ++bj) { acc[ai][bj][m][0] *= f; acc[ai][bj][m][1] *= f; }  asm volatile("" ::: "memory"); }
    }
    __device__ __forceinline__ void operator()(const acc_t& acc, const Unit& u, int wr, int wc, int fr, int fq) const {
        const int h = 2 * pair + u.i0;
        EPI_ROWS { bf16_t* rowp = Ob + (size_t)(u.i1 * LS + u.i2 * 256 + EPI_ROW) * 2048 + h * 512 + u.i3 * 256;
            EPI_COLS { *(u32x4*)(rowp + EPI_COL0) = pack8(acc[ai][bj][m][0], acc[ai][bj][m][1]); }  asm volatile("" ::: "memory"); }
    }
};
struct EpiG {
    static constexpr int NHOOK = 0; static constexpr int AFTER_DRAIN = 0; int h0, h1; Base F; const float* gnw; int rep; LAS unsigned char* stl;
    __device__ __forceinline__ void hook(acc_t&, const Unit&, int, int, int, int, int) const {}
    __device__ __forceinline__ void operator()(const acc_t& acc, const Unit& u, int wr, int wc, int fr, int fq) const {
        const int pm = u.i0, pn = u.i1, h = pn >> 1; u32x4 ov[1][4][2]; f32x2 st[1][4]; f32x4 gw[2][2];
#pragma unroll
        for (int bj = 0; bj < 2; ++bj) { gw[bj][0] = *(const f32x4*)(gnw + pn * 256 + EPI_COL0); gw[bj][1] = *(const f32x4*)(gnw + pn * 256 + EPI_COL0 + 4); }
#pragma unroll
        for (int ai = 0; ai < 2; ++ai) {
#pragma unroll
        for (int m = 0; m < 4; ++m) { const int pos = pm * 256 + EPI_ROW; st[0][m] = *(const LAS f32x2*)(stl + EPI_ROW * 8);
            EPI_COLS { ov[0][m][bj] = *(const u32x4*)(Ob + (size_t)pos * 2048 + pn * 256 + EPI_COL0); } }
#pragma unroll
        for (int m = 0; m < 4; ++m) { const int pos = pm * 256 + EPI_ROW; const f32x2 s2 = st[0][m];
            EPI_COLS { bf16_t* p = Ob + (size_t)pos * 2048 + pn * 256 + EPI_COL0; f32x4 o0, o1; unpack8(ov[0][m][bj], o0, o1);
                const f32x4 g0 = acc[ai][bj][m][0], g1 = acc[ai][bj][m][1]; f32x4 r0, r1;
#pragma unroll
                for (int e = 0; e < 4; ++e) { r0[e] = DBG_NORET ? 0.f : fsilu(g0[e]) * ((o0[e] - s2.x) * s2.y) * gw[bj][0][e]; r1[e] = DBG_NORET ? 0.f : fsilu(g1[e]) * ((o1[e] - s2.x) * s2.y) * gw[bj][1][e]; }
                *(u32x4*)p = rep == 0 ? pack8(r0, r1) : ov[0][m][bj]; } }
        asm volatile("" ::: "memory"); }
    }
};
struct EpiF {
    static constexpr int NHOOK = 0; static constexpr int AFTER_DRAIN = 0; int h0, h1; Base F;
    __device__ __forceinline__ void hook(acc_t&, const Unit&, int, int, int, int, int) const {}
    __device__ __forceinline__ void operator()(const acc_t& acc, const Unit& u, int wr, int wc, int fr, int fq) const {
        EPI_ROWS { const int mrow = u.i0 * 256 + EPI_ROW, ri = mrow >> 10, ch = mrow & 1023;
            EPI_COLS { const int c0 = EPI_COL0, l2 = 2 * u.i1 + (c0 >> 7), l1 = c0 & 127;
                *(u32x4*)(Wt + (size_t)(ch * 128 + l2) * 256 + ri * 128 + l1) = pack8(acc[ai][bj][m][0], acc[ai][bj][m][1]); }  asm volatile("" ::: "memory"); }
    }
};
struct EpiF1 {
    static constexpr int NHOOK = 0; static constexpr int AFTER_DRAIN = 0; int h0, h1; Base F;
    __device__ __forceinline__ void hook(acc_t&, const Unit&, int, int, int, int, int) const {}
    __device__ __forceinline__ void operator()(const acc_t& acc, const Unit& u, int wr, int wc, int fr, int fq) const {
        EPI_ROWS { const int r = EPI_ROW, k1 = r >> 1, ri = r & 1; const float sg = ri ? -1.0f : 1.0f;
            EPI_COLS { const int n = u.i1 * 256 + EPI_COL0, ch = n >> 7, l2 = n & 127; f32x4 v[2];
#pragma unroll
                for (int e = 0; e < 8; ++e) { const float rev = (float)((k1 * (l2 + e)) & 16383) * (1.0f / 16384.0f);
                    const float cs = __builtin_amdgcn_cosf(rev), sn = __builtin_amdgcn_sinf(rev); const float mine = acc[ai][bj][m][e >> 2][e & 3], other = __shfl_xor(mine, 1);
                    v[e >> 2][e & 3] = mine * cs + sg * other * sn; }
                *(u32x4*)(Bt + (size_t)(k1 * 1024 + ch) * 256 + ri * 128 + l2) = pack8(v[0], v[1]); }  asm volatile("" ::: "memory"); }
    }
};
struct EpiF2 {
    static constexpr int NHOOK = 0; static constexpr int AFTER_DRAIN = 0; int h0, h1; Base F;
    __device__ __forceinline__ void hook(acc_t&, const Unit&, int, int, int, int, int) const {}
    __device__ __forceinline__ void operator()(const acc_t& acc, const Unit& u, int wr, int wc, int fr, int fq) const {
        const int k1 = u.i1 >> 2, chb = (u.i1 & 3) * 256;
#pragma unroll
        for (int m = 0; m < 4; ++m) { const int k2 = 64 * wr + 16 * m + fr; bf16_t* rowp = MIXb + (size_t)(k1 + 128 * k2) * 2048 + chb;
            EPI_COLS { *(u32x4*)(rowp + EPI_COL0) = pack8(acc[0][bj][m][0], acc[0][bj][m][1]); } }
    }
};
struct EpiGate {
    static constexpr int NHOOK = 0; static constexpr int AFTER_DRAIN = 0; int h0, h1; Base F;
    __device__ __forceinline__ void hook(acc_t&, const Unit&, int, int, int, int, int) const {}
    __device__ __forceinline__ void operator()(const acc_t& acc, const Unit& u, int wr, int wc, int fr, int fq) const {
        bf16_t* dst = (u.i1 >> 2) ? GFb : GAb; const int cb = (u.i1 & 3) * 256;
        EPI_ROWS { bf16_t* rowp = dst + (size_t)(u.i0 * 256 + EPI_ROW) * DM + cb;
            EPI_COLS { f32x4 s0, s1;
#pragma unroll
                for (int e = 0; e < 4; ++e) { s0[e] = fsigmoid(acc[ai][bj][m][0][e]); s1[e] = fsigmoid(acc[ai][bj][m][1][e]); }
                *(u32x4*)(rowp + EPI_COL0) = pack8(s0, s1); }  asm volatile("" ::: "memory"); }
    }
};
struct EpiZ {
    static constexpr int NHOOK = 1; static constexpr int AFTER_DRAIN = 0; int h0, h1; Base F;
    __device__ __forceinline__ void hook(acc_t& acc, const Unit& u, int, int wr, int wc, int fr, int fq) const {
        EPI_ROWS { const size_t ro = (size_t)(u.i0 * 256 + EPI_ROW) * DM + u.i1 * 256;
            EPI_COLS { f32x4 a0, a1, f0, f1; unpack8(*(const u32x4*)(GAb + ro + EPI_COL0), a0, a1); unpack8(*(const u32x4*)(GFb + ro + EPI_COL0), f0, f1);
#pragma unroll
                for (int e = 0; e < 4; ++e) { acc[ai][bj][m][0][e] *= DBG_NOFOUR ? 0.f : f0[e] * __builtin_amdgcn_rcpf(fmaxf(a0[e], 1e-30f)); acc[ai][bj][m][1][e] *= DBG_NOFOUR ? 0.f : f1[e] * __builtin_amdgcn_rcpf(fmaxf(a1[e], 1e-30f)); } }  asm volatile("" ::: "memory"); }
    }
    __device__ __forceinline__ void operator()(const acc_t& acc, const Unit& u, int wr, int wc, int fr, int fq) const {
        EPI_ROWS { const size_t ro = (size_t)(u.i0 * 256 + EPI_ROW) * DM + u.i1 * 256;
            EPI_COLS { f32x4 a0, a1; unpack8(*(const u32x4*)(GAb + ro + EPI_COL0), a0, a1); f32x4 v0, v1;
#pragma unroll
                for (int e = 0; e < 4; ++e) { v0[e] = acc[ai][bj][m][0][e] * fmaxf(a0[e], 1e-30f); v1[e] = acc[ai][bj][m][1][e] * fmaxf(a1[e], 1e-30f); }
                *(u32x4*)(Zb + ro + EPI_COL0) = pack8(v0, v1); }  asm volatile("" ::: "memory"); }
    }
};

struct EpiSlab {
    static constexpr int NHOOK = 0; static constexpr int AFTER_DRAIN = 0; int h0, h1; Base F;
    __device__ __forceinline__ void hook(acc_t&, const Unit&, int, int, int, int, int) const {}
    __device__ __forceinline__ void operator()(const acc_t& acc, const Unit& u, int wr, int wc, int fr, int fq) const {
        float* dst = XcSlab + (size_t)u.i2 * CTX * DM + u.i1 * 256;
        EPI_ROWS { float* rowp = dst + (size_t)EPI_ROW * DM;
            EPI_COLS { *(f32x4*)(rowp + EPI_COL0) = acc[ai][bj][m][0]; *(f32x4*)(rowp + EPI_COL0 + 4) = acc[ai][bj][m][1]; } }
    }
};
struct JobCtxG2 {
    Base F;
    __device__ __forceinline__ void fill(int L, Unit& u) const { const int pn = L & 3, kc = L >> 2;
        u.a0 = (const char*)(Hc + kc * 256); u.a1 = u.a0; u.b = (const char*)(W2t + (size_t)pn * 256 * DFF + kc * 256); u.d = nullptr; u.i0 = 64; u.i1 = pn; u.i2 = kc; u.i3 = 0; }
};
struct EpiZ2 {
    static constexpr int NHOOK = 0; static constexpr int AFTER_DRAIN = 0; int h0, h1; Base F; int part;
    __device__ __forceinline__ void hook(acc_t&, const Unit&, int, int, int, int, int) const {}
    __device__ __forceinline__ void operator()(const acc_t& acc, const Unit& u, int wr, int wc, int fr, int fq) const {
        const bf16_t* G = part ? GAb : GFb;
#pragma unroll
        for (int ai = 0; ai < 2; ++ai) { u32x4 gv[4][2], tv[4][2];
#pragma unroll
            for (int m = 0; m < 4; ++m) { const size_t ro = (size_t)(u.i0 * 256 + EPI_ROW) * DM + u.i1 * 256, zo = (size_t)(u.i0 * 256 + EPI_ROW) * 2048 + u.i1 * 256;
                EPI_COLS { gv[m][bj] = *(const u32x4*)(G + ro + EPI_COL0); if (part) tv[m][bj] = *(const u32x4*)(Zb + zo + EPI_COL0); } }
#pragma unroll
            for (int m = 0; m < 4; ++m) { const size_t zo = (size_t)(u.i0 * 256 + EPI_ROW) * 2048 + u.i1 * 256;
                EPI_COLS { f32x4 g0, g1; unpack8(gv[m][bj], g0, g1); f32x4 v0 = acc[ai][bj][m][0] * g0, v1 = acc[ai][bj][m][1] * g1;
                    if (part) { f32x4 t0, t1; unpack8(tv[m][bj], t0, t1); v0 += t0; v1 += t1; }
                    *(u32x4*)(Zb + zo + EPI_COL0) = pack8(v0, v1); } }
            asm volatile("" ::: "memory"); }
    }
};
struct JobGate2 {
    Base F;
    __device__ __forceinline__ void fill(int L, Unit& u) const { const int c = L & 255, which = L >> 8; int pm, pn; pg::tile_pm_pn(c, 64, 4, pm, pn);
        u.a0 = (const char*)(Ax + (size_t)pm * 256 * DM); u.a1 = u.a0; u.b = (const char*)(Win + (size_t)(WR_GA + which * 1024 + pn * 256) * DM); u.d = nullptr; u.i0 = pm; u.i1 = which * 4 + pn; u.i2 = 0; u.i3 = 0; }
};
struct JobG2 {
    Base F;
    __device__ __forceinline__ void fill(int L, Unit& u) const { const int c = L & 255, half = L >> 8, pm = c >> 2, pn = 2 * (c & 3) + half;
        u.a0 = (const char*)(Ax + (size_t)pm * 256 * DM); u.a1 = u.a0; u.b = (const char*)(Win + (size_t)(WR_G + pn * 256) * DM); u.d = nullptr; u.i0 = pm; u.i1 = pn; u.i2 = 0; u.i3 = 0; }
};
struct JobFold {
    Base F;
    __device__ __forceinline__ void fill(int L, Unit& u) const { const int pn = L & 3, pm = (L >> 2) & 1, g = L >> 3;
        u.a0 = (const char*)(T256 + (size_t)pm * 256 * 256); u.a1 = u.a0; u.b = (const char*)(Wn + (size_t)pn * 256 * DM + g * 256);
        u.d = (char*)(Win + (size_t)(WR_F + pm * 1024 + g * 256) * DM + pn * 256); u.i0 = pm; u.i1 = pn; u.i2 = g; u.i3 = 0; }
};
struct JobRowCol {
    Base F; int sel, nM, nN; size_t aoff0, boff0, astep, bstep;
    __device__ __forceinline__ void fill(int L, Unit& u) const { int pm, pn; pg::tile_pm_pn(L, nM, nN, pm, pn);
        const bf16_t* A = sel == 0 ? Ax : (sel == 1 ? Win : Zb); const bf16_t* B = sel == 0 ? Win : (sel == 1 ? Ax : WoT);
        u.a0 = (const char*)(A + aoff0 + (size_t)pm * astep); u.a1 = u.a0; u.b = (const char*)(B + boff0 + (size_t)pn * bstep); u.d = nullptr; u.i0 = pm; u.i1 = pn; u.i2 = 0; u.i3 = 0; }
};
struct JobKc {
    Base F;
    __device__ __forceinline__ void fill(int L, Unit& u) const { const int h = L; u.a0 = (const char*)Ac; u.a1 = u.a0;
        u.b = (const char*)(Win + (size_t)((h >> 1) * 2048 + 512 + (h & 1) * 256) * DM); u.d = nullptr; u.i0 = 0; u.i1 = h; u.i2 = 0; u.i3 = 0; }
};
struct JobVc {
    Base F;
    __device__ __forceinline__ void fill(int L, Unit& u) const { const int t = L, h = t >> 1; u.a0 = (const char*)(Win + (size_t)((h >> 1) * 2048 + 1024 + (h & 1) * 512 + (t & 1) * 256) * DM); u.a1 = u.a0;
        u.b = (const char*)Ac; u.d = nullptr; u.i0 = t; u.i1 = 0; u.i2 = 0; u.i3 = 0; }
};
struct JobS0 {
    Base F;
    __device__ __forceinline__ void fill(int L, Unit& u) const { const int h = L >> 2, dir = (L >> 1) & 1, vt = L & 1;
        u.a0 = (const char*)(VcT + (size_t)(h * 512 + vt * 256) * CTX); u.a1 = u.a0; u.b = (const char*)(KcT + (size_t)dir * 1024 * CTX + (size_t)(h * 256) * CTX);
        u.d = nullptr; u.i0 = h; u.i1 = dir; u.i2 = 0; u.i3 = vt; }
};
struct JobR1 {
    Base F;
    __device__ __forceinline__ void fill(int L, Unit& u) const { const int w = pg::xcd_contig(L, 256), vt = w & 1, dir = (w >> 1) & 1, seg = (w >> 2) & 31, hl = w >> 7;
        u.a0 = (const char*)(B4 + ((size_t)((hl * NSEG + seg) * 512 + vt * 256)) * 1024 + 512); u.a1 = u.a0;
        u.b = (const char*)(Ktb_ + (size_t)dir * 512 * SEQ + (size_t)(hl * 256) * SEQ + seg * LS); u.d = nullptr; u.i0 = hl; u.i1 = dir; u.i2 = seg; u.i3 = vt; }
};
struct JobR3 {
    Base F;
    __device__ __forceinline__ void fill(int L, Unit& u) const { const int w = pg::xcd_contig(L, 256), jt = w & 1, it = (w >> 1) & 1, seg = (w >> 2) & 31, hl = w >> 7;
        u.a0 = (const char*)(Qb + (size_t)(seg * LS + it * 256) * 512 + hl * 256); u.a1 = u.a0; u.b = (const char*)(Knb + (size_t)(seg * LS + jt * 256) * 512 + hl * 256);
        u.d = nullptr; u.i0 = hl; u.i1 = seg; u.i2 = it; u.i3 = jt; }
};
struct JobR4 {
    Base F;
    __device__ __forceinline__ void fill(int L, Unit& u) const { const int w = pg::xcd_contig(L, 256), vt = w & 1, it = (w >> 1) & 1, seg = (w >> 2) & 31, hl = w >> 7;
        u.a0 = (const char*)(Qb + (size_t)(seg * LS + it * 256) * 512 + hl * 256); u.a1 = (const char*)(Pb + (size_t)(seg * LS + it * 256) * 1024 + hl * 512);
        u.b = (const char*)(B4 + ((size_t)((hl * NSEG + seg) * 512 + vt * 256)) * 1024); u.d = nullptr; u.i0 = hl; u.i1 = seg; u.i2 = it; u.i3 = vt; }
};
struct JobF1 {
    Base F;
    __device__ __forceinline__ void fill(int L, Unit& u) const { u.a0 = (const char*)FmT; u.a1 = u.a0; u.b = (const char*)(Wt + (size_t)L * 256 * 256); u.d = nullptr; u.i0 = 0; u.i1 = L; u.i2 = 0; u.i3 = 0; }
};
struct JobF2 {
    Base F;
    __device__ __forceinline__ void fill(int L, Unit& u) const { u.a0 = (const char*)GmT; u.a1 = u.a0; u.b = (const char*)(Bt + (size_t)L * 256 * 256); u.d = nullptr; u.i0 = 0; u.i1 = L; u.i2 = 0; u.i3 = 0; }
};
struct JobZ {
    Base F; int part;
    __device__ __forceinline__ void fill(int L, Unit& u) const { int pm, pn; pg::tile_pm_pn(L, 64, 4, pm, pn);
        u.a0 = (const char*)((part ? Ob : MIXb) + (size_t)pm * 256 * 2048); u.a1 = u.a0; u.b = (const char*)(Bz + (size_t)pn * 256 * 3072 + (part ? 1024 : 0)); u.d = nullptr; u.i0 = pm; u.i1 = pn; u.i2 = 0; u.i3 = 0; }
};

#define XB_TMO      128
#define XB_XCNT(j)  (256  + 64 * (j))
#define XB_XSUB(j)  (1280 + 64 * (j))
#define XB_XGEN(j)  (2304 + 64 * (j))
#define XB_TOP      3328
#define XB_TOPGEN   3392
#define XCD_BAR_WORDS 3456
#define XB_SPIN_CAP (1u << 22)
__device__ __forceinline__ unsigned xb_ld(unsigned* p)              { return __hip_atomic_load(p, __ATOMIC_RELAXED, __HIP_MEMORY_SCOPE_AGENT); }
__device__ __forceinline__ unsigned xb_add(unsigned* p, unsigned v) { return __hip_atomic_fetch_add(p, v, __ATOMIC_RELAXED, __HIP_MEMORY_SCOPE_AGENT); }
__device__ __forceinline__ unsigned xb_xcc_id() { return (unsigned)__builtin_amdgcn_s_getreg((3 << 11) | 20) & 0xFu; }
#define XB_SPIN(cond, bar) do { unsigned _sp = 0; while (cond) { __builtin_amdgcn_s_sleep(1); \
    if ((++_sp & 255u) == 0u) { if (xb_ld(&(bar)[XB_TMO])) break; if (_sp > XB_SPIN_CAP) { atomicAdd(&(bar)[XB_TMO], 1u); break; } } } } while (0)
struct XcdBarrier { unsigned* bar; unsigned x; volatile LAS unsigned* st; };
__device__ __forceinline__ XcdBarrier xcd_barrier_post(unsigned* bar, volatile LAS unsigned* st) {
    XcdBarrier b; b.bar = bar; b.x = xb_xcc_id(); b.st = st;
    if (threadIdx.x == 0) (void)xb_add(&bar[XB_XCNT(b.x)], 1u);
    return b;
}
__device__ __forceinline__ void xcd_barrier_complete(unsigned* bar, unsigned x, unsigned& nloc, unsigned& nx) {
    const unsigned G = gridDim.x * gridDim.y * gridDim.z;
    unsigned sum, cnt, mine, sp = 0u;
    for (;;) {
        sum = 0u; cnt = 0u; mine = 0u;
#pragma unroll
        for (unsigned j = 0; j < 16; ++j) { const unsigned c = xb_ld(&bar[XB_XCNT(j)]); sum += c; cnt += (c > 0u) ? 1u : 0u; mine = (j == x) ? c : mine; }
        if (sum == G) break;
        __builtin_amdgcn_s_sleep(1);
        if ((++sp & 255u) == 0u) { if (xb_ld(&bar[XB_TMO])) break; if (sp > XB_SPIN_CAP) { atomicAdd(&bar[XB_TMO], 1u); break; } }
    }
    nloc = mine > 0u ? mine : 1u; nx = cnt > 0u ? cnt : 1u;
}
__device__ __attribute__((noinline)) void xcd_barrier(unsigned* bar_, unsigned bx_, volatile LAS unsigned* st_) {
    XcdBarrier b; b.bar = bar_; b.x = bx_; b.st = st_;
    asm volatile("s_waitcnt vmcnt(0)" ::: "memory");
    __syncthreads();
    if (threadIdx.x == 0) {
        unsigned* bar = b.bar;
        __builtin_amdgcn_s_waitcnt(0);
        unsigned nloc = b.st[0], nx = b.st[1];
        if (nloc == 0u) { xcd_barrier_complete(bar, b.x, nloc, nx); b.st[0] = nloc; b.st[1] = nx; }
        const unsigned old = xb_add(&bar[XB_XSUB(b.x)], 1u);
        const unsigned gen = old / nloc;
        if (old + 1u == (gen + 1u) * nloc) {
            __builtin_amdgcn_fence(__ATOMIC_RELEASE, "agent");
            asm volatile("s_waitcnt vmcnt(0)" ::: "memory");
            const unsigned og = xb_add(&bar[XB_TOP], 1u);
            const unsigned tg = og / nx;
            if (og + 1u == (tg + 1u) * nx) xb_add(&bar[XB_TOPGEN], 1u);
            else XB_SPIN(xb_ld(&bar[XB_TOPGEN]) == tg, bar);
            __builtin_amdgcn_fence(__ATOMIC_ACQUIRE, "agent");
            xb_add(&bar[XB_XGEN(b.x)], 1u);
            asm volatile("s_waitcnt vmcnt(0)" ::: "memory");
        } else {
            XB_SPIN(xb_ld(&bar[XB_XGEN(b.x)]) == gen, bar);
            __builtin_amdgcn_fence(__ATOMIC_ACQUIRE, "agent");
            asm volatile("s_waitcnt vmcnt(0)" ::: "memory");
        }
    }
    __syncthreads();
}

constexpr int NWAVES = 8, NTHREADS = 512;
constexpr int RING_BYTES = 131072, MISC_OFF = RING_BYTES + 320, LDS_BYTES = 147456;
constexpr int CW_BAR = 4096;

struct Args { const float* in[21]; float* out; unsigned char* ws; int ph_lo, ph_hi; };

struct Ctx {
    LAS unsigned char* lds; int tid, lane, wave, G, vcu;
    unsigned char* ws; unsigned char* dout;
};
#define F_WS (F.ws)
#define F_DOUT (F.dout)

__device__ __forceinline__ void gemv_item(const Ctx& F, int item, const float* W, const float* b, const float* c, const float* cc) {
    LAS float* scr = (LAS float*)F.lds;
    const int cg = F.tid & 7, rg = F.tid >> 3, n0 = item * 32 + cg * 4;
    f32x4 ax = {0.f, 0.f, 0.f, 0.f}, ac = {0.f, 0.f, 0.f, 0.f};
#pragma unroll 4
    for (int k = rg; k < DM; k += 64) { const f32x4 w = *(const f32x4*)(W + (size_t)k * 9216 + n0); const float sx = c[k], sc = cc[k];
        ax += w * (sx / (1.f + expf(-sx))); ac += w * (sc / (1.f + expf(-sc))); }
    __syncthreads();
#pragma unroll
    for (int e = 0; e < 4; ++e) { scr[(rg * 8 + cg) * 8 + e] = ax[e]; scr[(rg * 8 + cg) * 8 + 4 + e] = ac[e]; }
    __syncthreads();
    if (F.tid < 64) { const int which = F.tid >> 5, col = F.tid & 31, g = col >> 2, e = col & 3; float s = 0.f;
        for (int r = 0; r < 64; ++r) s += scr[(r * 8 + g) * 8 + which * 4 + e];
        (which ? modc : modx)[item * 32 + col] = s + b[item * 32 + col]; }
    __syncthreads();
}
struct TrDesc { const float* W; int K, N; bf16_t* dst; int ld, coloff, kind; };
__device__ __forceinline__ int tr_dest_row(int kind, int n) {
    switch (kind) {
    case 0: { const int isb = n >= DFF, j = isb ? n - DFF : n; return 256 * (j >> 7) + 128 * isb + (j & 127); }
    case 2: {
        if (n < 1024) { const int h = n >> 8, d = n & 255; return (h >> 1) * 2048 + (h & 1) * 256 + d; }
        if (n < 2048) { const int h = (n - 1024) >> 8, d = n & 255; return (h >> 1) * 2048 + 512 + (h & 1) * 256 + d; }
        if (n < 4096) { const int h = (n - 2048) >> 9, v = (n - 2048) & 511; return (h >> 1) * 2048 + 1024 + (h & 1) * 512 + v; }
        if (n < 6144) return WR_G + (n - 4096);
        if (n < 7168) return -1;
        if (n < 8192) return WR_GA + (n - 7168);
        return WR_GF + (n - 8192); }
    default: return n; }
}
__device__ __forceinline__ void tr_item(const TrDesc& t, LAS float* scr, int item, int lane) {
    const int nblk = t.N / 32, kb = item / nblk, nb = item % nblk, k0 = 64 * kb, n0 = 32 * nb;
    if (t.kind == 2 && n0 >= 6144 && n0 < 7168) return;
#pragma unroll
    for (int i = 0; i < 8; ++i) { const int kk = 8 * i + (lane >> 3), c4 = (lane & 7) * 4; const f32x4 v = *(const f32x4*)(t.W + (size_t)(k0 + kk) * t.N + n0 + c4);
        scr[kk * 33 + c4] = v[0]; scr[kk * 33 + c4 + 1] = v[1]; scr[kk * 33 + c4 + 2] = v[2]; scr[kk * 33 + c4 + 3] = v[3]; }
    asm volatile("s_waitcnt lgkmcnt(0)" ::: "memory");
    const int c = lane & 7;
#pragma unroll
    for (int j = 0; j < 4; ++j) { const int n = (lane >> 3) + 8 * j; const LAS float* s = scr + (8 * c) * 33 + n;
        u32x4 o; o.x = cvt_pk_bf16(s[0 * 33], s[1 * 33]); o.y = cvt_pk_bf16(s[2 * 33], s[3 * 33]); o.z = cvt_pk_bf16(s[4 * 33], s[5 * 33]); o.w = cvt_pk_bf16(s[6 * 33], s[7 * 33]);
        const int dr = tr_dest_row(t.kind, n0 + n);
        *(u32x4*)(t.dst + (size_t)dr * t.ld + t.coloff + k0 + 8 * c) = o; }
    asm volatile("s_waitcnt lgkmcnt(0)" ::: "memory");
}
__device__ __forceinline__ void tr_all(const Ctx& F, const TrDesc& t) {
    LAS float* scr = (LAS float*)(F.lds + F.wave * 16384);
    const int gw = F.vcu * NWAVES + F.wave, NGW = F.G * NWAVES, nitems = (t.K / 64) * (t.N / 32);
    for (int it = gw; it < nitems; it += NGW) tr_item(t, scr, it, F.lane);
}
__device__ __forceinline__ void norm_rows(const Ctx& F, const float* xin, const float* cin, const float* nw, int modoff, const bf16_t* dx, const float* dcf, bool has_delta, int row0, int nrows) {
    const int gw = F.vcu * NWAVES + F.wave, NGW = F.G * NWAVES;
    for (int r = row0 + gw; r < nrows; r += NGW) {
        const bool isx = r < SEQ; const int rr = isx ? r : r - SEQ;
        const float* xr = (isx ? xin : cin) + (size_t)rr * DM; const bf16_t* dr = dx + (size_t)rr * DM; const float* drf = dcf + (size_t)rr * DM;
        const float* md = (isx ? modx : modc) + modoff; bf16_t* orow = (isx ? Ax : Ac) + (size_t)rr * DM;
        f32x4 v[4]; float ss = 0.f;
#pragma unroll
        for (int j = 0; j < 4; ++j) { v[j] = *(const f32x4*)(xr + 256 * j + 4 * F.lane);
            if (has_delta) { if (isx) { const u32x2 d = *(const u32x2*)(dr + 256 * j + 4 * F.lane); v[j] += (f32x4){bflo(d.x), bfhi(d.x), bflo(d.y), bfhi(d.y)}; } else { f32x4 sacc = {0.f, 0.f, 0.f, 0.f};
#pragma unroll
                for (int kc = 0; kc < 11; ++kc) sacc += *(const f32x4*)(drf + (size_t)kc * CTX * DM + 256 * j + 4 * F.lane);
                v[j] += sacc * (*(const f32x4*)(modc + 2 * DM + 256 * j + 4 * F.lane)) * 0.5f; } }
            ss += (v[j][0] * v[j][0] + v[j][1] * v[j][1]) + (v[j][2] * v[j][2] + v[j][3] * v[j][3]); }
        const float rinv = 1.0f / sqrtf(wave_sum(ss) * (1.f / DM) + EPS);
#pragma unroll
        for (int j = 0; j < 4; ++j) { const int c = 256 * j + 4 * F.lane; const f32x4 w = *(const f32x4*)(nw + c), sh = *(const f32x4*)(md + c), sc = *(const f32x4*)(md + 1024 + c);
            const f32x4 y = (v[j] * rinv) * w * (sc + 1.0f) + sh; u32x2 o; o.x = cvt_pk_bf16(y[0], y[1]); o.y = cvt_pk_bf16(y[2], y[3]);
            *(u32x2*)(orow + c) = o; }
    }
}
__device__ __forceinline__ void final_norm(const Ctx& F, const float* xin, const float* nw, const bf16_t* dx) {
    float* out = (float*)F_DOUT;
    const int gw = F.vcu * NWAVES + F.wave, NGW = F.G * NWAVES;
    for (int r = gw; r < SEQ; r += NGW) {
        const float* xr = xin + (size_t)r * DM; const bf16_t* dr = dx + (size_t)r * DM;
        f32x4 v[4]; float ss = 0.f;
#pragma unroll
        for (int j = 0; j < 4; ++j) { v[j] = *(const f32x4*)(xr + 256 * j + 4 * F.lane);
            const u32x2 d = *(const u32x2*)(dr + 256 * j + 4 * F.lane); v[j] += (f32x4){bflo(d.x), bfhi(d.x), bflo(d.y), bfhi(d.y)};
            ss += (v[j][0] * v[j][0] + v[j][1] * v[j][1]) + (v[j][2] * v[j][2] + v[j][3] * v[j][3]); }
        const float rinv = 1.0f / sqrtf(wave_sum(ss) * (1.f / DM) + EPS);
#pragma unroll
        for (int j = 0; j < 4; ++j) { const int c = 256 * j + 4 * F.lane; *(f32x4*)(out + (size_t)r * DM + c) = (v[j] * rinv) * *(const f32x4*)(nw + c); }
    }
}
__device__ __forceinline__ void copy_delta(const Ctx& F, const bf16_t* src, bf16_t* dst) {
    const size_t n16 = (size_t)SEQ * DM * 2 / 16; const u32x4* s = (const u32x4*)src; u32x4* d = (u32x4*)dst;
    for (size_t i = (size_t)F.vcu * NTHREADS + F.tid; i < n16; i += (size_t)F.G * NTHREADS) d[i] = s[i];
}


__device__ __forceinline__ float block_sum(LAS float* scr, float v, int tid) {
    v = wave_sum(v); __syncthreads(); if ((tid & 63) == 0) scr[tid >> 6] = v; __syncthreads();
    float s = 0.f; for (int i = 0; i < NWAVES; ++i) s += scr[i]; __syncthreads(); return s;
}
__device__ __forceinline__ void dbg_report(unsigned* word, float ref, float got, float floor_) {
    const float e = fabsf(got - ref) / fmaxf(fabsf(ref), floor_); atomicMax(word, __builtin_bit_cast(unsigned, e)); if (e > 0.05f) atomicAdd(word + 64, 1u);
}
__device__ __forceinline__ float bf2f(bf16_t b) { return __builtin_bit_cast(float, (unsigned)b << 16); }

__global__ void __launch_bounds__(NTHREADS, 2) fwd_kernel(Args args) {
    extern __shared__ __attribute__((aligned(16))) unsigned char lds_raw[];
    Ctx F;
    F.lds = (LAS unsigned char*)lds_raw;
    F.tid = threadIdx.x; F.lane = F.tid & 63; F.wave = __builtin_amdgcn_readfirstlane(F.tid >> 6);
    F.G = gridDim.x; { const int bx = blockIdx.x; F.vcu = (F.G % 8 == 0) ? (bx % 8) * (F.G / 8) + bx / 8 : bx; }
    F.ws = args.ws; F.dout = (unsigned char*)args.out;
    volatile LAS unsigned* MISC = (volatile LAS unsigned*)(F.lds + MISC_OFF);
    for (int u = F.tid; u < (LDS_BYTES - RING_BYTES) / 4; u += NTHREADS) ((LAS unsigned*)(F.lds + RING_BYTES))[u] = 0u;
    __syncthreads();
    unsigned* ctl = (unsigned*)(F_WS + WS_CTL);
    XcdBarrier bar = xcd_barrier_post(ctl + CW_BAR, MISC + 8);
    const int lo = args.ph_lo, hi = args.ph_hi;
    int phase = 0;
#define PHASE_BEGIN if (phase >= lo && phase < hi) { for (int _rep = 0; _rep < ((DBG_DUP >= 0 && phase == DBG_DUP) ? 2 : 1); ++_rep) { asm volatile("; MARK %0" :: "i"(__LINE__)); { unsigned char* _w = args.ws; unsigned char* _o = (unsigned char*)args.out; int _t = threadIdx.x; asm volatile("" : "+s"(_w), "+s"(_o), "+v"(_t)); F.ws = _w; F.dout = _o; F.tid = _t; F.lane = _t & 63; }
#define PHASE_END   } if (phase + 1 < hi) xcd_barrier((unsigned*)(F.ws + WS_CTL) + CW_BAR, bar.x, MISC + 8); if (DBG_TSEL >= 0 && bx == 0 && F.tid == 0) ((unsigned long long*)(F.ws + WS_CTL + 160000))[phase + 1] = __builtin_amdgcn_s_memrealtime(); } ++phase;
    const int bx = (int)blockIdx.x;

#define gtid ((size_t)F.vcu * NTHREADS + F.tid)
#define gthreads ((size_t)F.G * NTHREADS)
#define FB (Base{F.ws, F.dout})
    const Geo gK1024{DM, DM, DM, 128u * DM * 2u, 128u * DM * 2u, 128u * DM * 2u, DM / 64, 1 << 20, 1 << 20};
    const Geo gFfn2{DFF, DFF, DFF, 128u * DFF * 2u, 128u * DFF * 2u, 128u * DFF * 2u, DFF / 64, 1 << 20, 1 << 20};

    if (DBG_TSEL >= 0 && bx == 0 && threadIdx.x == 0) ((unsigned long long*)(args.ws + WS_CTL + 160000))[0] = __builtin_amdgcn_s_memrealtime();
    PHASE_BEGIN
        for (int it = F.vcu; it < 288; it += F.G) gemv_item(F, it, args.in[4], args.in[5], args.in[1], args.in[3]);
        __syncthreads();
        if (gtid == 0) { ((unsigned*)(F.ws + WS_CTL))[32768 + 192] = 255u; ((unsigned*)(F.ws + WS_CTL))[32768 + 193] = 255u; }
        if (gtid < 8) { const float x = (gtid < 4 ? args.in[11] : args.in[12])[gtid & 3]; modx[2 * 9216 + gtid] = -log1pf(expf(-x)); }
        for (size_t i = gtid; i < 256 * 64; i += gthreads) { const int p = (int)(i >> 6), f = (int)(i & 63); const float inv = powf(10000.0f, -(float)f / 64.0f), ang = (float)p * inv;
            ropeT[2 * i] = cosf(ang); ropeT[2 * i + 1] = sinf(ang); }
        for (size_t i = gtid; i < 128 * 128; i += gthreads) { const int k1 = (int)(i >> 7), l2 = (int)(i & 127); const float a = (float)((k1 * l2) & 16383) * (1.0f / 8192.0f);
            twT[2 * i] = cospif(a); twT[2 * i + 1] = sinpif(a); }
        for (size_t i = gtid; i < 256 * 256; i += gthreads) { const int r = (int)(i >> 8), cc = (int)(i & 255), rin = cc >> 7, l = cc & 127;
            { const int k1 = r >> 1, ri = r & 1; const float a = (float)((k1 * l) & 127) * (1.0f / 64.0f), c = cospif(a), s = sinpif(a);
              FmT[i] = f2bf(ri == 0 ? (rin == 0 ? c : s) : (rin == 0 ? -s : c)); }
            { const float a = (float)((r * l) & 127) * (1.0f / 64.0f), c = cospif(a), s = sinpif(a);
              GmT[i] = r < 128 ? f2bf((rin == 0 ? c : s) * (1.0f / 2048.0f)) : (bf16_t)0; } }
        for (size_t i = gtid; i < 512 * 256; i += gthreads) { const int r = (int)(i >> 8), c = (int)(i & 255), ri = r >> 8, cp = r & 255; const float a = (float)((c * cp) & 255) * (1.0f / 128.0f);
            T256[i] = f2bf(ri == 0 ? cospif(a) : -sinpif(a)); }
        for (size_t i = gtid; i < (size_t)DM * DM / 4; i += gthreads) { const int k = (int)(i >> 8), c4 = (int)(i & 255) * 4; const f32x4 w = *(const f32x4*)(args.in[10] + (size_t)k * 9216 + 6144 + c4);
            u32x2 o; o.x = cvt_pk_bf16(w[0], w[1]); o.y = cvt_pk_bf16(w[2], w[3]); *(u32x2*)(Wn + (size_t)k * DM + c4) = o; }
        { TrDesc t{args.in[7], DM, 2 * DFF, W13t, DM, 0, 0}; tr_all(F, t); }
        { TrDesc t{args.in[8], DFF, DM, W2t, DFF, 0, 1}; tr_all(F, t); }
        { TrDesc t{args.in[10], DM, 9216, Win, DM, 0, 2}; tr_all(F, t); }
        { TrDesc t{args.in[15], DM, DM, Bz, 3072, 0, 3}; tr_all(F, t); }
        { TrDesc t{args.in[14], 2048, DM, Bz, 3072, 1024, 4}; tr_all(F, t); }
        { TrDesc t{args.in[16], DM, DM, WoT, DM, 0, 5}; tr_all(F, t); }
        __syncthreads();
    PHASE_END
    for (int xb = 0; xb < DBG_XBAR; ++xb) {
    PHASE_BEGIN
    PHASE_END
    }
    PHASE_BEGIN
        norm_rows(F, args.in[0], args.in[2], args.in[6], 0, nullptr, nullptr, false, 0, SEQ + CTX);
        { Geo g{256, 256, DM, 128u * 256 * 2u, 128u * 256 * 2u, 128u * DM * 2u, 4, 1 << 20, 1 << 20};
          pg::Sched<JobFold> S{{FB}, 32, F.G, bx}; EpiStore E{0, 0, DM};
          pg::gemm_phase<EpiStore, pg::Sched<JobFold>, 1>(F.lds, g, S, E); }
    PHASE_END
    if constexpr (DBG_PROBE == 11) {
    PHASE_BEGIN
        unsigned* dw = (unsigned*)(F.ws + WS_CTL) + 32768;
        for (size_t idx = gtid; idx < (size_t)DM * 9216; idx += gthreads) { const int k = (int)(idx / 9216), n = (int)(idx % 9216); const int dr = tr_dest_row(2, n);
            if (dr >= 0) { const float a = args.in[10][idx]; const float b = bf2f(Win[(size_t)dr * DM + k]); if (fabsf(a - b) > 0.01f * fabsf(a) + 1e-6f) { atomicAdd(dw + 64, 1u); atomicMin(dw + 192, (unsigned)(dr >> 8)); } } }
    PHASE_END
    }
    PHASE_BEGIN
        pg::Sched<JobFfn1> S{{FB, 65}, 65 * 22, F.G, bx};
        EpiSwiglu E{0, 0, FB};
        pg::gemm_phase<EpiSwiglu, pg::Sched<JobFfn1>, 1>(F.lds, gK1024, S, E);
    PHASE_END
    PHASE_BEGIN
        { pg::Sched<JobFfn2> S{{FB, 64}, 64 * 4, F.G, bx};
          EpiFuse E{0, 0, FB, 0, args.in[0], args.in[9]};
          pg::gemm_phase<EpiFuse, pg::Sched<JobFfn2>, 1>(F.lds, gFfn2, S, E); }
        { Geo g{DFF, DFF, DFF, 128u * DFF * 2u, 128u * DFF * 2u, 128u * DFF * 2u, 4, 1 << 20, 1 << 20};
          pg::Sched<JobCtxG2> S{{FB}, 44, F.G, (bx + F.G - 64) % F.G}; EpiSlab E{0, 0, FB};
          pg::gemm_phase<EpiSlab, pg::Sched<JobCtxG2>, 1>(F.lds, g, S, E); }
    PHASE_END
    if constexpr (STOP_AFTER >= 3) {
    PHASE_BEGIN
        norm_rows(F, args.in[0], args.in[2], args.in[9], 3 * DM, Dx, XcSlab, true, SEQ, SEQ + CTX);
        { TrDesc t{args.in[18], DM, 2 * DFF, W13t, DM, 0, 0}; tr_all(F, t); }
        { TrDesc t{args.in[19], DFF, DM, W2t, DFF, 0, 1}; tr_all(F, t); }
        __syncthreads();
    PHASE_END
    for (int pair = 0; pair < 2; ++pair) {
        PHASE_BEGIN
            { pg::Sched<JobRowCol> S{{FB, 0, 64, 4, 0, (size_t)pair * 2048 * DM, (size_t)256 * DM, (size_t)256 * DM}, 256, F.G, bx};
              EpiQK E{0, 0, FB, pair};
              pg::gemm_phase<EpiQK, pg::Sched<JobRowCol>, 1>(F.lds, gK1024, S, E); }
            { pg::Sched<JobRowCol> S{{FB, 1, 4, 64, (size_t)(pair * 2048 + 1024) * DM, 0, (size_t)256 * DM, (size_t)256 * DM}, 256, F.G, bx};
              EpiVT E{0, 0, FB};
              pg::gemm_phase<EpiVT, pg::Sched<JobRowCol>, 1>(F.lds, gK1024, S, E); }
            if (pair == 0) {
                { pg::Sched<JobKc> S{{FB}, 4, F.G, (bx + F.G - 64) % F.G}; EpiKc E{0, 0, FB};
                  pg::gemm_phase<EpiKc, pg::Sched<JobKc>, 1>(F.lds, gK1024, S, E); }
                { pg::Sched<JobVc> S{{FB}, 8, F.G, (bx + F.G - 72) % F.G}; EpiVc E{0, 0, FB};
                  pg::gemm_phase<EpiVc, pg::Sched<JobVc>, 1>(F.lds, gK1024, S, E); }
            }
        PHASE_END
        if constexpr (DBG_PROBE == 5) {
        PHASE_BEGIN
            LAS float* scr = (LAS float*)F.lds; unsigned* dw = (unsigned*)(F.ws + WS_CTL) + 32768;
            const int s = bx; const int i = (int)(((unsigned)s * 2654435761u) >> 18) & 16383, hl = s & 1, h = 2 * pair + hl, pp = (s * 29 + 3) & 127, v = (s * 37 + 11) & 511;
            const float* win = args.in[10]; float q1 = 0.f, q2 = 0.f, k1 = 0.f, k2 = 0.f, vv = 0.f;
            for (int a = F.tid; a < DM; a += NTHREADS) { const float x = bf2f(Ax[(size_t)i * DM + a]); const float* wr_ = win + (size_t)a * 9216;
                q1 += x * wr_[h * 256 + 2 * pp]; q2 += x * wr_[h * 256 + 2 * pp + 1]; k1 += x * wr_[1024 + h * 256 + 2 * pp]; k2 += x * wr_[1024 + h * 256 + 2 * pp + 1]; vv += x * wr_[2048 + h * 512 + v]; }
            q1 = block_sum(scr, q1, F.tid); q2 = block_sum(scr, q2, F.tid); k1 = block_sum(scr, k1, F.tid); k2 = block_sum(scr, k2, F.tid); vv = block_sum(scr, vv, F.tid);
            if (F.tid == 0) { const float inv = powf(10000.0f, -(float)(pp & 63) / 64.0f), ang = (float)(pp < 64 ? (i >> 6) : (i & 63)) * inv, cs = cosf(ang), sn = sinf(ang);
                const float rq1 = (q1 * cs - q2 * sn) * 0.0625f, rq2 = (q1 * sn + q2 * cs) * 0.0625f, rk1 = k1 * cs - k2 * sn, rk2 = k1 * sn + k2 * cs; const int jl = i & 511;
                dbg_report(dw, rq1, bf2f(Qb[(size_t)i * 512 + hl * 256 + 2 * pp]), 1000.0f); dbg_report(dw, rq2, bf2f(Qb[(size_t)i * 512 + hl * 256 + 2 * pp + 1]), 1000.0f);
                dbg_report(dw, rk1, bf2f(Knb[(size_t)i * 512 + hl * 256 + 2 * pp]), 1000.0f); dbg_report(dw, rk2, bf2f(Knb[(size_t)i * 512 + hl * 256 + 2 * pp + 1]), 1000.0f);
                dbg_report(dw, rk2 * expf(lgp[h] * (float)(511 - jl)), bf2f(Ktb_[(size_t)(hl * 256 + 2 * pp + 1) * SEQ + i]), 1000.0f);
                dbg_report(dw, rk1 * expf(lgp[4 + h] * (float)jl), bf2f(Ktb_[(size_t)512 * SEQ + (size_t)(hl * 256 + 2 * pp) * SEQ + i]), 1000.0f);
                dbg_report(dw, vv, bf2f(B4[((size_t)((hl * NSEG + (i >> 9)) * 512 + v)) * 1024 + 512 + jl]), 1000.0f); }
        PHASE_END
        }
        PHASE_BEGIN
            { Geo g{1024, 1024, SEQ, 128u * 1024 * 2u, 128u * 1024 * 2u, 128u * (unsigned)SEQ * 2u, LS / 64, 1 << 20, 1 << 20};
              pg::Sched<JobR1> S{{FB}, 256, F.G, bx}; EpiU E{0, 0, FB};
              pg::gemm_phase<EpiU, pg::Sched<JobR1>, 1>(F.lds, g, S, E); }
            if (pair == 0) { Geo g{CTX, CTX, CTX, 128u * CTX * 2u, 128u * CTX * 2u, 128u * CTX * 2u, CTX / 64, 1 << 20, 1 << 20};
              pg::Sched<JobS0> S{{FB}, 16, F.G, (bx + F.G - 64) % F.G}; EpiS0 E{0, 0, FB};
              pg::gemm_phase<EpiS0, pg::Sched<JobS0>, 1>(F.lds, g, S, E); }
        PHASE_END
        if constexpr (DBG_PROBE == 6) {
        PHASE_BEGIN
            LAS float* scr = (LAS float*)F.lds; unsigned* dw = (unsigned*)(F.ws + WS_CTL) + 32768;
            const int s = bx, h = s & 3, dir = (s >> 2) & 1, d = (s * 29 + 3) & 255, v = (s * 37 + 11) & 511; const float* win = args.in[10];
            const int j = F.tid & 255, which = F.tid >> 8; const int col = which ? 2048 + h * 512 + v : 1024 + h * 256 + d; float dot = 0.f;
            for (int a = 0; a < DM; ++a) dot += bf2f(Ac[(size_t)j * DM + a]) * win[(size_t)a * 9216 + col];
            scr[16 + F.tid] = dot; __syncthreads();
            float term = 0.f; if (F.tid < 256) term = scr[16 + F.tid] * scr[16 + 256 + F.tid] * expf(lgp[dir * 4 + h] * (float)(dir ? j : 255 - j));
            __syncthreads();
            const float ref = block_sum(scr, term, F.tid);
            if (F.tid == 0) dbg_report(dw, ref, S0[((size_t)((h * 2 + dir) * 512 + v)) * 256 + d], 1000.0f);
        PHASE_END
        }
        PHASE_BEGIN
            { const int gw = F.vcu * NWAVES + F.wave, NGW = F.G * NWAVES;
              for (int rowid = gw; rowid < 1024; rowid += NGW) { const int hl = rowid >> 9, v = rowid & 511, h = 2 * pair + hl, dir = F.lane >> 5, d0 = (F.lane & 31) * 8;
                  const float* s0 = S0 + ((size_t)((h * 2 + dir) * 512 + v)) * 256 + d0; f32x4 c0 = *(const f32x4*)s0, c1 = *(const f32x4*)(s0 + 4);
                  const float dec = expf(lgp[dir * 4 + h] * (float)LS);
                  bf16_t* pb = B4 + ((size_t)(hl * NSEG * 512 + v)) * 1024 + dir * 256 + d0; const long sstep = dir ? -(long)512 * 1024 : (long)512 * 1024; if (dir) pb += (size_t)(NSEG - 1) * 512 * 1024;
                  u32x4 ub[NSEG];
#pragma unroll
                  for (int it = 0; it < NSEG; ++it) ub[it] = *(const u32x4*)(pb + (long)it * sstep);
#pragma unroll
                  for (int it = 0; it < NSEG; ++it) { f32x4 u0, u1; unpack8(ub[it], u0, u1); *(u32x4*)(pb + (long)it * sstep) = _rep == 0 ? pack8(c0, c1) : ub[it]; c0 = c0 * dec + u0; c1 = c1 * dec + u1; } } }
            { Geo g{512, 512, 512, 128u * 512 * 2u, 128u * 512 * 2u, 128u * 512 * 2u, 4, 1 << 20, 1 << 20};
              pg::Sched<JobR3> S{{FB}, 256, F.G, bx}; EpiP E{0, 0, FB, pair};
              pg::gemm_phase<EpiP, pg::Sched<JobR3>, 1>(F.lds, g, S, E); }
        PHASE_END
        PHASE_BEGIN
            Geo g{512, 1024, 1024, 128u * 512 * 2u, 128u * 1024 * 2u, 128u * 1024 * 2u, 16, 8, 4};
            pg::Sched<JobR4> S{{FB}, 256, F.G, bx}; EpiO E{4, 8, FB, pair};
            pg::gemm_phase<EpiO, pg::Sched<JobR4>, 2>(F.lds, g, S, E);
        PHASE_END
        if constexpr (DBG_PROBE == 1) {
        PHASE_BEGIN
            LAS float* scr = (LAS float*)F.lds; unsigned* dw = (unsigned*)(F.ws + WS_CTL) + 32768;
            const int s = bx; int i = (int)(((unsigned)s * 2654435761u) >> 18) & 16383; if (s < 8) { const int sp[8] = {0, 1, 511, 512, 513, 8191, 16382, 16383}; i = sp[s]; }
            const int hl = s & 1, h = 2 * pair + hl, v = (s * 37 + 11) & 511; const float lgf = lgp[h], lgb = lgp[4 + h];
            float part = 0.f;
            for (int j = F.tid; j < SEQ; j += NTHREADS) { float qk = 0.f;
                for (int d = 0; d < 256; ++d) qk += bf2f(Qb[(size_t)i * 512 + hl * 256 + d]) * bf2f(Knb[(size_t)j * 512 + hl * 256 + d]);
                const float D = j < i ? __expf(lgf * (float)(i - j)) : (j > i ? __expf(lgb * (float)(j - i)) : 2.0f);
                part += D * qk * bf2f(B4[((size_t)((hl * NSEG + (j >> 9)) * 512 + v)) * 1024 + 512 + (j & 511)]); }
            if (F.tid < 256) { const float q = bf2f(Qb[(size_t)i * 512 + hl * 256 + F.tid]);
                part += q * (__expf(lgf * (float)(i + 1)) * S0[((size_t)((h * 2 + 0) * 512 + v)) * 256 + F.tid] + __expf(lgb * (float)(SEQ - i)) * S0[((size_t)((h * 2 + 1) * 512 + v)) * 256 + F.tid]); }
            const float ref = block_sum(scr, part, F.tid);
            const float ov = bf2f(Ob[(size_t)i * 2048 + h * 512 + F.tid]); const float rms = sqrtf(block_sum(scr, ov * ov, F.tid) * (1.0f / 512.0f));
            if (F.tid == 0) dbg_report(dw, ref, bf2f(Ob[(size_t)i * 2048 + h * 512 + v]), rms * 1000.0f);
        PHASE_END
        }
    }
    if constexpr (DBG_PROBE == 7 || DBG_PROBE == 8) {
    PHASE_BEGIN
        LAS float* scr = (LAS float*)F.lds; unsigned* dw = (unsigned*)(F.ws + WS_CTL) + 32768; float* sav = (float*)(F.ws + WS_END);
        const int s = bx; const int i = s * 64 + 57, h = DBG_COL >> 9, v = DBG_COL & 511;
        const float ov = bf2f(Ob[(size_t)i * 2048 + h * 512 + F.tid]); const float mean = block_sum(scr, ov, F.tid) * (1.0f / 512.0f);
        const float var = block_sum(scr, (ov - mean) * (ov - mean), F.tid) * (1.0f / 512.0f); const float rstd = 1.0f / sqrtf(var + EPS);
        if (F.tid == 0) { if (DBG_PROBE == 7) { dbg_report(dw, mean, stats[(size_t)(i * 4 + h) * 2], 1000.0f); dbg_report(dw, rstd, stats[(size_t)(i * 4 + h) * 2 + 1], 1000.0f); }
            sav[s * 4 + 0] = (bf2f(Ob[(size_t)i * 2048 + h * 512 + v]) - mean) * rstd; }
    PHASE_END
    }
    PHASE_BEGIN
        { LAS unsigned char* stl = F.lds + RING_BYTES + 1024;
          if (_rep == 0) { const int pm = bx >> 2, h = bx & 3;
            for (int r = F.wave; r < 256; r += NWAVES) { const int pos = pm * 256 + r; f32x4 a, b; unpack8(*(const u32x4*)(Ob + (size_t)pos * 2048 + h * 512 + F.lane * 8), a, b);
                const float mean = wave_sum((a[0] + a[1]) + (a[2] + a[3]) + (b[0] + b[1]) + (b[2] + b[3])) * (1.0f / 512.0f);
                a -= mean; b -= mean; const float q = wave_sum((a[0] * a[0] + a[1] * a[1]) + (a[2] * a[2] + a[3] * a[3]) + (b[0] * b[0] + b[1] * b[1]) + (b[2] * b[2] + b[3] * b[3]));
                if (F.lane == 0) *(LAS f32x2*)(stl + r * 8) = (f32x2){mean, 1.0f / sqrtf(q * (1.0f / 512.0f) + EPS)}; }
            __syncthreads(); }
          pg::Sched<JobG2> S{{FB}, 512, F.G, bx};
          EpiG E{0, 0, FB, args.in[13], _rep, stl};
          pg::gemm_phase<EpiG, pg::Sched<JobG2>, 1>(F.lds, gK1024, S, E); }
        { Geo g{DM, DM, 128u * DM, 128u * DM * 2u, 128u * DM * 2u, (unsigned)DM * 2u, DM / 64, 1 << 20, 1 << 20};
          pg::Sched<JobRowCol> S{{FB, 1, 8, 64, (size_t)WR_F * DM, 0, (size_t)256 * DM, (size_t)2 * DM}, 512, F.G, bx};
          EpiF E{0, 0, FB};
          pg::gemm_phase<EpiF, pg::Sched<JobRowCol>, 1>(F.lds, g, S, E); }
    PHASE_END
    if constexpr (DBG_PROBE == 8) {
    PHASE_BEGIN
        LAS float* scr = (LAS float*)F.lds; unsigned* dw = (unsigned*)(F.ws + WS_CTL) + 32768; float* sav = (float*)(F.ws + WS_END);
        const int s = bx; const int i = s * 64 + 57, h = DBG_COL >> 9, v = DBG_COL & 511, col = h * 512 + v; float g = 0.f;
        for (int a = F.tid; a < DM; a += NTHREADS) g += bf2f(Ax[(size_t)i * DM + a]) * args.in[10][(size_t)a * 9216 + 4096 + col];
        g = block_sum(scr, g, F.tid);
        if (F.tid == 0) dbg_report(dw, g / (1.0f + expf(-g)) * sav[s * 4] * args.in[13][col], bf2f(Ob[(size_t)i * 2048 + col]), 1.0f);
    PHASE_END
    }
    PHASE_BEGIN
        Geo g{256, 256, 256, 128u * 256 * 2u, 128u * 256 * 2u, 128u * 256 * 2u, 4, 1 << 20, 1 << 20};
        pg::Sched<JobF1> S{{FB}, 512, F.G, bx}; EpiF1 E{0, 0, FB};
        pg::gemm_phase<EpiF1, pg::Sched<JobF1>, 1>(F.lds, g, S, E);
    PHASE_END
    if constexpr (DBG_PROBE == 2 || DBG_PROBE == 4) {
    PHASE_BEGIN
        LAS float* scr = (LAS float*)F.lds; unsigned* dw = (unsigned*)(F.ws + WS_CTL) + 32768;
        if (DBG_PROBE == 4) {
            const int s = bx; const int l = (int)(((unsigned)s * 2654435761u) >> 18) & 16383, ch = (s * 131 + 7) & 1023, g = ch >> 8, cp = ch & 255;
            const int c = F.tid & 255, hf = F.tid >> 8; float fpart = 0.f;
            for (int a = hf * 512; a < hf * 512 + 512; ++a) fpart += bf2f(Ax[(size_t)l * DM + a]) * args.in[10][(size_t)a * 9216 + 6144 + g * 256 + c];
            scr[16 + F.tid] = fpart; __syncthreads();
            float wr_ = 0.f, wi_ = 0.f;
            if (F.tid < 256) { const float fv = scr[16 + F.tid] + scr[16 + 256 + F.tid]; const float ang = (float)((c * cp) & 255) * (1.0f / 128.0f); wr_ = fv * cospif(ang); wi_ = -fv * sinpif(ang); }
            __syncthreads();
            const float Wr = block_sum(scr, wr_, F.tid), Wi = block_sum(scr, wi_, F.tid);
            const int l1 = l >> 7, l2 = l & 127;
            if (F.tid == 0) { dbg_report(dw, Wr, bf2f(Wt[(size_t)(ch * 128 + l2) * 256 + l1]), 16000.0f); dbg_report(dw, Wi, bf2f(Wt[(size_t)(ch * 128 + l2) * 256 + 128 + l1]), 16000.0f); }
        } else {
            const unsigned sid = (unsigned)(bx * NTHREADS + F.tid) * 2654435761u; const int k1 = (sid >> 8) & 127, l2 = (sid >> 15) & 127, ch = (sid >> 22) & 1023;
            float ar = 0.f, ai = 0.f;
            for (int l1 = 0; l1 < 128; ++l1) { const float wr_ = bf2f(Wt[(size_t)(ch * 128 + l2) * 256 + l1]), wi_ = bf2f(Wt[(size_t)(ch * 128 + l2) * 256 + 128 + l1]);
                const float a = (float)((k1 * l1) & 127) * (1.0f / 64.0f), cs = cospif(a), sn = sinpif(a); ar += cs * wr_ + sn * wi_; ai += cs * wi_ - sn * wr_; }
            const float t = (float)((k1 * l2) & 16383) * (1.0f / 8192.0f), ct = cospif(t), st = sinpif(t);
            const float br = ar * ct + ai * st, bi = ai * ct - ar * st;
            dbg_report(dw, br, bf2f(Bt[(size_t)(k1 * 1024 + ch) * 256 + l2]), 180000.0f); dbg_report(dw, bi, bf2f(Bt[(size_t)(k1 * 1024 + ch) * 256 + 128 + l2]), 180000.0f);
        }
    PHASE_END
    }
    PHASE_BEGIN
        Geo g{256, 256, 256, 128u * 256 * 2u, 128u * 256 * 2u, 128u * 256 * 2u, 4, 1 << 20, 1 << 20};
        pg::Sched<JobF2> S{{FB}, 512, F.G, bx}; EpiF2 E{0, 0, FB};
        pg::gemm_phase<EpiF2, pg::Sched<JobF2>, 1>(F.lds, g, S, E);
    PHASE_END
    if constexpr (DBG_PROBE == 3) {
    PHASE_BEGIN
        unsigned* dw = (unsigned*)(F.ws + WS_CTL) + 32768;
        const unsigned sid = (unsigned)(bx * NTHREADS + F.tid) * 2654435761u; const int k1 = (sid >> 8) & 127, k2 = (sid >> 15) & 127, ch = (sid >> 22) & 1023;
        float y = 0.f;
        for (int l2 = 0; l2 < 128; ++l2) { const float br = bf2f(Bt[(size_t)(k1 * 1024 + ch) * 256 + l2]), bi = bf2f(Bt[(size_t)(k1 * 1024 + ch) * 256 + 128 + l2]);
            const float a = (float)((k2 * l2) & 127) * (1.0f / 64.0f); y += br * cospif(a) + bi * sinpif(a); }
        dbg_report(dw, y * (1.0f / 2048.0f), bf2f(MIXb[(size_t)(k1 + 128 * k2) * 2048 + ch]), 1000.0f);
    PHASE_END
    }
    if constexpr (DBG_PROBE == 12) {
    PHASE_BEGIN
        unsigned* dw = (unsigned*)(F.ws + WS_CTL) + 32768;
        for (size_t idx = gtid; idx < (size_t)DM * 9216; idx += gthreads) { const int k = (int)(idx / 9216), n = (int)(idx % 9216); const int dr = tr_dest_row(2, n);
            if (dr >= 0) { const float a = args.in[10][idx]; const float b = bf2f(Win[(size_t)dr * DM + k]); if (fabsf(a - b) > 0.01f * fabsf(a) + 1e-6f) { atomicAdd(dw + 64, 1u); atomicMin(dw + 192, (unsigned)(dr >> 8)); } } }
    PHASE_END
    }
    if constexpr (DBG_PROBE == 9) {
    PHASE_BEGIN
        LAS float* scr = (LAS float*)F.lds; unsigned* dw = (unsigned*)(F.ws + WS_CTL) + 32768;
        const int s = bx; const int i = DBG_VAR == 0 ? 1210 : (DBG_VAR == 1 ? 1024 + s : (DBG_VAR == 2 ? s * 64 + 57 : 1210 + 256 * (s & 63))), n = DBG_VAR == 0 ? 4 * s : 736; float ga = 0.f, gf = 0.f;
        for (int a = F.tid; a < DM; a += NTHREADS) { const float x = bf2f(Ax[(size_t)i * DM + a]); ga += x * args.in[10][(size_t)a * 9216 + 7168 + n]; gf += x * args.in[10][(size_t)a * 9216 + 8192 + n]; }
        ga = block_sum(scr, ga, F.tid); gf = block_sum(scr, gf, F.tid);
        if (F.tid == 0) { const float ea = fabsf(1.0f / (1.0f + expf(-ga)) - bf2f(GAb[(size_t)i * DM + n])), ef = fabsf(1.0f / (1.0f + expf(-gf)) - bf2f(GFb[(size_t)i * DM + n]));
            if (ea > 0.05f) { atomicMin(dw + 192, (unsigned)s); atomicAdd(dw + 64, 1u); dbg_report(dw, 0.f, DBG_GF ? ea : bf2f(GAb[(size_t)i * DM + n]), 1000.0f); } if (ef > 0.05f) atomicMin(dw + 193, (unsigned)s); }
    PHASE_END
    }
    PHASE_BEGIN
        { pg::Sched<JobGate2> S{{FB}, 512, F.G, bx}; EpiGate E{0, 0, FB};
          pg::gemm_phase<EpiGate, pg::Sched<JobGate2>, 1>(F.lds, gK1024, S, E); }
        { Geo g{2048, 2048, 3072, 128u * 2048 * 2u, 128u * 2048 * 2u, 128u * 3072 * 2u, 16, 1 << 20, 1 << 20};
          pg::Sched<JobZ> S{{FB, 0}, 256, F.G, bx}; EpiZ2 E{0, 0, FB, 0};
          pg::gemm_phase<EpiZ2, pg::Sched<JobZ>, 1>(F.lds, g, S, E); }
        { Geo g{2048, 2048, 3072, 128u * 2048 * 2u, 128u * 2048 * 2u, 128u * 3072 * 2u, 32, 1 << 20, 1 << 20};
          pg::Sched<JobZ> S{{FB, 1}, 256, F.G, bx}; EpiZ2 E{0, 0, FB, 1};
          pg::gemm_phase<EpiZ2, pg::Sched<JobZ>, 1>(F.lds, g, S, E); }
    PHASE_END
    if constexpr (DBG_PROBE == 9 || DBG_PROBE == 10) {
    PHASE_BEGIN
        LAS float* scr = (LAS float*)F.lds; unsigned* dw = (unsigned*)(F.ws + WS_CTL) + 32768;
        const int s = bx; const int i = (int)(((unsigned)s * 2654435761u) >> 18) & 16383, n = (s * 131 + 7) & 1023;
        if (DBG_PROBE == 9) { float ga = 0.f, gf = 0.f;
            (void)ga; (void)gf;
        } else { float r = 0.f, fo = 0.f;
            for (int k = F.tid; k < 2048; k += NTHREADS) r += bf2f(Ob[(size_t)i * 2048 + k]) * args.in[14][(size_t)k * DM + n];
            for (int k = F.tid; k < 1024; k += NTHREADS) fo += bf2f(MIXb[(size_t)i * 2048 + k]) * args.in[15][(size_t)k * DM + n];
            r = block_sum(scr, r, F.tid); fo = block_sum(scr, fo, F.tid);
            if (F.tid == 0) dbg_report(dw, bf2f(GAb[(size_t)i * DM + n]) * r + bf2f(GFb[(size_t)i * DM + n]) * fo, bf2f(Zb[(size_t)i * DM + n]), 1000.0f); }
    PHASE_END
    }
    PHASE_BEGIN
        Geo g{2048, 2048, DM, 128u * 2048 * 2u, 128u * 2048 * 2u, 128u * DM * 2u, DM / 64, 1 << 20, 1 << 20};
        pg::Sched<JobRowCol> S{{FB, 2, 64, 4, 0, 0, (size_t)256 * 2048, (size_t)256 * DM}, 256, F.G, bx};
        EpiFuse E{0, 0, FB, 1, args.in[0], args.in[17]};
        pg::gemm_phase<EpiFuse, pg::Sched<JobRowCol>, 1>(F.lds, g, S, E);
    PHASE_END
    }
    PHASE_BEGIN
        pg::Sched<JobFfn1> S{{FB, 64}, 64 * 22, F.G, bx};
        EpiSwiglu E{0, 0, FB};
        pg::gemm_phase<EpiSwiglu, pg::Sched<JobFfn1>, 1>(F.lds, gK1024, S, E);
    PHASE_END
    PHASE_BEGIN
        pg::Sched<JobFfn2> S{{FB, 64}, 64 * 4, F.G, bx};
        EpiFuse E{0, 0, FB, 2, args.in[0], args.in[20]};
        pg::gemm_phase<EpiFuse, pg::Sched<JobFfn2>, 1>(F.lds, gFfn2, S, E);
    PHASE_END
    if constexpr (DBG_TSEL >= 0) {
    PHASE_BEGIN
        const unsigned long long* ts = (const unsigned long long*)(F.ws + WS_CTL + 160000);
        if (bx == 0) { const float a = 0.1f * (float)(ts[DBG_TSEL + 1] - ts[DBG_TSEL]), b = 0.1f * (float)(ts[DBG_TSEL2 + 1] - ts[DBG_TSEL2]);
            if (F.tid == 0) ((float*)F.dout)[0] = a; for (int i = F.tid; i < 1024; i += NTHREADS) ((float*)F.dout)[1024 + i] = b; }
    PHASE_END
    }
    if constexpr (DBG_PROBE != 0) {
    PHASE_BEGIN
        if (bx == 0 && F.tid == 0) { const float e = __builtin_bit_cast(float, ((unsigned*)(F.ws + WS_CTL))[32768]); ((float*)F.dout)[0] = DBG_COUNT == 3 ? 100.0f * (float)(16u + ((((unsigned*)(F.ws + WS_CTL))[32768 + 192 + DBG_GF] + 0xC0000000u - 0xC0000000u) >> DBG_SH & 15u)) : DBG_COUNT == 2 ? 100.0f * (float)(16u + ((unsigned*)(F.ws + WS_CTL))[32768 + 128]) : DBG_COUNT ? 1000.0f + 10.0f * (float)((unsigned*)(F.ws + WS_CTL))[32768 + 64] : 1000.0f * (10.0f + log10f(e + 1e-10f)); }
    PHASE_END
    }
}

extern "C" void kernel_launch(void* const* d_in, const int* in_sizes, int n_in, void* d_out, int out_size, void* d_ws, size_t ws_size, hipStream_t stream) {
    static int grid = 0;
    if (grid == 0) {
        if (n_in != 21 || out_size != SEQ * DM || ws_size < 256 * MiB) { fprintf(stderr, "kernel_launch: unexpected shapes (n_in %d out %d ws %zu)\n", n_in, out_size, ws_size); grid = -1; return; }
        int dev = 0, cus = 0, per_cu = 0;
        if (hipGetDevice(&dev) != hipSuccess || hipDeviceGetAttribute(&cus, hipDeviceAttributeMultiprocessorCount, dev) != hipSuccess) { grid = -1; return; }
        if (hipFuncSetAttribute((const void*)fwd_kernel, hipFuncAttributeMaxDynamicSharedMemorySize, LDS_BYTES) != hipSuccess) { fprintf(stderr, "kernel_launch: hipFuncSetAttribute failed\n"); grid = -1; return; }
        if (hipOccupancyMaxActiveBlocksPerMultiprocessor(&per_cu, (const void*)fwd_kernel, NTHREADS, LDS_BYTES) != hipSuccess || per_cu < 1) { fprintf(stderr, "kernel_launch: occupancy query says %d blocks/CU\n", per_cu); }
        (void)hipGetLastError();
        grid = cus;
    }
    if (grid < 0) return;
    (void)hipMemsetAsync((char*)d_ws + WS_CTL, 0, CTL_ZERO_BYTES, stream);
    Args a{};
    for (int i = 0; i < 21; ++i) a.in[i] = (const float*)d_in[i];
    a.out = (float*)d_out; a.ws = (unsigned char*)d_ws; a.ph_lo = 0; a.ph_hi = 1000;
    hipLaunchKernelGGL(fwd_kernel, dim3(grid), dim3(NTHREADS), LDS_BYTES, stream, a);
}
```

```cpp
#include <hip/hip_runtime.h>
#include <cstdio>
#include <cstdint>

#ifndef DBG_NOFOUR
#define DBG_NOFOUR 0
#endif
#ifndef DBG_NORET
#define DBG_NORET 0
#endif
#ifndef DBG_PROBE
#define DBG_PROBE 0
#endif
#ifndef DBG_COUNT
#define DBG_COUNT 0
#ifndef DBG_COL
#define DBG_COL 736
#endif
#ifndef DBG_VAR
#define DBG_VAR 2
#endif
#ifndef DBG_SH
#define DBG_SH 0
#endif
#ifndef DBG_GF
#define DBG_GF 1
#endif
#ifndef DBG_S0
#define DBG_S0 4
#endif
#endif
#ifndef DBG_XBAR
#define DBG_XBAR 0
#endif
#ifndef DBG_DUP
#define DBG_DUP -1
#endif
#ifndef DBG_TSEL
#define DBG_TSEL -1
#endif
#ifndef DBG_TSEL2
#define DBG_TSEL2 1
#endif
#ifndef PG_ALIGN
#define PG_ALIGN 1
#endif
#ifndef STOP_AFTER
#define STOP_AFTER 99
#endif

#define LAS __attribute__((address_space(3)))
typedef unsigned short bf16_t;
typedef short bf16x8 __attribute__((ext_vector_type(8)));
typedef float f32x4 __attribute__((ext_vector_type(4)));
typedef float f32x2 __attribute__((ext_vector_type(2)));
typedef unsigned u32x4 __attribute__((ext_vector_type(4)));
typedef unsigned u32x2 __attribute__((ext_vector_type(2)));

constexpr int DM = 1024, SEQ = 16384, CTX = 256, DFF = 2816;
constexpr float EPS = 1e-6f;
constexpr int LS = 512, NSEG = SEQ / LS;

constexpr size_t MiB = 1u << 20;
constexpr size_t WS_CTL = 0, CTL_ZERO_BYTES = 1 * MiB;
constexpr size_t WS_MOD = 1 * MiB;
constexpr size_t WS_TAB = 2 * MiB;
constexpr size_t WS_STATS = 3 * MiB;
constexpr size_t WS_S0 = 4 * MiB;
constexpr size_t WS_KC = 8 * MiB;
constexpr size_t WS_VC = 9 * MiB;
constexpr size_t WS_DC = 10 * MiB;
constexpr size_t WS_HC = 12 * MiB;
constexpr size_t WS_WIN = 14 * MiB;
constexpr size_t WS_WN = 34 * MiB;
constexpr size_t WS_WB = 36 * MiB;
constexpr size_t WS_H = 54 * MiB;
constexpr size_t WS_Q = 54 * MiB, WS_KN = 70 * MiB, WS_KT = 86 * MiB, WS_B4 = 118 * MiB;
constexpr size_t WS_O = 182 * MiB;
constexpr size_t WS_END = 246 * MiB;
constexpr size_t WS_XB = 11 * MiB;
constexpr size_t WS_OUTW = 246 * MiB;
constexpr size_t WS_XCSLAB = 150 * MiB;
constexpr size_t WS_WT = 118 * MiB, WS_BT = 54 * MiB, WS_MIX = 118 * MiB, WS_GA = 54 * MiB, WS_GF = 86 * MiB;
constexpr size_t DO_AX = 32 * MiB;
constexpr int WR_G = 4096, WR_F = 6144, WR_GA = 8192, WR_GF = 9216;
constexpr size_t WB_W13 = 0, WB_W2 = 11 * MiB;
constexpr size_t WB_BZ = 0, WB_WO = 6 * MiB;
constexpr size_t TB_ROPE = 0, TB_TW = 128 * 1024, TB_FM = 256 * 1024, TB_GM = 384 * 1024, TB_T256 = 512 * 1024;

typedef __bf16 bf16x2_t __attribute__((ext_vector_type(2)));
__device__ __forceinline__ unsigned cvt_pk_bf16(float lo, float hi) { const f32x2 v = {lo, hi}; return __builtin_bit_cast(unsigned, __builtin_convertvector(v, bf16x2_t)); }
__device__ __forceinline__ unsigned short f2bf(float f) { unsigned u = __builtin_bit_cast(unsigned, f); return (unsigned short)((u + 0x7fffu + ((u >> 16) & 1u)) >> 16); }
__device__ __forceinline__ float bflo(unsigned u) { return __builtin_bit_cast(float, u << 16); }
__device__ __forceinline__ float bfhi(unsigned u) { return __builtin_bit_cast(float, u & 0xffff0000u); }
__device__ __forceinline__ u32x4 pack8(const f32x4 a, const f32x4 b) { u32x4 w; w.x = cvt_pk_bf16(a[0], a[1]); w.y = cvt_pk_bf16(a[2], a[3]); w.z = cvt_pk_bf16(b[0], b[1]); w.w = cvt_pk_bf16(b[2], b[3]); return w; }
__device__ __forceinline__ void unpack8(const u32x4 w, f32x4& a, f32x4& b) { a = (f32x4){bflo(w.x), bfhi(w.x), bflo(w.y), bfhi(w.y)}; b = (f32x4){bflo(w.z), bfhi(w.z), bflo(w.w), bfhi(w.w)}; }

__device__ __forceinline__ void st16wt(void* p, const u32x4 v) { asm volatile("global_store_dwordx4 %0, %1, off sc1\n\ts_nop 1" :: "v"(p), "v"(v) : "memory"); }
__device__ __forceinline__ float fsigmoid(float a) { return __builtin_amdgcn_rcpf(1.0f + __expf(-a)); }
__device__ __forceinline__ float fsilu(float a) { return a * fsigmoid(a); }
__device__ __forceinline__ float wave_sum(float v) {
#pragma unroll
    for (int o = 1; o < 64; o <<= 1) v += __shfl_xor(v, o);
    return v;
}

namespace pg {
constexpr int BM = 256, BK = 64, HALF = 128, HTB = HALF * BK * 2, STAGE_BYTES = 8 * HTB, NXCD = 8, WGM = 4;
__device__ __forceinline__ int lds_byte(int r, int c) { const int st = (r >> 4) * 2 + (c >> 5), rr = r & 15, cc = c & 31, ob = rr * 64 + cc * 2; return st * 1024 + (ob ^ (((ob >> 9) & 1) << 5)); }
__device__ __forceinline__ void stage_rc(int b, int& R, int& C) { const int st = b / 1024, sb = b % 1024, swz = sb ^ (((sb >> 9) & 1) << 5); R = (st >> 1) * 16 + swz / 64; C = (st & 1) * 32 + (swz % 64) / 2; }
__device__ __forceinline__ int perm32(int rho) { const int n = rho >> 4, i = rho & 15; return 8 * (i >> 2) + 4 * n + (i & 3); }

struct Unit { const char* a0; const char* a1; const char* b; char* d; int i0, i1, i2, i3; };
struct Geo { unsigned lda0, lda1, ldb;
             unsigned hsA0, hsA1, hsB;
             int nt, c0, rep0; };

__device__ __forceinline__ void tile_pm_pn(int L, int nM, int nN, int& pm, int& pn) {
    const int nwg = nM * nN; int wgid = L;
    { const int q = nwg / NXCD, r = nwg % NXCD, xcd = wgid % NXCD, off = wgid / NXCD; wgid = (xcd < r ? xcd * (q + 1) : r * (q + 1) + (xcd - r) * q) + off; }
    const int nig = WGM * nN, gid = wgid / nig, fm = gid * WGM, gsz = (nM - fm) < WGM ? (nM - fm) : WGM;
    pm = fm + ((wgid % nig) % gsz); pn = (wgid % nig) / gsz;
}
__device__ __forceinline__ int xcd_contig(int L, int n) { return (L % NXCD) * (n / NXCD) + L / NXCD; }

template <class Job> struct Sched {
    Job j; int n, G, c;
    __device__ __forceinline__ bool next(int i, Unit& u) const { const long L = (long)i * G + c; if (L >= n) return false; j.fill((int)L, u); return true; }
};

template <class Epi, class Sch, int ASEG>
__device__ __forceinline__ void gemm_phase(LAS unsigned char* lds, const Geo g, const Sch& S, const Epi& E) {
    int tid = threadIdx.x; asm volatile("" : "+v"(tid));
    const int wid = __builtin_amdgcn_readfirstlane(tid >> 6), lane = tid & 63, wr = wid >> 2, wc = wid & 3, fr = lane & 15, fq = lane >> 4;
    int nt = g.nt; asm volatile("" : "+s"(nt));
    unsigned voffA0[2], voffA1[2], voffB[2];
#pragma unroll
    for (int i = 0; i < 2; ++i) { int R, C; stage_rc(tid * 16 + i * 8192, R, C); const int Rb = (R & ~31) + perm32(R & 31);
        voffA0[i] = (unsigned)(R * g.lda0 + C) * 2u; voffA1[i] = (ASEG == 2) ? (unsigned)(R * g.lda1 + C) * 2u : 0u; voffB[i] = (unsigned)(Rb * g.ldb + C) * 2u; }
    const unsigned ldsw = (unsigned)wid * 1024u;
    const int aoff = lds_byte(wr * 64 + fr, fq * 8), boff = lds_byte(wc * 32 + fr, fq * 8);
#define PG_SA(b, h) (((b) * 2 + (h)) * HTB)
#define PG_SB(b, h) ((4 + (b) * 2 + (h)) * HTB)
#define PG_GLDS(gp, lp) __builtin_amdgcn_global_load_lds((const unsigned*)(gp), (LAS unsigned*)(lp), 16, 0, 0)
#define PG_ASEL(T) (ASEG == 2 && (T) >= g.c0)
#define PG_APTR(U, T) (PG_ASEL(T) ? (U).a1 + (size_t)((T) - g.c0) * 128 : (U).a0 + (size_t)((T) & (g.rep0 - 1)) * 128)
#define PG_STAGE_A(bufoff, gbase, h, sel) do { const bool _s = (sel); const unsigned _v0 = _s ? voffA1[0] : voffA0[0], _v1 = _s ? voffA1[1] : voffA0[1]; \
        const char* _p = (gbase) + ((h) ? (size_t)(_s ? g.hsA1 : g.hsA0) : (size_t)0); \
        PG_GLDS(_p + _v0, lds + (bufoff) + ldsw); PG_GLDS(_p + _v1, lds + (bufoff) + ldsw + 8192); } while (0)
#define PG_STAGE_B(bufoff, gbase, h) do { const char* _p = (gbase) + ((h) ? (size_t)g.hsB : (size_t)0); \
        PG_GLDS(_p + voffB[0], lds + (bufoff) + ldsw); PG_GLDS(_p + voffB[1], lds + (bufoff) + ldsw + 8192); } while (0)
#define PG_LDA(dst, b, h) do { _Pragma("unroll") for (int m = 0; m < 4; ++m) _Pragma("unroll") for (int k = 0; k < 2; ++k) dst[m][k] = *(const LAS bf16x8*)(lds + PG_SA(b, h) + aoff + m * 2048 + k * 1024); } while (0)
#define PG_LDB(dst, b, h) do { _Pragma("unroll") for (int n = 0; n < 2; ++n) _Pragma("unroll") for (int k = 0; k < 2; ++k) dst[n][k] = *(const LAS bf16x8*)(lds + PG_SB(b, h) + boff + n * 2048 + k * 1024); } while (0)
#define PG_MMA(ai, bj, At, Bt) do { __builtin_amdgcn_s_setprio(1); _Pragma("unroll") for (int m = 0; m < 4; ++m) _Pragma("unroll") for (int n = 0; n < 2; ++n) _Pragma("unroll") for (int k = 0; k < 2; ++k) \
        acc[ai][bj][m][n] = __builtin_amdgcn_mfma_f32_16x16x32_bf16(Bt[n][k], At[m][k], acc[ai][bj][m][n], 0, 0, 0); __builtin_amdgcn_s_setprio(0); } while (0)
#define PG_WAIT_V(n) asm volatile("s_waitcnt vmcnt(" #n ")" ::: "memory")
#define PG_WAIT_L(n) asm volatile("s_waitcnt lgkmcnt(" #n ")" ::: "memory")
#define PG_BAR __builtin_amdgcn_s_barrier()
#define PG_SCHED __builtin_amdgcn_sched_barrier(0)
    Unit cur, nxt; int ui = 0;
    if (!S.next(0, cur)) return;
    f32x4 acc[2][2][4][2];
#pragma unroll
    for (int a = 0; a < 2; ++a)
#pragma unroll
        for (int b = 0; b < 2; ++b)
#pragma unroll
            for (int m = 0; m < 4; ++m)
#pragma unroll
                for (int n = 0; n < 2; ++n) acc[a][b][m][n] = (f32x4){0.f, 0.f, 0.f, 0.f};
    bf16x8 At[4][2], B0[2][2], B1[2][2];
    { const char* p0 = PG_APTR(cur, 0); const char* p1 = PG_APTR(cur, 1);
      PG_STAGE_B(PG_SB(0, 0), cur.b, 0); PG_STAGE_B(PG_SB(0, 1), cur.b, 1); PG_STAGE_A(PG_SA(0, 0), p0, 0, PG_ASEL(0)); PG_STAGE_A(PG_SA(0, 1), p0, 1, PG_ASEL(0));
      if (wr == 1) PG_BAR;
      PG_WAIT_V(2); PG_BAR;
      PG_STAGE_B(PG_SB(1, 0), cur.b + 128, 0); PG_STAGE_A(PG_SA(1, 0), p1, 0, PG_ASEL(1)); PG_STAGE_B(PG_SB(1, 1), cur.b + 128, 1);
      PG_WAIT_V(6); PG_BAR; }
    for (;;) {
        const bool has_next = S.next(ui + 1, nxt);
        const char* nA0 = has_next ? PG_APTR(nxt, 0) : PG_APTR(cur, 0); const char* nA1 = has_next ? PG_APTR(nxt, 1) : PG_APTR(cur, 1); const char* nB = has_next ? nxt.b : cur.b;
        for (int t = 0; t < nt; t += 2) {
            const bool last = (t == nt - 2);
            if constexpr (Epi::NHOOK >= 1) { if (t == E.h0) { int t2 = threadIdx.x; asm volatile("" : "+v"(t2)); E.hook(acc, cur, 0, wr, wc, t2 & 15, (t2 >> 4) & 3); } }
            if constexpr (Epi::NHOOK >= 2) { if (t == E.h1) { int t2 = threadIdx.x; asm volatile("" : "+v"(t2)); E.hook(acc, cur, 1, wr, wc, t2 & 15, (t2 >> 4) & 3); } }
            const char* a1 = PG_APTR(cur, t + 1); const bool s1 = PG_ASEL(t + 1);
            const char* a2 = last ? nA0 : PG_APTR(cur, t + 2); const char* a3 = last ? nA1 : PG_APTR(cur, t + 3);
            const char* b2 = last ? nB : cur.b + (size_t)(t + 2) * 128; const char* b3 = b2 + 128;
            const bool s2 = last ? PG_ASEL(0) : PG_ASEL(t + 2), s3 = last ? PG_ASEL(1) : PG_ASEL(t + 3);
            PG_LDB(B0, 0, 0); PG_LDB(B1, 0, 1); PG_SCHED; PG_LDA(At, 0, 0); PG_STAGE_A(PG_SA(1, 1), a1, 1, s1);
            PG_WAIT_V(8); PG_WAIT_L(0); PG_BAR; PG_MMA(0, 0, At, B0); PG_MMA(0, 1, At, B1); PG_BAR; PG_SCHED;
            PG_LDA(At, 0, 1); PG_STAGE_B(PG_SB(0, 0), b2, 0); PG_STAGE_B(PG_SB(0, 1), b2, 1); PG_STAGE_A(PG_SA(0, 0), a2, 0, s2);
            PG_WAIT_V(8); PG_WAIT_L(0); PG_BAR; PG_MMA(1, 0, At, B0); PG_MMA(1, 1, At, B1); PG_BAR; PG_SCHED;
            PG_LDB(B0, 1, 0); PG_LDB(B1, 1, 1); PG_SCHED; PG_LDA(At, 1, 0); PG_STAGE_A(PG_SA(0, 1), a2, 1, s2);
            PG_WAIT_V(8); PG_WAIT_L(0); PG_BAR; PG_MMA(0, 0, At, B0); PG_MMA(0, 1, At, B1); PG_BAR; PG_SCHED;
            PG_LDA(At, 1, 1); PG_STAGE_B(PG_SB(1, 0), b3, 0); PG_STAGE_B(PG_SB(1, 1), b3, 1); PG_STAGE_A(PG_SA(1, 0), a3, 0, s3);
            PG_WAIT_V(8); PG_WAIT_L(0); PG_BAR; PG_MMA(1, 0, At, B0); PG_MMA(1, 1, At, B1); PG_BAR; PG_SCHED;
        }
        if (PG_ALIGN && wr == 0) PG_BAR;
        if constexpr (!Epi::AFTER_DRAIN) { int t2 = threadIdx.x; asm volatile("" : "+v"(t2)); E(acc, cur, wr, wc, t2 & 15, (t2 >> 4) & 3); }
        if (!has_next) break;
#pragma unroll
        for (int a = 0; a < 2; ++a)
#pragma unroll
            for (int b = 0; b < 2; ++b)
#pragma unroll
                for (int m = 0; m < 4; ++m)
#pragma unroll
                    for (int n = 0; n < 2; ++n) acc[a][b][m][n] = (f32x4){0.f, 0.f, 0.f, 0.f};
        cur = nxt; ++ui;
        if (PG_ALIGN && wr == 1) PG_BAR;
    }
    PG_WAIT_V(0);
    if (!PG_ALIGN && wr == 0) PG_BAR;
    PG_BAR;
    if constexpr (Epi::AFTER_DRAIN) { int t2 = threadIdx.x; asm volatile("" : "+v"(t2)); E.fused(acc, cur, wr, wc, t2 & 15, (t2 >> 4) & 3, lds, wid, t2 & 63); }
#undef PG_SA
#undef PG_SB
#undef PG_GLDS
#undef PG_ASEL
#undef PG_APTR
#undef PG_STAGE_A
#undef PG_STAGE_B
#undef PG_LDA
#undef PG_LDB
#undef PG_MMA
#undef PG_WAIT_V
#undef PG_WAIT_L
#undef PG_BAR
#undef PG_SCHED
}
}
using pg::Unit; using pg::Geo;

#define EPI_ROWS _Pragma("unroll") for (int ai = 0; ai < 2; ++ai) _Pragma("unroll") for (int m = 0; m < 4; ++m)
#define EPI_ROW (128 * ai + 64 * wr + 16 * m + fr)
#define EPI_COLS _Pragma("unroll") for (int bj = 0; bj < 2; ++bj)
#define EPI_COL0 (128 * bj + 32 * wc + 8 * fq)
typedef f32x4 acc_t[2][2][4][2];

struct Base { unsigned char* ws; unsigned char* dout; };
#define modx ((float*)(F.ws + WS_MOD))
#define modc (modx + 9216)
#define lgp (modx + 2 * 9216)
#define Ax ((bf16_t*)(F.dout + DO_AX))
#define Ac ((bf16_t*)(F.ws + WS_DC + 512 * 1024))
#define Dx ((bf16_t*)F.dout)
#define Dc ((bf16_t*)(F.ws + WS_DC))
#define Hb ((bf16_t*)(F.ws + WS_H))
#define Hc ((bf16_t*)(F.ws + WS_HC))
#define W13t ((bf16_t*)(F.ws + WS_WB + WB_W13))
#define W2t ((bf16_t*)(F.ws + WS_WB + WB_W2))
#define W13t1 ((bf16_t*)(F.ws + WS_O + WB_W13))
#define W2t1 ((bf16_t*)(F.ws + WS_O + WB_W2))
#define ropeT ((float*)(F.ws + WS_TAB + TB_ROPE))
#define twT ((float*)(F.ws + WS_TAB + TB_TW))
#define FmT ((bf16_t*)(F.ws + WS_TAB + TB_FM))
#define GmT ((bf16_t*)(F.ws + WS_TAB + TB_GM))
#define T256 ((bf16_t*)(F.ws + WS_TAB + TB_T256))
#define Win ((bf16_t*)(F.ws + WS_WIN))
#define Wn ((bf16_t*)(F.ws + WS_WN))
#define Bz ((bf16_t*)(F.ws + WS_OUTW))
#define WoT ((bf16_t*)(F.ws + WS_OUTW + 6 * MiB))
#define Qb ((bf16_t*)(F.ws + WS_Q))
#define Knb ((bf16_t*)(F.ws + WS_KN))
#define Ktb_ ((bf16_t*)(F.ws + WS_KT))
#define Pb Ktb_
#define B4 ((bf16_t*)(F.ws + WS_B4))
#define Ob ((bf16_t*)(F.ws + WS_O))
#define S0 ((float*)(F.ws + WS_S0))
#define stats ((float*)(F.ws + WS_STATS))
#define KcT ((bf16_t*)(F.ws + WS_KC))
#define VcT ((bf16_t*)(F.ws + WS_VC))
#define Wt ((bf16_t*)(F.ws + WS_WT))
#define Bt ((bf16_t*)(F.ws + WS_BT))
#define MIXb ((bf16_t*)(F.ws + WS_MIX))
#define GAb ((bf16_t*)(F.ws + WS_GA))
#define GFb ((bf16_t*)(F.ws + WS_GF))
#define Zb (MIXb + 1024)
#define XcSlab ((float*)(F.ws + WS_XCSLAB))

struct EpiSwiglu {
    static constexpr int NHOOK = 0; static constexpr int AFTER_DRAIN = 0; int h0, h1;
    Base F;
    __device__ __forceinline__ void hook(acc_t&, const Unit&, int, int, int, int, int) const {}
    __device__ __forceinline__ void operator()(const acc_t& acc, const Unit& u, int wr, int wc, int fr, int fq) const {
        bf16_t* base = u.i0 < 64 ? Hb + (size_t)u.i0 * 256 * DFF : Hc;
        EPI_ROWS { bf16_t* rowp = base + (size_t)EPI_ROW * DFF + u.i1 * 128 + 32 * wc + 8 * fq; f32x4 h[2];
#pragma unroll
            for (int n = 0; n < 2; ++n)
#pragma unroll
                for (int e = 0; e < 4; ++e) h[n][e] = fsilu(acc[ai][0][m][n][e]) * acc[ai][1][m][n][e];
            if (u.i0 == 64) st16wt(rowp, pack8(h[0], h[1])); else *(u32x4*)rowp = pack8(h[0], h[1]); if (m & 1) asm volatile("" ::: "memory"); }
        if (u.i0 == 64) { asm volatile("s_waitcnt vmcnt(0)" ::: "memory");
            if (fr == 0 && fq == 0) __hip_atomic_fetch_add((unsigned*)(F.ws + WS_CTL) + 24576, 1u, __ATOMIC_RELAXED, __HIP_MEMORY_SCOPE_AGENT); }
    }
};
struct EpiResid {
    static constexpr int NHOOK = 0; static constexpr int AFTER_DRAIN = 0; int h0, h1;
    Base F; int mode;
    __device__ __forceinline__ void hook(acc_t&, const Unit&, int, int, int, int, int) const {}
    __device__ __forceinline__ void operator()(const acc_t& acc, const Unit& u, int wr, int wc, int fr, int fq) const {
        const bool isx = u.i0 < 64; const int has_old = mode != 0; const float scale = mode == 1 ? 1.0f : 0.5f;
        const bf16_t* din = Dx + (size_t)u.i0 * 256 * DM; bf16_t* dout = isx ? (mode == 2 ? Ob : Dx) + (size_t)u.i0 * 256 * DM : Dc;
        const float* coef = (isx ? modx : modc) + (mode == 0 ? 2 : (mode == 1 ? 5 : 8)) * DM + u.i1 * 256;
        EPI_COLS { const int c = EPI_COL0; const f32x4 c0 = *(const f32x4*)(coef + c) * scale, c1 = *(const f32x4*)(coef + c + 4) * scale;
#pragma unroll
            for (int ai = 0; ai < 2; ++ai)
#pragma unroll
                for (int m = 0; m < 4; ++m) { const size_t off = (size_t)EPI_ROW * DM + u.i1 * 256 + c;
                    f32x4 v0 = acc[ai][bj][m][0] * c0, v1 = acc[ai][bj][m][1] * c1;
                    if (has_old) { f32x4 o0, o1; unpack8(*(const u32x4*)(din + off), o0, o1); v0 += o0; v1 += o1; }
                    *(u32x4*)(dout + off) = pack8(v0, v1); if (m & 1) asm volatile("" ::: "memory"); } }
    }
};

struct EpiFuse {
    static constexpr int NHOOK = 0; static constexpr int AFTER_DRAIN = 1; int h0, h1; Base F; int mode; const float* x; const float* nw;
    __device__ __forceinline__ void hook(acc_t&, const Unit&, int, int, int, int, int) const {}
    __device__ __forceinline__ void operator()(const acc_t&, const Unit&, int, int, int, int) const {}
    __device__ __forceinline__ void fused(acc_t& acc, const Unit& u, int wr, int wc, int fr, int fq, LAS unsigned char* lds, int wid, int lane) const {
        const int pm = u.i0, pn = u.i1; const float scale = mode == 1 ? 1.0f : 0.5f;
        const float* coef = modx + (mode == 0 ? 2 : (mode == 1 ? 5 : 8)) * DM + pn * 256;
        const bf16_t* din = (mode == 2 ? Ob : Dx) + (size_t)pm * 256 * DM + pn * 256; bf16_t* dout = (mode == 1 ? Ob : Dx) + (size_t)pm * 256 * DM + pn * 256;
        const float* xt = x + (size_t)pm * 256 * DM + pn * 256;
        LAS float* P = (LAS float*)lds; LAS float* S = (LAS float*)(lds + 4096);
        f32x4 cf[2][2];
#pragma unroll
        for (int bj = 0; bj < 2; ++bj) { cf[bj][0] = *(const f32x4*)(coef + EPI_COL0) * scale; cf[bj][1] = *(const f32x4*)(coef + EPI_COL0 + 4) * scale; }
#pragma unroll
        for (int aim = 0; aim < 4; ++aim) { const int ai = aim >> 1; f32x4 xv[4][2][2]; u32x4 ov[4][2];
#pragma unroll
            for (int m = 2 * (aim & 1); m < 2 * (aim & 1) + 2; ++m) EPI_COLS { const size_t off = (size_t)EPI_ROW * DM + EPI_COL0; xv[m][bj][0] = *(const f32x4*)(xt + off); xv[m][bj][1] = *(const f32x4*)(xt + off + 4); if (mode != 0) ov[m][bj] = *(const u32x4*)(din + off); }
#pragma unroll
            for (int m = 2 * (aim & 1); m < 2 * (aim & 1) + 2; ++m) { const int row = EPI_ROW; float ss = 0.f;
                EPI_COLS { const size_t off = (size_t)row * DM + EPI_COL0; f32x4 d0 = acc[ai][bj][m][0] * cf[bj][0], d1 = acc[ai][bj][m][1] * cf[bj][1];
                    if (mode != 0) { f32x4 o0, o1; unpack8(ov[m][bj], o0, o1); d0 += o0; d1 += o1; }
                    if (mode != 2) *(u32x4*)(dout + off) = pack8(d0, d1);
                    const f32x4 v0 = xv[m][bj][0] + d0, v1 = xv[m][bj][1] + d1; acc[ai][bj][m][0] = v0; acc[ai][bj][m][1] = v1;
                    ss += (v0[0] * v0[0] + v0[1] * v0[1]) + (v0[2] * v0[2] + v0[3] * v0[3]) + (v1[0] * v1[0] + v1[1] * v1[1]) + (v1[2] * v1[2] + v1[3] * v1[3]); }
                ss += __shfl_xor(ss, 16); ss += __shfl_xor(ss, 32);
                if (fq == 0) P[row * 4 + wc] = ss; }
            asm volatile("" ::: "memory"); }
        asm volatile("s_waitcnt lgkmcnt(0)" ::: "memory"); __builtin_amdgcn_s_barrier(); asm volatile("" ::: "memory");
        float* xb = (float*)(F.ws + WS_XB) + (size_t)mode * 64 * 256 * 4; unsigned* cnt = (unsigned*)(F.ws + WS_CTL) + 8192 + mode * 4096 + 64 * pm;
        const int prow = wid * 32 + (lane & 31);
        if (lane < 32) { const float t = (P[prow * 4 + 0] + P[prow * 4 + 1]) + (P[prow * 4 + 2] + P[prow * 4 + 3]);
            __hip_atomic_store(xb + ((size_t)(pm * 256 + prow) * 4 + pn), t, __ATOMIC_RELAXED, __HIP_MEMORY_SCOPE_AGENT); }
        asm volatile("s_waitcnt vmcnt(0)" ::: "memory");
        if (lane == 0) __hip_atomic_fetch_add(cnt, 1u, __ATOMIC_RELAXED, __HIP_MEMORY_SCOPE_AGENT);
        if (wid == 0) { unsigned sp = 0;
            while ((unsigned)__builtin_amdgcn_readfirstlane(__hip_atomic_load(cnt, __ATOMIC_RELAXED, __HIP_MEMORY_SCOPE_AGENT)) < 32u) { __builtin_amdgcn_s_sleep(2); if (++sp > (1u << 22)) break; }
            __builtin_amdgcn_fence(__ATOMIC_ACQUIRE, "agent"); }
        asm volatile("s_waitcnt vmcnt(0) lgkmcnt(0)" ::: "memory"); __builtin_amdgcn_s_barrier(); asm volatile("" ::: "memory");
        if (lane < 32) { const float* sl = xb + (size_t)(pm * 256 + prow) * 4; float t = 0.f;
#pragma unroll
            for (int q = 0; q < 4; ++q) t += __hip_atomic_load(sl + q, __ATOMIC_RELAXED, __HIP_MEMORY_SCOPE_AGENT);
            S[prow] = 1.0f / sqrtf(t * (1.0f / DM) + EPS); }
        asm volatile("s_waitcnt lgkmcnt(0)" ::: "memory"); __builtin_amdgcn_s_barrier(); asm volatile("" ::: "memory");
        const float* md = modx + (mode == 0 ? 3 : 6) * DM + pn * 256; const float* nwp = nw + pn * 256;
        f32x4 wv[2][2], shv[2][2];
#pragma unroll
        for (int bj = 0; bj < 2; ++bj)
#pragma unroll
            for (int n = 0; n < 2; ++n) { const int c = EPI_COL0 + 4 * n; const f32x4 w = *(const f32x4*)(nwp + c);
                if (mode == 2) { wv[bj][n] = w; shv[bj][n] = (f32x4){0.f, 0.f, 0.f, 0.f}; } else { wv[bj][n] = w * (*(const f32x4*)(md + DM + c) + 1.0f); shv[bj][n] = *(const f32x4*)(md + c); } }
        EPI_ROWS { const int row = EPI_ROW; const float rinv = S[row];
            EPI_COLS { const size_t off = (size_t)row * DM + EPI_COL0;
                const f32x4 y0 = (acc[ai][bj][m][0] * rinv) * wv[bj][0] + shv[bj][0], y1 = (acc[ai][bj][m][1] * rinv) * wv[bj][1] + shv[bj][1];
                if (mode == 2) { float* o = (float*)F.dout + (size_t)pm * 256 * DM + pn * 256 + off; *(f32x4*)o = y0; *(f32x4*)(o + 4) = y1; }
                else *(u32x4*)(Ax + (size_t)pm * 256 * DM + pn * 256 + off) = pack8(y0, y1); } }
        asm volatile("s_waitcnt lgkmcnt(0)" ::: "memory"); __builtin_amdgcn_s_barrier(); asm volatile("" ::: "memory");
    }
};
struct JobFfn1 {
    Base F; int nM, first;
    __device__ __forceinline__ void fill(int L, Unit& u) const { int pm, pn; if (first) { if (L < 22) { pm = 64; pn = L; } else pg::tile_pm_pn(L - 22, 64, 22, pm, pn); } else pg::tile_pm_pn(L, nM, 22, pm, pn);
        u.a0 = (const char*)(pm < 64 ? Ax + (size_t)pm * 256 * DM : Ac); u.a1 = u.a0; u.b = (const char*)((first ? W13t1 : W13t) + (size_t)pn * 256 * DM); u.d = nullptr; u.i0 = pm; u.i1 = pn; u.i2 = 0; u.i3 = 0; }
};
struct JobFfn2 {
    Base F; int nM, first;
    __device__ __forceinline__ void fill(int L, Unit& u) const { int pm, pn; pg::tile_pm_pn(L, nM, 4, pm, pn);
        u.a0 = (const char*)(pm < 64 ? Hb + (size_t)pm * 256 * DFF : Hc); u.a1 = u.a0; u.b = (const char*)((first ? W2t1 : W2t) + (size_t)pn * 256 * DFF); u.d = nullptr; u.i0 = pm; u.i1 = pn; u.i2 = 0; u.i3 = 0; }
};

struct EpiStore {
    static constexpr int NHOOK = 0; static constexpr int AFTER_DRAIN = 0; int h0, h1; int ldd;
    __device__ __forceinline__ void hook(acc_t&, const Unit&, int, int, int, int, int) const {}
    __device__ __forceinline__ void operator()(const acc_t& acc, const Unit& u, int wr, int wc, int fr, int fq) const {
        bf16_t* d = (bf16_t*)u.d;
        EPI_ROWS { EPI_COLS { *(u32x4*)(d + (size_t)EPI_ROW * ldd + EPI_COL0) = pack8(acc[ai][bj][m][0], acc[ai][bj][m][1]); }  asm volatile("" ::: "memory"); }
    }
};
struct EpiQK {
    static constexpr int NHOOK = 0; static constexpr int AFTER_DRAIN = 1; int h0, h1;
    Base F; int pair;
    __device__ __forceinline__ void hook(acc_t&, const Unit&, int, int, int, int, int) const {}
    __device__ __forceinline__ void operator()(const acc_t&, const Unit&, int, int, int, int) const {}
    __device__ __forceinline__ void fused(acc_t& acc, const Unit& u, int wr, int wc, int fr, int fq, LAS unsigned char* lds, int wid, int lane) const {
        const int pm = u.i0, pn = u.i1, hl = pn & 1, h = 2 * pair + hl; const bool isk = pn >= 2; const float lgf = lgp[h], lgb = lgp[4 + h]; const float* rope = ropeT;
        constexpr int PITCH = 528;
        const int tid = wid * 64 + lane, p8 = tid & 31;
        float zf[8], zb[8];
#pragma unroll
        for (int e = 0; e < 8; ++e) { const int jl = (pm * 256 + p8 * 8 + e) & (LS - 1); zf[e] = __expf(lgf * (float)(LS - 1 - jl)); zb[e] = __expf(lgb * (float)jl); }
#pragma unroll
        for (int bj = 0; bj < 2; ++bj) {
            EPI_ROWS { const int row = EPI_ROW, pos = pm * 256 + row, prow = pos >> 6, pcol = pos & 63;
                const int d0 = EPI_COL0, i0 = d0 >> 1, p = i0 < 64 ? prow : pcol, f0 = i0 & 63;
                const f32x4 t0 = *(const f32x4*)(rope + (size_t)(p * 64 + f0) * 2), t1 = *(const f32x4*)(rope + (size_t)(p * 64 + f0) * 2 + 4);
                f32x4 a = acc[ai][bj][m][0], b = acc[ai][bj][m][1];
                if (!isk) { a *= 0.0625f; b *= 0.0625f; }
                const f32x4 ra = {a[0] * t0[0] - a[1] * t0[1], a[0] * t0[1] + a[1] * t0[0], a[2] * t0[2] - a[3] * t0[3], a[2] * t0[3] + a[3] * t0[2]};
                const f32x4 rb = {b[0] * t1[0] - b[1] * t1[1], b[0] * t1[1] + b[1] * t1[0], b[2] * t1[2] - b[3] * t1[3], b[2] * t1[3] + b[3] * t1[2]};
                const u32x4 pk = pack8(ra, rb);
                if (!isk) *(u32x4*)(Qb + (size_t)pos * 512 + hl * 256 + d0) = pk;
                else { *(u32x4*)(Knb + (size_t)pos * 512 + hl * 256 + d0) = pk;
                    LAS unsigned short* tp = (LAS unsigned short*)(lds + (32 * wc + 8 * fq) * PITCH + row * 2);
                    tp[0 * PITCH / 2] = (unsigned short)pk.x; tp[1 * PITCH / 2] = (unsigned short)(pk.x >> 16); tp[2 * PITCH / 2] = (unsigned short)pk.y; tp[3 * PITCH / 2] = (unsigned short)(pk.y >> 16);
                    tp[4 * PITCH / 2] = (unsigned short)pk.z; tp[5 * PITCH / 2] = (unsigned short)(pk.z >> 16); tp[6 * PITCH / 2] = (unsigned short)pk.w; tp[7 * PITCH / 2] = (unsigned short)(pk.w >> 16); }
                if (m & 1) asm volatile("" ::: "memory"); }
            if (isk) {
                asm volatile("s_waitcnt lgkmcnt(0)" ::: "memory"); __builtin_amdgcn_s_barrier(); asm volatile("" ::: "memory");
#pragma unroll
                for (int k = 0; k < 8; ++k) { const int dl = (tid >> 5) + 16 * k;
                    f32x4 v0, v1; unpack8(*(const LAS u32x4*)(lds + dl * PITCH + p8 * 16), v0, v1);
                    const f32x4 f0v = {v0[0] * zf[0], v0[1] * zf[1], v0[2] * zf[2], v0[3] * zf[3]}, f1v = {v1[0] * zf[4], v1[1] * zf[5], v1[2] * zf[6], v1[3] * zf[7]};
                    const f32x4 b0v = {v0[0] * zb[0], v0[1] * zb[1], v0[2] * zb[2], v0[3] * zb[3]}, b1v = {v1[0] * zb[4], v1[1] * zb[5], v1[2] * zb[6], v1[3] * zb[7]};
                    const size_t o = (size_t)(hl * 256 + bj * 128 + dl) * SEQ + pm * 256 + p8 * 8;
                    *(u32x4*)(Ktb_ + o) = pack8(f0v, f1v); *(u32x4*)(Ktb_ + (size_t)512 * SEQ + o) = pack8(b0v, b1v); }
                asm volatile("s_waitcnt lgkmcnt(0)" ::: "memory"); __builtin_amdgcn_s_barrier(); asm volatile("" ::: "memory");
            }
        }
    }
};
struct EpiVT {
    static constexpr int NHOOK = 0; static constexpr int AFTER_DRAIN = 0; int h0, h1; Base F;
    __device__ __forceinline__ void hook(acc_t&, const Unit&, int, int, int, int, int) const {}
    __device__ __forceinline__ void operator()(const acc_t& acc, const Unit& u, int wr, int wc, int fr, int fq) const {
        const int hl = u.i0 >> 1, vt = u.i0 & 1, pn = u.i1;
        EPI_ROWS { const int v = vt * 256 + EPI_ROW;
            EPI_COLS { const int pos = pn * 256 + EPI_COL0, seg = pos >> 9, jl = pos & (LS - 1);
                *(u32x4*)(B4 + ((size_t)((hl * NSEG + seg) * 512 + v)) * 1024 + 512 + jl) = pack8(acc[ai][bj][m][0], acc[ai][bj][m][1]); }  asm volatile("" ::: "memory"); }
    }
};
struct EpiKc {
    static constexpr int NHOOK = 0; static constexpr int AFTER_DRAIN = 0; int h0, h1; Base F;
    __device__ __forceinline__ void hook(acc_t&, const Unit&, int, int, int, int, int) const {}
    __device__ __forceinline__ void operator()(const acc_t& acc, const Unit& u, int wr, int wc, int fr, int fq) const {
        const int h = u.i1; const float lgf = lgp[h], lgb = lgp[4 + h]; bf16_t* Kcf = KcT; bf16_t* Kcb = KcT + (size_t)1024 * CTX;
        EPI_ROWS { const int j = EPI_ROW; const float zf = __expf(lgf * (float)(CTX - 1 - j)), zb = __expf(lgb * (float)j);
            EPI_COLS { const int d0 = EPI_COL0;
#pragma unroll
                for (int e = 0; e < 8; ++e) { const float v = acc[ai][bj][m][e >> 2][e & 3]; const size_t o = (size_t)(h * 256 + d0 + e) * CTX + j;
                    Kcf[o] = f2bf(v * zf); Kcb[o] = f2bf(v * zb); } }  asm volatile("" ::: "memory"); }
    }
};
struct EpiVc {
    static constexpr int NHOOK = 0; static constexpr int AFTER_DRAIN = 0; int h0, h1; Base F;
    __device__ __forceinline__ void hook(acc_t&, const Unit&, int, int, int, int, int) const {}
    __device__ __forceinline__ void operator()(const acc_t& acc, const Unit& u, int wr, int wc, int fr, int fq) const {
        const int h = u.i0 >> 1, vt = u.i0 & 1;
        EPI_ROWS { const int v = vt * 256 + EPI_ROW;
            EPI_COLS { *(u32x4*)(VcT + (size_t)(h * 512 + v) * CTX + EPI_COL0) = pack8(acc[ai][bj][m][0], acc[ai][bj][m][1]); }  asm volatile("" ::: "memory"); }
    }
};
struct EpiS0 {
    static constexpr int NHOOK = 0; static constexpr int AFTER_DRAIN = 0; int h0, h1; Base F;
    __device__ __forceinline__ void hook(acc_t&, const Unit&, int, int, int, int, int) const {}
    __device__ __forceinline__ void operator()(const acc_t& acc, const Unit& u, int wr, int wc, int fr, int fq) const {
        EPI_ROWS { float* rowp = S0 + ((size_t)((u.i0 * 2 + u.i1) * 512 + u.i3 * 256 + EPI_ROW)) * 256;
            EPI_COLS { *(f32x4*)(rowp + EPI_COL0) = acc[ai][bj][m][0]; *(f32x4*)(rowp + EPI_COL0 + 4) = acc[ai][bj][m][1]; }  asm volatile("" ::: "memory"); }
    }
};
struct EpiU {
    static constexpr int NHOOK = 0; static constexpr int AFTER_DRAIN = 0; int h0, h1; Base F;
    __device__ __forceinline__ void hook(acc_t&, const Unit&, int, int, int, int, int) const {}
    __device__ __forceinline__ void operator()(const acc_t& acc, const Unit& u, int wr, int wc, int fr, int fq) const {
        EPI_ROWS { bf16_t* rowp = B4 + ((size_t)((u.i0 * NSEG + u.i2) * 512 + u.i3 * 256 + EPI_ROW)) * 1024 + u.i1 * 256;
            EPI_COLS { *(u32x4*)(rowp + EPI_COL0) = pack8(acc[ai][bj][m][0], acc[ai][bj][m][1]); }  asm volatile("" ::: "memory"); }
    }
};
struct EpiP {
    static constexpr int NHOOK = 0; static constexpr int AFTER_DRAIN = 0; int h0, h1; Base F; int pair;
    __device__ __forceinline__ void hook(acc_t&, const Unit&, int, int, int, int, int) const {}
    __device__ __forceinline__ void operator()(const acc_t& acc, const Unit& u, int wr, int wc, int fr, int fq) const {
        const int hl = u.i0, seg = u.i1, it = u.i2, jt = u.i3, h = 2 * pair + hl; const float l2f = lgp[h] * 1.44269504f, l2b = lgp[4 + h] * 1.44269504f;
        EPI_ROWS { const int il = it * 256 + EPI_ROW; bf16_t* rowp = Pb + (size_t)(seg * LS + il) * 1024 + hl * 512 + jt * 256;
            EPI_COLS { const int j0 = jt * 256 + EPI_COL0; f32x4 v[2];
#pragma unroll
                for (int e = 0; e < 8; ++e) { const int dl = il - (j0 + e); const float w = dl > 0 ? __builtin_amdgcn_exp2f((float)dl * l2f) : (dl < 0 ? __builtin_amdgcn_exp2f((float)(-dl) * l2b) : 2.0f);
                    v[e >> 2][e & 3] = acc[ai][bj][m][e >> 2][e & 3] * w; }
                *(u32x4*)(rowp + EPI_COL0) = pack8(v[0], v[1]); }  asm volatile("" ::: "memory"); }
    }
};
struct EpiO {
    static constexpr int NHOOK = 2; static constexpr int AFTER_DRAIN = 0; int h0, h1; Base F; int pair;
    __device__ __forceinline__ void hook(acc_t& acc, const Unit& u, int k, int wr, int wc, int fr, int fq) const {
        const int h = 2 * pair + u.i0; const float lgf = lgp[h], lgb = lgp[4 + h];
        EPI_ROWS { const int il = u.i2 * 256 + EPI_ROW; const float eb = lgb * (float)(LS - il);
            const float f = k == 0 ? __expf(lgf * (float)(il + 1) - eb) : __expf(eb);
#pragma unroll
            for (int bj = 0; bj < 2; ++bj) { acc[ai][bj][m][0] *= f; acc[ai][bj][m][1] *= f; }  asm volatile("" ::: "memory"); }
    }
    __device__ __forceinline__ void operator()(const acc_t& acc, const Unit& u, int wr, int wc, int fr, int fq) const {
        const int h = 2 * pair + u.i0;
        EPI_ROWS { bf16_t* rowp = Ob + (size_t)(u.i1 * LS + u.i2 * 256 + EPI_ROW) * 2048 + h * 512 + u.i3 * 256;
            EPI_COLS { *(u32x4*)(rowp + EPI_COL0) = pack8(acc[ai][bj][m][0], acc[ai][bj][m][1]); }  asm volatile("" ::: "memory"); }
    }
};
struct EpiG {
    static constexpr int NHOOK = 0; static constexpr int AFTER_DRAIN = 0; int h0, h1; Base F; const float* gnw; int rep; LAS unsigned char* stl;
    __device__ __forceinline__ void hook(acc_t&, const Unit&, int, int, int, int, int) const {}
    __device__ __forceinline__ void operator()(const acc_t& acc, const Unit& u, int wr, int wc, int fr, int fq) const {
        const int pm = u.i0, pn = u.i1, h = pn >> 1; u32x4 ov[1][4][2]; f32x2 st[1][4]; f32x4 gw[2][2];
#pragma unroll
        for (int bj = 0; bj < 2; ++bj) { gw[bj][0] = *(const f32x4*)(gnw + pn * 256 + EPI_COL0); gw[bj][1] = *(const f32x4*)(gnw + pn * 256 + EPI_COL0 + 4); }
#pragma unroll
        for (int ai = 0; ai < 2; ++ai) {
#pragma unroll
        for (int m = 0; m < 4; ++m) { const int pos = pm * 256 + EPI_ROW; st[0][m] = *(const LAS f32x2*)(stl + EPI_ROW * 8);
            EPI_COLS { ov[0][m][bj] = *(const u32x4*)(Ob + (size_t)pos * 2048 + pn * 256 + EPI_COL0); } }
#pragma unroll
        for (int m = 0; m < 4; ++m) { const int pos = pm * 256 + EPI_ROW; const f32x2 s2 = st[0][m];
            EPI_COLS { bf16_t* p = Ob + (size_t)pos * 2048 + pn * 256 + EPI_COL0; f32x4 o0, o1; unpack8(ov[0][m][bj], o0, o1);
                const f32x4 g0 = acc[ai][bj][m][0], g1 = acc[ai][bj][m][1]; f32x4 r0, r1;
#pragma unroll
                for (int e = 0; e < 4; ++e) { r0[e] = DBG_NORET ? 0.f : fsilu(g0[e]) * ((o0[e] - s2.x) * s2.y) * gw[bj][0][e]; r1[e] = DBG_NORET ? 0.f : fsilu(g1[e]) * ((o1[e] - s2.x) * s2.y) * gw[bj][1][e]; }
                *(u32x4*)p = rep == 0 ? pack8(r0, r1) : ov[0][m][bj]; } }
        asm volatile("" ::: "memory"); }
    }
};
struct EpiF {
    static constexpr int NHOOK = 0; static constexpr int AFTER_DRAIN = 0; int h0, h1; Base F;
    __device__ __forceinline__ void hook(acc_t&, const Unit&, int, int, int, int, int) const {}
    __device__ __forceinline__ void operator()(const acc_t& acc, const Unit& u, int wr, int wc, int fr, int fq) const {
        EPI_ROWS { const int mrow = u.i0 * 256 + EPI_ROW, ri = mrow >> 10, ch = mrow & 1023;
            EPI_COLS { const int c0 = EPI_COL0, l2 = 2 * u.i1 + (c0 >> 7), l1 = c0 & 127;
                *(u32x4*)(Wt + (size_t)(ch * 128 + l2) * 256 + ri * 128 + l1) = pack8(acc[ai][bj][m][0], acc[ai][bj][m][1]); }  asm volatile("" ::: "memory"); }
    }
};
struct EpiF1 {
    static constexpr int NHOOK = 0; static constexpr int AFTER_DRAIN = 0; int h0, h1; Base F;
    __device__ __forceinline__ void hook(acc_t&, const Unit&, int, int, int, int, int) const {}
    __device__ __forceinline__ void operator()(const acc_t& acc, const Unit& u, int wr, int wc, int fr, int fq) const {
        EPI_ROWS { const int r = EPI_ROW, k1 = r >> 1, ri = r & 1; const float sg = ri ? -1.0f : 1.0f;
            EPI_COLS { const int n = u.i1 * 256 + EPI_COL0, ch = n >> 7, l2 = n & 127; f32x4 v[2];
#pragma unroll
                for (int e = 0; e < 8; ++e) { const float rev = (float)((k1 * (l2 + e)) & 16383) * (1.0f / 16384.0f);
                    const float cs = __builtin_amdgcn_cosf(rev), sn = __builtin_amdgcn_sinf(rev); const float mine = acc[ai][bj][m][e >> 2][e & 3], other = __shfl_xor(mine, 1);
                    v[e >> 2][e & 3] = mine * cs + sg * other * sn; }
                *(u32x4*)(Bt + (size_t)(k1 * 1024 + ch) * 256 + ri * 128 + l2) = pack8(v[0], v[1]); }  asm volatile("" ::: "memory"); }
    }
};
struct EpiF2 {
    static constexpr int NHOOK = 0; static constexpr int AFTER_DRAIN = 0; int h0, h1; Base F;
    __device__ __forceinline__ void hook(acc_t&, const Unit&, int, int, int, int, int) const {}
    __device__ __forceinline__ void operator()(const acc_t& acc, const Unit& u, int wr, int wc, int fr, int fq) const {
        const int k1 = u.i1 >> 2, chb = (u.i1 & 3) * 256;
#pragma unroll
        for (int m = 0; m < 4; ++m) { const int k2 = 64 * wr + 16 * m + fr; bf16_t* rowp = MIXb + (size_t)(k1 + 128 * k2) * 2048 + chb;
            EPI_COLS { *(u32x4*)(rowp + EPI_COL0) = pack8(acc[0][bj][m][0], acc[0][bj][m][1]); } }
    }
};
struct EpiGate {
    static constexpr int NHOOK = 0; static constexpr int AFTER_DRAIN = 0; int h0, h1; Base F;
    __device__ __forceinline__ void hook(acc_t&, const Unit&, int, int, int, int, int) const {}
    __device__ __forceinline__ void operator()(const acc_t& acc, const Unit& u, int wr, int wc, int fr, int fq) const {
        bf16_t* dst = (u.i1 >> 2) ? GFb : GAb; const int cb = (u.i1 & 3) * 256;
        EPI_ROWS { bf16_t* rowp = dst + (size_t)(u.i0 * 256 + EPI_ROW) * DM + cb;
            EPI_COLS { f32x4 s0, s1;
#pragma unroll
                for (int e = 0; e < 4; ++e) { s0[e] = fsigmoid(acc[ai][bj][m][0][e]); s1[e] = fsigmoid(acc[ai][bj][m][1][e]); }
                *(u32x4*)(rowp + EPI_COL0) = pack8(s0, s1); }  asm volatile("" ::: "memory"); }
    }
};
struct EpiZ {
    static constexpr int NHOOK = 1; static constexpr int AFTER_DRAIN = 0; int h0, h1; Base F;
    __device__ __forceinline__ void hook(acc_t& acc, const Unit& u, int, int wr, int wc, int fr, int fq) const {
        EPI_ROWS { const size_t ro = (size_t)(u.i0 * 256 + EPI_ROW) * DM + u.i1 * 256;
            EPI_COLS { f32x4 a0, a1, f0, f1; unpack8(*(const u32x4*)(GAb + ro + EPI_COL0), a0, a1); unpack8(*(const u32x4*)(GFb + ro + EPI_COL0), f0, f1);
#pragma unroll
                for (int e = 0; e < 4; ++e) { acc[ai][bj][m][0][e] *= DBG_NOFOUR ? 0.f : f0[e] * __builtin_amdgcn_rcpf(fmaxf(a0[e], 1e-30f)); acc[ai][bj][m][1][e] *= DBG_NOFOUR ? 0.f : f1[e] * __builtin_amdgcn_rcpf(fmaxf(a1[e], 1e-30f)); } }  asm volatile("" ::: "memory"); }
    }
    __device__ __forceinline__ void operator()(const acc_t& acc, const Unit& u, int wr, int wc, int fr, int fq) const {
        EPI_ROWS { const size_t ro = (size_t)(u.i0 * 256 + EPI_ROW) * DM + u.i1 * 256;
            EPI_COLS { f32x4 a0, a1; unpack8(*(const u32x4*)(GAb + ro + EPI_COL0), a0, a1); f32x4 v0, v1;
#pragma unroll
                for (int e = 0; e < 4; ++e) { v0[e] = acc[ai][bj][m][0][e] * fmaxf(a0[e], 1e-30f); v1[e] = acc[ai][bj][m][1][e] * fmaxf(a1[e], 1e-30f); }
                *(u32x4*)(Zb + ro + EPI_COL0) = pack8(v0, v1); }  asm volatile("" ::: "memory"); }
    }
};

struct EpiSlab {
    static constexpr int NHOOK = 0; static constexpr int AFTER_DRAIN = 0; int h0, h1; Base F;
    __device__ __forceinline__ void hook(acc_t&, const Unit&, int, int, int, int, int) const {}
    __device__ __forceinline__ void operator()(const acc_t& acc, const Unit& u, int wr, int wc, int fr, int fq) const {
        float* dst = XcSlab + (size_t)u.i2 * CTX * DM + u.i1 * 256;
        EPI_ROWS { float* rowp = dst + (size_t)EPI_ROW * DM;
            EPI_COLS { *(f32x4*)(rowp + EPI_COL0) = acc[ai][bj][m][0]; *(f32x4*)(rowp + EPI_COL0 + 4) = acc[ai][bj][m][1]; } }
    }
};
struct JobCtxG2 {
    Base F;
    __device__ __forceinline__ void fill(int L, Unit& u) const { const int pn = L & 3, kc = L >> 2;
        u.a0 = (const char*)(Hc + kc * 256); u.a1 = u.a0; u.b = (const char*)(W2t1 + (size_t)pn * 256 * DFF + kc * 256); u.d = nullptr; u.i0 = 64; u.i1 = pn; u.i2 = kc; u.i3 = 0; }
};
struct EpiZ2 {
    static constexpr int NHOOK = 0; static constexpr int AFTER_DRAIN = 0; int h0, h1; Base F; int part;
    __device__ __forceinline__ void hook(acc_t&, const Unit&, int, int, int, int, int) const {}
    __device__ __forceinline__ void operator()(const acc_t& acc, const Unit& u, int wr, int wc, int fr, int fq) const {
        const bf16_t* G = part ? GAb : GFb;
#pragma unroll
        for (int ai = 0; ai < 2; ++ai) { u32x4 gv[4][2], tv[4][2];
#pragma unroll
            for (int m = 0; m < 4; ++m) { const size_t ro = (size_t)(u.i0 * 256 + EPI_ROW) * DM + u.i1 * 256, zo = (size_t)(u.i0 * 256 + EPI_ROW) * 2048 + u.i1 * 256;
                EPI_COLS { gv[m][bj] = *(const u32x4*)(G + ro + EPI_COL0); if (part) tv[m][bj] = *(const u32x4*)(Zb + zo + EPI_COL0); } }
#pragma unroll
            for (int m = 0; m < 4; ++m) { const size_t zo = (size_t)(u.i0 * 256 + EPI_ROW) * 2048 + u.i1 * 256;
                EPI_COLS { f32x4 g0, g1; unpack8(gv[m][bj], g0, g1); f32x4 v0 = acc[ai][bj][m][0] * g0, v1 = acc[ai][bj][m][1] * g1;
                    if (part) { f32x4 t0, t1; unpack8(tv[m][bj], t0, t1); v0 += t0; v1 += t1; }
                    *(u32x4*)(Zb + zo + EPI_COL0) = pack8(v0, v1); } }
            asm volatile("" ::: "memory"); }
    }
};
struct JobGate2 {
    Base F;
    __device__ __forceinline__ void fill(int L, Unit& u) const { const int c = L & 255, which = L >> 8; int pm, pn; pg::tile_pm_pn(c, 64, 4, pm, pn);
        u.a0 = (const char*)(Ax + (size_t)pm * 256 * DM); u.a1 = u.a0; u.b = (const char*)(Win + (size_t)(WR_GA + which * 1024 + pn * 256) * DM); u.d = nullptr; u.i0 = pm; u.i1 = which * 4 + pn; u.i2 = 0; u.i3 = 0; }
};
struct JobG2 {
    Base F;
    __device__ __forceinline__ void fill(int L, Unit& u) const { const int c = L & 255, half = L >> 8, pm = c >> 2, pn = 2 * (c & 3) + half;
        u.a0 = (const char*)(Ax + (size_t)pm * 256 * DM); u.a1 = u.a0; u.b = (const char*)(Win + (size_t)(WR_G + pn * 256) * DM); u.d = nullptr; u.i0 = pm; u.i1 = pn; u.i2 = 0; u.i3 = 0; }
};
struct JobFold {
    Base F;
    __device__ __forceinline__ void fill(int L, Unit& u) const { const int pn = L & 3, pm = (L >> 2) & 1, g = L >> 3;
        u.a0 = (const char*)(T256 + (size_t)pm * 256 * 256); u.a1 = u.a0; u.b = (const char*)(Wn + (size_t)pn * 256 * DM + g * 256);
        u.d = (char*)(Win + (size_t)(WR_F + pm * 1024 + g * 256) * DM + pn * 256); u.i0 = pm; u.i1 = pn; u.i2 = g; u.i3 = 0; }
};
struct JobRowCol {
    Base F; int sel, nM, nN; size_t aoff0, boff0, astep, bstep;
    __device__ __forceinline__ void fill(int L, Unit& u) const { int pm, pn; pg::tile_pm_pn(L, nM, nN, pm, pn);
        const bf16_t* A = sel == 0 ? Ax : (sel == 1 ? Win : Zb); const bf16_t* B = sel == 0 ? Win : (sel == 1 ? Ax : WoT);
        u.a0 = (const char*)(A + aoff0 + (size_t)pm * astep); u.a1 = u.a0; u.b = (const char*)(B + boff0 + (size_t)pn * bstep); u.d = nullptr; u.i0 = pm; u.i1 = pn; u.i2 = 0; u.i3 = 0; }
};
struct JobKc {
    Base F;
    __device__ __forceinline__ void fill(int L, Unit& u) const { const int h = L; u.a0 = (const char*)Ac; u.a1 = u.a0;
        u.b = (const char*)(Win + (size_t)((h >> 1) * 2048 + 512 + (h & 1) * 256) * DM); u.d = nullptr; u.i0 = 0; u.i1 = h; u.i2 = 0; u.i3 = 0; }
};
struct JobVc {
    Base F;
    __device__ __forceinline__ void fill(int L, Unit& u) const { const int t = L, h = t >> 1; u.a0 = (const char*)(Win + (size_t)((h >> 1) * 2048 + 1024 + (h & 1) * 512 + (t & 1) * 256) * DM); u.a1 = u.a0;
        u.b = (const char*)Ac; u.d = nullptr; u.i0 = t; u.i1 = 0; u.i2 = 0; u.i3 = 0; }
};
struct JobS0 {
    Base F;
    __device__ __forceinline__ void fill(int L, Unit& u) const { const int h = L >> 2, dir = (L >> 1) & 1, vt = L & 1;
        u.a0 = (const char*)(VcT + (size_t)(h * 512 + vt * 256) * CTX); u.a1 = u.a0; u.b = (const char*)(KcT + (size_t)dir * 1024 * CTX + (size_t)(h * 256) * CTX);
        u.d = nullptr; u.i0 = h; u.i1 = dir; u.i2 = 0; u.i3 = vt; }
};
struct JobR1 {
    Base F;
    __device__ __forceinline__ void fill(int L, Unit& u) const { const int w = pg::xcd_contig(L, 256), vt = w & 1, dir = (w >> 1) & 1, seg = (w >> 2) & 31, hl = w >> 7;
        u.a0 = (const char*)(B4 + ((size_t)((hl * NSEG + seg) * 512 + vt * 256)) * 1024 + 512); u.a1 = u.a0;
        u.b = (const char*)(Ktb_ + (size_t)dir * 512 * SEQ + (size_t)(hl * 256) * SEQ + seg * LS); u.d = nullptr; u.i0 = hl; u.i1 = dir; u.i2 = seg; u.i3 = vt; }
};
struct JobR3 {
    Base F;
    __device__ __forceinline__ void fill(int L, Unit& u) const { const int w = pg::xcd_contig(L, 256), jt = w & 1, it = (w >> 1) & 1, seg = (w >> 2) & 31, hl = w >> 7;
        u.a0 = (const char*)(Qb + (size_t)(seg * LS + it * 256) * 512 + hl * 256); u.a1 = u.a0; u.b = (const char*)(Knb + (size_t)(seg * LS + jt * 256) * 512 + hl * 256);
        u.d = nullptr; u.i0 = hl; u.i1 = seg; u.i2 = it; u.i3 = jt; }
};
struct JobR4 {
    Base F;
    __device__ __forceinline__ void fill(int L, Unit& u) const { const int w = pg::xcd_contig(L, 256), vt = w & 1, it = (w >> 1) & 1, seg = (w >> 2) & 31, hl = w >> 7;
        u.a0 = (const char*)(Qb + (size_t)(seg * LS + it * 256) * 512 + hl * 256); u.a1 = (const char*)(Pb + (size_t)(seg * LS + it * 256) * 1024 + hl * 512);
        u.b = (const char*)(B4 + ((size_t)((hl * NSEG + seg) * 512 + vt * 256)) * 1024); u.d = nullptr; u.i0 = hl; u.i1 = seg; u.i2 = it; u.i3 = vt; }
};
struct JobF1 {
    Base F;
    __device__ __forceinline__ void fill(int L, Unit& u) const { u.a0 = (const char*)FmT; u.a1 = u.a0; u.b = (const char*)(Wt + (size_t)L * 256 * 256); u.d = nullptr; u.i0 = 0; u.i1 = L; u.i2 = 0; u.i3 = 0; }
};
struct JobF2 {
    Base F;
    __device__ __forceinline__ void fill(int L, Unit& u) const { u.a0 = (const char*)GmT; u.a1 = u.a0; u.b = (const char*)(Bt + (size_t)L * 256 * 256); u.d = nullptr; u.i0 = 0; u.i1 = L; u.i2 = 0; u.i3 = 0; }
};
struct JobZ {
    Base F; int part;
    __device__ __forceinline__ void fill(int L, Unit& u) const { int pm, pn; pg::tile_pm_pn(L, 64, 4, pm, pn);
        u.a0 = (const char*)((part ? Ob : MIXb) + (size_t)pm * 256 * 2048); u.a1 = u.a0; u.b = (const char*)(Bz + (size_t)pn * 256 * 3072 + (part ? 1024 : 0)); u.d = nullptr; u.i0 = pm; u.i1 = pn; u.i2 = 0; u.i3 = 0; }
};

#define XB_TMO      128
#define XB_XCNT(j)  (256  + 64 * (j))
#define XB_XSUB(j)  (1280 + 64 * (j))
#define XB_XGEN(j)  (2304 + 64 * (j))
#define XB_TOP      3328
#define XB_TOPGEN   3392
#define XCD_BAR_WORDS 3456
#define XB_SPIN_CAP (1u << 22)
__device__ __forceinline__ unsigned xb_ld(unsigned* p)              { return __hip_atomic_load(p, __ATOMIC_RELAXED, __HIP_MEMORY_SCOPE_AGENT); }
__device__ __forceinline__ unsigned xb_add(unsigned* p, unsigned v) { return __hip_atomic_fetch_add(p, v, __ATOMIC_RELAXED, __HIP_MEMORY_SCOPE_AGENT); }
__device__ __forceinline__ unsigned xb_xcc_id() { return (unsigned)__builtin_amdgcn_s_getreg((3 << 11) | 20) & 0xFu; }
#define XB_SPIN(cond, bar) do { unsigned _sp = 0; while (cond) { __builtin_amdgcn_s_sleep(1); \
    if ((++_sp & 255u) == 0u) { if (xb_ld(&(bar)[XB_TMO])) break; if (_sp > XB_SPIN_CAP) { atomicAdd(&(bar)[XB_TMO], 1u); break; } } } } while (0)
struct XcdBarrier { unsigned* bar; unsigned x; volatile LAS unsigned* st; };
__device__ __forceinline__ XcdBarrier xcd_barrier_post(unsigned* bar, volatile LAS unsigned* st) {
    XcdBarrier b; b.bar = bar; b.x = xb_xcc_id(); b.st = st;
    if (threadIdx.x == 0) (void)xb_add(&bar[XB_XCNT(b.x)], 1u);
    return b;
}
__device__ __forceinline__ void xcd_barrier_complete(unsigned* bar, unsigned x, unsigned& nloc, unsigned& nx) {
    const unsigned G = gridDim.x * gridDim.y * gridDim.z;
    unsigned sum, cnt, mine, sp = 0u;
    for (;;) {
        sum = 0u; cnt = 0u; mine = 0u;
#pragma unroll
        for (unsigned j = 0; j < 16; ++j) { const unsigned c = xb_ld(&bar[XB_XCNT(j)]); sum += c; cnt += (c > 0u) ? 1u : 0u; mine = (j == x) ? c : mine; }
        if (sum == G) break;
        __builtin_amdgcn_s_sleep(1);
        if ((++sp & 255u) == 0u) { if (xb_ld(&bar[XB_TMO])) break; if (sp > XB_SPIN_CAP) { atomicAdd(&bar[XB_TMO], 1u); break; } }
    }
    nloc = mine > 0u ? mine : 1u; nx = cnt > 0u ? cnt : 1u;
}
__device__ __attribute__((noinline)) void xcd_barrier(unsigned* bar_, unsigned bx_, volatile LAS unsigned* st_) {
    XcdBarrier b; b.bar = bar_; b.x = bx_; b.st = st_;
    asm volatile("s_waitcnt vmcnt(0)" ::: "memory");
    __syncthreads();
    if (threadIdx.x == 0) {
        unsigned* bar = b.bar;
        __builtin_amdgcn_s_waitcnt(0);
        unsigned nloc = b.st[0], nx = b.st[1];
        if (nloc == 0u) { xcd_barrier_complete(bar, b.x, nloc, nx); b.st[0] = nloc; b.st[1] = nx; }
        const unsigned old = xb_add(&bar[XB_XSUB(b.x)], 1u);
        const unsigned gen = old / nloc;
        if (old + 1u == (gen + 1u) * nloc) {
            __builtin_amdgcn_fence(__ATOMIC_RELEASE, "agent");
            asm volatile("s_waitcnt vmcnt(0)" ::: "memory");
            const unsigned og = xb_add(&bar[XB_TOP], 1u);
            const unsigned tg = og / nx;
            if (og + 1u == (tg + 1u) * nx) xb_add(&bar[XB_TOPGEN], 1u);
            else XB_SPIN(xb_ld(&bar[XB_TOPGEN]) == tg, bar);
            __builtin_amdgcn_fence(__ATOMIC_ACQUIRE, "agent");
            xb_add(&bar[XB_XGEN(b.x)], 1u);
            asm volatile("s_waitcnt vmcnt(0)" ::: "memory");
        } else {
            XB_SPIN(xb_ld(&bar[XB_XGEN(b.x)]) == gen, bar);
            __builtin_amdgcn_fence(__ATOMIC_ACQUIRE, "agent");
            asm volatile("s_waitcnt vmcnt(0)" ::: "memory");
        }
    }
    __syncthreads();
}

constexpr int NWAVES = 8, NTHREADS = 512;
constexpr int RING_BYTES = 131072, MISC_OFF = RING_BYTES + 320, LDS_BYTES = 147456;
constexpr int CW_BAR = 4096;

struct Args { const float* in[21]; float* out; unsigned char* ws; int ph_lo, ph_hi; };

struct Ctx {
    LAS unsigned char* lds; int tid, lane, wave, G, vcu;
    unsigned char* ws; unsigned char* dout;
};
#define F_WS (F.ws)
#define F_DOUT (F.dout)

__device__ __forceinline__ void gemv_item(const Ctx& F, int item, const float* W, const float* b, const float* c, const float* cc) {
    LAS float* scr = (LAS float*)F.lds;
    const int cg = F.tid & 7, rg = F.tid >> 3, n0 = item * 32 + cg * 4;
    f32x4 ax = {0.f, 0.f, 0.f, 0.f}, ac = {0.f, 0.f, 0.f, 0.f};
#pragma unroll 4
    for (int k = rg; k < DM; k += 64) { const f32x4 w = *(const f32x4*)(W + (size_t)k * 9216 + n0); const float sx = c[k], sc = cc[k];
        ax += w * (sx / (1.f + expf(-sx))); ac += w * (sc / (1.f + expf(-sc))); }
    __syncthreads();
#pragma unroll
    for (int e = 0; e < 4; ++e) { scr[(rg * 8 + cg) * 8 + e] = ax[e]; scr[(rg * 8 + cg) * 8 + 4 + e] = ac[e]; }
    __syncthreads();
    if (F.tid < 64) { const int which = F.tid >> 5, col = F.tid & 31, g = col >> 2, e = col & 3; float s = 0.f;
        for (int r = 0; r < 64; ++r) s += scr[(r * 8 + g) * 8 + which * 4 + e];
        (which ? modc : modx)[item * 32 + col] = s + b[item * 32 + col]; }
    __syncthreads();
}
struct TrDesc { const float* W; int K, N; bf16_t* dst; int ld, coloff, kind; };
__device__ __forceinline__ int tr_dest_row(int kind, int n) {
    switch (kind) {
    case 0: { const int isb = n >= DFF, j = isb ? n - DFF : n; return 256 * (j >> 7) + 128 * isb + (j & 127); }
    case 2: {
        if (n < 1024) { const int h = n >> 8, d = n & 255; return (h >> 1) * 2048 + (h & 1) * 256 + d; }
        if (n < 2048) { const int h = (n - 1024) >> 8, d = n & 255; return (h >> 1) * 2048 + 512 + (h & 1) * 256 + d; }
        if (n < 4096) { const int h = (n - 2048) >> 9, v = (n - 2048) & 511; return (h >> 1) * 2048 + 1024 + (h & 1) * 512 + v; }
        if (n < 6144) return WR_G + (n - 4096);
        if (n < 7168) return -1;
        if (n < 8192) return WR_GA + (n - 7168);
        return WR_GF + (n - 8192); }
    default: return n; }
}
__device__ __forceinline__ void tr_item(const TrDesc& t, LAS float* scr, int item, int lane) {
    const int nblk = t.N / 32, kb = item / nblk, nb = item % nblk, k0 = 64 * kb, n0 = 32 * nb;
    if (t.kind == 2 && n0 >= 6144 && n0 < 7168) return;
#pragma unroll
    for (int i = 0; i < 8; ++i) { const int kk = 8 * i + (lane >> 3), c4 = (lane & 7) * 4; const f32x4 v = *(const f32x4*)(t.W + (size_t)(k0 + kk) * t.N + n0 + c4);
        scr[kk * 33 + c4] = v[0]; scr[kk * 33 + c4 + 1] = v[1]; scr[kk * 33 + c4 + 2] = v[2]; scr[kk * 33 + c4 + 3] = v[3]; }
    asm volatile("s_waitcnt lgkmcnt(0)" ::: "memory");
    const int c = lane & 7;
#pragma unroll
    for (int j = 0; j < 4; ++j) { const int n = (lane >> 3) + 8 * j; const LAS float* s = scr + (8 * c) * 33 + n;
        u32x4 o; o.x = cvt_pk_bf16(s[0 * 33], s[1 * 33]); o.y = cvt_pk_bf16(s[2 * 33], s[3 * 33]); o.z = cvt_pk_bf16(s[4 * 33], s[5 * 33]); o.w = cvt_pk_bf16(s[6 * 33], s[7 * 33]);
        const int dr = tr_dest_row(t.kind, n0 + n);
        *(u32x4*)(t.dst + (size_t)dr * t.ld + t.coloff + k0 + 8 * c) = o; }
    asm volatile("s_waitcnt lgkmcnt(0)" ::: "memory");
}
__device__ __forceinline__ void tr_all(const Ctx& F, const TrDesc& t, int gw, int NGW) {
    LAS float* scr = (LAS float*)(F.lds + F.wave * 16384);
    const int nitems = (t.K / 64) * (t.N / 32);
    for (int it = gw; it < nitems; it += NGW) tr_item(t, scr, it, F.lane);
}
__device__ __forceinline__ void norm_rows(const Ctx& F, const float* xin, const float* cin, const float* nw, int modoff, const bf16_t* dx, const float* dcf, bool has_delta, int row0, int nrows) {
    const int gw = F.vcu * NWAVES + F.wave, NGW = F.G * NWAVES;
    for (int r = row0 + gw; r < nrows; r += NGW) {
        const bool isx = r < SEQ; const int rr = isx ? r : r - SEQ;
        const float* xr = (isx ? xin : cin) + (size_t)rr * DM; const bf16_t* dr = dx + (size_t)rr * DM; const float* drf = dcf + (size_t)rr * DM;
        const float* md = (isx ? modx : modc) + modoff; bf16_t* orow = (isx ? Ax : Ac) + (size_t)rr * DM;
        f32x4 v[4]; float ss = 0.f;
#pragma unroll
        for (int j = 0; j < 4; ++j) { v[j] = *(const f32x4*)(xr + 256 * j + 4 * F.lane);
            if (has_delta) { if (isx) { const u32x2 d = *(const u32x2*)(dr + 256 * j + 4 * F.lane); v[j] += (f32x4){bflo(d.x), bfhi(d.x), bflo(d.y), bfhi(d.y)}; } else { f32x4 sacc = {0.f, 0.f, 0.f, 0.f};
#pragma unroll
                for (int kc = 0; kc < 11; ++kc) sacc += *(const f32x4*)(drf + (size_t)kc * CTX * DM + 256 * j + 4 * F.lane);
                v[j] += sacc * (*(const f32x4*)(modc + 2 * DM + 256 * j + 4 * F.lane)) * 0.5f; } }
            ss += (v[j][0] * v[j][0] + v[j][1] * v[j][1]) + (v[j][2] * v[j][2] + v[j][3] * v[j][3]); }
        const float rinv = 1.0f / sqrtf(wave_sum(ss) * (1.f / DM) + EPS);
#pragma unroll
        for (int j = 0; j < 4; ++j) { const int c = 256 * j + 4 * F.lane; const f32x4 w = *(const f32x4*)(nw + c), sh = *(const f32x4*)(md + c), sc = *(const f32x4*)(md + 1024 + c);
            const f32x4 y = (v[j] * rinv) * w * (sc + 1.0f) + sh; u32x2 o; o.x = cvt_pk_bf16(y[0], y[1]); o.y = cvt_pk_bf16(y[2], y[3]);
            *(u32x2*)(orow + c) = o; }
    }
}
__device__ __forceinline__ void final_norm(const Ctx& F, const float* xin, const float* nw, const bf16_t* dx) {
    float* out = (float*)F_DOUT;
    const int gw = F.vcu * NWAVES + F.wave, NGW = F.G * NWAVES;
    for (int r = gw; r < SEQ; r += NGW) {
        const float* xr = xin + (size_t)r * DM; const bf16_t* dr = dx + (size_t)r * DM;
        f32x4 v[4]; float ss = 0.f;
#pragma unroll
        for (int j = 0; j < 4; ++j) { v[j] = *(const f32x4*)(xr + 256 * j + 4 * F.lane);
            const u32x2 d = *(const u32x2*)(dr + 256 * j + 4 * F.lane); v[j] += (f32x4){bflo(d.x), bfhi(d.x), bflo(d.y), bfhi(d.y)};
            ss += (v[j][0] * v[j][0] + v[j][1] * v[j][1]) + (v[j][2] * v[j][2] + v[j][3] * v[j][3]); }
        const float rinv = 1.0f / sqrtf(wave_sum(ss) * (1.f / DM) + EPS);
#pragma unroll
        for (int j = 0; j < 4; ++j) { const int c = 256 * j + 4 * F.lane; *(f32x4*)(out + (size_t)r * DM + c) = (v[j] * rinv) * *(const f32x4*)(nw + c); }
    }
}
__device__ __forceinline__ void copy_delta(const Ctx& F, const bf16_t* src, bf16_t* dst) {
    const size_t n16 = (size_t)SEQ * DM * 2 / 16; const u32x4* s = (const u32x4*)src; u32x4* d = (u32x4*)dst;
    for (size_t i = (size_t)F.vcu * NTHREADS + F.tid; i < n16; i += (size_t)F.G * NTHREADS) d[i] = s[i];
}


__device__ __forceinline__ float block_sum(LAS float* scr, float v, int tid) {
    v = wave_sum(v); __syncthreads(); if ((tid & 63) == 0) scr[tid >> 6] = v; __syncthreads();
    float s = 0.f; for (int i = 0; i < NWAVES; ++i) s += scr[i]; __syncthreads(); return s;
}
__device__ __forceinline__ void dbg_report(unsigned* word, float ref, float got, float floor_) {
    const float e = fabsf(got - ref) / fmaxf(fabsf(ref), floor_); atomicMax(word, __builtin_bit_cast(unsigned, e)); if (e > 0.05f) atomicAdd(word + 64, 1u);
}
__device__ __forceinline__ float bf2f(bf16_t b) { return __builtin_bit_cast(float, (unsigned)b << 16); }

__global__ void __launch_bounds__(NTHREADS, 2) fwd_kernel(Args args) {
    extern __shared__ __attribute__((aligned(16))) unsigned char lds_raw[];
    Ctx F;
    F.lds = (LAS unsigned char*)lds_raw;
    F.tid = threadIdx.x; F.lane = F.tid & 63; F.wave = __builtin_amdgcn_readfirstlane(F.tid >> 6);
    F.G = gridDim.x; { const int bx = blockIdx.x; F.vcu = (F.G % 8 == 0) ? (bx % 8) * (F.G / 8) + bx / 8 : bx; }
    F.ws = args.ws; F.dout = (unsigned char*)args.out;
    volatile LAS unsigned* MISC = (volatile LAS unsigned*)(F.lds + MISC_OFF);
    for (int u = F.tid; u < (LDS_BYTES - RING_BYTES) / 4; u += NTHREADS) ((LAS unsigned*)(F.lds + RING_BYTES))[u] = 0u;
    __syncthreads();
    unsigned* ctl = (unsigned*)(F_WS + WS_CTL);
    XcdBarrier bar = xcd_barrier_post(ctl + CW_BAR, MISC + 8);
    const int lo = args.ph_lo, hi = args.ph_hi;
    int phase = 0;
#define PHASE_BEGIN if (phase >= lo && phase < hi) { for (int _rep = 0; _rep < ((DBG_DUP >= 0 && phase == DBG_DUP) ? 2 : 1); ++_rep) { asm volatile("; MARK %0" :: "i"(__LINE__)); { unsigned char* _w = args.ws; unsigned char* _o = (unsigned char*)args.out; int _t = threadIdx.x; asm volatile("" : "+s"(_w), "+s"(_o), "+v"(_t)); F.ws = _w; F.dout = _o; F.tid = _t; F.lane = _t & 63; }
#define PHASE_END   } if (phase + 1 < hi) xcd_barrier((unsigned*)(F.ws + WS_CTL) + CW_BAR, bar.x, MISC + 8); if (DBG_TSEL >= 0 && bx == 0 && F.tid == 0) ((unsigned long long*)(F.ws + WS_CTL + 160000))[phase + 1] = __builtin_amdgcn_s_memrealtime(); } ++phase;
    const int bx = (int)blockIdx.x;

#define gtid ((size_t)F.vcu * NTHREADS + F.tid)
#define gthreads ((size_t)F.G * NTHREADS)
#define FB (Base{F.ws, F.dout})
    const Geo gK1024{DM, DM, DM, 128u * DM * 2u, 128u * DM * 2u, 128u * DM * 2u, DM / 64, 1 << 20, 1 << 20};
    const Geo gFfn2{DFF, DFF, DFF, 128u * DFF * 2u, 128u * DFF * 2u, 128u * DFF * 2u, DFF / 64, 1 << 20, 1 << 20};

    if (DBG_TSEL >= 0 && bx == 0 && threadIdx.x == 0) ((unsigned long long*)(args.ws + WS_CTL + 160000))[0] = __builtin_amdgcn_s_memrealtime();
    PHASE_BEGIN
        for (int it = F.vcu; it < 288; it += F.G) gemv_item(F, it, args.in[4], args.in[5], args.in[1], args.in[3]);
        __syncthreads();
        if (gtid == 0) { ((unsigned*)(F.ws + WS_CTL))[32768 + 192] = 255u; ((unsigned*)(F.ws + WS_CTL))[32768 + 193] = 255u; }
        if (gtid < 8) { const float x = (gtid < 4 ? args.in[11] : args.in[12])[gtid & 3]; modx[2 * 9216 + gtid] = -log1pf(expf(-x)); }
        for (size_t i = gtid; i < 256 * 64; i += gthreads) { const int p = (int)(i >> 6), f = (int)(i & 63); const float inv = powf(10000.0f, -(float)f / 64.0f), ang = (float)p * inv;
            ropeT[2 * i] = cosf(ang); ropeT[2 * i + 1] = sinf(ang); }
        for (size_t i = gtid; i < 128 * 128; i += gthreads) { const int k1 = (int)(i >> 7), l2 = (int)(i & 127); const float a = (float)((k1 * l2) & 16383) * (1.0f / 8192.0f);
            twT[2 * i] = cospif(a); twT[2 * i + 1] = sinpif(a); }
        for (size_t i = gtid; i < 256 * 256; i += gthreads) { const int r = (int)(i >> 8), cc = (int)(i & 255), rin = cc >> 7, l = cc & 127;
            { const int k1 = r >> 1, ri = r & 1; const float a = (float)((k1 * l) & 127) * (1.0f / 64.0f), c = cospif(a), s = sinpif(a);
              FmT[i] = f2bf(ri == 0 ? (rin == 0 ? c : s) : (rin == 0 ? -s : c)); }
            { const float a = (float)((r * l) & 127) * (1.0f / 64.0f), c = cospif(a), s = sinpif(a);
              GmT[i] = r < 128 ? f2bf((rin == 0 ? c : s) * (1.0f / 2048.0f)) : (bf16_t)0; } }
        for (size_t i = gtid; i < 512 * 256; i += gthreads) { const int r = (int)(i >> 8), c = (int)(i & 255), ri = r >> 8, cp = r & 255; const float a = (float)((c * cp) & 255) * (1.0f / 128.0f);
            T256[i] = f2bf(ri == 0 ? cospif(a) : -sinpif(a)); }
        for (size_t i = gtid; i < (size_t)DM * DM / 4; i += gthreads) { const int k = (int)(i >> 8), c4 = (int)(i & 255) * 4; const f32x4 w = *(const f32x4*)(args.in[10] + (size_t)k * 9216 + 6144 + c4);
            u32x2 o; o.x = cvt_pk_bf16(w[0], w[1]); o.y = cvt_pk_bf16(w[2], w[3]); *(u32x2*)(Wn + (size_t)k * DM + c4) = o; }
        { TrDesc t{args.in[7], DM, 2 * DFF, W13t1, DM, 0, 0}; tr_all(F, t, F.vcu * NWAVES + F.wave, F.G * NWAVES); }
        { TrDesc t{args.in[8], DFF, DM, W2t1, DFF, 0, 1}; tr_all(F, t, F.vcu * NWAVES + F.wave, F.G * NWAVES); }
        { TrDesc t{args.in[10], DM, 9216, Win, DM, 0, 2}; tr_all(F, t, F.vcu * NWAVES + F.wave, F.G * NWAVES); }
        { TrDesc t{args.in[15], DM, DM, Bz, 3072, 0, 3}; tr_all(F, t, F.vcu * NWAVES + F.wave, F.G * NWAVES); }
        { TrDesc t{args.in[14], 2048, DM, Bz, 3072, 1024, 4}; tr_all(F, t, F.vcu * NWAVES + F.wave, F.G * NWAVES); }
        { TrDesc t{args.in[16], DM, DM, WoT, DM, 0, 5}; tr_all(F, t, F.vcu * NWAVES + F.wave, F.G * NWAVES); }
        __syncthreads();
    PHASE_END
    for (int xb = 0; xb < DBG_XBAR; ++xb) {
    PHASE_BEGIN
    PHASE_END
    }
    PHASE_BEGIN
        norm_rows(F, args.in[0], args.in[2], args.in[6], 0, nullptr, nullptr, false, 0, SEQ + CTX);
        { Geo g{256, 256, DM, 128u * 256 * 2u, 128u * 256 * 2u, 128u * DM * 2u, 4, 1 << 20, 1 << 20};
          pg::Sched<JobFold> S{{FB}, 32, F.G, bx}; EpiStore E{0, 0, DM};
          pg::gemm_phase<EpiStore, pg::Sched<JobFold>, 1>(F.lds, g, S, E); }
    PHASE_END
    if constexpr (DBG_PROBE == 11) {
    PHASE_BEGIN
        unsigned* dw = (unsigned*)(F.ws + WS_CTL) + 32768;
        for (size_t idx = gtid; idx < (size_t)DM * 9216; idx += gthreads) { const int k = (int)(idx / 9216), n = (int)(idx % 9216); const int dr = tr_dest_row(2, n);
            if (dr >= 0) { const float a = args.in[10][idx]; const float b = bf2f(Win[(size_t)dr * DM + k]); if (fabsf(a - b) > 0.01f * fabsf(a) + 1e-6f) { atomicAdd(dw + 64, 1u); atomicMin(dw + 192, (unsigned)(dr >> 8)); } } }
    PHASE_END
    }
    PHASE_BEGIN
        { pg::Sched<JobFfn1> S{{FB, 65, 1}, 65 * 22, F.G, bx};
          EpiSwiglu E{0, 0, FB};
          pg::gemm_phase<EpiSwiglu, pg::Sched<JobFfn1>, 1>(F.lds, gK1024, S, E); }
        if (bx >= 150 && bx < 194 && _rep == 0) {
            if (F.tid < 64) { unsigned* cnt = (unsigned*)(F.ws + WS_CTL) + 24576; unsigned sp = 0;
                while ((unsigned)__builtin_amdgcn_readfirstlane(__hip_atomic_load(cnt, __ATOMIC_RELAXED, __HIP_MEMORY_SCOPE_AGENT)) < 22u * 8u) { __builtin_amdgcn_s_sleep(2); if (++sp > (1u << 22)) break; }
                __builtin_amdgcn_fence(__ATOMIC_ACQUIRE, "agent"); asm volatile("s_waitcnt vmcnt(0)" ::: "memory"); }
            __syncthreads();
            Geo g{DFF, DFF, DFF, 128u * DFF * 2u, 128u * DFF * 2u, 128u * DFF * 2u, 4, 1 << 20, 1 << 20};
            pg::Sched<JobCtxG2> S{{FB}, 44, 1 << 20, bx - 150}; EpiSlab E{0, 0, FB};
            pg::gemm_phase<EpiSlab, pg::Sched<JobCtxG2>, 1>(F.lds, g, S, E);
        } else if (bx >= 194 && _rep == 0) {
            { TrDesc t{args.in[18], DM, 2 * DFF, W13t, DM, 0, 0}; tr_all(F, t, (bx - 194) * NWAVES + F.wave, (F.G - 194) * NWAVES); }
            { TrDesc t{args.in[19], DFF, DM, W2t, DFF, 0, 1}; tr_all(F, t, (bx - 194) * NWAVES + F.wave, (F.G - 194) * NWAVES); }
            __syncthreads();
        }
    PHASE_END
    PHASE_BEGIN
        if (_rep == 0) norm_rows(F, args.in[0], args.in[2], args.in[9], 3 * DM, Dx, XcSlab, true, SEQ, SEQ + CTX);
        { pg::Sched<JobFfn2> S{{FB, 64, 1}, 64 * 4, F.G, bx};
          EpiFuse E{0, 0, FB, 0, args.in[0], args.in[9]};
          pg::gemm_phase<EpiFuse, pg::Sched<JobFfn2>, 1>(F.lds, gFfn2, S, E); }
    PHASE_END
    if constexpr (STOP_AFTER >= 3) {
    for (int pair = 0; pair < 2; ++pair) {
        PHASE_BEGIN
            { pg::Sched<JobRowCol> S{{FB, 0, 64, 4, 0, (size_t)pair * 2048 * DM, (size_t)256 * DM, (size_t)256 * DM}, 256, F.G, bx};
              EpiQK E{0, 0, FB, pair};
              pg::gemm_phase<EpiQK, pg::Sched<JobRowCol>, 1>(F.lds, gK1024, S, E); }
            { pg::Sched<JobRowCol> S{{FB, 1, 4, 64, (size_t)(pair * 2048 + 1024) * DM, 0, (size_t)256 * DM, (size_t)256 * DM}, 256, F.G, bx};
              EpiVT E{0, 0, FB};
              pg::gemm_phase<EpiVT, pg::Sched<JobRowCol>, 1>(F.lds, gK1024, S, E); }
            if (pair == 0) {
                { pg::Sched<JobKc> S{{FB}, 4, F.G, (bx + F.G - 64) % F.G}; EpiKc E{0, 0, FB};
                  pg::gemm_phase<EpiKc, pg::Sched<JobKc>, 1>(F.lds, gK1024, S, E); }
                { pg::Sched<JobVc> S{{FB}, 8, F.G, (bx + F.G - 72) % F.G}; EpiVc E{0, 0, FB};
                  pg::gemm_phase<EpiVc, pg::Sched<JobVc>, 1>(F.lds, gK1024, S, E); }
            }
        PHASE_END
        if constexpr (DBG_PROBE == 5) {
        PHASE_BEGIN
            LAS float* scr = (LAS float*)F.lds; unsigned* dw = (unsigned*)(F.ws + WS_CTL) + 32768;
            const int s = bx; const int i = (int)(((unsigned)s * 2654435761u) >> 18) & 16383, hl = s & 1, h = 2 * pair + hl, pp = (s * 29 + 3) & 127, v = (s * 37 + 11) & 511;
            const float* win = args.in[10]; float q1 = 0.f, q2 = 0.f, k1 = 0.f, k2 = 0.f, vv = 0.f;
            for (int a = F.tid; a < DM; a += NTHREADS) { const float x = bf2f(Ax[(size_t)i * DM + a]); const float* wr_ = win + (size_t)a * 9216;
                q1 += x * wr_[h * 256 + 2 * pp]; q2 += x * wr_[h * 256 + 2 * pp + 1]; k1 += x * wr_[1024 + h * 256 + 2 * pp]; k2 += x * wr_[1024 + h * 256 + 2 * pp + 1]; vv += x * wr_[2048 + h * 512 + v]; }
            q1 = block_sum(scr, q1, F.tid); q2 = block_sum(scr, q2, F.tid); k1 = block_sum(scr, k1, F.tid); k2 = block_sum(scr, k2, F.tid); vv = block_sum(scr, vv, F.tid);
            if (F.tid == 0) { const float inv = powf(10000.0f, -(float)(pp & 63) / 64.0f), ang = (float)(pp < 64 ? (i >> 6) : (i & 63)) * inv, cs = cosf(ang), sn = sinf(ang);
                const float rq1 = (q1 * cs - q2 * sn) * 0.0625f, rq2 = (q1 * sn + q2 * cs) * 0.0625f, rk1 = k1 * cs - k2 * sn, rk2 = k1 * sn + k2 * cs; const int jl = i & 511;
                dbg_report(dw, rq1, bf2f(Qb[(size_t)i * 512 + hl * 256 + 2 * pp]), 1000.0f); dbg_report(dw, rq2, bf2f(Qb[(size_t)i * 512 + hl * 256 + 2 * pp + 1]), 1000.0f);
                dbg_report(dw, rk1, bf2f(Knb[(size_t)i * 512 + hl * 256 + 2 * pp]), 1000.0f); dbg_report(dw, rk2, bf2f(Knb[(size_t)i * 512 + hl * 256 + 2 * pp + 1]), 1000.0f);
                dbg_report(dw, rk2 * expf(lgp[h] * (float)(511 - jl)), bf2f(Ktb_[(size_t)(hl * 256 + 2 * pp + 1) * SEQ + i]), 1000.0f);
                dbg_report(dw, rk1 * expf(lgp[4 + h] * (float)jl), bf2f(Ktb_[(size_t)512 * SEQ + (size_t)(hl * 256 + 2 * pp) * SEQ + i]), 1000.0f);
                dbg_report(dw, vv, bf2f(B4[((size_t)((hl * NSEG + (i >> 9)) * 512 + v)) * 1024 + 512 + jl]), 1000.0f); }
        PHASE_END
        }
        PHASE_BEGIN
            { Geo g{1024, 1024, SEQ, 128u * 1024 * 2u, 128u * 1024 * 2u, 128u * (unsigned)SEQ * 2u, LS / 64, 1 << 20, 1 << 20};
              pg::Sched<JobR1> S{{FB}, 256, F.G, bx}; EpiU E{0, 0, FB};
              pg::gemm_phase<EpiU, pg::Sched<JobR1>, 1>(F.lds, g, S, E); }
            if (pair == 0) { Geo g{CTX, CTX, CTX, 128u * CTX * 2u, 128u * CTX * 2u, 128u * CTX * 2u, CTX / 64, 1 << 20, 1 << 20};
              pg::Sched<JobS0> S{{FB}, 16, F.G, (bx + F.G - 64) % F.G}; EpiS0 E{0, 0, FB};
              pg::gemm_phase<EpiS0, pg::Sched<JobS0>, 1>(F.lds, g, S, E); }
        PHASE_END
        if constexpr (DBG_PROBE == 6) {
        PHASE_BEGIN
            LAS float* scr = (LAS float*)F.lds; unsigned* dw = (unsigned*)(F.ws + WS_CTL) + 32768;
            const int s = bx, h = s & 3, dir = (s >> 2) & 1, d = (s * 29 + 3) & 255, v = (s * 37 + 11) & 511; const float* win = args.in[10];
            const int j = F.tid & 255, which = F.tid >> 8; const int col = which ? 2048 + h * 512 + v : 1024 + h * 256 + d; float dot = 0.f;
            for (int a = 0; a < DM; ++a) dot += bf2f(Ac[(size_t)j * DM + a]) * win[(size_t)a * 9216 + col];
            scr[16 + F.tid] = dot; __syncthreads();
            float term = 0.f; if (F.tid < 256) term = scr[16 + F.tid] * scr[16 + 256 + F.tid] * expf(lgp[dir * 4 + h] * (float)(dir ? j : 255 - j));
            __syncthreads();
            const float ref = block_sum(scr, term, F.tid);
            if (F.tid == 0) dbg_report(dw, ref, S0[((size_t)((h * 2 + dir) * 512 + v)) * 256 + d], 1000.0f);
        PHASE_END
        }
        PHASE_BEGIN
            { const int gw = F.vcu * NWAVES + F.wave, NGW = F.G * NWAVES;
              for (int rowid = gw; rowid < 1024; rowid += NGW) { const int hl = rowid >> 9, v = rowid & 511, h = 2 * pair + hl, dir = F.lane >> 5, d0 = (F.lane & 31) * 8;
                  const float* s0 = S0 + ((size_t)((h * 2 + dir) * 512 + v)) * 256 + d0; f32x4 c0 = *(const f32x4*)s0, c1 = *(const f32x4*)(s0 + 4);
                  const float dec = expf(lgp[dir * 4 + h] * (float)LS);
                  bf16_t* pb = B4 + ((size_t)(hl * NSEG * 512 + v)) * 1024 + dir * 256 + d0; const long sstep = dir ? -(long)512 * 1024 : (long)512 * 1024; if (dir) pb += (size_t)(NSEG - 1) * 512 * 1024;
                  u32x4 ub[NSEG];
#pragma unroll
                  for (int it = 0; it < NSEG; ++it) ub[it] = *(const u32x4*)(pb + (long)it * sstep);
#pragma unroll
                  for (int it = 0; it < NSEG; ++it) { f32x4 u0, u1; unpack8(ub[it], u0, u1); *(u32x4*)(pb + (long)it * sstep) = _rep == 0 ? pack8(c0, c1) : ub[it]; c0 = c0 * dec + u0; c1 = c1 * dec + u1; } } }
            { Geo g{512, 512, 512, 128u * 512 * 2u, 128u * 512 * 2u, 128u * 512 * 2u, 4, 1 << 20, 1 << 20};
              pg::Sched<JobR3> S{{FB}, 256, F.G, bx}; EpiP E{0, 0, FB, pair};
              pg::gemm_phase<EpiP, pg::Sched<JobR3>, 1>(F.lds, g, S, E); }
        PHASE_END
        PHASE_BEGIN
            Geo g{512, 1024, 1024, 128u * 512 * 2u, 128u * 1024 * 2u, 128u * 1024 * 2u, 16, 8, 4};
            pg::Sched<JobR4> S{{FB}, 256, F.G, bx}; EpiO E{4, 8, FB, pair};
            pg::gemm_phase<EpiO, pg::Sched<JobR4>, 2>(F.lds, g, S, E);
        PHASE_END
        if constexpr (DBG_PROBE == 1) {
        PHASE_BEGIN
            LAS float* scr = (LAS float*)F.lds; unsigned* dw = (unsigned*)(F.ws + WS_CTL) + 32768;
            const int s = bx; int i = (int)(((unsigned)s * 2654435761u) >> 18) & 16383; if (s < 8) { const int sp[8] = {0, 1, 511, 512, 513, 8191, 16382, 16383}; i = sp[s]; }
            const int hl = s & 1, h = 2 * pair + hl, v = (s * 37 + 11) & 511; const float lgf = lgp[h], lgb = lgp[4 + h];
            float part = 0.f;
            for (int j = F.tid; j < SEQ; j += NTHREADS) { float qk = 0.f;
                for (int d = 0; d < 256; ++d) qk += bf2f(Qb[(size_t)i * 512 + hl * 256 + d]) * bf2f(Knb[(size_t)j * 512 + hl * 256 + d]);
                const float D = j < i ? __expf(lgf * (float)(i - j)) : (j > i ? __expf(lgb * (float)(j - i)) : 2.0f);
                part += D * qk * bf2f(B4[((size_t)((hl * NSEG + (j >> 9)) * 512 + v)) * 1024 + 512 + (j & 511)]); }
            if (F.tid < 256) { const float q = bf2f(Qb[(size_t)i * 512 + hl * 256 + F.tid]);
                part += q * (__expf(lgf * (float)(i + 1)) * S0[((size_t)((h * 2 + 0) * 512 + v)) * 256 + F.tid] + __expf(lgb * (float)(SEQ - i)) * S0[((size_t)((h * 2 + 1) * 512 + v)) * 256 + F.tid]); }
            const float ref = block_sum(scr, part, F.tid);
            const float ov = bf2f(Ob[(size_t)i * 2048 + h * 512 + F.tid]); const float rms = sqrtf(block_sum(scr, ov * ov, F.tid) * (1.0f / 512.0f));
            if (F.tid == 0) dbg_report(dw, ref, bf2f(Ob[(size_t)i * 2048 + h * 512 + v]), rms * 1000.0f);
        PHASE_END
        }
    }
    if constexpr (DBG_PROBE == 7 || DBG_PROBE == 8) {
    PHASE_BEGIN
        LAS float* scr = (LAS float*)F.lds; unsigned* dw = (unsigned*)(F.ws + WS_CTL) + 32768; float* sav = (float*)(F.ws + WS_END);
        const int s = bx; const int i = s * 64 + 57, h = DBG_COL >> 9, v = DBG_COL & 511;
        const float ov = bf2f(Ob[(size_t)i * 2048 + h * 512 + F.tid]); const float mean = block_sum(scr, ov, F.tid) * (1.0f / 512.0f);
        const float var = block_sum(scr, (ov - mean) * (ov - mean), F.tid) * (1.0f / 512.0f); const float rstd = 1.0f / sqrtf(var + EPS);
        if (F.tid == 0) { if (DBG_PROBE == 7) { dbg_report(dw, mean, stats[(size_t)(i * 4 + h) * 2], 1000.0f); dbg_report(dw, rstd, stats[(size_t)(i * 4 + h) * 2 + 1], 1000.0f); }
            sav[s * 4 + 0] = (bf2f(Ob[(size_t)i * 2048 + h * 512 + v]) - mean) * rstd; }
    PHASE_END
    }
    PHASE_BEGIN
        { LAS unsigned char* stl = F.lds + RING_BYTES + 1024;
          if (_rep == 0) { const int pm = bx >> 2, h = bx & 3;
            for (int r = F.wave; r < 256; r += NWAVES) { const int pos = pm * 256 + r; f32x4 a, b; unpack8(*(const u32x4*)(Ob + (size_t)pos * 2048 + h * 512 + F.lane * 8), a, b);
                const float mean = wave_sum((a[0] + a[1]) + (a[2] + a[3]) + (b[0] + b[1]) + (b[2] + b[3])) * (1.0f / 512.0f);
                a -= mean; b -= mean; const float q = wave_sum((a[0] * a[0] + a[1] * a[1]) + (a[2] * a[2] + a[3] * a[3]) + (b[0] * b[0] + b[1] * b[1]) + (b[2] * b[2] + b[3] * b[3]));
                if (F.lane == 0) *(LAS f32x2*)(stl + r * 8) = (f32x2){mean, 1.0f / sqrtf(q * (1.0f / 512.0f) + EPS)}; }
            __syncthreads(); }
          pg::Sched<JobG2> S{{FB}, 512, F.G, bx};
          EpiG E{0, 0, FB, args.in[13], _rep, stl};
          pg::gemm_phase<EpiG, pg::Sched<JobG2>, 1>(F.lds, gK1024, S, E); }
        { Geo g{DM, DM, 128u * DM, 128u * DM * 2u, 128u * DM * 2u, (unsigned)DM * 2u, DM / 64, 1 << 20, 1 << 20};
          pg::Sched<JobRowCol> S{{FB, 1, 8, 64, (size_t)WR_F * DM, 0, (size_t)256 * DM, (size_t)2 * DM}, 512, F.G, bx};
          EpiF E{0, 0, FB};
          pg::gemm_phase<EpiF, pg::Sched<JobRowCol>, 1>(F.lds, g, S, E); }
    PHASE_END
    if constexpr (DBG_PROBE == 8) {
    PHASE_BEGIN
        LAS float* scr = (LAS float*)F.lds; unsigned* dw = (unsigned*)(F.ws + WS_CTL) + 32768; float* sav = (float*)(F.ws + WS_END);
        const int s = bx; const int i = s * 64 + 57, h = DBG_COL >> 9, v = DBG_COL & 511, col = h * 512 + v; float g = 0.f;
        for (int a = F.tid; a < DM; a += NTHREADS) g += bf2f(Ax[(size_t)i * DM + a]) * args.in[10][(size_t)a * 9216 + 4096 + col];
        g = block_sum(scr, g, F.tid);
        if (F.tid == 0) dbg_report(dw, g / (1.0f + expf(-g)) * sav[s * 4] * args.in[13][col], bf2f(Ob[(size_t)i * 2048 + col]), 1.0f);
    PHASE_END
    }
    PHASE_BEGIN
        Geo g{256, 256, 256, 128u * 256 * 2u, 128u * 256 * 2u, 128u * 256 * 2u, 4, 1 << 20, 1 << 20};
        pg::Sched<JobF1> S{{FB}, 512, F.G, bx}; EpiF1 E{0, 0, FB};
        pg::gemm_phase<EpiF1, pg::Sched<JobF1>, 1>(F.lds, g, S, E);
    PHASE_END
    if constexpr (DBG_PROBE == 2 || DBG_PROBE == 4) {
    PHASE_BEGIN
        LAS float* scr = (LAS float*)F.lds; unsigned* dw = (unsigned*)(F.ws + WS_CTL) + 32768;
        if (DBG_PROBE == 4) {
            const int s = bx; const int l = (int)(((unsigned)s * 2654435761u) >> 18) & 16383, ch = (s * 131 + 7) & 1023, g = ch >> 8, cp = ch & 255;
            const int c = F.tid & 255, hf = F.tid >> 8; float fpart = 0.f;
            for (int a = hf * 512; a < hf * 512 + 512; ++a) fpart += bf2f(Ax[(size_t)l * DM + a]) * args.in[10][(size_t)a * 9216 + 6144 + g * 256 + c];
            scr[16 + F.tid] = fpart; __syncthreads();
            float wr_ = 0.f, wi_ = 0.f;
            if (F.tid < 256) { const float fv = scr[16 + F.tid] + scr[16 + 256 + F.tid]; const float ang = (float)((c * cp) & 255) * (1.0f / 128.0f); wr_ = fv * cospif(ang); wi_ = -fv * sinpif(ang); }
            __syncthreads();
            const float Wr = block_sum(scr, wr_, F.tid), Wi = block_sum(scr, wi_, F.tid);
            const int l1 = l >> 7, l2 = l & 127;
            if (F.tid == 0) { dbg_report(dw, Wr, bf2f(Wt[(size_t)(ch * 128 + l2) * 256 + l1]), 16000.0f); dbg_report(dw, Wi, bf2f(Wt[(size_t)(ch * 128 + l2) * 256 + 128 + l1]), 16000.0f); }
        } else {
            const unsigned sid = (unsigned)(bx * NTHREADS + F.tid) * 2654435761u; const int k1 = (sid >> 8) & 127, l2 = (sid >> 15) & 127, ch = (sid >> 22) & 1023;
            float ar = 0.f, ai = 0.f;
            for (int l1 = 0; l1 < 128; ++l1) { const float wr_ = bf2f(Wt[(size_t)(ch * 128 + l2) * 256 + l1]), wi_ = bf2f(Wt[(size_t)(ch * 128 + l2) * 256 + 128 + l1]);
                const float a = (float)((k1 * l1) & 127) * (1.0f / 64.0f), cs = cospif(a), sn = sinpif(a); ar += cs * wr_ + sn * wi_; ai += cs * wi_ - sn * wr_; }
            const float t = (float)((k1 * l2) & 16383) * (1.0f / 8192.0f), ct = cospif(t), st = sinpif(t);
            const float br = ar * ct + ai * st, bi = ai * ct - ar * st;
            dbg_report(dw, br, bf2f(Bt[(size_t)(k1 * 1024 + ch) * 256 + l2]), 180000.0f); dbg_report(dw, bi, bf2f(Bt[(size_t)(k1 * 1024 + ch) * 256 + 128 + l2]), 180000.0f);
        }
    PHASE_END
    }
    PHASE_BEGIN
        Geo g{256, 256, 256, 128u * 256 * 2u, 128u * 256 * 2u, 128u * 256 * 2u, 4, 1 << 20, 1 << 20};
        pg::Sched<JobF2> S{{FB}, 512, F.G, bx}; EpiF2 E{0, 0, FB};
        pg::gemm_phase<EpiF2, pg::Sched<JobF2>, 1>(F.lds, g, S, E);
    PHASE_END
    if constexpr (DBG_PROBE == 3) {
    PHASE_BEGIN
        unsigned* dw = (unsigned*)(F.ws + WS_CTL) + 32768;
        const unsigned sid = (unsigned)(bx * NTHREADS + F.tid) * 2654435761u; const int k1 = (sid >> 8) & 127, k2 = (sid >> 15) & 127, ch = (sid >> 22) & 1023;
        float y = 0.f;
        for (int l2 = 0; l2 < 128; ++l2) { const float br = bf2f(Bt[(size_t)(k1 * 1024 + ch) * 256 + l2]), bi = bf2f(Bt[(size_t)(k1 * 1024 + ch) * 256 + 128 + l2]);
            const float a = (float)((k2 * l2) & 127) * (1.0f / 64.0f); y += br * cospif(a) + bi * sinpif(a); }
        dbg_report(dw, y * (1.0f / 2048.0f), bf2f(MIXb[(size_t)(k1 + 128 * k2) * 2048 + ch]), 1000.0f);
    PHASE_END
    }
    if constexpr (DBG_PROBE == 12) {
    PHASE_BEGIN
        unsigned* dw = (unsigned*)(F.ws + WS_CTL) + 32768;
        for (size_t idx = gtid; idx < (size_t)DM * 9216; idx += gthreads) { const int k = (int)(idx / 9216), n = (int)(idx % 9216); const int dr = tr_dest_row(2, n);
            if (dr >= 0) { const float a = args.in[10][idx]; const float b = bf2f(Win[(size_t)dr * DM + k]); if (fabsf(a - b) > 0.01f * fabsf(a) + 1e-6f) { atomicAdd(dw + 64, 1u); atomicMin(dw + 192, (unsigned)(dr >> 8)); } } }
    PHASE_END
    }
    if constexpr (DBG_PROBE == 9) {
    PHASE_BEGIN
        LAS float* scr = (LAS float*)F.lds; unsigned* dw = (unsigned*)(F.ws + WS_CTL) + 32768;
        const int s = bx; const int i = DBG_VAR == 0 ? 1210 : (DBG_VAR == 1 ? 1024 + s : (DBG_VAR == 2 ? s * 64 + 57 : 1210 + 256 * (s & 63))), n = DBG_VAR == 0 ? 4 * s : 736; float ga = 0.f, gf = 0.f;
        for (int a = F.tid; a < DM; a += NTHREADS) { const float x = bf2f(Ax[(size_t)i * DM + a]); ga += x * args.in[10][(size_t)a * 9216 + 7168 + n]; gf += x * args.in[10][(size_t)a * 9216 + 8192 + n]; }
        ga = block_sum(scr, ga, F.tid); gf = block_sum(scr, gf, F.tid);
        if (F.tid == 0) { const float ea = fabsf(1.0f / (1.0f + expf(-ga)) - bf2f(GAb[(size_t)i * DM + n])), ef = fabsf(1.0f / (1.0f + expf(-gf)) - bf2f(GFb[(size_t)i * DM + n]));
            if (ea > 0.05f) { atomicMin(dw + 192, (unsigned)s); atomicAdd(dw + 64, 1u); dbg_report(dw, 0.f, DBG_GF ? ea : bf2f(GAb[(size_t)i * DM + n]), 1000.0f); } if (ef > 0.05f) atomicMin(dw + 193, (unsigned)s); }
    PHASE_END
    }
    PHASE_BEGIN
        { pg::Sched<JobGate2> S{{FB}, 512, F.G, bx}; EpiGate E{0, 0, FB};
          pg::gemm_phase<EpiGate, pg::Sched<JobGate2>, 1>(F.lds, gK1024, S, E); }
        { Geo g{2048, 2048, 3072, 128u * 2048 * 2u, 128u * 2048 * 2u, 128u * 3072 * 2u, 16, 1 << 20, 1 << 20};
          pg::Sched<JobZ> S{{FB, 0}, 256, F.G, bx}; EpiZ2 E{0, 0, FB, 0};
          pg::gemm_phase<EpiZ2, pg::Sched<JobZ>, 1>(F.lds, g, S, E); }
        { Geo g{2048, 2048, 3072, 128u * 2048 * 2u, 128u * 2048 * 2u, 128u * 3072 * 2u, 32, 1 << 20, 1 << 20};
          pg::Sched<JobZ> S{{FB, 1}, 256, F.G, bx}; EpiZ2 E{0, 0, FB, 1};
          pg::gemm_phase<EpiZ2, pg::Sched<JobZ>, 1>(F.lds, g, S, E); }
    PHASE_END
    if constexpr (DBG_PROBE == 9 || DBG_PROBE == 10) {
    PHASE_BEGIN
        LAS float* scr = (LAS float*)F.lds; unsigned* dw = (unsigned*)(F.ws + WS_CTL) + 32768;
        const int s = bx; const int i = (int)(((unsigned)s * 2654435761u) >> 18) & 16383, n = (s * 131 + 7) & 1023;
        if (DBG_PROBE == 9) { float ga = 0.f, gf = 0.f;
            (void)ga; (void)gf;
        } else { float r = 0.f, fo = 0.f;
            for (int k = F.tid; k < 2048; k += NTHREADS) r += bf2f(Ob[(size_t)i * 2048 + k]) * args.in[14][(size_t)k * DM + n];
            for (int k = F.tid; k < 1024; k += NTHREADS) fo += bf2f(MIXb[(size_t)i * 2048 + k]) * args.in[15][(size_t)k * DM + n];
            r = block_sum(scr, r, F.tid); fo = block_sum(scr, fo, F.tid);
            if (F.tid == 0) dbg_report(dw, bf2f(GAb[(size_t)i * DM + n]) * r + bf2f(GFb[(size_t)i * DM + n]) * fo, bf2f(Zb[(size_t)i * DM + n]), 1000.0f); }
    PHASE_END
    }
    PHASE_BEGIN
        Geo g{2048, 2048, DM, 128u * 2048 * 2u, 128u * 2048 * 2u, 128u * DM * 2u, DM / 64, 1 << 20, 1 << 20};
        pg::Sched<JobRowCol> S{{FB, 2, 64, 4, 0, 0, (size_t)256 * 2048, (size_t)256 * DM}, 256, F.G, bx};
        EpiFuse E{0, 0, FB, 1, args.in[0], args.in[17]};
        pg::gemm_phase<EpiFuse, pg::Sched<JobRowCol>, 1>(F.lds, g, S, E);
    PHASE_END
    }
    PHASE_BEGIN
        pg::Sched<JobFfn1> S{{FB, 64, 0}, 64 * 22, F.G, bx};
        EpiSwiglu E{0, 0, FB};
        pg::gemm_phase<EpiSwiglu, pg::Sched<JobFfn1>, 1>(F.lds, gK1024, S, E);
    PHASE_END
    PHASE_BEGIN
        pg::Sched<JobFfn2> S{{FB, 64, 0}, 64 * 4, F.G, bx};
        EpiFuse E{0, 0, FB, 2, args.in[0], args.in[20]};
        pg::gemm_phase<EpiFuse, pg::Sched<JobFfn2>, 1>(F.lds, gFfn2, S, E);
    PHASE_END
    if constexpr (DBG_TSEL >= 0) {
    PHASE_BEGIN
        const unsigned long long* ts = (const unsigned long long*)(F.ws + WS_CTL + 160000);
        if (bx == 0) { const float a = 0.1f * (float)(ts[DBG_TSEL + 1] - ts[DBG_TSEL]), b = 0.1f * (float)(ts[DBG_TSEL2 + 1] - ts[DBG_TSEL2]);
            if (F.tid == 0) ((float*)F.dout)[0] = a; for (int i = F.tid; i < 1024; i += NTHREADS) ((float*)F.dout)[1024 + i] = b; }
    PHASE_END
    }
    if constexpr (DBG_PROBE != 0) {
    PHASE_BEGIN
        if (bx == 0 && F.tid == 0) { const float e = __builtin_bit_cast(float, ((unsigned*)(F.ws + WS_CTL))[32768]); ((float*)F.dout)[0] = DBG_COUNT == 3 ? 100.0f * (float)(16u + ((((unsigned*)(F.ws + WS_CTL))[32768 + 192 + DBG_GF] + 0xC0000000u - 0xC0000000u) >> DBG_SH & 15u)) : DBG_COUNT == 2 ? 100.0f * (float)(16u + ((unsigned*)(F.ws + WS_CTL))[32768 + 128]) : DBG_COUNT ? 1000.0f + 10.0f * (float)((unsigned*)(F.ws + WS_CTL))[32768 + 64] : 1000.0f * (10.0f + log10f(e + 1e-10f)); }
    PHASE_END
    }
}

extern "C" void kernel_launch(void* const* d_in, const int* in_sizes, int n_in, void* d_out, int out_size, void* d_ws, size_t ws_size, hipStream_t stream) {
    static int grid = 0;
    if (grid == 0) {
        if (n_in != 21 || out_size != SEQ * DM || ws_size < 256 * MiB) { fprintf(stderr, "kernel_launch: unexpected shapes (n_in %d out %d ws %zu)\n", n_in, out_size, ws_size); grid = -1; return; }
        int dev = 0, cus = 0, per_cu = 0;
        if (hipGetDevice(&dev) != hipSuccess || hipDeviceGetAttribute(&cus, hipDeviceAttributeMultiprocessorCount, dev) != hipSuccess) { grid = -1; return; }
        if (hipFuncSetAttribute((const void*)fwd_kernel, hipFuncAttributeMaxDynamicSharedMemorySize, LDS_BYTES) != hipSuccess) { fprintf(stderr, "kernel_launch: hipFuncSetAttribute failed\n"); grid = -1; return; }
        if (hipOccupancyMaxActiveBlocksPerMultiprocessor(&per_cu, (const void*)fwd_kernel, NTHREADS, LDS_BYTES) != hipSuccess || per_cu < 1) { fprintf(stderr, "kernel_launch: occupancy query says %d blocks/CU\n", per_cu); }
        (void)hipGetLastError();
        grid = cus;
    }
    if (grid < 0) return;
    (void)hipMemsetAsync((char*)d_ws + WS_CTL, 0, CTL_ZERO_BYTES, stream);
    Args a{};
    for (int i = 0; i < 21; ++i) a.in[i] = (const float*)d_in[i];
    a.out = (float*)d_out; a.ws = (unsigned char*)d_ws; a.ph_lo = 0; a.ph_hi = 1000;
    hipLaunchKernelGGL(fwd_kernel, dim3(grid), dim3(NTHREADS), LDS_BYTES, stream, a);
}
```

```cpp
#include <hip/hip_runtime.h>
#include <cstdio>
#include <cstdint>

#ifndef DBG_NOFOUR
#define DBG_NOFOUR 0
#endif
#ifndef DBG_NORET
#define DBG_NORET 0
#endif
#ifndef DBG_PROBE
#define DBG_PROBE 0
#endif
#ifndef DBG_COUNT
#define DBG_COUNT 0
#ifndef DBG_COL
#define DBG_COL 736
#endif
#ifndef DBG_VAR
#define DBG_VAR 2
#endif
#ifndef DBG_SH
#define DBG_SH 0
#endif
#ifndef DBG_GF
#define DBG_GF 1
#endif
#ifndef DBG_S0
#define DBG_S0 4
#endif
#endif
#ifndef DBG_XBAR
#define DBG_XBAR 0
#endif
#ifndef DBG_DUP
#define DBG_DUP -1
#endif
#ifndef DBG_TSEL
#define DBG_TSEL -1
#endif
#ifndef DBG_TSEL2
#define DBG_TSEL2 1
#endif
#ifndef PG_ALIGN
#define PG_ALIGN 1
#endif
#ifndef STOP_AFTER
#define STOP_AFTER 99
#endif

#define LAS __attribute__((address_space(3)))
typedef unsigned short bf16_t;
typedef short bf16x8 __attribute__((ext_vector_type(8)));
typedef float f32x4 __attribute__((ext_vector_type(4)));
typedef float f32x2 __attribute__((ext_vector_type(2)));
typedef unsigned u32x4 __attribute__((ext_vector_type(4)));
typedef unsigned u32x2 __attribute__((ext_vector_type(2)));

constexpr int DM = 1024, SEQ = 16384, CTX = 256, DFF = 2816;
constexpr float EPS = 1e-6f;
constexpr int LS = 512, NSEG = SEQ / LS;

constexpr size_t MiB = 1u << 20;
constexpr size_t WS_CTL = 0, CTL_ZERO_BYTES = 1 * MiB;
constexpr size_t WS_MOD = 1 * MiB;
constexpr size_t WS_TAB = 2 * MiB;
constexpr size_t WS_STATS = 3 * MiB;
constexpr size_t WS_S0 = 4 * MiB;
constexpr size_t WS_KC = 8 * MiB;
constexpr size_t WS_VC = 9 * MiB;
constexpr size_t WS_DC = 10 * MiB;
constexpr size_t WS_HC = 12 * MiB;
constexpr size_t WS_WIN = 14 * MiB;
constexpr size_t WS_WN = 34 * MiB;
constexpr size_t WS_WB = 36 * MiB;
constexpr size_t WS_H = 54 * MiB;
constexpr size_t WS_Q = 54 * MiB, WS_KN = 70 * MiB, WS_KT = 86 * MiB, WS_B4 = 118 * MiB;
constexpr size_t WS_O = 182 * MiB;
constexpr size_t WS_END = 246 * MiB;
constexpr size_t WS_XB = 11 * MiB;
constexpr size_t WS_OUTW = 246 * MiB;
constexpr size_t WS_XCSLAB = 150 * MiB;
constexpr size_t WS_WT = 118 * MiB, WS_BT = 54 * MiB, WS_MIX = 118 * MiB, WS_GA = 54 * MiB, WS_GF = 86 * MiB;
constexpr size_t DO_AX = 32 * MiB;
constexpr int WR_G = 4096, WR_F = 6144, WR_GA = 8192, WR_GF = 9216;
constexpr size_t WB_W13 = 0, WB_W2 = 11 * MiB;
constexpr size_t WB_BZ = 0, WB_WO = 6 * MiB;
constexpr size_t TB_ROPE = 0, TB_TW = 128 * 1024, TB_FM = 256 * 1024, TB_GM = 384 * 1024, TB_T256 = 512 * 1024;

typedef __bf16 bf16x2_t __attribute__((ext_vector_type(2)));
__device__ __forceinline__ unsigned cvt_pk_bf16(float lo, float hi) { const f32x2 v = {lo, hi}; return __builtin_bit_cast(unsigned, __builtin_convertvector(v, bf16x2_t)); }
__device__ __forceinline__ unsigned short f2bf(float f) { unsigned u = __builtin_bit_cast(unsigned, f); return (unsigned short)((u + 0x7fffu + ((u >> 16) & 1u)) >> 16); }
__device__ __forceinline__ float bflo(unsigned u) { return __builtin_bit_cast(float, u << 16); }
__device__ __forceinline__ float bfhi(unsigned u) { return __builtin_bit_cast(float, u & 0xffff0000u); }
__device__ __forceinline__ u32x4 pack8(const f32x4 a, const f32x4 b) { u32x4 w; w.x = cvt_pk_bf16(a[0], a[1]); w.y = cvt_pk_bf16(a[2], a[3]); w.z = cvt_pk_bf16(b[0], b[1]); w.w = cvt_pk_bf16(b[2], b[3]); return w; }
__device__ __forceinline__ void unpack8(const u32x4 w, f32x4& a, f32x4& b) { a = (f32x4){bflo(w.x), bfhi(w.x), bflo(w.y), bfhi(w.y)}; b = (f32x4){bflo(w.z), bfhi(w.z), bflo(w.w), bfhi(w.w)}; }

__device__ __forceinline__ void st16wt(void* p, const u32x4 v) { asm volatile("global_store_dwordx4 %0, %1, off sc1\n\ts_nop 1" :: "v"(p), "v"(v) : "memory"); }
__device__ __forceinline__ float fsigmoid(float a) { return __builtin_amdgcn_rcpf(1.0f + __expf(-a)); }
__device__ __forceinline__ float fsilu(float a) { return a * fsigmoid(a); }
__device__ __forceinline__ float wave_sum(float v) {
#pragma unroll
    for (int o = 1; o < 64; o <<= 1) v += __shfl_xor(v, o);
    return v;
}

namespace pg {
constexpr int BM = 256, BK = 64, HALF = 128, HTB = HALF * BK * 2, STAGE_BYTES = 8 * HTB, NXCD = 8, WGM = 4;
__device__ __forceinline__ int lds_byte(int r, int c) { const int st = (r >> 4) * 2 + (c >> 5), rr = r & 15, cc = c & 31, ob = rr * 64 + cc * 2; return st * 1024 + (ob ^ (((ob >> 9) & 1) << 5)); }
__device__ __forceinline__ void stage_rc(int b, int& R, int& C) { const int st = b / 1024, sb = b % 1024, swz = sb ^ (((sb >> 9) & 1) << 5); R = (st >> 1) * 16 + swz / 64; C = (st & 1) * 32 + (swz % 64) / 2; }
__device__ __forceinline__ int perm32(int rho) { const int n = rho >> 4, i = rho & 15; return 8 * (i >> 2) + 4 * n + (i & 3); }

struct Unit { const char* a0; const char* a1; const char* b; char* d; int i0, i1, i2, i3; };
struct Geo { unsigned lda0, lda1, ldb;
             unsigned hsA0, hsA1, hsB;
             int nt, c0, rep0; };

__device__ __forceinline__ void tile_pm_pn(int L, int nM, int nN, int& pm, int& pn) {
    const int nwg = nM * nN; int wgid = L;
    { const int q = nwg / NXCD, r = nwg % NXCD, xcd = wgid % NXCD, off = wgid / NXCD; wgid = (xcd < r ? xcd * (q + 1) : r * (q + 1) + (xcd - r) * q) + off; }
    const int nig = WGM * nN, gid = wgid / nig, fm = gid * WGM, gsz = (nM - fm) < WGM ? (nM - fm) : WGM;
    pm = fm + ((wgid % nig) % gsz); pn = (wgid % nig) / gsz;
}
__device__ __forceinline__ int xcd_contig(int L, int n) { return (L % NXCD) * (n / NXCD) + L / NXCD; }

template <class Job> struct Sched {
    Job j; int n, G, c;
    __device__ __forceinline__ bool next(int i, Unit& u) const { const long L = (long)i * G + c; if (L >= n) return false; j.fill((int)L, u); return true; }
};

template <class Epi, class Sch, int ASEG>
__device__ __forceinline__ void gemm_phase(LAS unsigned char* lds, const Geo g, const Sch& S, const Epi& E) {
    int tid = threadIdx.x; asm volatile("" : "+v"(tid));
    const int wid = __builtin_amdgcn_readfirstlane(tid >> 6), lane = tid & 63, wr = wid >> 2, wc = wid & 3, fr = lane & 15, fq = lane >> 4;
    int nt = g.nt; asm volatile("" : "+s"(nt));
    unsigned voffA0[2], voffA1[2], voffB[2];
#pragma unroll
    for (int i = 0; i < 2; ++i) { int R, C; stage_rc(tid * 16 + i * 8192, R, C); const int Rb = (R & ~31) + perm32(R & 31);
        voffA0[i] = (unsigned)(R * g.lda0 + C) * 2u; voffA1[i] = (ASEG == 2) ? (unsigned)(R * g.lda1 + C) * 2u : 0u; voffB[i] = (unsigned)(Rb * g.ldb + C) * 2u; }
    const unsigned ldsw = (unsigned)wid * 1024u;
    const int aoff = lds_byte(wr * 64 + fr, fq * 8), boff = lds_byte(wc * 32 + fr, fq * 8);
#define PG_SA(b, h) (((b) * 2 + (h)) * HTB)
#define PG_SB(b, h) ((4 + (b) * 2 + (h)) * HTB)
#define PG_GLDS(gp, lp) __builtin_amdgcn_global_load_lds((const unsigned*)(gp), (LAS unsigned*)(lp), 16, 0, 0)
#define PG_ASEL(T) (ASEG == 2 && (T) >= g.c0)
#define PG_APTR(U, T) (PG_ASEL(T) ? (U).a1 + (size_t)((T) - g.c0) * 128 : (U).a0 + (size_t)((T) & (g.rep0 - 1)) * 128)
#define PG_STAGE_A(bufoff, gbase, h, sel) do { const bool _s = (sel); const unsigned _v0 = _s ? voffA1[0] : voffA0[0], _v1 = _s ? voffA1[1] : voffA0[1]; \
        const char* _p = (gbase) + ((h) ? (size_t)(_s ? g.hsA1 : g.hsA0) : (size_t)0); \
        PG_GLDS(_p + _v0, lds + (bufoff) + ldsw); PG_GLDS(_p + _v1, lds + (bufoff) + ldsw + 8192); } while (0)
#define PG_STAGE_B(bufoff, gbase, h) do { const char* _p = (gbase) + ((h) ? (size_t)g.hsB : (size_t)0); \
        PG_GLDS(_p + voffB[0], lds + (bufoff) + ldsw); PG_GLDS(_p + voffB[1], lds + (bufoff) + ldsw + 8192); } while (0)
#define PG_LDA(dst, b, h) do { _Pragma("unroll") for (int m = 0; m < 4; ++m) _Pragma("unroll") for (int k = 0; k < 2; ++k) dst[m][k] = *(const LAS bf16x8*)(lds + PG_SA(b, h) + aoff + m * 2048 + k * 1024); } while (0)
#define PG_LDB(dst, b, h) do { _Pragma("unroll") for (int n = 0; n < 2; ++n) _Pragma("unroll") for (int k = 0; k < 2; ++k) dst[n][k] = *(const LAS bf16x8*)(lds + PG_SB(b, h) + boff + n * 2048 + k * 1024); } while (0)
#define PG_MMA(ai, bj, At, Bt) do { __builtin_amdgcn_s_setprio(1); _Pragma("unroll") for (int m = 0; m < 4; ++m) _Pragma("unroll") for (int n = 0; n < 2; ++n) _Pragma("unroll") for (int k = 0; k < 2; ++k) \
        acc[ai][bj][m][n] = __builtin_amdgcn_mfma_f32_16x16x32_bf16(Bt[n][k], At[m][k], acc[ai][bj][m][n], 0, 0, 0); __builtin_amdgcn_s_setprio(0); } while (0)
#define PG_WAIT_V(n) asm volatile("s_waitcnt vmcnt(" #n ")" ::: "memory")
#define PG_WAIT_L(n) asm volatile("s_waitcnt lgkmcnt(" #n ")" ::: "memory")
#define PG_BAR __builtin_amdgcn_s_barrier()
#define PG_SCHED __builtin_amdgcn_sched_barrier(0)
    Unit cur, nxt; int ui = 0;
    if (!S.next(0, cur)) return;
    f32x4 acc[2][2][4][2];
#pragma unroll
    for (int a = 0; a < 2; ++a)
#pragma unroll
        for (int b = 0; b < 2; ++b)
#pragma unroll
            for (int m = 0; m < 4; ++m)
#pragma unroll
                for (int n = 0; n < 2; ++n) acc[a][b][m][n] = (f32x4){0.f, 0.f, 0.f, 0.f};
    bf16x8 At[4][2], B0[2][2], B1[2][2];
    { const char* p0 = PG_APTR(cur, 0); const char* p1 = PG_APTR(cur, 1);
      PG_STAGE_B(PG_SB(0, 0), cur.b, 0); PG_STAGE_B(PG_SB(0, 1), cur.b, 1); PG_STAGE_A(PG_SA(0, 0), p0, 0, PG_ASEL(0)); PG_STAGE_A(PG_SA(0, 1), p0, 1, PG_ASEL(0));
      if (wr == 1) PG_BAR;
      PG_WAIT_V(2); PG_BAR;
      PG_STAGE_B(PG_SB(1, 0), cur.b + 128, 0); PG_STAGE_A(PG_SA(1, 0), p1, 0, PG_ASEL(1)); PG_STAGE_B(PG_SB(1, 1), cur.b + 128, 1);
      PG_WAIT_V(6); PG_BAR; }
    for (;;) {
        const bool has_next = S.next(ui + 1, nxt);
        const char* nA0 = has_next ? PG_APTR(nxt, 0) : PG_APTR(cur, 0); const char* nA1 = has_next ? PG_APTR(nxt, 1) : PG_APTR(cur, 1); const char* nB = has_next ? nxt.b : cur.b;
        for (int t = 0; t < nt; t += 2) {
            const bool last = (t == nt - 2);
            if constexpr (Epi::NHOOK >= 1) { if (t == E.h0) { int t2 = threadIdx.x; asm volatile("" : "+v"(t2)); E.hook(acc, cur, 0, wr, wc, t2 & 15, (t2 >> 4) & 3); } }
            if constexpr (Epi::NHOOK >= 2) { if (t == E.h1) { int t2 = threadIdx.x; asm volatile("" : "+v"(t2)); E.hook(acc, cur, 1, wr, wc, t2 & 15, (t2 >> 4) & 3); } }
            const char* a1 = PG_APTR(cur, t + 1); const bool s1 = PG_ASEL(t + 1);
            const char* a2 = last ? nA0 : PG_APTR(cur, t + 2); const char* a3 = last ? nA1 : PG_APTR(cur, t + 3);
            const char* b2 = last ? nB : cur.b + (size_t)(t + 2) * 128; const char* b3 = b2 + 128;
            const bool s2 = last ? PG_ASEL(0) : PG_ASEL(t + 2), s3 = last ? PG_ASEL(1) : PG_ASEL(t + 3);
            PG_LDB(B0, 0, 0); PG_LDB(B1, 0, 1); PG_SCHED; PG_LDA(At, 0, 0); PG_STAGE_A(PG_SA(1, 1), a1, 1, s1);
            PG_WAIT_V(8); PG_WAIT_L(0); PG_BAR; PG_MMA(0, 0, At, B0); PG_MMA(0, 1, At, B1); PG_BAR; PG_SCHED;
            PG_LDA(At, 0, 1); PG_STAGE_B(PG_SB(0, 0), b2, 0); PG_STAGE_B(PG_SB(0, 1), b2, 1); PG_STAGE_A(PG_SA(0, 0), a2, 0, s2);
            PG_WAIT_V(8); PG_WAIT_L(0); PG_BAR; PG_MMA(1, 0, At, B0); PG_MMA(1, 1, At, B1); PG_BAR; PG_SCHED;
            PG_LDB(B0, 1, 0); PG_LDB(B1, 1, 1); PG_SCHED; PG_LDA(At, 1, 0); PG_STAGE_A(PG_SA(0, 1), a2, 1, s2);
            PG_WAIT_V(8); PG_WAIT_L(0); PG_BAR; PG_MMA(0, 0, At, B0); PG_MMA(0, 1, At, B1); PG_BAR; PG_SCHED;
            PG_LDA(At, 1, 1); PG_STAGE_B(PG_SB(1, 0), b3, 0); PG_STAGE_B(PG_SB(1, 1), b3, 1); PG_STAGE_A(PG_SA(1, 0), a3, 0, s3);
            PG_WAIT_V(8); PG_WAIT_L(0); PG_BAR; PG_MMA(1, 0, At, B0); PG_MMA(1, 1, At, B1); PG_BAR; PG_SCHED;
        }
        if (PG_ALIGN && wr == 0) PG_BAR;
        if constexpr (!Epi::AFTER_DRAIN) { int t2 = threadIdx.x; asm volatile("" : "+v"(t2)); E(acc, cur, wr, wc, t2 & 15, (t2 >> 4) & 3); }
        if (!has_next) break;
#pragma unroll
        for (int a = 0; a < 2; ++a)
#pragma unroll
            for (int b = 0; b < 2; ++b)
#pragma unroll
                for (int m = 0; m < 4; ++m)
#pragma unroll
                    for (int n = 0; n < 2; ++n) acc[a][b][m][n] = (f32x4){0.f, 0.f, 0.f, 0.f};
        cur = nxt; ++ui;
        if (PG_ALIGN && wr == 1) PG_BAR;
    }
    PG_WAIT_V(0);
    if (!PG_ALIGN && wr == 0) PG_BAR;
    PG_BAR;
    if constexpr (Epi::AFTER_DRAIN) { int t2 = threadIdx.x; asm volatile("" : "+v"(t2)); E.fused(acc, cur, wr, wc, t2 & 15, (t2 >> 4) & 3, lds, wid, t2 & 63); }
#undef PG_SA
#undef PG_SB
#undef PG_GLDS
#undef PG_ASEL
#undef PG_APTR
#undef PG_STAGE_A
#undef PG_STAGE_B
#undef PG_LDA
#undef PG_LDB
#undef PG_MMA
#undef PG_WAIT_V
#undef PG_WAIT_L
#undef PG_BAR
#undef PG_SCHED
}
}
using pg::Unit; using pg::Geo;

#define EPI_ROWS _Pragma("unroll") for (int ai = 0; ai < 2; ++ai) _Pragma("unroll") for (int m = 0; m < 4; ++m)
#define EPI_ROW (128 * ai + 64 * wr + 16 * m + fr)
#define EPI_COLS _Pragma("unroll") for (int bj = 0; bj < 2; ++bj)
#define EPI_COL0 (128 * bj + 32 * wc + 8 * fq)
typedef f32x4 acc_t[2][2][4][2];

struct Base { unsigned char* ws; unsigned char* dout; };
#define modx ((float*)(F.ws + WS_MOD))
#define modc (modx + 9216)
#define lgp (modx + 2 * 9216)
#define Ax ((bf16_t*)(F.dout + DO_AX))
#define Ac ((bf16_t*)(F.ws + WS_DC + 512 * 1024))
#define Dx ((bf16_t*)F.dout)
#define Dc ((bf16_t*)(F.ws + WS_DC))
#define Hb ((bf16_t*)(F.ws + WS_H))
#define Hc ((bf16_t*)(F.ws + WS_HC))
#define W13t ((bf16_t*)(F.ws + WS_WB + WB_W13))
#define W2t ((bf16_t*)(F.ws + WS_WB + WB_W2))
#define W13t1 ((bf16_t*)(F.ws + WS_O + WB_W13))
#define W2t1 ((bf16_t*)(F.ws + WS_O + WB_W2))
#define ropeT ((float*)(F.ws + WS_TAB + TB_ROPE))
#define twT ((float*)(F.ws + WS_TAB + TB_TW))
#define FmT ((bf16_t*)(F.ws + WS_TAB + TB_FM))
#define GmT ((bf16_t*)(F.ws + WS_TAB + TB_GM))
#define T256 ((bf16_t*)(F.ws + WS_TAB + TB_T256))
#define Win ((bf16_t*)(F.ws + WS_WIN))
#define Wn ((bf16_t*)(F.ws + WS_WN))
#define Bz ((bf16_t*)(F.ws + WS_OUTW))
#define WoT ((bf16_t*)(F.ws + WS_OUTW + 6 * MiB))
#define Qb ((bf16_t*)(F.ws + WS_Q))
#define Knb ((bf16_t*)(F.ws + WS_KN))
#define Ktb_ ((bf16_t*)(F.ws + WS_KT))
#define Pb Ktb_
#define B4 ((bf16_t*)(F.ws + WS_B4))
#define Ob ((bf16_t*)(F.ws + WS_O))
#define S0 ((float*)(F.ws + WS_S0))
#define stats ((float*)(F.ws + WS_STATS))
#define KcT ((bf16_t*)(F.ws + WS_KC))
#define VcT ((bf16_t*)(F.ws + WS_VC))
#define Wt ((bf16_t*)(F.ws + WS_WT))
#define Bt ((bf16_t*)(F.ws + WS_BT))
#define MIXb ((bf16_t*)(F.ws + WS_MIX))
#define GAb ((bf16_t*)(F.ws + WS_GA))
#define GFb ((bf16_t*)(F.ws + WS_GF))
#define Zb (MIXb + 1024)
#define XcSlab ((float*)(F.ws + WS_XCSLAB))

struct EpiSwiglu {
    static constexpr int NHOOK = 0; static constexpr int AFTER_DRAIN = 0; int h0, h1;
    Base F;
    __device__ __forceinline__ void hook(acc_t&, const Unit&, int, int, int, int, int) const {}
    __device__ __forceinline__ void operator()(const acc_t& acc, const Unit& u, int wr, int wc, int fr, int fq) const {
        bf16_t* base = u.i0 < 64 ? Hb + (size_t)u.i0 * 256 * DFF : Hc;
        EPI_ROWS { bf16_t* rowp = base + (size_t)EPI_ROW * DFF + u.i1 * 128 + 32 * wc + 8 * fq; f32x4 h[2];
#pragma unroll
            for (int n = 0; n < 2; ++n)
#pragma unroll
                for (int e = 0; e < 4; ++e) h[n][e] = fsilu(acc[ai][0][m][n][e]) * acc[ai][1][m][n][e];
            if (u.i0 == 64) st16wt(rowp, pack8(h[0], h[1])); else *(u32x4*)rowp = pack8(h[0], h[1]); if (m & 1) asm volatile("" ::: "memory"); }
        if (u.i0 == 64) { asm volatile("s_waitcnt vmcnt(0)" ::: "memory");
            if (fr == 0 && fq == 0) __hip_atomic_fetch_add((unsigned*)(F.ws + WS_CTL) + 24576, 1u, __ATOMIC_RELAXED, __HIP_MEMORY_SCOPE_AGENT); }
    }
};
struct EpiResid {
    static constexpr int NHOOK = 0; static constexpr int AFTER_DRAIN = 0; int h0, h1;
    Base F; int mode;
    __device__ __forceinline__ void hook(acc_t&, const Unit&, int, int, int, int, int) const {}
    __device__ __forceinline__ void operator()(const acc_t& acc, const Unit& u, int wr, int wc, int fr, int fq) const {
        const bool isx = u.i0 < 64; const int has_old = mode != 0; const float scale = mode == 1 ? 1.0f : 0.5f;
        const bf16_t* din = Dx + (size_t)u.i0 * 256 * DM; bf16_t* dout = isx ? (mode == 2 ? Ob : Dx) + (size_t)u.i0 * 256 * DM : Dc;
        const float* coef = (isx ? modx : modc) + (mode == 0 ? 2 : (mode == 1 ? 5 : 8)) * DM + u.i1 * 256;
        EPI_COLS { const int c = EPI_COL0; const f32x4 c0 = *(const f32x4*)(coef + c) * scale, c1 = *(const f32x4*)(coef + c + 4) * scale;
#pragma unroll
            for (int ai = 0; ai < 2; ++ai)
#pragma unroll
                for (int m = 0; m < 4; ++m) { const size_t off = (size_t)EPI_ROW * DM + u.i1 * 256 + c;
                    f32x4 v0 = acc[ai][bj][m][0] * c0, v1 = acc[ai][bj][m][1] * c1;
                    if (has_old) { f32x4 o0, o1; unpack8(*(const u32x4*)(din + off), o0, o1); v0 += o0; v1 += o1; }
                    *(u32x4*)(dout + off) = pack8(v0, v1); if (m & 1) asm volatile("" ::: "memory"); } }
    }
};

struct EpiFuse {
    static constexpr int NHOOK = 0; static constexpr int AFTER_DRAIN = 1; int h0, h1; Base F; int mode; const float* x; const float* nw;
    __device__ __forceinline__ void hook(acc_t&, const Unit&, int, int, int, int, int) const {}
    __device__ __forceinline__ void operator()(const acc_t&, const Unit&, int, int, int, int) const {}
    __device__ __forceinline__ void fused(acc_t& acc, const Unit& u, int wr, int wc, int fr, int fq, LAS unsigned char* lds, int wid, int lane) const {
        const int pm = u.i0, pn = u.i1; const float scale = mode == 1 ? 1.0f : 0.5f;
        const float* coef = modx + (mode == 0 ? 2 : (mode == 1 ? 5 : 8)) * DM + pn * 256;
        const bf16_t* din = (mode == 2 ? Ob : Dx) + (size_t)pm * 256 * DM + pn * 256; bf16_t* dout = (mode == 1 ? Ob : Dx) + (size_t)pm * 256 * DM + pn * 256;
        const float* xt = x + (size_t)pm * 256 * DM + pn * 256;
        LAS float* P = (LAS float*)lds; LAS float* S = (LAS float*)(lds + 4096);
        f32x4 cf[2][2];
#pragma unroll
        for (int bj = 0; bj < 2; ++bj) { cf[bj][0] = *(const f32x4*)(coef + EPI_COL0) * scale; cf[bj][1] = *(const f32x4*)(coef + EPI_COL0 + 4) * scale; }
#pragma unroll
        for (int aim = 0; aim < 4; ++aim) { const int ai = aim >> 1; f32x4 xv[4][2][2]; u32x4 ov[4][2];
#pragma unroll
            for (int m = 2 * (aim & 1); m < 2 * (aim & 1) + 2; ++m) EPI_COLS { const size_t off = (size_t)EPI_ROW * DM + EPI_COL0; xv[m][bj][0] = *(const f32x4*)(xt + off); xv[m][bj][1] = *(const f32x4*)(xt + off + 4); if (mode != 0) ov[m][bj] = *(const u32x4*)(din + off); }
#pragma unroll
            for (int m = 2 * (aim & 1); m < 2 * (aim & 1) + 2; ++m) { const int row = EPI_ROW; float ss = 0.f;
                EPI_COLS { const size_t off = (size_t)row * DM + EPI_COL0; f32x4 d0 = acc[ai][bj][m][0] * cf[bj][0], d1 = acc[ai][bj][m][1] * cf[bj][1];
                    if (mode != 0) { f32x4 o0, o1; unpack8(ov[m][bj], o0, o1); d0 += o0; d1 += o1; }
                    if (mode != 2) *(u32x4*)(dout + off) = pack8(d0, d1);
                    const f32x4 v0 = xv[m][bj][0] + d0, v1 = xv[m][bj][1] + d1; acc[ai][bj][m][0] = v0; acc[ai][bj][m][1] = v1;
                    ss += (v0[0] * v0[0] + v0[1] * v0[1]) + (v0[2] * v0[2] + v0[3] * v0[3]) + (v1[0] * v1[0] + v1[1] * v1[1]) + (v1[2] * v1[2] + v1[3] * v1[3]); }
                ss += __shfl_xor(ss, 16); ss += __shfl_xor(ss, 32);
                if (fq == 0) P[row * 4 + wc] = ss; }
            asm volatile("" ::: "memory"); }
        asm volatile("s_waitcnt lgkmcnt(0)" ::: "memory"); __builtin_amdgcn_s_barrier(); asm volatile("" ::: "memory");
        float* xb = (float*)(F.ws + WS_XB) + (size_t)mode * 64 * 256 * 4; unsigned* cnt = (unsigned*)(F.ws + WS_CTL) + 8192 + mode * 4096 + 64 * pm;
        const int prow = wid * 32 + (lane & 31);
        if (lane < 32) { const float t = (P[prow * 4 + 0] + P[prow * 4 + 1]) + (P[prow * 4 + 2] + P[prow * 4 + 3]);
            __hip_atomic_store(xb + ((size_t)(pm * 256 + prow) * 4 + pn), t, __ATOMIC_RELAXED, __HIP_MEMORY_SCOPE_AGENT); }
        asm volatile("s_waitcnt vmcnt(0)" ::: "memory");
        if (lane == 0) __hip_atomic_fetch_add(cnt, 1u, __ATOMIC_RELAXED, __HIP_MEMORY_SCOPE_AGENT);
        if (wid == 0) { unsigned sp = 0;
            while ((unsigned)__builtin_amdgcn_readfirstlane(__hip_atomic_load(cnt, __ATOMIC_RELAXED, __HIP_MEMORY_SCOPE_AGENT)) < 32u) { __builtin_amdgcn_s_sleep(2); if (++sp > (1u << 22)) break; }
            __builtin_amdgcn_fence(__ATOMIC_ACQUIRE, "agent"); }
        asm volatile("s_waitcnt vmcnt(0) lgkmcnt(0)" ::: "memory"); __builtin_amdgcn_s_barrier(); asm volatile("" ::: "memory");
        if (lane < 32) { const float* sl = xb + (size_t)(pm * 256 + prow) * 4; float t = 0.f;
#pragma unroll
            for (int q = 0; q < 4; ++q) t += __hip_atomic_load(sl + q, __ATOMIC_RELAXED, __HIP_MEMORY_SCOPE_AGENT);
            S[prow] = 1.0f / sqrtf(t * (1.0f / DM) + EPS); }
        asm volatile("s_waitcnt lgkmcnt(0)" ::: "memory"); __builtin_amdgcn_s_barrier(); asm volatile("" ::: "memory");
        const float* md = modx + (mode == 0 ? 3 : 6) * DM + pn * 256; const float* nwp = nw + pn * 256;
        f32x4 wv[2][2], shv[2][2];
#pragma unroll
        for (int bj = 0; bj < 2; ++bj)
#pragma unroll
            for (int n = 0; n < 2; ++n) { const int c = EPI_COL0 + 4 * n; const f32x4 w = *(const f32x4*)(nwp + c);
                if (mode == 2) { wv[bj][n] = w; shv[bj][n] = (f32x4){0.f, 0.f, 0.f, 0.f}; } else { wv[bj][n] = w * (*(const f32x4*)(md + DM + c) + 1.0f); shv[bj][n] = *(const f32x4*)(md + c); } }
        EPI_ROWS { const int row = EPI_ROW; const float rinv = S[row];
            EPI_COLS { const size_t off = (size_t)row * DM + EPI_COL0;
                const f32x4 y0 = (acc[ai][bj][m][0] * rinv) * wv[bj][0] + shv[bj][0], y1 = (acc[ai][bj][m][1] * rinv) * wv[bj][1] + shv[bj][1];
                if (mode == 2) { float* o = (float*)F.dout + (size_t)pm * 256 * DM + pn * 256 + off; *(f32x4*)o = y0; *(f32x4*)(o + 4) = y1; }
                else *(u32x4*)(Ax + (size_t)pm * 256 * DM + pn * 256 + off) = pack8(y0, y1); } }
        asm volatile("s_waitcnt lgkmcnt(0)" ::: "memory"); __builtin_amdgcn_s_barrier(); asm volatile("" ::: "memory");
    }
};
struct JobFfn1 {
    Base F; int nM, first;
    __device__ __forceinline__ void fill(int L, Unit& u) const { int pm, pn; if (first) { if (L < 22) { pm = 64; pn = L; } else pg::tile_pm_pn(L - 22, 64, 22, pm, pn); } else pg::tile_pm_pn(L, nM, 22, pm, pn);
        u.a0 = (const char*)(pm < 64 ? Ax + (size_t)pm * 256 * DM : Ac); u.a1 = u.a0; u.b = (const char*)((first ? W13t1 : W13t) + (size_t)pn * 256 * DM); u.d = nullptr; u.i0 = pm; u.i1 = pn; u.i2 = 0; u.i3 = 0; }
};
struct JobFfn2 {
    Base F; int nM, first;
    __device__ __forceinline__ void fill(int L, Unit& u) const { int pm, pn; pg::tile_pm_pn(L, nM, 4, pm, pn);
        u.a0 = (const char*)(pm < 64 ? Hb + (size_t)pm * 256 * DFF : Hc); u.a1 = u.a0; u.b = (const char*)((first ? W2t1 : W2t) + (size_t)pn * 256 * DFF); u.d = nullptr; u.i0 = pm; u.i1 = pn; u.i2 = 0; u.i3 = 0; }
};

struct EpiStore {
    static constexpr int NHOOK = 0; static constexpr int AFTER_DRAIN = 0; int h0, h1; int ldd;
    __device__ __forceinline__ void hook(acc_t&, const Unit&, int, int, int, int, int) const {}
    __device__ __forceinline__ void operator()(const acc_t& acc, const Unit& u, int wr, int wc, int fr, int fq) const {
        bf16_t* d = (bf16_t*)u.d;
        EPI_ROWS { EPI_COLS { *(u32x4*)(d + (size_t)EPI_ROW * ldd + EPI_COL0) = pack8(acc[ai][bj][m][0], acc[ai][bj][m][1]); }  asm volatile("" ::: "memory"); }
    }
};
struct EpiQK {
    static constexpr int NHOOK = 0; static constexpr int AFTER_DRAIN = 1; int h0, h1;
    Base F; int pair;
    __device__ __forceinline__ void hook(acc_t&, const Unit&, int, int, int, int, int) const {}
    __device__ __forceinline__ void operator()(const acc_t&, const Unit&, int, int, int, int) const {}
    __device__ __forceinline__ void fused(acc_t& acc, const Unit& u, int wr, int wc, int fr, int fq, LAS unsigned char* lds, int wid, int lane) const {
        const int pm = u.i0, pn = u.i1, hl = pn & 1, h = 2 * pair + hl; const bool isk = pn >= 2; const float lgf = lgp[h], lgb = lgp[4 + h]; const float* rope = ropeT;
        constexpr int PITCH = 528;
        const int tid = wid * 64 + lane, p8 = tid & 31;
        float zf[8], zb[8];
#pragma unroll
        for (int e = 0; e < 8; ++e) { const int jl = (pm * 256 + p8 * 8 + e) & (LS - 1); zf[e] = __expf(lgf * (float)(LS - 1 - jl)); zb[e] = __expf(lgb * (float)jl); }
#pragma unroll
        for (int bj = 0; bj < 2; ++bj) {
            EPI_ROWS { const int row = EPI_ROW, pos = pm * 256 + row, prow = pos >> 6, pcol = pos & 63;
                const int d0 = EPI_COL0, i0 = d0 >> 1, p = i0 < 64 ? prow : pcol, f0 = i0 & 63;
                const f32x4 t0 = *(const f32x4*)(rope + (size_t)(p * 64 + f0) * 2), t1 = *(const f32x4*)(rope + (size_t)(p * 64 + f0) * 2 + 4);
                f32x4 a = acc[ai][bj][m][0], b = acc[ai][bj][m][1];
                if (!isk) { a *= 0.0625f; b *= 0.0625f; }
                const f32x4 ra = {a[0] * t0[0] - a[1] * t0[1], a[0] * t0[1] + a[1] * t0[0], a[2] * t0[2] - a[3] * t0[3], a[2] * t0[3] + a[3] * t0[2]};
                const f32x4 rb = {b[0] * t1[0] - b[1] * t1[1], b[0] * t1[1] + b[1] * t1[0], b[2] * t1[2] - b[3] * t1[3], b[2] * t1[3] + b[3] * t1[2]};
                const u32x4 pk = pack8(ra, rb);
                if (!isk) *(u32x4*)(Qb + (size_t)pos * 512 + hl * 256 + d0) = pk;
                else { *(u32x4*)(Knb + (size_t)pos * 512 + hl * 256 + d0) = pk;
                    LAS unsigned short* tp = (LAS unsigned short*)(lds + (32 * wc + 8 * fq) * PITCH + row * 2);
                    tp[0 * PITCH / 2] = (unsigned short)pk.x; tp[1 * PITCH / 2] = (unsigned short)(pk.x >> 16); tp[2 * PITCH / 2] = (unsigned short)pk.y; tp[3 * PITCH / 2] = (unsigned short)(pk.y >> 16);
                    tp[4 * PITCH / 2] = (unsigned short)pk.z; tp[5 * PITCH / 2] = (unsigned short)(pk.z >> 16); tp[6 * PITCH / 2] = (unsigned short)pk.w; tp[7 * PITCH / 2] = (unsigned short)(pk.w >> 16); }
                if (m & 1) asm volatile("" ::: "memory"); }
            if (isk) {
                asm volatile("s_waitcnt lgkmcnt(0)" ::: "memory"); __builtin_amdgcn_s_barrier(); asm volatile("" ::: "memory");
#pragma unroll
                for (int k = 0; k < 8; ++k) { const int dl = (tid >> 5) + 16 * k;
                    f32x4 v0, v1; unpack8(*(const LAS u32x4*)(lds + dl * PITCH + p8 * 16), v0, v1);
                    const f32x4 f0v = {v0[0] * zf[0], v0[1] * zf[1], v0[2] * zf[2], v0[3] * zf[3]}, f1v = {v1[0] * zf[4], v1[1] * zf[5], v1[2] * zf[6], v1[3] * zf[7]};
                    const f32x4 b0v = {v0[0] * zb[0], v0[1] * zb[1], v0[2] * zb[2], v0[3] * zb[3]}, b1v = {v1[0] * zb[4], v1[1] * zb[5], v1[2] * zb[6], v1[3] * zb[7]};
                    const size_t o = (size_t)(hl * 256 + bj * 128 + dl) * SEQ + pm * 256 + p8 * 8;
                    *(u32x4*)(Ktb_ + o) = pack8(f0v, f1v); *(u32x4*)(Ktb_ + (size_t)512 * SEQ + o) = pack8(b0v, b1v); }
                asm volatile("s_waitcnt lgkmcnt(0)" ::: "memory"); __builtin_amdgcn_s_barrier(); asm volatile("" ::: "memory");
            }
        }
    }
};
struct EpiVT {
    static constexpr int NHOOK = 0; static constexpr int AFTER_DRAIN = 0; int h0, h1; Base F;
    __device__ __forceinline__ void hook(acc_t&, const Unit&, int, int, int, int, int) const {}
    __device__ __forceinline__ void operator()(const acc_t& acc, const Unit& u, int wr, int wc, int fr, int fq) const {
        const int hl = u.i0 >> 1, vt = u.i0 & 1, pn = u.i1;
        EPI_ROWS { const int v = vt * 256 + EPI_ROW;
            EPI_COLS { const int pos = pn * 256 + EPI_COL0, seg = pos >> 9, jl = pos & (LS - 1);
                *(u32x4*)(B4 + ((size_t)((hl * NSEG + seg) * 512 + v)) * 1024 + 512 + jl) = pack8(acc[ai][bj][m][0], acc[ai][bj][m][1]); }  asm volatile("" ::: "memory"); }
    }
};
struct EpiKc {
    static constexpr int NHOOK = 0; static constexpr int AFTER_DRAIN = 0; int h0, h1; Base F;
    __device__ __forceinline__ void hook(acc_t&, const Unit&, int, int, int, int, int) const {}
    __device__ __forceinline__ void operator()(const acc_t& acc, const Unit& u, int wr, int wc, int fr, int fq) const {
        const int h = u.i1; const float lgf = lgp[h], lgb = lgp[4 + h]; bf16_t* Kcf = KcT; bf16_t* Kcb = KcT + (size_t)1024 * CTX;
        EPI_ROWS { const int j = EPI_ROW; const float zf = __expf(lgf * (float)(CTX - 1 - j)), zb = __expf(lgb * (float)j);
            EPI_COLS { const int d0 = EPI_COL0;
#pragma unroll
                for (int e = 0; e < 8; ++e) { const float v = acc[ai][bj][m][e >> 2][e & 3]; const size_t o = (size_t)(h * 256 + d0 + e) * CTX + j;
                    Kcf[o] = f2bf(v * zf); Kcb[o] = f2bf(v * zb); } }  asm volatile("" ::: "memory"); }
    }
};
struct EpiVc {
    static constexpr int NHOOK = 0; static constexpr int AFTER_DRAIN = 0; int h0, h1; Base F;
    __device__ __forceinline__ void hook(acc_t&, const Unit&, int, int, int, int, int) const {}
    __device__ __forceinline__ void operator()(const acc_t& acc, const Unit& u, int wr, int wc, int fr, int fq) const {
        const int h = u.i0 >> 1, vt = u.i0 & 1;
        EPI_ROWS { const int v = vt * 256 + EPI_ROW;
            EPI_COLS { *(u32x4*)(VcT + (size_t)(h * 512 + v) * CTX + EPI_COL0) = pack8(acc[ai][bj][m][0], acc[ai][bj][m][1]); }  asm volatile("" ::: "memory"); }
    }
};
struct EpiS0 {
    static constexpr int NHOOK = 0; static constexpr int AFTER_DRAIN = 0; int h0, h1; Base F;
    __device__ __forceinline__ void hook(acc_t&, const Unit&, int, int, int, int, int) const {}
    __device__ __forceinline__ void operator()(const acc_t& acc, const Unit& u, int wr, int wc, int fr, int fq) const {
        EPI_ROWS { float* rowp = S0 + ((size_t)((u.i0 * 2 + u.i1) * 512 + u.i3 * 256 + EPI_ROW)) * 256;
            EPI_COLS { *(f32x4*)(rowp + EPI_COL0) = acc[ai][bj][m][0]; *(f32x4*)(rowp + EPI_COL0 + 4) = acc[ai][bj][m][1]; }  asm volatile("" ::: "memory"); }
    }
};
struct EpiU {
    static constexpr int NHOOK = 0; static constexpr int AFTER_DRAIN = 0; int h0, h1; Base F;
    __device__ __forceinline__ void hook(acc_t&, const Unit&, int, int, int, int, int) const {}
    __device__ __forceinline__ void operator()(const acc_t& acc, const Unit& u, int wr, int wc, int fr, int fq) const {
        EPI_ROWS { bf16_t* rowp = B4 + ((size_t)((u.i0 * NSEG + u.i2) * 512 + u.i3 * 256 + EPI_ROW)) * 1024 + u.i1 * 256;
            EPI_COLS { *(u32x4*)(rowp + EPI_COL0) = pack8(acc[ai][bj][m][0], acc[ai][bj][m][1]); }  asm volatile("" ::: "memory"); }
    }
};
struct EpiP {
    static constexpr int NHOOK = 0; static constexpr int AFTER_DRAIN = 0; int h0, h1; Base F; int pair;
    __device__ __forceinline__ void hook(acc_t&, const Unit&, int, int, int, int, int) const {}
    __device__ __forceinline__ void operator()(const acc_t& acc, const Unit& u, int wr, int wc, int fr, int fq) const {
        const int hl = u.i0, seg = u.i1, it = u.i2, jt = u.i3, h = 2 * pair + hl; const float l2f = lgp[h] * 1.44269504f, l2b = lgp[4 + h] * 1.44269504f;
        EPI_ROWS { const int il = it * 256 + EPI_ROW; bf16_t* rowp = Pb + (size_t)(seg * LS + il) * 1024 + hl * 512 + jt * 256;
            EPI_COLS { const int j0 = jt * 256 + EPI_COL0; f32x4 v[2];
#pragma unroll
                for (int e = 0; e < 8; ++e) { const int dl = il - (j0 + e); const float w = dl > 0 ? __builtin_amdgcn_exp2f((float)dl * l2f) : (dl < 0 ? __builtin_amdgcn_exp2f((float)(-dl) * l2b) : 2.0f);
                    v[e >> 2][e & 3] = acc[ai][bj][m][e >> 2][e & 3] * w; }
                *(u32x4*)(rowp + EPI_COL0) = pack8(v[0], v[1]); }  asm volatile("" ::: "memory"); }
    }
};
struct EpiO {
    static constexpr int NHOOK = 2; static constexpr int AFTER_DRAIN = 0; int h0, h1; Base F; int pair;
    __device__ __forceinline__ void hook(acc_t& acc, const Unit& u, int k, int wr, int wc, int fr, int fq) const {
        const int h = 2 * pair + u.i0; const float lgf = lgp[h], lgb = lgp[4 + h];
        EPI_ROWS { const int il = u.i2 * 256 + EPI_ROW; const float eb = lgb * (float)(LS - il);
            const float f = k == 0 ? __expf(lgf * (float)(il + 1) - eb) : __expf(eb);
#pragma unroll
            for (int bj = 0; bj < 2; ++bj) { acc[ai][bj][m][0] *= f; acc[ai][bj][m][1] *= f; }  asm volatile("" ::: "memory"); }
    }
    __device__ __forceinline__ void operator()(const acc_t& acc, const Unit& u, int wr, int wc, int fr, int fq) const {
        const int h = 2 * pair + u.i0;
        EPI_ROWS { bf16_t* rowp = Ob + (size_t)(u.i1 * LS + u.i2 * 256 + EPI_ROW) * 2048 + h * 512 + u.i3 * 256;
            EPI_COLS { *(u32x4*)(rowp + EPI_COL0) = pack8(acc[ai][bj][m][0], acc[ai][bj][m][1]); }  asm volatile("" ::: "memory"); }
    }
};
struct EpiG {
    static constexpr int NHOOK = 0; static constexpr int AFTER_DRAIN = 0; int h0, h1; Base F; const float* gnw; int rep; LAS unsigned char* stl;
    __device__ __forceinline__ void hook(acc_t&, const Unit&, int, int, int, int, int) const {}
    __device__ __forceinline__ void operator()(const acc_t& acc, const Unit& u, int wr, int wc, int fr, int fq) const {
        const int pm = u.i0, pn = u.i1, h = pn >> 1; u32x4 ov[1][4][2]; f32x2 st[1][4]; f32x4 gw[2][2];
#pragma unroll
        for (int bj = 0; bj < 2; ++bj) { gw[bj][0] = *(const f32x4*)(gnw + pn * 256 + EPI_COL0); gw[bj][1] = *(const f32x4*)(gnw + pn * 256 + EPI_COL0 + 4); }
#pragma unroll
        for (int ai = 0; ai < 2; ++ai) {
#pragma unroll
        for (int m = 0; m < 4; ++m) { const int pos = pm * 256 + EPI_ROW; st[0][m] = *(const LAS f32x2*)(stl + EPI_ROW * 8);
            EPI_COLS { ov[0][m][bj] = *(const u32x4*)(Ob + (size_t)pos * 2048 + pn * 256 + EPI_COL0); } }
#pragma unroll
        for (int m = 0; m < 4; ++m) { const int pos = pm * 256 + EPI_ROW; const f32x2 s2 = st[0][m];
            EPI_COLS { bf16_t* p = Ob + (size_t)pos * 2048 + pn * 256 + EPI_COL0; f32x4 o0, o1; unpack8(ov[0][m][bj], o0, o1);
                const f32x4 g0 = acc[ai][bj][m][0], g1 = acc[ai][bj][m][1]; f32x4 r0, r1;
#pragma unroll
                for (int e = 0; e < 4; ++e) { r0[e] = DBG_NORET ? 0.f : fsilu(g0[e]) * ((o0[e] - s2.x) * s2.y) * gw[bj][0][e]; r1[e] = DBG_NORET ? 0.f : fsilu(g1[e]) * ((o1[e] - s2.x) * s2.y) * gw[bj][1][e]; }
                *(u32x4*)p = rep == 0 ? pack8(r0, r1) : ov[0][m][bj]; } }
        asm volatile("" ::: "memory"); }
    }
};
struct EpiF {
    static constexpr int NHOOK = 0; static constexpr int AFTER_DRAIN = 0; int h0, h1; Base F;
    __device__ __forceinline__ void hook(acc_t&, const Unit&, int, int, int, int, int) const {}
    __device__ __forceinline__ void operator()(const acc_t& acc, const Unit& u, int wr, int wc, int fr, int fq) const {
        EPI_ROWS { const int mrow = u.i0 * 256 + EPI_ROW, ri = mrow >> 10, ch = mrow & 1023;
            EPI_COLS { const int c0 = EPI_COL0, l2 = 2 * u.i1 + (c0 >> 7), l1 = c0 & 127;
                *(u32x4*)(Wt + (size_t)(ch * 128 + l2) * 256 + ri * 128 + l1) = pack8(acc[ai][bj][m][0], acc[ai][bj][m][1]); }  asm volatile("" ::: "memory"); }
    }
};
struct EpiF1 {
    static constexpr int NHOOK = 0; static constexpr int AFTER_DRAIN = 0; int h0, h1; Base F;
    __device__ __forceinline__ void hook(acc_t&, const Unit&, int, int, int, int, int) const {}
    __device__ __forceinline__ void operator()(const acc_t& acc, const Unit& u, int wr, int wc, int fr, int fq) const {
        EPI_ROWS { const int r = EPI_ROW, k1 = r >> 1, ri = r & 1; const float sg = ri ? -1.0f : 1.0f;
            EPI_COLS { const int n = u.i1 * 256 + EPI_COL0, ch = n >> 7, l2 = n & 127; f32x4 v[2];
#pragma unroll
                for (int e = 0; e < 8; ++e) { const float rev = (float)((k1 * (l2 + e)) & 16383) * (1.0f / 16384.0f);
                    const float cs = __builtin_amdgcn_cosf(rev), sn = __builtin_amdgcn_sinf(rev); const float mine = acc[ai][bj][m][e >> 2][e & 3], other = __shfl_xor(mine, 1);
                    v[e >> 2][e & 3] = mine * cs + sg * other * sn; }
                *(u32x4*)(Bt + (size_t)(k1 * 1024 + ch) * 256 + ri * 128 + l2) = pack8(v[0], v[1]); }  asm volatile("" ::: "memory"); }
    }
};
struct EpiF2 {
    static constexpr int NHOOK = 0; static constexpr int AFTER_DRAIN = 0; int h0, h1; Base F;
    __device__ __forceinline__ void hook(acc_t&, const Unit&, int, int, int, int, int) const {}
    __device__ __forceinline__ void operator()(const acc_t& acc, const Unit& u, int wr, int wc, int fr, int fq) const {
        const int k1 = u.i1 >> 2, chb = (u.i1 & 3) * 256;
#pragma unroll
        for (int m = 0; m < 4; ++m) { const int k2 = 64 * wr + 16 * m + fr; bf16_t* rowp = MIXb + (size_t)(k1 + 128 * k2) * 2048 + chb;
            EPI_COLS { *(u32x4*)(rowp + EPI_COL0) = pack8(acc[0][bj][m][0], acc[0][bj][m][1]); } }
    }
};
struct EpiGate {
    static constexpr int NHOOK = 0; static constexpr int AFTER_DRAIN = 0; int h0, h1; Base F;
    __device__ __forceinline__ void hook(acc_t&, const Unit&, int, int, int, int, int) const {}
    __device__ __forceinline__ void operator()(const acc_t& acc, const Unit& u, int wr, int wc, int fr, int fq) const {
        bf16_t* dst = (u.i1 >> 2) ? GFb : GAb; const int cb = (u.i1 & 3) * 256;
        EPI_ROWS { bf16_t* rowp = dst + (size_t)(u.i0 * 256 + EPI_ROW) * DM + cb;
            EPI_COLS { f32x4 s0, s1;
#pragma unroll
                for (int e = 0; e < 4; ++e) { s0[e] = fsigmoid(acc[ai][bj][m][0][e]); s1[e] = fsigmoid(acc[ai][bj][m][1][e]); }
                *(u32x4*)(rowp + EPI_COL0) = pack8(s0, s1); }  asm volatile("" ::: "memory"); }
    }
};
struct EpiZ {
    static constexpr int NHOOK = 1; static constexpr int AFTER_DRAIN = 0; int h0, h1; Base F;
    __device__ __forceinline__ void hook(acc_t& acc, const Unit& u, int, int wr, int wc, int fr, int fq) const {
        EPI_ROWS { const size_t ro = (size_t)(u.i0 * 256 + EPI_ROW) * DM + u.i1 * 256;
            EPI_COLS { f32x4 a0, a1, f0, f1; unpack8(*(const u32x4*)(GAb + ro + EPI_COL0), a0, a1); unpack8(*(const u32x4*)(GFb + ro + EPI_COL0), f0, f1);
#pragma unroll
                for (int e = 0; e < 4; ++e) { acc[ai][bj][m][0][e] *= DBG_NOFOUR ? 0.f : f0[e] * __builtin_amdgcn_rcpf(fmaxf(a0[e], 1e-30f)); acc[ai][bj][m][1][e] *= DBG_NOFOUR ? 0.f : f1[e] * __builtin_amdgcn_rcpf(fmaxf(a1[e], 1e-30f)); } }  asm volatile("" ::: "memory"); }
    }
    __device__ __forceinline__ void operator()(const acc_t& acc, const Unit& u, int wr, int wc, int fr, int fq) const {
        EPI_ROWS { const size_t ro = (size_t)(u.i0 * 256 + EPI_ROW) * DM + u.i1 * 256;
            EPI_COLS { f32x4 a0, a1; unpack8(*(const u32x4*)(GAb + ro + EPI_COL0), a0, a1); f32x4 v0, v1;
#pragma unroll
                for (int e = 0; e < 4; ++e) { v0[e] = acc[ai][bj][m][0][e] * fmaxf(a0[e], 1e-30f); v1[e] = acc[ai][bj][m][1][e] * fmaxf(a1[e], 1e-30f); }
                *(u32x4*)(Zb + ro + EPI_COL0) = pack8(v0, v1); }  asm volatile("" ::: "memory"); }
    }
};

struct EpiSlab {
    static constexpr int NHOOK = 0; static constexpr int AFTER_DRAIN = 0; int h0, h1; Base F;
    __device__ __forceinline__ void hook(acc_t&, const Unit&, int, int, int, int, int) const {}
    __device__ __forceinline__ void operator()(const acc_t& acc, const Unit& u, int wr, int wc, int fr, int fq) const {
        float* dst = XcSlab + (size_t)u.i2 * CTX * DM + u.i1 * 256;
        EPI_ROWS { float* rowp = dst + (size_t)EPI_ROW * DM;
            EPI_COLS { *(f32x4*)(rowp + EPI_COL0) = acc[ai][bj][m][0]; *(f32x4*)(rowp + EPI_COL0 + 4) = acc[ai][bj][m][1]; } }
    }
};
struct JobCtxG2 {
    Base F;
    __device__ __forceinline__ void fill(int L, Unit& u) const { const int pn = L & 3, kc = L >> 2;
        u.a0 = (const char*)(Hc + kc * 256); u.a1 = u.a0; u.b = (const char*)(W2t1 + (size_t)pn * 256 * DFF + kc * 256); u.d = nullptr; u.i0 = 64; u.i1 = pn; u.i2 = kc; u.i3 = 0; }
};
struct EpiZ2 {
    static constexpr int NHOOK = 0; static constexpr int AFTER_DRAIN = 0; int h0, h1; Base F; int part;
    __device__ __forceinline__ void hook(acc_t&, const Unit&, int, int, int, int, int) const {}
    __device__ __forceinline__ void operator()(const acc_t& acc, const Unit& u, int wr, int wc, int fr, int fq) const {
        const bf16_t* G = part ? GAb : GFb;
#pragma unroll
        for (int ai = 0; ai < 2; ++ai) { u32x4 gv[4][2], tv[4][2];
#pragma unroll
            for (int m = 0; m < 4; ++m) { const size_t ro = (size_t)(u.i0 * 256 + EPI_ROW) * DM + u.i1 * 256, zo = (size_t)(u.i0 * 256 + EPI_ROW) * 2048 + u.i1 * 256;
                EPI_COLS { gv[m][bj] = *(const u32x4*)(G + ro + EPI_COL0); if (part) tv[m][bj] = *(const u32x4*)(Zb + zo + EPI_COL0); } }
#pragma unroll
            for (int m = 0; m < 4; ++m) { const size_t zo = (size_t)(u.i0 * 256 + EPI_ROW) * 2048 + u.i1 * 256;
                EPI_COLS { f32x4 g0, g1; unpack8(gv[m][bj], g0, g1); f32x4 v0 = acc[ai][bj][m][0] * g0, v1 = acc[ai][bj][m][1] * g1;
                    if (part) { f32x4 t0, t1; unpack8(tv[m][bj], t0, t1); v0 += t0; v1 += t1; }
                    *(u32x4*)(Zb + zo + EPI_COL0) = pack8(v0, v1); } }
            asm volatile("" ::: "memory"); }
    }
};
struct JobGate2 {
    Base F;
    __device__ __forceinline__ void fill(int L, Unit& u) const { const int c = L & 255, which = L >> 8; int pm, pn; pg::tile_pm_pn(c, 64, 4, pm, pn);
        u.a0 = (const char*)(Ax + (size_t)pm * 256 * DM); u.a1 = u.a0; u.b = (const char*)(Win + (size_t)(WR_GA + which * 1024 + pn * 256) * DM); u.d = nullptr; u.i0 = pm; u.i1 = which * 4 + pn; u.i2 = 0; u.i3 = 0; }
};
struct JobG2 {
    Base F;
    __device__ __forceinline__ void fill(int L, Unit& u) const { const int c = L & 255, half = L >> 8, pm = c >> 2, pn = 2 * (c & 3) + half;
        u.a0 = (const char*)(Ax + (size_t)pm * 256 * DM); u.a1 = u.a0; u.b = (const char*)(Win + (size_t)(WR_G + pn * 256) * DM); u.d = nullptr; u.i0 = pm; u.i1 = pn; u.i2 = 0; u.i3 = 0; }
};
struct JobFold {
    Base F;
    __device__ __forceinline__ void fill(int L, Unit& u) const { const int pn = L & 3, pm = (L >> 2) & 1, g = L >> 3;
        u.a0 = (const char*)(T256 + (size_t)pm * 256 * 256); u.a1 = u.a0; u.b = (const char*)(Wn + (size_t)pn * 256 * DM + g * 256);
        u.d = (char*)(Win + (size_t)(WR_F + pm * 1024 + g * 256) * DM + pn * 256); u.i0 = pm; u.i1 = pn; u.i2 = g; u.i3 = 0; }
};
struct JobRowCol {
    Base F; int sel, nM, nN; size_t aoff0, boff0, astep, bstep;
    __device__ __forceinline__ void fill(int L, Unit& u) const { int pm, pn; pg::tile_pm_pn(L, nM, nN, pm, pn);
        const bf16_t* A = sel == 0 ? Ax : (sel == 1 ? Win : Zb); const bf16_t* B = sel == 0 ? Win : (sel == 1 ? Ax : WoT);
        u.a0 = (const char*)(A + aoff0 + (size_t)pm * astep); u.a1 = u.a0; u.b = (const char*)(B + boff0 + (size_t)pn * bstep); u.d = nullptr; u.i0 = pm; u.i1 = pn; u.i2 = 0; u.i3 = 0; }
};
struct JobKc {
    Base F;
    __device__ __forceinline__ void fill(int L, Unit& u) const { const int h = L; u.a0 = (const char*)Ac; u.a1 = u.a0;
        u.b = (const char*)(Win + (size_t)((h >> 1) * 2048 + 512 + (h & 1) * 256) * DM); u.d = nullptr; u.i0 = 0; u.i1 = h; u.i2 = 0; u.i3 = 0; }
};
struct JobVc {
    Base F;
    __device__ __forceinline__ void fill(int L, Unit& u) const { const int t = L, h = t >> 1; u.a0 = (const char*)(Win + (size_t)((h >> 1) * 2048 + 1024 + (h & 1) * 512 + (t & 1) * 256) * DM); u.a1 = u.a0;
        u.b = (const char*)Ac; u.d = nullptr; u.i0 = t; u.i1 = 0; u.i2 = 0; u.i3 = 0; }
};
struct JobS0 {
    Base F;
    __device__ __forceinline__ void fill(int L, Unit& u) const { const int h = L >> 2, dir = (L >> 1) & 1, vt = L & 1;
        u.a0 = (const char*)(VcT + (size_t)(h * 512 + vt * 256) * CTX); u.a1 = u.a0; u.b = (const char*)(KcT + (size_t)dir * 1024 * CTX + (size_t)(h * 256) * CTX);
        u.d = nullptr; u.i0 = h; u.i1 = dir; u.i2 = 0; u.i3 = vt; }
};
struct JobR1 {
    Base F;
    __device__ __forceinline__ void fill(int L, Unit& u) const { const int w = pg::xcd_contig(L, 256), vt = w & 1, dir = (w >> 1) & 1, seg = (w >> 2) & 31, hl = w >> 7;
        u.a0 = (const char*)(B4 + ((size_t)((hl * NSEG + seg) * 512 + vt * 256)) * 1024 + 512); u.a1 = u.a0;
        u.b = (const char*)(Ktb_ + (size_t)dir * 512 * SEQ + (size_t)(hl * 256) * SEQ + seg * LS); u.d = nullptr; u.i0 = hl; u.i1 = dir; u.i2 = seg; u.i3 = vt; }
};
struct JobR3 {
    Base F;
    __device__ __forceinline__ void fill(int L, Unit& u) const { const int w = pg::xcd_contig(L, 256), jt = w & 1, it = (w >> 1) & 1, seg = (w >> 2) & 31, hl = w >> 7;
        u.a0 = (const char*)(Qb + (size_t)(seg * LS + it * 256) * 512 + hl * 256); u.a1 = u.a0; u.b = (const char*)(Knb + (size_t)(seg * LS + jt * 256) * 512 + hl * 256);
        u.d = nullptr; u.i0 = hl; u.i1 = seg; u.i2 = it; u.i3 = jt; }
};
struct JobR4 {
    Base F;
    __device__ __forceinline__ void fill(int L, Unit& u) const { const int w = pg::xcd_contig(L, 256), vt = w & 1, it = (w >> 1) & 1, seg = (w >> 2) & 31, hl = w >> 7;
        u.a0 = (const char*)(Qb + (size_t)(seg * LS + it * 256) * 512 + hl * 256); u.a1 = (const char*)(Pb + (size_t)(seg * LS + it * 256) * 1024 + hl * 512);
        u.b = (const char*)(B4 + ((size_t)((hl * NSEG + seg) * 512 + vt * 256)) * 1024); u.d = nullptr; u.i0 = hl; u.i1 = seg; u.i2 = it; u.i3 = vt; }
};
struct JobF1 {
    Base F;
    __device__ __forceinline__ void fill(int L, Unit& u) const { u.a0 = (const char*)FmT; u.a1 = u.a0; u.b = (const char*)(Wt + (size_t)L * 256 * 256); u.d = nullptr; u.i0 = 0; u.i1 = L; u.i2 = 0; u.i3 = 0; }
};
struct JobF2 {
    Base F;
    __device__ __forceinline__ void fill(int L, Unit& u) const { u.a0 = (const char*)GmT; u.a1 = u.a0; u.b = (const char*)(Bt + (size_t)L * 256 * 256); u.d = nullptr; u.i0 = 0; u.i1 = L; u.i2 = 0; u.i3 = 0; }
};
struct JobZ {
    Base F; int part;
    __device__ __forceinline__ void fill(int L, Unit& u) const { int pm, pn; pg::tile_pm_pn(L, 64, 4, pm, pn);
        u.a0 = (const char*)((part ? Ob : MIXb) + (size_t)pm * 256 * 2048); u.a1 = u.a0; u.b = (const char*)(Bz + (size_t)pn * 256 * 3072 + (part ? 1024 : 0)); u.d = nullptr; u.i0 = pm; u.i1 = pn; u.i2 = 0; u.i3 = 0; }
};

#define XB_TMO      128
#define XB_XCNT(j)  (256  + 64 * (j))
#define XB_XSUB(j)  (1280 + 64 * (j))
#define XB_XGEN(j)  (2304 + 64 * (j))
#define XB_TOP      3328
#define XB_TOPGEN   3392
#define XCD_BAR_WORDS 3456
#define XB_SPIN_CAP (1u << 22)
__device__ __forceinline__ unsigned xb_ld(unsigned* p)              { return __hip_atomic_load(p, __ATOMIC_RELAXED, __HIP_MEMORY_SCOPE_AGENT); }
__device__ __forceinline__ unsigned xb_add(unsigned* p, unsigned v) { return __hip_atomic_fetch_add(p, v, __ATOMIC_RELAXED, __HIP_MEMORY_SCOPE_AGENT); }
__device__ __forceinline__ unsigned xb_xcc_id() { return (unsigned)__builtin_amdgcn_s_getreg((3 << 11) | 20) & 0xFu; }
#define XB_SPIN(cond, bar) do { unsigned _sp = 0; while (cond) { __builtin_amdgcn_s_sleep(1); \
    if ((++_sp & 255u) == 0u) { if (xb_ld(&(bar)[XB_TMO])) break; if (_sp > XB_SPIN_CAP) { atomicAdd(&(bar)[XB_TMO], 1u); break; } } } } while (0)
struct XcdBarrier { unsigned* bar; unsigned x; volatile LAS unsigned* st; };
__device__ __forceinline__ XcdBarrier xcd_barrier_post(unsigned* bar, volatile LAS unsigned* st) {
    XcdBarrier b; b.bar = bar; b.x = xb_xcc_id(); b.st = st;
    if (threadIdx.x == 0) (void)xb_add(&bar[XB_XCNT(b.x)], 1u);
    return b;
}
__device__ __forceinline__ void xcd_barrier_complete(unsigned* bar, unsigned x, unsigned& nloc, unsigned& nx) {
    const unsigned G = gridDim.x * gridDim.y * gridDim.z;
    unsigned sum, cnt, mine, sp = 0u;
    for (;;) {
        sum = 0u; cnt = 0u; mine = 0u;
#pragma unroll
        for (unsigned j = 0; j < 16; ++j) { const unsigned c = xb_ld(&bar[XB_XCNT(j)]); sum += c; cnt += (c > 0u) ? 1u : 0u; mine = (j == x) ? c : mine; }
        if (sum == G) break;
        __builtin_amdgcn_s_sleep(1);
        if ((++sp & 255u) == 0u) { if (xb_ld(&bar[XB_TMO])) break; if (sp > XB_SPIN_CAP) { atomicAdd(&bar[XB_TMO], 1u); break; } }
    }
    nloc = mine > 0u ? mine : 1u; nx = cnt > 0u ? cnt : 1u;
}
__device__ __attribute__((noinline)) void xcd_barrier(unsigned* bar_, unsigned bx_, volatile LAS unsigned* st_) {
    XcdBarrier b; b.bar = bar_; b.x = bx_; b.st = st_;
    asm volatile("s_waitcnt vmcnt(0)" ::: "memory");
    __syncthreads();
    if (threadIdx.x == 0) {
        unsigned* bar = b.bar;
        __builtin_amdgcn_s_waitcnt(0);
        unsigned nloc = b.st[0], nx = b.st[1];
        if (nloc == 0u) { xcd_barrier_complete(bar, b.x, nloc, nx); b.st[0] = nloc; b.st[1] = nx; }
        const unsigned old = xb_add(&bar[XB_XSUB(b.x)], 1u);
        const unsigned gen = old / nloc;
        if (old + 1u == (gen + 1u) * nloc) {
            __builtin_amdgcn_fence(__ATOMIC_RELEASE, "agent");
            asm volatile("s_waitcnt vmcnt(0)" ::: "memory");
            const unsigned og = xb_add(&bar[XB_TOP], 1u);
            const unsigned tg = og / nx;
            if (og + 1u == (tg + 1u) * nx) xb_add(&bar[XB_TOPGEN], 1u);
            else XB_SPIN(xb_ld(&bar[XB_TOPGEN]) == tg, bar);
            __builtin_amdgcn_fence(__ATOMIC_ACQUIRE, "agent");
            xb_add(&bar[XB_XGEN(b.x)], 1u);
            asm volatile("s_waitcnt vmcnt(0)" ::: "memory");
        } else {
            XB_SPIN(xb_ld(&bar[XB_XGEN(b.x)]) == gen, bar);
            __builtin_amdgcn_fence(__ATOMIC_ACQUIRE, "agent");
            asm volatile("s_waitcnt vmcnt(0)" ::: "memory");
        }
    }
    __syncthreads();
}

constexpr int NWAVES = 8, NTHREADS = 512;
constexpr int RING_BYTES = 131072, MISC_OFF = RING_BYTES + 320, LDS_BYTES = 147456;
constexpr int CW_BAR = 4096;

struct Args { const float* in[21]; float* out; unsigned char* ws; int ph_lo, ph_hi; };

struct Ctx {
    LAS unsigned char* lds; int tid, lane, wave, G, vcu;
    unsigned char* ws; unsigned char* dout;
};
#define F_WS (F.ws)
#define F_DOUT (F.dout)

__device__ __forceinline__ void gemv_item(const Ctx& F, int item, const float* W, const float* b, const float* c, const float* cc) {
    LAS float* scr = (LAS float*)F.lds;
    const int cg = F.tid & 7, rg = F.tid >> 3, n0 = item * 32 + cg * 4;
    f32x4 ax = {0.f, 0.f, 0.f, 0.f}, ac = {0.f, 0.f, 0.f, 0.f};
#pragma unroll 4
    for (int k = rg; k < DM; k += 64) { const f32x4 w = *(const f32x4*)(W + (size_t)k * 9216 + n0); const float sx = c[k], sc = cc[k];
        ax += w * (sx / (1.f + expf(-sx))); ac += w * (sc / (1.f + expf(-sc))); }
    __syncthreads();
#pragma unroll
    for (int e = 0; e < 4; ++e) { scr[(rg * 8 + cg) * 8 + e] = ax[e]; scr[(rg * 8 + cg) * 8 + 4 + e] = ac[e]; }
    __syncthreads();
    if (F.tid < 64) { const int which = F.tid >> 5, col = F.tid & 31, g = col >> 2, e = col & 3; float s = 0.f;
        for (int r = 0; r < 64; ++r) s += scr[(r * 8 + g) * 8 + which * 4 + e];
        (which ? modc : modx)[item * 32 + col] = s + b[item * 32 + col]; }
    __syncthreads();
}
struct TrDesc { const float* W; int K, N; bf16_t* dst; int ld, coloff, kind; };
__device__ __forceinline__ int tr_dest_row(int kind, int n) {
    switch (kind) {
    case 0: { const int isb = n >= DFF, j = isb ? n - DFF : n; return 256 * (j >> 7) + 128 * isb + (j & 127); }
    case 2: {
        if (n < 1024) { const int h = n >> 8, d = n & 255; return (h >> 1) * 2048 + (h & 1) * 256 + d; }
        if (n < 2048) { const int h = (n - 1024) >> 8, d = n & 255; return (h >> 1) * 2048 + 512 + (h & 1) * 256 + d; }
        if (n < 4096) { const int h = (n - 2048) >> 9, v = (n - 2048) & 511; return (h >> 1) * 2048 + 1024 + (h & 1) * 512 + v; }
        if (n < 6144) return WR_G + (n - 4096);
        if (n < 7168) return -1;
        if (n < 8192) return WR_GA + (n - 7168);
        return WR_GF + (n - 8192); }
    default: return n; }
}
__device__ __forceinline__ void tr_item(const TrDesc& t, LAS float* scr, int item, int lane) {
    const int nblk = t.N / 32, kb = item / nblk, nb = item % nblk, k0 = 64 * kb, n0 = 32 * nb;
    if (t.kind == 2 && n0 >= 6144 && n0 < 7168) return;
#pragma unroll
    for (int i = 0; i < 8; ++i) { const int kk = 8 * i + (lane >> 3), c4 = (lane & 7) * 4; const f32x4 v = *(const f32x4*)(t.W + (size_t)(k0 + kk) * t.N + n0 + c4);
        scr[kk * 33 + c4] = v[0]; scr[kk * 33 + c4 + 1] = v[1]; scr[kk * 33 + c4 + 2] = v[2]; scr[kk * 33 + c4 + 3] = v[3]; }
    asm volatile("s_waitcnt lgkmcnt(0)" ::: "memory");
    const int c = lane & 7;
#pragma unroll
    for (int j = 0; j < 4; ++j) { const int n = (lane >> 3) + 8 * j; const LAS float* s = scr + (8 * c) * 33 + n;
        u32x4 o; o.x = cvt_pk_bf16(s[0 * 33], s[1 * 33]); o.y = cvt_pk_bf16(s[2 * 33], s[3 * 33]); o.z = cvt_pk_bf16(s[4 * 33], s[5 * 33]); o.w = cvt_pk_bf16(s[6 * 33], s[7 * 33]);
        const int dr = tr_dest_row(t.kind, n0 + n);
        *(u32x4*)(t.dst + (size_t)dr * t.ld + t.coloff + k0 + 8 * c) = o; }
    asm volatile("s_waitcnt lgkmcnt(0)" ::: "memory");
}
__device__ __forceinline__ void tr_all(const Ctx& F, const TrDesc& t, int gw, int NGW) {
    LAS float* scr = (LAS float*)(F.lds + F.wave * 16384);
    const int nitems = (t.K / 64) * (t.N / 32);
    for (int it = gw; it < nitems; it += NGW) tr_item(t, scr, it, F.lane);
}
__device__ __forceinline__ void norm_rows(const Ctx& F, const float* xin, const float* cin, const float* nw, int modoff, const bf16_t* dx, const float* dcf, bool has_delta, int row0, int nrows) {
    const int gw = F.vcu * NWAVES + F.wave, NGW = F.G * NWAVES;
    for (int r = row0 + gw; r < nrows; r += NGW) {
        const bool isx = r < SEQ; const int rr = isx ? r : r - SEQ;
        const float* xr = (isx ? xin : cin) + (size_t)rr * DM; const bf16_t* dr = dx + (size_t)rr * DM; const float* drf = dcf + (size_t)rr * DM;
        const float* md = (isx ? modx : modc) + modoff; bf16_t* orow = (isx ? Ax : Ac) + (size_t)rr * DM;
        f32x4 v[4]; float ss = 0.f;
#pragma unroll
        for (int j = 0; j < 4; ++j) { v[j] = *(const f32x4*)(xr + 256 * j + 4 * F.lane);
            if (has_delta) { if (isx) { const u32x2 d = *(const u32x2*)(dr + 256 * j + 4 * F.lane); v[j] += (f32x4){bflo(d.x), bfhi(d.x), bflo(d.y), bfhi(d.y)}; } else { f32x4 sacc = {0.f, 0.f, 0.f, 0.f};
#pragma unroll
                for (int kc = 0; kc < 11; ++kc) sacc += *(const f32x4*)(drf + (size_t)kc * CTX * DM + 256 * j + 4 * F.lane);
                v[j] += sacc * (*(const f32x4*)(modc + 2 * DM + 256 * j + 4 * F.lane)) * 0.5f; } }
            ss += (v[j][0] * v[j][0] + v[j][1] * v[j][1]) + (v[j][2] * v[j][2] + v[j][3] * v[j][3]); }
        const float rinv = 1.0f / sqrtf(wave_sum(ss) * (1.f / DM) + EPS);
#pragma unroll
        for (int j = 0; j < 4; ++j) { const int c = 256 * j + 4 * F.lane; const f32x4 w = *(const f32x4*)(nw + c), sh = *(const f32x4*)(md + c), sc = *(const f32x4*)(md + 1024 + c);
            const f32x4 y = (v[j] * rinv) * w * (sc + 1.0f) + sh; u32x2 o; o.x = cvt_pk_bf16(y[0], y[1]); o.y = cvt_pk_bf16(y[2], y[3]);
            *(u32x2*)(orow + c) = o; }
    }
}
__device__ __forceinline__ void final_norm(const Ctx& F, const float* xin, const float* nw, const bf16_t* dx) {
    float* out = (float*)F_DOUT;
    const int gw = F.vcu * NWAVES + F.wave, NGW = F.G * NWAVES;
    for (int r = gw; r < SEQ; r += NGW) {
        const float* xr = xin + (size_t)r * DM; const bf16_t* dr = dx + (size_t)r * DM;
        f32x4 v[4]; float ss = 0.f;
#pragma unroll
        for (int j = 0; j < 4; ++j) { v[j] = *(const f32x4*)(xr + 256 * j + 4 * F.lane);
            const u32x2 d = *(const u32x2*)(dr + 256 * j + 4 * F.lane); v[j] += (f32x4){bflo(d.x), bfhi(d.x), bflo(d.y), bfhi(d.y)};
            ss += (v[j][0] * v[j][0] + v[j][1] * v[j][1]) + (v[j][2] * v[j][2] + v[j][3] * v[j][3]); }
        const float rinv = 1.0f / sqrtf(wave_sum(ss) * (1.f / DM) + EPS);
#pragma unroll
        for (int j = 0; j < 4; ++j) { const int c = 256 * j + 4 * F.lane; *(f32x4*)(out + (size_t)r * DM + c) = (v[j] * rinv) * *(const f32x4*)(nw + c); }
    }
}
__device__ __forceinline__ void copy_delta(const Ctx& F, const bf16_t* src, bf16_t* dst) {
    const size_t n16 = (size_t)SEQ * DM * 2 / 16; const u32x4* s = (const u32x4*)src; u32x4* d = (u32x4*)dst;
    for (size_t i = (size_t)F.vcu * NTHREADS + F.tid; i < n16; i += (size_t)F.G * NTHREADS) d[i] = s[i];
}


__device__ __forceinline__ float block_sum(LAS float* scr, float v, int tid) {
    v = wave_sum(v); __syncthreads(); if ((tid & 63) == 0) scr[tid >> 6] = v; __syncthreads();
    float s = 0.f; for (int i = 0; i < NWAVES; ++i) s += scr[i]; __syncthreads(); return s;
}
__device__ __forceinline__ void dbg_report(unsigned* word, float ref, float got, float floor_) {
    const float e = fabsf(got - ref) / fmaxf(fabsf(ref), floor_); atomicMax(word, __builtin_bit_cast(unsigned, e)); if (e > 0.05f) atomicAdd(word + 64, 1u);
}
__device__ __forceinline__ float bf2f(bf16_t b) { return __builtin_bit_cast(float, (unsigned)b << 16); }

__global__ void __launch_bounds__(NTHREADS, 2) fwd_kernel(Args args) {
    extern __shared__ __attribute__((aligned(16))) unsigned char lds_raw[];
    Ctx F;
    F.lds = (LAS unsigned char*)lds_raw;
    F.tid = threadIdx.x; F.lane = F.tid & 63; F.wave = __builtin_amdgcn_readfirstlane(F.tid >> 6);
    F.G = gridDim.x; { const int bx = blockIdx.x; F.vcu = (F.G % 8 == 0) ? (bx % 8) * (F.G / 8) + bx / 8 : bx; }
    F.ws = args.ws; F.dout = (unsigned char*)args.out;
    volatile LAS unsigned* MISC = (volatile LAS unsigned*)(F.lds + MISC_OFF);
    for (int u = F.tid; u < (LDS_BYTES - RING_BYTES) / 4; u += NTHREADS) ((LAS unsigned*)(F.lds + RING_BYTES))[u] = 0u;
    __syncthreads();
    unsigned* ctl = (unsigned*)(F_WS + WS_CTL);
    XcdBarrier bar = xcd_barrier_post(ctl + CW_BAR, MISC + 8);
    const int lo = args.ph_lo, hi = args.ph_hi;
    int phase = 0;
#define PHASE_BEGIN if (phase >= lo && phase < hi) { for (int _rep = 0; _rep < ((DBG_DUP >= 0 && phase == DBG_DUP) ? 2 : 1); ++_rep) { asm volatile("; MARK %0" :: "i"(__LINE__)); { unsigned char* _w = args.ws; unsigned char* _o = (unsigned char*)args.out; int _t = threadIdx.x; asm volatile("" : "+s"(_w), "+s"(_o), "+v"(_t)); F.ws = _w; F.dout = _o; F.tid = _t; F.lane = _t & 63; }
#define PHASE_END   } if (phase + 1 < hi) xcd_barrier((unsigned*)(F.ws + WS_CTL) + CW_BAR, bar.x, MISC + 8); if (DBG_TSEL >= 0 && bx == 0 && F.tid == 0) ((unsigned long long*)(F.ws + WS_CTL + 160000))[phase + 1] = __builtin_amdgcn_s_memrealtime(); } ++phase;
    const int bx = (int)blockIdx.x;

#define gtid ((size_t)F.vcu * NTHREADS + F.tid)
#define gthreads ((size_t)F.G * NTHREADS)
#define FB (Base{F.ws, F.dout})
    const Geo gK1024{DM, DM, DM, 128u * DM * 2u, 128u * DM * 2u, 128u * DM * 2u, DM / 64, 1 << 20, 1 << 20};
    const Geo gFfn2{DFF, DFF, DFF, 128u * DFF * 2u, 128u * DFF * 2u, 128u * DFF * 2u, DFF / 64, 1 << 20, 1 << 20};

    if (DBG_TSEL >= 0 && bx == 0 && threadIdx.x == 0) ((unsigned long long*)(args.ws + WS_CTL + 160000))[0] = __builtin_amdgcn_s_memrealtime();
    PHASE_BEGIN
        for (int it = F.vcu; it < 288; it += F.G) gemv_item(F, it, args.in[4], args.in[5], args.in[1], args.in[3]);
        __syncthreads();
        if (gtid == 0) { ((unsigned*)(F.ws + WS_CTL))[32768 + 192] = 255u; ((unsigned*)(F.ws + WS_CTL))[32768 + 193] = 255u; }
        if (gtid < 8) { const float x = (gtid < 4 ? args.in[11] : args.in[12])[gtid & 3]; modx[2 * 9216 + gtid] = -log1pf(expf(-x)); }
        for (size_t i = gtid; i < 256 * 64; i += gthreads) { const int p = (int)(i >> 6), f = (int)(i & 63); const float inv = powf(10000.0f, -(float)f / 64.0f), ang = (float)p * inv;
            ropeT[2 * i] = cosf(ang); ropeT[2 * i + 1] = sinf(ang); }
        for (size_t i = gtid; i < 128 * 128; i += gthreads) { const int k1 = (int)(i >> 7), l2 = (int)(i & 127); const float a = (float)((k1 * l2) & 16383) * (1.0f / 8192.0f);
            twT[2 * i] = cospif(a); twT[2 * i + 1] = sinpif(a); }
        for (size_t i = gtid; i < 256 * 256; i += gthreads) { const int r = (int)(i >> 8), cc = (int)(i & 255), rin = cc >> 7, l = cc & 127;
            { const int k1 = r >> 1, ri = r & 1; const float a = (float)((k1 * l) & 127) * (1.0f / 64.0f), c = cospif(a), s = sinpif(a);
              FmT[i] = f2bf(ri == 0 ? (rin == 0 ? c : s) : (rin == 0 ? -s : c)); }
            { const float a = (float)((r * l) & 127) * (1.0f / 64.0f), c = cospif(a), s = sinpif(a);
              GmT[i] = r < 128 ? f2bf((rin == 0 ? c : s) * (1.0f / 2048.0f)) : (bf16_t)0; } }
        for (size_t i = gtid; i < 512 * 256; i += gthreads) { const int r = (int)(i >> 8), c = (int)(i & 255), ri = r >> 8, cp = r & 255; const float a = (float)((c * cp) & 255) * (1.0f / 128.0f);
            T256[i] = f2bf(ri == 0 ? cospif(a) : -sinpif(a)); }
        for (size_t i = gtid; i < (size_t)DM * DM / 4; i += gthreads) { const int k = (int)(i >> 8), c4 = (int)(i & 255) * 4; const f32x4 w = *(const f32x4*)(args.in[10] + (size_t)k * 9216 + 6144 + c4);
            u32x2 o; o.x = cvt_pk_bf16(w[0], w[1]); o.y = cvt_pk_bf16(w[2], w[3]); *(u32x2*)(Wn + (size_t)k * DM + c4) = o; }
        { TrDesc t{args.in[7], DM, 2 * DFF, W13t1, DM, 0, 0}; tr_all(F, t, F.vcu * NWAVES + F.wave, F.G * NWAVES); }
        { TrDesc t{args.in[8], DFF, DM, W2t1, DFF, 0, 1}; tr_all(F, t, F.vcu * NWAVES + F.wave, F.G * NWAVES); }
        { TrDesc t{args.in[10], DM, 9216, Win, DM, 0, 2}; tr_all(F, t, F.vcu * NWAVES + F.wave, F.G * NWAVES); }
        __syncthreads();
    PHASE_END
    for (int xb = 0; xb < DBG_XBAR; ++xb) {
    PHASE_BEGIN
    PHASE_END
    }
    PHASE_BEGIN
        norm_rows(F, args.in[0], args.in[2], args.in[6], 0, nullptr, nullptr, false, 0, SEQ + CTX);
        { Geo g{256, 256, DM, 128u * 256 * 2u, 128u * 256 * 2u, 128u * DM * 2u, 4, 1 << 20, 1 << 20};
          pg::Sched<JobFold> S{{FB}, 32, F.G, bx}; EpiStore E{0, 0, DM};
          pg::gemm_phase<EpiStore, pg::Sched<JobFold>, 1>(F.lds, g, S, E); }
    PHASE_END
    if constexpr (DBG_PROBE == 11) {
    PHASE_BEGIN
        unsigned* dw = (unsigned*)(F.ws + WS_CTL) + 32768;
        for (size_t idx = gtid; idx < (size_t)DM * 9216; idx += gthreads) { const int k = (int)(idx / 9216), n = (int)(idx % 9216); const int dr = tr_dest_row(2, n);
            if (dr >= 0) { const float a = args.in[10][idx]; const float b = bf2f(Win[(size_t)dr * DM + k]); if (fabsf(a - b) > 0.01f * fabsf(a) + 1e-6f) { atomicAdd(dw + 64, 1u); atomicMin(dw + 192, (unsigned)(dr >> 8)); } } }
    PHASE_END
    }
    PHASE_BEGIN
        { pg::Sched<JobFfn1> S{{FB, 65, 1}, 65 * 22, F.G, bx};
          EpiSwiglu E{0, 0, FB};
          pg::gemm_phase<EpiSwiglu, pg::Sched<JobFfn1>, 1>(F.lds, gK1024, S, E); }
        if (bx >= 150 && bx < 194 && _rep == 0) {
            if (F.tid < 64) { unsigned* cnt = (unsigned*)(F.ws + WS_CTL) + 24576; unsigned sp = 0;
                while ((unsigned)__builtin_amdgcn_readfirstlane(__hip_atomic_load(cnt, __ATOMIC_RELAXED, __HIP_MEMORY_SCOPE_AGENT)) < 22u * 8u) { __builtin_amdgcn_s_sleep(2); if (++sp > (1u << 22)) break; }
                __builtin_amdgcn_fence(__ATOMIC_ACQUIRE, "agent"); asm volatile("s_waitcnt vmcnt(0)" ::: "memory"); }
            __syncthreads();
            Geo g{DFF, DFF, DFF, 128u * DFF * 2u, 128u * DFF * 2u, 128u * DFF * 2u, 4, 1 << 20, 1 << 20};
            pg::Sched<JobCtxG2> S{{FB}, 44, 1 << 20, bx - 150}; EpiSlab E{0, 0, FB};
            pg::gemm_phase<EpiSlab, pg::Sched<JobCtxG2>, 1>(F.lds, g, S, E);
        } else if (bx >= 194 && _rep == 0) {
            { TrDesc t{args.in[18], DM, 2 * DFF, W13t, DM, 0, 0}; tr_all(F, t, (bx - 194) * NWAVES + F.wave, (F.G - 194) * NWAVES); }
            { TrDesc t{args.in[19], DFF, DM, W2t, DFF, 0, 1}; tr_all(F, t, (bx - 194) * NWAVES + F.wave, (F.G - 194) * NWAVES); }
            __syncthreads();
        }
    PHASE_END
    PHASE_BEGIN
        if (_rep == 0) norm_rows(F, args.in[0], args.in[2], args.in[9], 3 * DM, Dx, XcSlab, true, SEQ, SEQ + CTX);
        { pg::Sched<JobFfn2> S{{FB, 64, 1}, 64 * 4, F.G, bx};
          EpiFuse E{0, 0, FB, 0, args.in[0], args.in[9]};
          pg::gemm_phase<EpiFuse, pg::Sched<JobFfn2>, 1>(F.lds, gFfn2, S, E); }
    PHASE_END
    if constexpr (STOP_AFTER >= 3) {
    for (int pair = 0; pair < 2; ++pair) {
        PHASE_BEGIN
            { pg::Sched<JobRowCol> S{{FB, 0, 64, 4, 0, (size_t)pair * 2048 * DM, (size_t)256 * DM, (size_t)256 * DM}, 256, F.G, bx};
              EpiQK E{0, 0, FB, pair};
              pg::gemm_phase<EpiQK, pg::Sched<JobRowCol>, 1>(F.lds, gK1024, S, E); }
            { pg::Sched<JobRowCol> S{{FB, 1, 4, 64, (size_t)(pair * 2048 + 1024) * DM, 0, (size_t)256 * DM, (size_t)256 * DM}, 256, F.G, bx};
              EpiVT E{0, 0, FB};
              pg::gemm_phase<EpiVT, pg::Sched<JobRowCol>, 1>(F.lds, gK1024, S, E); }
            if (pair == 0) {
                { pg::Sched<JobKc> S{{FB}, 4, F.G, (bx + F.G - 64) % F.G}; EpiKc E{0, 0, FB};
                  pg::gemm_phase<EpiKc, pg::Sched<JobKc>, 1>(F.lds, gK1024, S, E); }
                { pg::Sched<JobVc> S{{FB}, 8, F.G, (bx + F.G - 72) % F.G}; EpiVc E{0, 0, FB};
                  pg::gemm_phase<EpiVc, pg::Sched<JobVc>, 1>(F.lds, gK1024, S, E); }
            }
        PHASE_END
        if constexpr (DBG_PROBE == 5) {
        PHASE_BEGIN
            LAS float* scr = (LAS float*)F.lds; unsigned* dw = (unsigned*)(F.ws + WS_CTL) + 32768;
            const int s = bx; const int i = (int)(((unsigned)s * 2654435761u) >> 18) & 16383, hl = s & 1, h = 2 * pair + hl, pp = (s * 29 + 3) & 127, v = (s * 37 + 11) & 511;
            const float* win = args.in[10]; float q1 = 0.f, q2 = 0.f, k1 = 0.f, k2 = 0.f, vv = 0.f;
            for (int a = F.tid; a < DM; a += NTHREADS) { const float x = bf2f(Ax[(size_t)i * DM + a]); const float* wr_ = win + (size_t)a * 9216;
                q1 += x * wr_[h * 256 + 2 * pp]; q2 += x * wr_[h * 256 + 2 * pp + 1]; k1 += x * wr_[1024 + h * 256 + 2 * pp]; k2 += x * wr_[1024 + h * 256 + 2 * pp + 1]; vv += x * wr_[2048 + h * 512 + v]; }
            q1 = block_sum(scr, q1, F.tid); q2 = block_sum(scr, q2, F.tid); k1 = block_sum(scr, k1, F.tid); k2 = block_sum(scr, k2, F.tid); vv = block_sum(scr, vv, F.tid);
            if (F.tid == 0) { const float inv = powf(10000.0f, -(float)(pp & 63) / 64.0f), ang = (float)(pp < 64 ? (i >> 6) : (i & 63)) * inv, cs = cosf(ang), sn = sinf(ang);
                const float rq1 = (q1 * cs - q2 * sn) * 0.0625f, rq2 = (q1 * sn + q2 * cs) * 0.0625f, rk1 = k1 * cs - k2 * sn, rk2 = k1 * sn + k2 * cs; const int jl = i & 511;
                dbg_report(dw, rq1, bf2f(Qb[(size_t)i * 512 + hl * 256 + 2 * pp]), 1000.0f); dbg_report(dw, rq2, bf2f(Qb[(size_t)i * 512 + hl * 256 + 2 * pp + 1]), 1000.0f);
                dbg_report(dw, rk1, bf2f(Knb[(size_t)i * 512 + hl * 256 + 2 * pp]), 1000.0f); dbg_report(dw, rk2, bf2f(Knb[(size_t)i * 512 + hl * 256 + 2 * pp + 1]), 1000.0f);
                dbg_report(dw, rk2 * expf(lgp[h] * (float)(511 - jl)), bf2f(Ktb_[(size_t)(hl * 256 + 2 * pp + 1) * SEQ + i]), 1000.0f);
                dbg_report(dw, rk1 * expf(lgp[4 + h] * (float)jl), bf2f(Ktb_[(size_t)512 * SEQ + (size_t)(hl * 256 + 2 * pp) * SEQ + i]), 1000.0f);
                dbg_report(dw, vv, bf2f(B4[((size_t)((hl * NSEG + (i >> 9)) * 512 + v)) * 1024 + 512 + jl]), 1000.0f); }
        PHASE_END
        }
        PHASE_BEGIN
            { Geo g{1024, 1024, SEQ, 128u * 1024 * 2u, 128u * 1024 * 2u, 128u * (unsigned)SEQ * 2u, LS / 64, 1 << 20, 1 << 20};
              pg::Sched<JobR1> S{{FB}, 256, F.G, bx}; EpiU E{0, 0, FB};
              pg::gemm_phase<EpiU, pg::Sched<JobR1>, 1>(F.lds, g, S, E); }
            if (pair == 0) { Geo g{CTX, CTX, CTX, 128u * CTX * 2u, 128u * CTX * 2u, 128u * CTX * 2u, CTX / 64, 1 << 20, 1 << 20};
              pg::Sched<JobS0> S{{FB}, 16, F.G, (bx + F.G - 64) % F.G}; EpiS0 E{0, 0, FB};
              pg::gemm_phase<EpiS0, pg::Sched<JobS0>, 1>(F.lds, g, S, E); }
        PHASE_END
        if constexpr (DBG_PROBE == 6) {
        PHASE_BEGIN
            LAS float* scr = (LAS float*)F.lds; unsigned* dw = (unsigned*)(F.ws + WS_CTL) + 32768;
            const int s = bx, h = s & 3, dir = (s >> 2) & 1, d = (s * 29 + 3) & 255, v = (s * 37 + 11) & 511; const float* win = args.in[10];
            const int j = F.tid & 255, which = F.tid >> 8; const int col = which ? 2048 + h * 512 + v : 1024 + h * 256 + d; float dot = 0.f;
            for (int a = 0; a < DM; ++a) dot += bf2f(Ac[(size_t)j * DM + a]) * win[(size_t)a * 9216 + col];
            scr[16 + F.tid] = dot; __syncthreads();
            float term = 0.f; if (F.tid < 256) term = scr[16 + F.tid] * scr[16 + 256 + F.tid] * expf(lgp[dir * 4 + h] * (float)(dir ? j : 255 - j));
            __syncthreads();
            const float ref = block_sum(scr, term, F.tid);
            if (F.tid == 0) dbg_report(dw, ref, S0[((size_t)((h * 2 + dir) * 512 + v)) * 256 + d], 1000.0f);
        PHASE_END
        }
        PHASE_BEGIN
            { const int gw = F.vcu * NWAVES + F.wave, NGW = F.G * NWAVES;
              for (int rowid = gw; rowid < 1024; rowid += NGW) { const int hl = rowid >> 9, v = rowid & 511, h = 2 * pair + hl, dir = F.lane >> 5, d0 = (F.lane & 31) * 8;
                  const float* s0 = S0 + ((size_t)((h * 2 + dir) * 512 + v)) * 256 + d0; f32x4 c0 = *(const f32x4*)s0, c1 = *(const f32x4*)(s0 + 4);
                  const float dec = expf(lgp[dir * 4 + h] * (float)LS);
                  bf16_t* pb = B4 + ((size_t)(hl * NSEG * 512 + v)) * 1024 + dir * 256 + d0; const long sstep = dir ? -(long)512 * 1024 : (long)512 * 1024; if (dir) pb += (size_t)(NSEG - 1) * 512 * 1024;
                  u32x4 ub[NSEG];
#pragma unroll
                  for (int it = 0; it < NSEG; ++it) ub[it] = *(const u32x4*)(pb + (long)it * sstep);
#pragma unroll
                  for (int it = 0; it < NSEG; ++it) { f32x4 u0, u1; unpack8(ub[it], u0, u1); *(u32x4*)(pb + (long)it * sstep) = _rep == 0 ? pack8(c0, c1) : ub[it]; c0 = c0 * dec + u0; c1 = c1 * dec + u1; } } }
            if (pair == 0 && F.vcu >= 128 && _rep == 0) {
                { TrDesc t{args.in[15], DM, DM, Bz, 3072, 0, 3}; tr_all(F, t, (F.vcu - 128) * NWAVES + F.wave, (F.G - 128) * NWAVES); }
                { TrDesc t{args.in[14], 2048, DM, Bz, 3072, 1024, 4}; tr_all(F, t, (F.vcu - 128) * NWAVES + F.wave, (F.G - 128) * NWAVES); }
                { TrDesc t{args.in[16], DM, DM, WoT, DM, 0, 5}; tr_all(F, t, (F.vcu - 128) * NWAVES + F.wave, (F.G - 128) * NWAVES); }
                __syncthreads(); }
            { Geo g{512, 512, 512, 128u * 512 * 2u, 128u * 512 * 2u, 128u * 512 * 2u, 4, 1 << 20, 1 << 20};
              pg::Sched<JobR3> S{{FB}, 256, F.G, bx}; EpiP E{0, 0, FB, pair};
              pg::gemm_phase<EpiP, pg::Sched<JobR3>, 1>(F.lds, g, S, E); }
        PHASE_END
        PHASE_BEGIN
            Geo g{512, 1024, 1024, 128u * 512 * 2u, 128u * 1024 * 2u, 128u * 1024 * 2u, 16, 8, 4};
            pg::Sched<JobR4> S{{FB}, 256, F.G, bx}; EpiO E{4, 8, FB, pair};
            pg::gemm_phase<EpiO, pg::Sched<JobR4>, 2>(F.lds, g, S, E);
        PHASE_END
        if constexpr (DBG_PROBE == 1) {
        PHASE_BEGIN
            LAS float* scr = (LAS float*)F.lds; unsigned* dw = (unsigned*)(F.ws + WS_CTL) + 32768;
            const int s = bx; int i = (int)(((unsigned)s * 2654435761u) >> 18) & 16383; if (s < 8) { const int sp[8] = {0, 1, 511, 512, 513, 8191, 16382, 16383}; i = sp[s]; }
            const int hl = s & 1, h = 2 * pair + hl, v = (s * 37 + 11) & 511; const float lgf = lgp[h], lgb = lgp[4 + h];
            float part = 0.f;
            for (int j = F.tid; j < SEQ; j += NTHREADS) { float qk = 0.f;
                for (int d = 0; d < 256; ++d) qk += bf2f(Qb[(size_t)i * 512 + hl * 256 + d]) * bf2f(Knb[(size_t)j * 512 + hl * 256 + d]);
                const float D = j < i ? __expf(lgf * (float)(i - j)) : (j > i ? __expf(lgb * (float)(j - i)) : 2.0f);
                part += D * qk * bf2f(B4[((size_t)((hl * NSEG + (j >> 9)) * 512 + v)) * 1024 + 512 + (j & 511)]); }
            if (F.tid < 256) { const float q = bf2f(Qb[(size_t)i * 512 + hl * 256 + F.tid]);
                part += q * (__expf(lgf * (float)(i + 1)) * S0[((size_t)((h * 2 + 0) * 512 + v)) * 256 + F.tid] + __expf(lgb * (float)(SEQ - i)) * S0[((size_t)((h * 2 + 1) * 512 + v)) * 256 + F.tid]); }
            const float ref = block_sum(scr, part, F.tid);
            const float ov = bf2f(Ob[(size_t)i * 2048 + h * 512 + F.tid]); const float rms = sqrtf(block_sum(scr, ov * ov, F.tid) * (1.0f / 512.0f));
            if (F.tid == 0) dbg_report(dw, ref, bf2f(Ob[(size_t)i * 2048 + h * 512 + v]), rms * 1000.0f);
        PHASE_END
        }
    }
    if constexpr (DBG_PROBE == 7 || DBG_PROBE == 8) {
    PHASE_BEGIN
        LAS float* scr = (LAS float*)F.lds; unsigned* dw = (unsigned*)(F.ws + WS_CTL) + 32768; float* sav = (float*)(F.ws + WS_END);
        const int s = bx; const int i = s * 64 + 57, h = DBG_COL >> 9, v = DBG_COL & 511;
        const float ov = bf2f(Ob[(size_t)i * 2048 + h * 512 + F.tid]); const float mean = block_sum(scr, ov, F.tid) * (1.0f / 512.0f);
        const float var = block_sum(scr, (ov - mean) * (ov - mean), F.tid) * (1.0f / 512.0f); const float rstd = 1.0f / sqrtf(var + EPS);
        if (F.tid == 0) { if (DBG_PROBE == 7) { dbg_report(dw, mean, stats[(size_t)(i * 4 + h) * 2], 1000.0f); dbg_report(dw, rstd, stats[(size_t)(i * 4 + h) * 2 + 1], 1000.0f); }
            sav[s * 4 + 0] = (bf2f(Ob[(size_t)i * 2048 + h * 512 + v]) - mean) * rstd; }
    PHASE_END
    }
    PHASE_BEGIN
        { LAS unsigned char* stl = F.lds + RING_BYTES + 1024;
          if (_rep == 0) { const int pm = bx >> 2, h = bx & 3;
            for (int r = F.wave; r < 256; r += NWAVES) { const int pos = pm * 256 + r; f32x4 a, b; unpack8(*(const u32x4*)(Ob + (size_t)pos * 2048 + h * 512 + F.lane * 8), a, b);
                const float mean = wave_sum((a[0] + a[1]) + (a[2] + a[3]) + (b[0] + b[1]) + (b[2] + b[3])) * (1.0f / 512.0f);
                a -= mean; b -= mean; const float q = wave_sum((a[0] * a[0] + a[1] * a[1]) + (a[2] * a[2] + a[3] * a[3]) + (b[0] * b[0] + b[1] * b[1]) + (b[2] * b[2] + b[3] * b[3]));
                if (F.lane == 0) *(LAS f32x2*)(stl + r * 8) = (f32x2){mean, 1.0f / sqrtf(q * (1.0f / 512.0f) + EPS)}; }
            __syncthreads(); }
          pg::Sched<JobG2> S{{FB}, 512, F.G, bx};
          EpiG E{0, 0, FB, args.in[13], _rep, stl};
          pg::gemm_phase<EpiG, pg::Sched<JobG2>, 1>(F.lds, gK1024, S, E); }
        { Geo g{DM, DM, 128u * DM, 128u * DM * 2u, 128u * DM * 2u, (unsigned)DM * 2u, DM / 64, 1 << 20, 1 << 20};
          pg::Sched<JobRowCol> S{{FB, 1, 8, 64, (size_t)WR_F * DM, 0, (size_t)256 * DM, (size_t)2 * DM}, 512, F.G, bx};
          EpiF E{0, 0, FB};
          pg::gemm_phase<EpiF, pg::Sched<JobRowCol>, 1>(F.lds, g, S, E); }
    PHASE_END
    if constexpr (DBG_PROBE == 8) {
    PHASE_BEGIN
        LAS float* scr = (LAS float*)F.lds; unsigned* dw = (unsigned*)(F.ws + WS_CTL) + 32768; float* sav = (float*)(F.ws + WS_END);
        const int s = bx; const int i = s * 64 + 57, h = DBG_COL >> 9, v = DBG_COL & 511, col = h * 512 + v; float g = 0.f;
        for (int a = F.tid; a < DM; a += NTHREADS) g += bf2f(Ax[(size_t)i * DM + a]) * args.in[10][(size_t)a * 9216 + 4096 + col];
        g = block_sum(scr, g, F.tid);
        if (F.tid == 0) dbg_report(dw, g / (1.0f + expf(-g)) * sav[s * 4] * args.in[13][col], bf2f(Ob[(size_t)i * 2048 + col]), 1.0f);
    PHASE_END
    }
    PHASE_BEGIN
        Geo g{256, 256, 256, 128u * 256 * 2u, 128u * 256 * 2u, 128u * 256 * 2u, 4, 1 << 20, 1 << 20};
        pg::Sched<JobF1> S{{FB}, 512, F.G, bx}; EpiF1 E{0, 0, FB};
        pg::gemm_phase<EpiF1, pg::Sched<JobF1>, 1>(F.lds, g, S, E);
    PHASE_END
    if constexpr (DBG_PROBE == 2 || DBG_PROBE == 4) {
    PHASE_BEGIN
        LAS float* scr = (LAS float*)F.lds; unsigned* dw = (unsigned*)(F.ws + WS_CTL) + 32768;
        if (DBG_PROBE == 4) {
            const int s = bx; const int l = (int)(((unsigned)s * 2654435761u) >> 18) & 16383, ch = (s * 131 + 7) & 1023, g = ch >> 8, cp = ch & 255;
            const int c = F.tid & 255, hf = F.tid >> 8; float fpart = 0.f;
            for (int a = hf * 512; a < hf * 512 + 512; ++a) fpart += bf2f(Ax[(size_t)l * DM + a]) * args.in[10][(size_t)a * 9216 + 6144 + g * 256 + c];
            scr[16 + F.tid] = fpart; __syncthreads();
            float wr_ = 0.f, wi_ = 0.f;
            if (F.tid < 256) { const float fv = scr[16 + F.tid] + scr[16 + 256 + F.tid]; const float ang = (float)((c * cp) & 255) * (1.0f / 128.0f); wr_ = fv * cospif(ang); wi_ = -fv * sinpif(ang); }
            __syncthreads();
            const float Wr = block_sum(scr, wr_, F.tid), Wi = block_sum(scr, wi_, F.tid);
            const int l1 = l >> 7, l2 = l & 127;
            if (F.tid == 0) { dbg_report(dw, Wr, bf2f(Wt[(size_t)(ch * 128 + l2) * 256 + l1]), 16000.0f); dbg_report(dw, Wi, bf2f(Wt[(size_t)(ch * 128 + l2) * 256 + 128 + l1]), 16000.0f); }
        } else {
            const unsigned sid = (unsigned)(bx * NTHREADS + F.tid) * 2654435761u; const int k1 = (sid >> 8) & 127, l2 = (sid >> 15) & 127, ch = (sid >> 22) & 1023;
            float ar = 0.f, ai = 0.f;
            for (int l1 = 0; l1 < 128; ++l1) { const float wr_ = bf2f(Wt[(size_t)(ch * 128 + l2) * 256 + l1]), wi_ = bf2f(Wt[(size_t)(ch * 128 + l2) * 256 + 128 + l1]);
                const float a = (float)((k1 * l1) & 127) * (1.0f / 64.0f), cs = cospif(a), sn = sinpif(a); ar += cs * wr_ + sn * wi_; ai += cs * wi_ - sn * wr_; }
            const float t = (float)((k1 * l2) & 16383) * (1.0f / 8192.0f), ct = cospif(t), st = sinpif(t);
            const float br = ar * ct + ai * st, bi = ai * ct - ar * st;
            dbg_report(dw, br, bf2f(Bt[(size_t)(k1 * 1024 + ch) * 256 + l2]), 180000.0f); dbg_report(dw, bi, bf2f(Bt[(size_t)(k1 * 1024 + ch) * 256 + 128 + l2]), 180000.0f);
        }
    PHASE_END
    }
    PHASE_BEGIN
        Geo g{256, 256, 256, 128u * 256 * 2u, 128u * 256 * 2u, 128u * 256 * 2u, 4, 1 << 20, 1 << 20};
        pg::Sched<JobF2> S{{FB}, 512, F.G, bx}; EpiF2 E{0, 0, FB};
        pg::gemm_phase<EpiF2, pg::Sched<JobF2>, 1>(F.lds, g, S, E);
    PHASE_END
    if constexpr (DBG_PROBE == 3) {
    PHASE_BEGIN
        unsigned* dw = (unsigned*)(F.ws + WS_CTL) + 32768;
        const unsigned sid = (unsigned)(bx * NTHREADS + F.tid) * 2654435761u; const int k1 = (sid >> 8) & 127, k2 = (sid >> 15) & 127, ch = (sid >> 22) & 1023;
        float y = 0.f;
        for (int l2 = 0; l2 < 128; ++l2) { const float br = bf2f(Bt[(size_t)(k1 * 1024 + ch) * 256 + l2]), bi = bf2f(Bt[(size_t)(k1 * 1024 + ch) * 256 + 128 + l2]);
            const float a = (float)((k2 * l2) & 127) * (1.0f / 64.0f); y += br * cospif(a) + bi * sinpif(a); }
        dbg_report(dw, y * (1.0f / 2048.0f), bf2f(MIXb[(size_t)(k1 + 128 * k2) * 2048 + ch]), 1000.0f);
    PHASE_END
    }
    if constexpr (DBG_PROBE == 12) {
    PHASE_BEGIN
        unsigned* dw = (unsigned*)(F.ws + WS_CTL) + 32768;
        for (size_t idx = gtid; idx < (size_t)DM * 9216; idx += gthreads) { const int k = (int)(idx / 9216), n = (int)(idx % 9216); const int dr = tr_dest_row(2, n);
            if (dr >= 0) { const float a = args.in[10][idx]; const float b = bf2f(Win[(size_t)dr * DM + k]); if (fabsf(a - b) > 0.01f * fabsf(a) + 1e-6f) { atomicAdd(dw + 64, 1u); atomicMin(dw + 192, (unsigned)(dr >> 8)); } } }
    PHASE_END
    }
    if constexpr (DBG_PROBE == 9) {
    PHASE_BEGIN
        LAS float* scr = (LAS float*)F.lds; unsigned* dw = (unsigned*)(F.ws + WS_CTL) + 32768;
        const int s = bx; const int i = DBG_VAR == 0 ? 1210 : (DBG_VAR == 1 ? 1024 + s : (DBG_VAR == 2 ? s * 64 + 57 : 1210 + 256 * (s & 63))), n = DBG_VAR == 0 ? 4 * s : 736; float ga = 0.f, gf = 0.f;
        for (int a = F.tid; a < DM; a += NTHREADS) { const float x = bf2f(Ax[(size_t)i * DM + a]); ga += x * args.in[10][(size_t)a * 9216 + 7168 + n]; gf += x * args.in[10][(size_t)a * 9216 + 8192 + n]; }
        ga = block_sum(scr, ga, F.tid); gf = block_sum(scr, gf, F.tid);
        if (F.tid == 0) { const float ea = fabsf(1.0f / (1.0f + expf(-ga)) - bf2f(GAb[(size_t)i * DM + n])), ef = fabsf(1.0f / (1.0f + expf(-gf)) - bf2f(GFb[(size_t)i * DM + n]));
            if (ea > 0.05f) { atomicMin(dw + 192, (unsigned)s); atomicAdd(dw + 64, 1u); dbg_report(dw, 0.f, DBG_GF ? ea : bf2f(GAb[(size_t)i * DM + n]), 1000.0f); } if (ef > 0.05f) atomicMin(dw + 193, (unsigned)s); }
    PHASE_END
    }
    PHASE_BEGIN
        { pg::Sched<JobGate2> S{{FB}, 512, F.G, bx}; EpiGate E{0, 0, FB};
          pg::gemm_phase<EpiGate, pg::Sched<JobGate2>, 1>(F.lds, gK1024, S, E); }
        { Geo g{2048, 2048, 3072, 128u * 2048 * 2u, 128u * 2048 * 2u, 128u * 3072 * 2u, 16, 1 << 20, 1 << 20};
          pg::Sched<JobZ> S{{FB, 0}, 256, F.G, bx}; EpiZ2 E{0, 0, FB, 0};
          pg::gemm_phase<EpiZ2, pg::Sched<JobZ>, 1>(F.lds, g, S, E); }
        { Geo g{2048, 2048, 3072, 128u * 2048 * 2u, 128u * 2048 * 2u, 128u * 3072 * 2u, 32, 1 << 20, 1 << 20};
          pg::Sched<JobZ> S{{FB, 1}, 256, F.G, bx}; EpiZ2 E{0, 0, FB, 1};
          pg::gemm_phase<EpiZ2, pg::Sched<JobZ>, 1>(F.lds, g, S, E); }
    PHASE_END
    if constexpr (DBG_PROBE == 9 || DBG_PROBE == 10) {
    PHASE_BEGIN
        LAS float* scr = (LAS float*)F.lds; unsigned* dw = (unsigned*)(F.ws + WS_CTL) + 32768;
        const int s = bx; const int i = (int)(((unsigned)s * 2654435761u) >> 18) & 16383, n = (s * 131 + 7) & 1023;
        if (DBG_PROBE == 9) { float ga = 0.f, gf = 0.f;
            (void)ga; (void)gf;
        } else { float r = 0.f, fo = 0.f;
            for (int k = F.tid; k < 2048; k += NTHREADS) r += bf2f(Ob[(size_t)i * 2048 + k]) * args.in[14][(size_t)k * DM + n];
            for (int k = F.tid; k < 1024; k += NTHREADS) fo += bf2f(MIXb[(size_t)i * 2048 + k]) * args.in[15][(size_t)k * DM + n];
            r = block_sum(scr, r, F.tid); fo = block_sum(scr, fo, F.tid);
            if (F.tid == 0) dbg_report(dw, bf2f(GAb[(size_t)i * DM + n]) * r + bf2f(GFb[(size_t)i * DM + n]) * fo, bf2f(Zb[(size_t)i * DM + n]), 1000.0f); }
    PHASE_END
    }
    PHASE_BEGIN
        Geo g{2048, 2048, DM, 128u * 2048 * 2u, 128u * 2048 * 2u, 128u * DM * 2u, DM / 64, 1 << 20, 1 << 20};
        pg::Sched<JobRowCol> S{{FB, 2, 64, 4, 0, 0, (size_t)256 * 2048, (size_t)256 * DM}, 256, F.G, bx};
        EpiFuse E{0, 0, FB, 1, args.in[0], args.in[17]};
        pg::gemm_phase<EpiFuse, pg::Sched<JobRowCol>, 1>(F.lds, g, S, E);
    PHASE_END
    }
    PHASE_BEGIN
        pg::Sched<JobFfn1> S{{FB, 64, 0}, 64 * 22, F.G, bx};
        EpiSwiglu E{0, 0, FB};
        pg::gemm_phase<EpiSwiglu, pg::Sched<JobFfn1>, 1>(F.lds, gK1024, S, E);
    PHASE_END
    PHASE_BEGIN
        pg::Sched<JobFfn2> S{{FB, 64, 0}, 64 * 4, F.G, bx};
        EpiFuse E{0, 0, FB, 2, args.in[0], args.in[20]};
        pg::gemm_phase<EpiFuse, pg::Sched<JobFfn2>, 1>(F.lds, gFfn2, S, E);
    PHASE_END
    if constexpr (DBG_TSEL >= 0) {
    PHASE_BEGIN
        const unsigned long long* ts = (const unsigned long long*)(F.ws + WS_CTL + 160000);
        if (bx == 0) { const float a = 0.1f * (float)(ts[DBG_TSEL + 1] - ts[DBG_TSEL]), b = 0.1f * (float)(ts[DBG_TSEL2 + 1] - ts[DBG_TSEL2]);
            if (F.tid == 0) ((float*)F.dout)[0] = a; for (int i = F.tid; i < 1024; i += NTHREADS) ((float*)F.dout)[1024 + i] = b; }
    PHASE_END
    }
    if constexpr (DBG_PROBE != 0) {
    PHASE_BEGIN
        if (bx == 0 && F.tid == 0) { const float e = __builtin_bit_cast(float, ((unsigned*)(F.ws + WS_CTL))[32768]); ((float*)F.dout)[0] = DBG_COUNT == 3 ? 100.0f * (float)(16u + ((((unsigned*)(F.ws + WS_CTL))[32768 + 192 + DBG_GF] + 0xC0000000u - 0xC0000000u) >> DBG_SH & 15u)) : DBG_COUNT == 2 ? 100.0f * (float)(16u + ((unsigned*)(F.ws + WS_CTL))[32768 + 128]) : DBG_COUNT ? 1000.0f + 10.0f * (float)((unsigned*)(F.ws + WS_CTL))[32768 + 64] : 1000.0f * (10.0f + log10f(e + 1e-10f)); }
    PHASE_END
    }
}

extern "C" void kernel_launch(void* const* d_in, const int* in_sizes, int n_in, void* d_out, int out_size, void* d_ws, size_t ws_size, hipStream_t stream) {
    static int grid = 0;
    if (grid == 0) {
        if (n_in != 21 || out_size != SEQ * DM || ws_size < 256 * MiB) { fprintf(stderr, "kernel_launch: unexpected shapes (n_in %d out %d ws %zu)\n", n_in, out_size, ws_size); grid = -1; return; }
        int dev = 0, cus = 0, per_cu = 0;
        if (hipGetDevice(&dev) != hipSuccess || hipDeviceGetAttribute(&cus, hipDeviceAttributeMultiprocessorCount, dev) != hipSuccess) { grid = -1; return; }
        if (hipFuncSetAttribute((const void*)fwd_kernel, hipFuncAttributeMaxDynamicSharedMemorySize, LDS_BYTES) != hipSuccess) { fprintf(stderr, "kernel_launch: hipFuncSetAttribute failed\n"); grid = -1; return; }
        if (hipOccupancyMaxActiveBlocksPerMultiprocessor(&per_cu, (const void*)fwd_kernel, NTHREADS, LDS_BYTES) != hipSuccess || per_cu < 1) { fprintf(stderr, "kernel_launch: occupancy query says %d blocks/CU\n", per_cu); }
        (void)hipGetLastError();
        grid = cus;
    }
    if (grid < 0) return;
    (void)hipMemsetAsync((char*)d_ws + WS_CTL, 0, CTL_ZERO_BYTES, stream);
    Args a{};
    for (int i = 0; i < 21; ++i) a.in[i] = (const float*)d_in[i];
    a.out = (float*)d_out; a.ws = (unsigned char*)d_ws; a.ph_lo = 0; a.ph_hi = 1000;
    hipLaunchKernelGGL(fwd_kernel, dim3(grid), dim3(NTHREADS), LDS_BYTES, stream, a);
}
```

```cpp
#include <hip/hip_runtime.h>
#include <cstdio>
#include <cstdint>

#ifndef DBG_NOFOUR
#define DBG_NOFOUR 0
#endif
#ifndef DBG_NORET
#define DBG_NORET 0
#endif
#ifndef DBG_PROBE
#define DBG_PROBE 0
#endif
#ifndef DBG_COUNT
#define DBG_COUNT 0
#ifndef DBG_COL
#define DBG_COL 736
#endif
#ifndef DBG_VAR
#define DBG_VAR 2
#endif
#ifndef DBG_SH
#define DBG_SH 0
#endif
#ifndef DBG_GF
#define DBG_GF 1
#endif
#ifndef DBG_S0
#define DBG_S0 4
#endif
#endif
#ifndef DBG_XBAR
#define DBG_XBAR 0
#endif
#ifndef DBG_DUP
#define DBG_DUP -1
#endif
#ifndef DBG_TSEL
#define DBG_TSEL -1
#endif
#ifndef DBG_TSEL2
#define DBG_TSEL2 1
#endif
#ifndef PG_ALIGN
#define PG_ALIGN 1
#endif
#ifndef STOP_AFTER
#define STOP_AFTER 99
#endif

#define LAS __attribute__((address_space(3)))
typedef unsigned short bf16_t;
typedef short bf16x8 __attribute__((ext_vector_type(8)));
typedef float f32x4 __attribute__((ext_vector_type(4)));
typedef float f32x2 __attribute__((ext_vector_type(2)));
typedef unsigned u32x4 __attribute__((ext_vector_type(4)));
typedef unsigned u32x2 __attribute__((ext_vector_type(2)));

constexpr int DM = 1024, SEQ = 16384, CTX = 256, DFF = 2816;
constexpr float EPS = 1e-6f;
constexpr int LS = 512, NSEG = SEQ / LS;

constexpr size_t MiB = 1u << 20;
constexpr size_t WS_CTL = 0, CTL_ZERO_BYTES = 1 * MiB;
constexpr size_t WS_MOD = 1 * MiB;
constexpr size_t WS_TAB = 2 * MiB;
constexpr size_t WS_STATS = 3 * MiB;
constexpr size_t WS_S0 = 4 * MiB;
constexpr size_t WS_KC = 8 * MiB;
constexpr size_t WS_VC = 9 * MiB;
constexpr size_t WS_DC = 10 * MiB;
constexpr size_t WS_HC = 12 * MiB;
constexpr size_t WS_WIN = 14 * MiB;
constexpr size_t WS_WN = 34 * MiB;
constexpr size_t WS_WB = 36 * MiB;
constexpr size_t WS_H = 54 * MiB;
constexpr size_t WS_Q = 54 * MiB, WS_KN = 70 * MiB, WS_KT = 86 * MiB, WS_B4 = 118 * MiB;
constexpr size_t WS_O = 182 * MiB;
constexpr size_t WS_END = 246 * MiB;
constexpr size_t WS_XB = 11 * MiB;
constexpr size_t WS_OUTW = 246 * MiB;
constexpr size_t WS_XCSLAB = 150 * MiB;
constexpr size_t WS_WT = 118 * MiB, WS_BT = 54 * MiB, WS_MIX = 118 * MiB, WS_GA = 54 * MiB, WS_GF = 86 * MiB;
constexpr size_t DO_AX = 32 * MiB;
constexpr int WR_G = 4096, WR_F = 6144, WR_GA = 8192, WR_GF = 9216;
constexpr size_t WB_W13 = 0, WB_W2 = 11 * MiB;
constexpr size_t WB_BZ = 0, WB_WO = 6 * MiB;
constexpr size_t TB_ROPE = 0, TB_TW = 128 * 1024, TB_FM = 256 * 1024, TB_GM = 384 * 1024, TB_T256 = 512 * 1024;

typedef __bf16 bf16x2_t __attribute__((ext_vector_type(2)));
__device__ __forceinline__ unsigned cvt_pk_bf16(float lo, float hi) { const f32x2 v = {lo, hi}; return __builtin_bit_cast(unsigned, __builtin_convertvector(v, bf16x2_t)); }
__device__ __forceinline__ unsigned short f2bf(float f) { unsigned u = __builtin_bit_cast(unsigned, f); return (unsigned short)((u + 0x7fffu + ((u >> 16) & 1u)) >> 16); }
__device__ __forceinline__ float bflo(unsigned u) { return __builtin_bit_cast(float, u << 16); }
__device__ __forceinline__ float bfhi(unsigned u) { return __builtin_bit_cast(float, u & 0xffff0000u); }
__device__ __forceinline__ u32x4 pack8(const f32x4 a, const f32x4 b) { u32x4 w; w.x = cvt_pk_bf16(a[0], a[1]); w.y = cvt_pk_bf16(a[2], a[3]); w.z = cvt_pk_bf16(b[0], b[1]); w.w = cvt_pk_bf16(b[2], b[3]); return w; }
__device__ __forceinline__ void unpack8(const u32x4 w, f32x4& a, f32x4& b) { a = (f32x4){bflo(w.x), bfhi(w.x), bflo(w.y), bfhi(w.y)}; b = (f32x4){bflo(w.z), bfhi(w.z), bflo(w.w), bfhi(w.w)}; }

__device__ __forceinline__ void st16wt(void* p, const u32x4 v) { asm volatile("global_store_dwordx4 %0, %1, off sc1\n\ts_nop 1" :: "v"(p), "v"(v) : "memory"); }
__device__ __forceinline__ float fsigmoid(float a) { return __builtin_amdgcn_rcpf(1.0f + __expf(-a)); }
__device__ __forceinline__ float fsilu(float a) { return a * fsigmoid(a); }
__device__ __forceinline__ float wave_sum(float v) {
#pragma unroll
    for (int o = 1; o < 64; o <<= 1) v += __shfl_xor(v, o);
    return v;
}

namespace pg {
constexpr int BM = 256, BK = 64, HALF = 128, HTB = HALF * BK * 2, STAGE_BYTES = 8 * HTB, NXCD = 8, WGM = 4;
__device__ __forceinline__ int lds_byte(int r, int c) { const int st = (r >> 4) * 2 + (c >> 5), rr = r & 15, cc = c & 31, ob = rr * 64 + cc * 2; return st * 1024 + (ob ^ (((ob >> 9) & 1) << 5)); }
__device__ __forceinline__ void stage_rc(int b, int& R, int& C) { const int st = b / 1024, sb = b % 1024, swz = sb ^ (((sb >> 9) & 1) << 5); R = (st >> 1) * 16 + swz / 64; C = (st & 1) * 32 + (swz % 64) / 2; }
__device__ __forceinline__ int perm32(int rho) { const int n = rho >> 4, i = rho & 15; return 8 * (i >> 2) + 4 * n + (i & 3); }

struct Unit { const char* a0; const char* a1; const char* b; char* d; int i0, i1, i2, i3; };
struct Geo { unsigned lda0, lda1, ldb;
             unsigned hsA0, hsA1, hsB;
             int nt, c0, rep0; };

__device__ __forceinline__ void tile_pm_pn(int L, int nM, int nN, int& pm, int& pn) {
    const int nwg = nM * nN; int wgid = L;
    { const int q = nwg / NXCD, r = nwg % NXCD, xcd = wgid % NXCD, off = wgid / NXCD; wgid = (xcd < r ? xcd * (q + 1) : r * (q + 1) + (xcd - r) * q) + off; }
    const int nig = WGM * nN, gid = wgid / nig, fm = gid * WGM, gsz = (nM - fm) < WGM ? (nM - fm) : WGM;
    pm = fm + ((wgid % nig) % gsz); pn = (wgid % nig) / gsz;
}
__device__ __forceinline__ int xcd_contig(int L, int n) { return (L % NXCD) * (n / NXCD) + L / NXCD; }

template <class Job> struct Sched {
    Job j; int n, G, c;
    __device__ __forceinline__ bool next(int i, Unit& u) const { const long L = (long)i * G + c; if (L >= n) return false; j.fill((int)L, u); return true; }
};

template <class Epi, class Sch, int ASEG>
__device__ __forceinline__ void gemm_phase(LAS unsigned char* lds, const Geo g, const Sch& S, const Epi& E) {
    int tid = threadIdx.x; asm volatile("" : "+v"(tid));
    const int wid = __builtin_amdgcn_readfirstlane(tid >> 6), lane = tid & 63, wr = wid >> 2, wc = wid & 3, fr = lane & 15, fq = lane >> 4;
    int nt = g.nt; asm volatile("" : "+s"(nt));
    unsigned voffA0[2], voffA1[2], voffB[2];
#pragma unroll
    for (int i = 0; i < 2; ++i) { int R, C; stage_rc(tid * 16 + i * 8192, R, C); const int Rb = (R & ~31) + perm32(R & 31);
        voffA0[i] = (unsigned)(R * g.lda0 + C) * 2u; voffA1[i] = (ASEG == 2) ? (unsigned)(R * g.lda1 + C) * 2u : 0u; voffB[i] = (unsigned)(Rb * g.ldb + C) * 2u; }
    const unsigned ldsw = (unsigned)wid * 1024u;
    const int aoff = lds_byte(wr * 64 + fr, fq * 8), boff = lds_byte(wc * 32 + fr, fq * 8);
#define PG_SA(b, h) (((b) * 2 + (h)) * HTB)
#define PG_SB(b, h) ((4 + (b) * 2 + (h)) * HTB)
#define PG_GLDS(gp, lp) __builtin_amdgcn_global_load_lds((const unsigned*)(gp), (LAS unsigned*)(lp), 16, 0, 0)
#define PG_ASEL(T) (ASEG == 2 && (T) >= g.c0)
#define PG_APTR(U, T) (PG_ASEL(T) ? (U).a1 + (size_t)((T) - g.c0) * 128 : (U).a0 + (size_t)((T) & (g.rep0 - 1)) * 128)
#define PG_STAGE_A(bufoff, gbase, h, sel) do { const bool _s = (sel); const unsigned _v0 = _s ? voffA1[0] : voffA0[0], _v1 = _s ? voffA1[1] : voffA0[1]; \
        const char* _p = (gbase) + ((h) ? (size_t)(_s ? g.hsA1 : g.hsA0) : (size_t)0); \
        PG_GLDS(_p + _v0, lds + (bufoff) + ldsw); PG_GLDS(_p + _v1, lds + (bufoff) + ldsw + 8192); } while (0)
#define PG_STAGE_B(bufoff, gbase, h) do { const char* _p = (gbase) + ((h) ? (size_t)g.hsB : (size_t)0); \
        PG_GLDS(_p + voffB[0], lds + (bufoff) + ldsw); PG_GLDS(_p + voffB[1], lds + (bufoff) + ldsw + 8192); } while (0)
#define PG_LDA(dst, b, h) do { _Pragma("unroll") for (int m = 0; m < 4; ++m) _Pragma("unroll") for (int k = 0; k < 2; ++k) dst[m][k] = *(const LAS bf16x8*)(lds + PG_SA(b, h) + aoff + m * 2048 + k * 1024); } while (0)
#define PG_LDB(dst, b, h) do { _Pragma("unroll") for (int n = 0; n < 2; ++n) _Pragma("unroll") for (int k = 0; k < 2; ++k) dst[n][k] = *(const LAS bf16x8*)(lds + PG_SB(b, h) + boff + n * 2048 + k * 1024); } while (0)
#define PG_MMA(ai, bj, At, Bt) do { __builtin_amdgcn_s_setprio(1); _Pragma("unroll") for (int m = 0; m < 4; ++m) _Pragma("unroll") for (int n = 0; n < 2; ++n) _Pragma("unroll") for (int k = 0; k < 2; ++k) \
        acc[ai][bj][m][n] = __builtin_amdgcn_mfma_f32_16x16x32_bf16(Bt[n][k], At[m][k], acc[ai][bj][m][n], 0, 0, 0); __builtin_amdgcn_s_setprio(0); } while (0)
#define PG_WAIT_V(n) asm volatile("s_waitcnt vmcnt(" #n ")" ::: "memory")
#define PG_WAIT_L(n) asm volatile("s_waitcnt lgkmcnt(" #n ")" ::: "memory")
#define PG_BAR __builtin_amdgcn_s_barrier()
#define PG_SCHED __builtin_amdgcn_sched_barrier(0)
    Unit cur, nxt; int ui = 0;
    if (!S.next(0, cur)) return;
    f32x4 acc[2][2][4][2];
#pragma unroll
    for (int a = 0; a < 2; ++a)
#pragma unroll
        for (int b = 0; b < 2; ++b)
#pragma unroll
            for (int m = 0; m < 4; ++m)
#pragma unroll
                for (int n = 0; n < 2; ++n) acc[a][b][m][n] = (f32x4){0.f, 0.f, 0.f, 0.f};
    bf16x8 At[4][2], B0[2][2], B1[2][2];
    { const char* p0 = PG_APTR(cur, 0); const char* p1 = PG_APTR(cur, 1);
      PG_STAGE_B(PG_SB(0, 0), cur.b, 0); PG_STAGE_B(PG_SB(0, 1), cur.b, 1); PG_STAGE_A(PG_SA(0, 0), p0, 0, PG_ASEL(0)); PG_STAGE_A(PG_SA(0, 1), p0, 1, PG_ASEL(0));
      if (wr == 1) PG_BAR;
      PG_WAIT_V(2); PG_BAR;
      PG_STAGE_B(PG_SB(1, 0), cur.b + 128, 0); PG_STAGE_A(PG_SA(1, 0), p1, 0, PG_ASEL(1)); PG_STAGE_B(PG_SB(1, 1), cur.b + 128, 1);
      PG_WAIT_V(6); PG_BAR; }
    for (;;) {
        const bool has_next = S.next(ui + 1, nxt);
        const char* nA0 = has_next ? PG_APTR(nxt, 0) : PG_APTR(cur, 0); const char* nA1 = has_next ? PG_APTR(nxt, 1) : PG_APTR(cur, 1); const char* nB = has_next ? nxt.b : cur.b;
        for (int t = 0; t < nt; t += 2) {
            const bool last = (t == nt - 2);
            if constexpr (Epi::NHOOK >= 1) { if (t == E.h0) { int t2 = threadIdx.x; asm volatile("" : "+v"(t2)); E.hook(acc, cur, 0, wr, wc, t2 & 15, (t2 >> 4) & 3); } }
            if constexpr (Epi::NHOOK >= 2) { if (t == E.h1) { int t2 = threadIdx.x; asm volatile("" : "+v"(t2)); E.hook(acc, cur, 1, wr, wc, t2 & 15, (t2 >> 4) & 3); } }
            const char* a1 = PG_APTR(cur, t + 1); const bool s1 = PG_ASEL(t + 1);
            const char* a2 = last ? nA0 : PG_APTR(cur, t + 2); const char* a3 = last ? nA1 : PG_APTR(cur, t + 3);
            const char* b2 = last ? nB : cur.b + (size_t)(t + 2) * 128; const char* b3 = b2 + 128;
            const bool s2 = last ? PG_ASEL(0) : PG_ASEL(t + 2), s3 = last ? PG_ASEL(1) : PG_ASEL(t + 3);
            PG_LDB(B0, 0, 0); PG_LDB(B1, 0, 1); PG_SCHED; PG_LDA(At, 0, 0); PG_STAGE_A(PG_SA(1, 1), a1, 1, s1);
            PG_WAIT_V(8); PG_WAIT_L(0); PG_BAR; PG_MMA(0, 0, At, B0); PG_MMA(0, 1, At, B1); PG_BAR; PG_SCHED;
            PG_LDA(At, 0, 1); PG_STAGE_B(PG_SB(0, 0), b2, 0); PG_STAGE_B(PG_SB(0, 1), b2, 1); PG_STAGE_A(PG_SA(0, 0), a2, 0, s2);
            PG_WAIT_V(8); PG_WAIT_L(0); PG_BAR; PG_MMA(1, 0, At, B0); PG_MMA(1, 1, At, B1); PG_BAR; PG_SCHED;
            PG_LDB(B0, 1, 0); PG_LDB(B1, 1, 1); PG_SCHED; PG_LDA(At, 1, 0); PG_STAGE_A(PG_SA(0, 1), a2, 1, s2);
            PG_WAIT_V(8); PG_WAIT_L(0); PG_BAR; PG_MMA(0, 0, At, B0); PG_MMA(0, 1, At, B1); PG_BAR; PG_SCHED;
            PG_LDA(At, 1, 1); PG_STAGE_B(PG_SB(1, 0), b3, 0); PG_STAGE_B(PG_SB(1, 1), b3, 1); PG_STAGE_A(PG_SA(1, 0), a3, 0, s3);
            PG_WAIT_V(8); PG_WAIT_L(0); PG_BAR; PG_MMA(1, 0, At, B0); PG_MMA(1, 1, At, B1); PG_BAR; PG_SCHED;
        }
        if (PG_ALIGN && wr == 0) PG_BAR;
        if constexpr (!Epi::AFTER_DRAIN) { int t2 = threadIdx.x; asm volatile("" : "+v"(t2)); E(acc, cur, wr, wc, t2 & 15, (t2 >> 4) & 3); }
        if (!has_next) break;
#pragma unroll
        for (int a = 0; a < 2; ++a)
#pragma unroll
            for (int b = 0; b < 2; ++b)
#pragma unroll
                for (int m = 0; m < 4; ++m)
#pragma unroll
                    for (int n = 0; n < 2; ++n) acc[a][b][m][n] = (f32x4){0.f, 0.f, 0.f, 0.f};
        cur = nxt; ++ui;
        if (PG_ALIGN && wr == 1) PG_BAR;
    }
    PG_WAIT_V(0);
    if (!PG_ALIGN && wr == 0) PG_BAR;
    PG_BAR;
    if constexpr (Epi::AFTER_DRAIN) { int t2 = threadIdx.x; asm volatile("" : "+v"(t2)); E.fused(acc, cur, wr, wc, t2 & 15, (t2 >> 4) & 3, lds, wid, t2 & 63); }
#undef PG_SA
#undef PG_SB
#undef PG_GLDS
#undef PG_ASEL
#undef PG_APTR
#undef PG_STAGE_A
#undef PG_STAGE_B
#undef PG_LDA
#undef PG_LDB
#undef PG_MMA
#undef PG_WAIT_V
#undef PG_WAIT_L
#undef PG_BAR
#undef PG_SCHED
}
}
using pg::Unit; using pg::Geo;

#define EPI_ROWS _Pragma("unroll") for (int ai = 0; ai < 2; ++ai) _Pragma("unroll") for (int m = 0; m < 4; ++m)
#define EPI_ROW (128 * ai + 64 * wr + 16 * m + fr)
#define EPI_COLS _Pragma("unroll") for (int bj = 0; bj < 2; ++bj)
#define EPI_COL0 (128 * bj + 32 * wc + 8 * fq)
typedef f32x4 acc_t[2][2][4][2];

struct Base { unsigned char* ws; unsigned char* dout; };
#define modx ((float*)(F.ws + WS_MOD))
#define modc (modx + 9216)
#define lgp (modx + 2 * 9216)
#define Ax ((bf16_t*)(F.dout + DO_AX))
#define Ac ((bf16_t*)(F.ws + WS_DC + 512 * 1024))
#define Dx ((bf16_t*)F.dout)
#define Dc ((bf16_t*)(F.ws + WS_DC))
#define Hb ((bf16_t*)(F.ws + WS_H))
#define Hc ((bf16_t*)(F.ws + WS_HC))
#define W13t ((bf16_t*)(F.ws + WS_WB + WB_W13))
#define W2t ((bf16_t*)(F.ws + WS_WB + WB_W2))
#define W13t1 ((bf16_t*)(F.ws + WS_O + WB_W13))
#define W2t1 ((bf16_t*)(F.ws + WS_O + WB_W2))
#define ropeT ((float*)(F.ws + WS_TAB + TB_ROPE))
#define twT ((float*)(F.ws + WS_TAB + TB_TW))
#define FmT ((bf16_t*)(F.ws + WS_TAB + TB_FM))
#define GmT ((bf16_t*)(F.ws + WS_TAB + TB_GM))
#define T256 ((bf16_t*)(F.ws + WS_TAB + TB_T256))
#define Win ((bf16_t*)(F.ws + WS_WIN))
#define Wn ((bf16_t*)(F.ws + WS_WN))
#define Bz ((bf16_t*)(F.ws + WS_OUTW))
#define WoT ((bf16_t*)(F.ws + WS_OUTW + 6 * MiB))
#define Qb ((bf16_t*)(F.ws + WS_Q))
#define Knb ((bf16_t*)(F.ws + WS_KN))
#define Ktb_ ((bf16_t*)(F.ws + WS_KT))
#define Pb Ktb_
#define B4 ((bf16_t*)(F.ws + WS_B4))
#define Ob ((bf16_t*)(F.ws + WS_O))
#define S0 ((float*)(F.ws + WS_S0))
#define stats ((float*)(F.ws + WS_STATS))
#define KcT ((bf16_t*)(F.ws + WS_KC))
#define VcT ((bf16_t*)(F.ws + WS_VC))
#define Wt ((bf16_t*)(F.ws + WS_WT))
#define Bt ((bf16_t*)(F.ws + WS_BT))
#define MIXb ((bf16_t*)(F.ws + WS_MIX))
#define GAb ((bf16_t*)(F.ws + WS_GA))
#define GFb ((bf16_t*)(F.ws + WS_GF))
#define Zb (MIXb + 1024)
#define XcSlab ((float*)(F.ws + WS_XCSLAB))

struct EpiSwiglu {
    static constexpr int NHOOK = 0; static constexpr int AFTER_DRAIN = 0; int h0, h1;
    Base F;
    __device__ __forceinline__ void hook(acc_t&, const Unit&, int, int, int, int, int) const {}
    __device__ __forceinline__ void operator()(const acc_t& acc, const Unit& u, int wr, int wc, int fr, int fq) const {
        bf16_t* base = u.i0 < 64 ? Hb + (size_t)u.i0 * 256 * DFF : Hc;
        EPI_ROWS { bf16_t* rowp = base + (size_t)EPI_ROW * DFF + u.i1 * 128 + 32 * wc + 8 * fq; f32x4 h[2];
#pragma unroll
            for (int n = 0; n < 2; ++n)
#pragma unroll
                for (int e = 0; e < 4; ++e) h[n][e] = fsilu(acc[ai][0][m][n][e]) * acc[ai][1][m][n][e];
            if (u.i0 == 64) st16wt(rowp, pack8(h[0], h[1])); else *(u32x4*)rowp = pack8(h[0], h[1]); if (m & 1) asm volatile("" ::: "memory"); }
        if (u.i0 == 64) { asm volatile("s_waitcnt vmcnt(0)" ::: "memory");
            if (fr == 0 && fq == 0) __hip_atomic_fetch_add((unsigned*)(F.ws + WS_CTL) + 24576, 1u, __ATOMIC_RELAXED, __HIP_MEMORY_SCOPE_AGENT); }
    }
};
struct EpiResid {
    static constexpr int NHOOK = 0; static constexpr int AFTER_DRAIN = 0; int h0, h1;
    Base F; int mode;
    __device__ __forceinline__ void hook(acc_t&, const Unit&, int, int, int, int, int) const {}
    __device__ __forceinline__ void operator()(const acc_t& acc, const Unit& u, int wr, int wc, int fr, int fq) const {
        const bool isx = u.i0 < 64; const int has_old = mode != 0; const float scale = mode == 1 ? 1.0f : 0.5f;
        const bf16_t* din = Dx + (size_t)u.i0 * 256 * DM; bf16_t* dout = isx ? (mode == 2 ? Ob : Dx) + (size_t)u.i0 * 256 * DM : Dc;
        const float* coef = (isx ? modx : modc) + (mode == 0 ? 2 : (mode == 1 ? 5 : 8)) * DM + u.i1 * 256;
        EPI_COLS { const int c = EPI_COL0; const f32x4 c0 = *(const f32x4*)(coef + c) * scale, c1 = *(const f32x4*)(coef + c + 4) * scale;
#pragma unroll
            for (int ai = 0; ai < 2; ++ai)
#pragma unroll
                for (int m = 0; m < 4; ++m) { const size_t off = (size_t)EPI_ROW * DM + u.i1 * 256 + c;
                    f32x4 v0 = acc[ai][bj][m][0] * c0, v1 = acc[ai][bj][m][1] * c1;
                    if (has_old) { f32x4 o0, o1; unpack8(*(const u32x4*)(din + off), o0, o1); v0 += o0; v1 += o1; }
                    *(u32x4*)(dout + off) = pack8(v0, v1); if (m & 1) asm volatile("" ::: "memory"); } }
    }
};

struct EpiFuse {
    static constexpr int NHOOK = 0; static constexpr int AFTER_DRAIN = 1; int h0, h1; Base F; int mode; const float* x; const float* nw;
    __device__ __forceinline__ void hook(acc_t&, const Unit&, int, int, int, int, int) const {}
    __device__ __forceinline__ void operator()(const acc_t&, const Unit&, int, int, int, int) const {}
    __device__ __forceinline__ void fused(acc_t& acc, const Unit& u, int wr, int wc, int fr, int fq, LAS unsigned char* lds, int wid, int lane) const {
        const int pm = u.i0, pn = u.i1; const float scale = mode == 1 ? 1.0f : 0.5f;
        const float* coef = modx + (mode == 0 ? 2 : (mode == 1 ? 5 : 8)) * DM + pn * 256;
        const bf16_t* din = (mode == 2 ? Ob : Dx) + (size_t)pm * 256 * DM + pn * 256; bf16_t* dout = (mode == 1 ? Ob : Dx) + (size_t)pm * 256 * DM + pn * 256;
        const float* xt = x + (size_t)pm * 256 * DM + pn * 256;
        LAS float* P = (LAS float*)lds; LAS float* S = (LAS float*)(lds + 4096);
        f32x4 cf[2][2];
#pragma unroll
        for (int bj = 0; bj < 2; ++bj) { cf[bj][0] = *(const f32x4*)(coef + EPI_COL0) * scale; cf[bj][1] = *(const f32x4*)(coef + EPI_COL0 + 4) * scale; }
#pragma unroll
        for (int aim = 0; aim < 4; ++aim) { const int ai = aim >> 1; f32x4 xv[4][2][2]; u32x4 ov[4][2];
#pragma unroll
            for (int m = 2 * (aim & 1); m < 2 * (aim & 1) + 2; ++m) EPI_COLS { const size_t off = (size_t)EPI_ROW * DM + EPI_COL0; xv[m][bj][0] = *(const f32x4*)(xt + off); xv[m][bj][1] = *(const f32x4*)(xt + off + 4); if (mode != 0) ov[m][bj] = *(const u32x4*)(din + off); }
#pragma unroll
            for (int m = 2 * (aim & 1); m < 2 * (aim & 1) + 2; ++m) { const int row = EPI_ROW; float ss = 0.f;
                EPI_COLS { const size_t off = (size_t)row * DM + EPI_COL0; f32x4 d0 = acc[ai][bj][m][0] * cf[bj][0], d1 = acc[ai][bj][m][1] * cf[bj][1];
                    if (mode != 0) { f32x4 o0, o1; unpack8(ov[m][bj], o0, o1); d0 += o0; d1 += o1; }
                    if (mode != 2) *(u32x4*)(dout + off) = pack8(d0, d1);
                    const f32x4 v0 = xv[m][bj][0] + d0, v1 = xv[m][bj][1] + d1; acc[ai][bj][m][0] = v0; acc[ai][bj][m][1] = v1;
                    ss += (v0[0] * v0[0] + v0[1] * v0[1]) + (v0[2] * v0[2] + v0[3] * v0[3]) + (v1[0] * v1[0] + v1[1] * v1[1]) + (v1[2] * v1[2] + v1[3] * v1[3]); }
                ss += __shfl_xor(ss, 16); ss += __shfl_xor(ss, 32);
                if (fq == 0) P[row * 4 + wc] = ss; }
            asm volatile("" ::: "memory"); }
        asm volatile("s_waitcnt lgkmcnt(0)" ::: "memory"); __builtin_amdgcn_s_barrier(); asm volatile("" ::: "memory");
        float* xb = (float*)(F.ws + WS_XB) + (size_t)mode * 64 * 256 * 4; unsigned* cnt = (unsigned*)(F.ws + WS_CTL) + 8192 + mode * 4096 + 64 * pm;
        const int prow = wid * 32 + (lane & 31);
        if (lane < 32) { const float t = (P[prow * 4 + 0] + P[prow * 4 + 1]) + (P[prow * 4 + 2] + P[prow * 4 + 3]);
            __hip_atomic_store(xb + ((size_t)(pm * 256 + prow) * 4 + pn), t, __ATOMIC_RELAXED, __HIP_MEMORY_SCOPE_AGENT); }
        asm volatile("s_waitcnt vmcnt(0)" ::: "memory");
        if (lane == 0) __hip_atomic_fetch_add(cnt, 1u, __ATOMIC_RELAXED, __HIP_MEMORY_SCOPE_AGENT);
        if (wid == 0) { unsigned sp = 0;
            while ((unsigned)__builtin_amdgcn_readfirstlane(__hip_atomic_load(cnt, __ATOMIC_RELAXED, __HIP_MEMORY_SCOPE_AGENT)) < 32u) { __builtin_amdgcn_s_sleep(2); if (++sp > (1u << 22)) break; }
            __builtin_amdgcn_fence(__ATOMIC_ACQUIRE, "agent"); }
        asm volatile("s_waitcnt vmcnt(0) lgkmcnt(0)" ::: "memory"); __builtin_amdgcn_s_barrier(); asm volatile("" ::: "memory");
        if (lane < 32) { const float* sl = xb + (size_t)(pm * 256 + prow) * 4; float t = 0.f;
#pragma unroll
            for (int q = 0; q < 4; ++q) t += __hip_atomic_load(sl + q, __ATOMIC_RELAXED, __HIP_MEMORY_SCOPE_AGENT);
            S[prow] = 1.0f / sqrtf(t * (1.0f / DM) + EPS); }
        asm volatile("s_waitcnt lgkmcnt(0)" ::: "memory"); __builtin_amdgcn_s_barrier(); asm volatile("" ::: "memory");
        const float* md = modx + (mode == 0 ? 3 : 6) * DM + pn * 256; const float* nwp = nw + pn * 256;
        f32x4 wv[2][2], shv[2][2];
#pragma unroll
        for (int bj = 0; bj < 2; ++bj)
#pragma unroll
            for (int n = 0; n < 2; ++n) { const int c = EPI_COL0 + 4 * n; const f32x4 w = *(const f32x4*)(nwp + c);
                if (mode == 2) { wv[bj][n] = w; shv[bj][n] = (f32x4){0.f, 0.f, 0.f, 0.f}; } else { wv[bj][n] = w * (*(const f32x4*)(md + DM + c) + 1.0f); shv[bj][n] = *(const f32x4*)(md + c); } }
        EPI_ROWS { const int row = EPI_ROW; const float rinv = S[row];
            EPI_COLS { const size_t off = (size_t)row * DM + EPI_COL0;
                const f32x4 y0 = (acc[ai][bj][m][0] * rinv) * wv[bj][0] + shv[bj][0], y1 = (acc[ai][bj][m][1] * rinv) * wv[bj][1] + shv[bj][1];
                if (mode == 2) { float* o = (float*)F.dout + (size_t)pm * 256 * DM + pn * 256 + off; *(f32x4*)o = y0; *(f32x4*)(o + 4) = y1; }
                else *(u32x4*)(Ax + (size_t)pm * 256 * DM + pn * 256 + off) = pack8(y0, y1); } }
        asm volatile("s_waitcnt lgkmcnt(0)" ::: "memory"); __builtin_amdgcn_s_barrier(); asm volatile("" ::: "memory");
    }
};
struct JobFfn1 {
    Base F; int nM, first;
    __device__ __forceinline__ void fill(int L, Unit& u) const { int pm, pn; if (first) { if (L < 22) { pm = 64; pn = L; } else pg::tile_pm_pn(L - 22, 64, 22, pm, pn); } else pg::tile_pm_pn(L, nM, 22, pm, pn);
        u.a0 = (const char*)(pm < 64 ? Ax + (size_t)pm * 256 * DM : Ac); u.a1 = u.a0; u.b = (const char*)((first ? W13t1 : W13t) + (size_t)pn * 256 * DM); u.d = nullptr; u.i0 = pm; u.i1 = pn; u.i2 = 0; u.i3 = 0; }
};
struct JobFfn2 {
    Base F; int nM, first;
    __device__ __forceinline__ void fill(int L, Unit& u) const { int pm, pn; pg::tile_pm_pn(L, nM, 4, pm, pn);
        u.a0 = (const char*)(pm < 64 ? Hb + (size_t)pm * 256 * DFF : Hc); u.a1 = u.a0; u.b = (const char*)((first ? W2t1 : W2t) + (size_t)pn * 256 * DFF); u.d = nullptr; u.i0 = pm; u.i1 = pn; u.i2 = 0; u.i3 = 0; }
};

struct EpiStore {
    static constexpr int NHOOK = 0; static constexpr int AFTER_DRAIN = 0; int h0, h1; int ldd;
    __device__ __forceinline__ void hook(acc_t&, const Unit&, int, int, int, int, int) const {}
    __device__ __forceinline__ void operator()(const acc_t& acc, const Unit& u, int wr, int wc, int fr, int fq) const {
        bf16_t* d = (bf16_t*)u.d;
        EPI_ROWS { EPI_COLS { *(u32x4*)(d + (size_t)EPI_ROW * ldd + EPI_COL0) = pack8(acc[ai][bj][m][0], acc[ai][bj][m][1]); }  asm volatile("" ::: "memory"); }
    }
};
struct EpiQK {
    static constexpr int NHOOK = 0; static constexpr int AFTER_DRAIN = 1; int h0, h1;
    Base F; int pair;
    __device__ __forceinline__ void hook(acc_t&, const Unit&, int, int, int, int, int) const {}
    __device__ __forceinline__ void operator()(const acc_t&, const Unit&, int, int, int, int) const {}
    __device__ __forceinline__ void fused(acc_t& acc, const Unit& u, int wr, int wc, int fr, int fq, LAS unsigned char* lds, int wid, int lane) const {
        const int pm = u.i0, pn = u.i1, hl = pn & 1, h = 2 * pair + hl; const bool isk = pn >= 2; const float lgf = lgp[h], lgb = lgp[4 + h]; const float* rope = ropeT;
        constexpr int PITCH = 528;
        const int tid = wid * 64 + lane, p8 = tid & 31;
        float zf[8], zb[8];
#pragma unroll
        for (int e = 0; e < 8; ++e) { const int jl = (pm * 256 + p8 * 8 + e) & (LS - 1); zf[e] = __expf(lgf * (float)(LS - 1 - jl)); zb[e] = __expf(lgb * (float)jl); }
#pragma unroll
        for (int bj = 0; bj < 2; ++bj) {
            EPI_ROWS { const int row = EPI_ROW, pos = pm * 256 + row, prow = pos >> 6, pcol = pos & 63;
                const int d0 = EPI_COL0, i0 = d0 >> 1, p = i0 < 64 ? prow : pcol, f0 = i0 & 63;
                const f32x4 t0 = *(const f32x4*)(rope + (size_t)(p * 64 + f0) * 2), t1 = *(const f32x4*)(rope + (size_t)(p * 64 + f0) * 2 + 4);
                f32x4 a = acc[ai][bj][m][0], b = acc[ai][bj][m][1];
                if (!isk) { a *= 0.0625f; b *= 0.0625f; }
                const f32x4 ra = {a[0] * t0[0] - a[1] * t0[1], a[0] * t0[1] + a[1] * t0[0], a[2] * t0[2] - a[3] * t0[3], a[2] * t0[3] + a[3] * t0[2]};
                const f32x4 rb = {b[0] * t1[0] - b[1] * t1[1], b[0] * t1[1] + b[1] * t1[0], b[2] * t1[2] - b[3] * t1[3], b[2] * t1[3] + b[3] * t1[2]};
                const u32x4 pk = pack8(ra, rb);
                if (!isk) *(u32x4*)(Qb + (size_t)pos * 512 + hl * 256 + d0) = pk;
                else { *(u32x4*)(Knb + (size_t)pos * 512 + hl * 256 + d0) = pk;
                    LAS unsigned short* tp = (LAS unsigned short*)(lds + (32 * wc + 8 * fq) * PITCH + row * 2);
                    tp[0 * PITCH / 2] = (unsigned short)pk.x; tp[1 * PITCH / 2] = (unsigned short)(pk.x >> 16); tp[2 * PITCH / 2] = (unsigned short)pk.y; tp[3 * PITCH / 2] = (unsigned short)(pk.y >> 16);
                    tp[4 * PITCH / 2] = (unsigned short)pk.z; tp[5 * PITCH / 2] = (unsigned short)(pk.z >> 16); tp[6 * PITCH / 2] = (unsigned short)pk.w; tp[7 * PITCH / 2] = (unsigned short)(pk.w >> 16); }
                if (m & 1) asm volatile("" ::: "memory"); }
            if (isk) {
                asm volatile("s_waitcnt lgkmcnt(0)" ::: "memory"); __builtin_amdgcn_s_barrier(); asm volatile("" ::: "memory");
#pragma unroll
                for (int k = 0; k < 8; ++k) { const int dl = (tid >> 5) + 16 * k;
                    f32x4 v0, v1; unpack8(*(const LAS u32x4*)(lds + dl * PITCH + p8 * 16), v0, v1);
                    const f32x4 f0v = {v0[0] * zf[0], v0[1] * zf[1], v0[2] * zf[2], v0[3] * zf[3]}, f1v = {v1[0] * zf[4], v1[1] * zf[5], v1[2] * zf[6], v1[3] * zf[7]};
                    const f32x4 b0v = {v0[0] * zb[0], v0[1] * zb[1], v0[2] * zb[2], v0[3] * zb[3]}, b1v = {v1[0] * zb[4], v1[1] * zb[5], v1[2] * zb[6], v1[3] * zb[7]};
                    const size_t o = (size_t)(hl * 256 + bj * 128 + dl) * SEQ + pm * 256 + p8 * 8;
                    *(u32x4*)(Ktb_ + o) = pack8(f0v, f1v); *(u32x4*)(Ktb_ + (size_t)512 * SEQ + o) = pack8(b0v, b1v); }
                asm volatile("s_waitcnt lgkmcnt(0)" ::: "memory"); __builtin_amdgcn_s_barrier(); asm volatile("" ::: "memory");
            }
        }
    }
};
struct EpiVT {
    static constexpr int NHOOK = 0; static constexpr int AFTER_DRAIN = 0; int h0, h1; Base F;
    __device__ __forceinline__ void hook(acc_t&, const Unit&, int, int, int, int, int) const {}
    __device__ __forceinline__ void operator()(const acc_t& acc, const Unit& u, int wr, int wc, int fr, int fq) const {
        const int hl = u.i0 >> 1, vt = u.i0 & 1, pn = u.i1;
        EPI_ROWS { const int v = vt * 256 + EPI_ROW;
            EPI_COLS { const int pos = pn * 256 + EPI_COL0, seg = pos >> 9, jl = pos & (LS - 1);
                *(u32x4*)(B4 + ((size_t)((hl * NSEG + seg) * 512 + v)) * 1024 + 512 + jl) = pack8(acc[ai][bj][m][0], acc[ai][bj][m][1]); }  asm volatile("" ::: "memory"); }
    }
};
struct EpiKc {
    static constexpr int NHOOK = 0; static constexpr int AFTER_DRAIN = 0; int h0, h1; Base F;
    __device__ __forceinline__ void hook(acc_t&, const Unit&, int, int, int, int, int) const {}
    __device__ __forceinline__ void operator()(const acc_t& acc, const Unit& u, int wr, int wc, int fr, int fq) const {
        const int h = u.i1; const float lgf = lgp[h], lgb = lgp[4 + h]; bf16_t* Kcf = KcT; bf16_t* Kcb = KcT + (size_t)1024 * CTX;
        EPI_ROWS { const int j = EPI_ROW; const float zf = __expf(lgf * (float)(CTX - 1 - j)), zb = __expf(lgb * (float)j);
            EPI_COLS { const int d0 = EPI_COL0;
#pragma unroll
                for (int e = 0; e < 8; ++e) { const float v = acc[ai][bj][m][e >> 2][e & 3]; const size_t o = (size_t)(h * 256 + d0 + e) * CTX + j;
                    Kcf[o] = f2bf(v * zf); Kcb[o] = f2bf(v * zb); } }  asm volatile("" ::: "memory"); }
    }
};
struct EpiVc {
    static constexpr int NHOOK = 0; static constexpr int AFTER_DRAIN = 0; int h0, h1; Base F;
    __device__ __forceinline__ void hook(acc_t&, const Unit&, int, int, int, int, int) const {}
    __device__ __forceinline__ void operator()(const acc_t& acc, const Unit& u, int wr, int wc, int fr, int fq) const {
        const int h = u.i0 >> 1, vt = u.i0 & 1;
        EPI_ROWS { const int v = vt * 256 + EPI_ROW;
            EPI_COLS { *(u32x4*)(VcT + (size_t)(h * 512 + v) * CTX + EPI_COL0) = pack8(acc[ai][bj][m][0], acc[ai][bj][m][1]); }  asm volatile("" ::: "memory"); }
    }
};
struct EpiS0 {
    static constexpr int NHOOK = 0; static constexpr int AFTER_DRAIN = 0; int h0, h1; Base F;
    __device__ __forceinline__ void hook(acc_t&, const Unit&, int, int, int, int, int) const {}
    __device__ __forceinline__ void operator()(const acc_t& acc, const Unit& u, int wr, int wc, int fr, int fq) const {
        EPI_ROWS { float* rowp = S0 + ((size_t)((u.i0 * 2 + u.i1) * 512 + u.i3 * 256 + EPI_ROW)) * 256;
            EPI_COLS { *(f32x4*)(rowp + EPI_COL0) = acc[ai][bj][m][0]; *(f32x4*)(rowp + EPI_COL0 + 4) = acc[ai][bj][m][1]; }  asm volatile("" ::: "memory"); }
    }
};
struct EpiU {
    static constexpr int NHOOK = 0; static constexpr int AFTER_DRAIN = 0; int h0, h1; Base F;
    __device__ __forceinline__ void hook(acc_t&, const Unit&, int, int, int, int, int) const {}
    __device__ __forceinline__ void operator()(const acc_t& acc, const Unit& u, int wr, int wc, int fr, int fq) const {
        EPI_ROWS { bf16_t* rowp = B4 + ((size_t)((u.i0 * NSEG + u.i2) * 512 + u.i3 * 256 + EPI_ROW)) * 1024 + u.i1 * 256;
            EPI_COLS { *(u32x4*)(rowp + EPI_COL0) = pack8(acc[ai][bj][m][0], acc[ai][bj][m][1]); }  asm volatile("" ::: "memory"); }
    }
};
struct EpiP {
    static constexpr int NHOOK = 0; static constexpr int AFTER_DRAIN = 0; int h0, h1; Base F; int pair;
    __device__ __forceinline__ void hook(acc_t&, const Unit&, int, int, int, int, int) const {}
    __device__ __forceinline__ void operator()(const acc_t& acc, const Unit& u, int wr, int wc, int fr, int fq) const {
        const int hl = u.i0, seg = u.i1, it = u.i2, jt = u.i3, h = 2 * pair + hl; const float l2f = lgp[h] * 1.44269504f, l2b = lgp[4 + h] * 1.44269504f;
        EPI_ROWS { const int il = it * 256 + EPI_ROW; bf16_t* rowp = Pb + (size_t)(seg * LS + il) * 1024 + hl * 512 + jt * 256;
            EPI_COLS { const int j0 = jt * 256 + EPI_COL0; f32x4 v[2];
#pragma unroll
                for (int e = 0; e < 8; ++e) { const int dl = il - (j0 + e); const float w = dl > 0 ? __builtin_amdgcn_exp2f((float)dl * l2f) : (dl < 0 ? __builtin_amdgcn_exp2f((float)(-dl) * l2b) : 2.0f);
                    v[e >> 2][e & 3] = acc[ai][bj][m][e >> 2][e & 3] * w; }
                *(u32x4*)(rowp + EPI_COL0) = pack8(v[0], v[1]); }  asm volatile("" ::: "memory"); }
    }
};
struct EpiO {
    static constexpr int NHOOK = 2; static constexpr int AFTER_DRAIN = 0; int h0, h1; Base F; int pair;
    __device__ __forceinline__ void hook(acc_t& acc, const Unit& u, int k, int wr, int wc, int fr, int fq) const {
        const int h = 2 * pair + u.i0; const float lgf = lgp[h], lgb = lgp[4 + h];
        EPI_ROWS { const int il = u.i2 * 256 + EPI_ROW; const float eb = lgb * (float)(LS - il);
            const float f = k == 0 ? __expf(lgf * (float)(il + 1) - eb) : __expf(eb);
#pragma unroll
            for (int bj = 0; bj < 2; ++bj) { acc[ai][bj][m][0] *= f; acc[ai][bj][m][1] *= f; }  asm volatile("" ::: "memory"); }
    }
    __device__ __forceinline__ void operator()(const acc_t& acc, const Unit& u, int wr, int wc, int fr, int fq) const {
        const int h = 2 * pair + u.i0;
        EPI_ROWS { bf16_t* rowp = Ob + (size_t)(u.i1 * LS + u.i2 * 256 + EPI_ROW) * 2048 + h * 512 + u.i3 * 256;
            EPI_COLS { *(u32x4*)(rowp + EPI_COL0) = pack8(acc[ai][bj][m][0], acc[ai][bj][m][1]); }  asm volatile("" ::: "memory"); }
    }
};
struct EpiG {
    static constexpr int NHOOK = 0; static constexpr int AFTER_DRAIN = 0; int h0, h1; Base F; const float* gnw; int rep; LAS unsigned char* stl;
    __device__ __forceinline__ void hook(acc_t&, const Unit&, int, int, int, int, int) const {}
    __device__ __forceinline__ void operator()(const acc_t& acc, const Unit& u, int wr, int wc, int fr, int fq) const {
        const int pm = u.i0, pn = u.i1, h = pn >> 1; u32x4 ov[1][4][2]; f32x2 st[1][4]; f32x4 gw[2][2];
#pragma unroll
        for (int bj = 0; bj < 2; ++bj) { gw[bj][0] = *(const f32x4*)(gnw + pn * 256 + EPI_COL0); gw[bj][1] = *(const f32x4*)(gnw + pn * 256 + EPI_COL0 + 4); }
#pragma unroll
        for (int ai = 0; ai < 2; ++ai) {
#pragma unroll
        for (int m = 0; m < 4; ++m) { const int pos = pm * 256 + EPI_ROW; st[0][m] = *(const LAS f32x2*)(stl + EPI_ROW * 8);
            EPI_COLS { ov[0][m][bj] = *(const u32x4*)(Ob + (size_t)pos * 2048 + pn * 256 + EPI_COL0); } }
#pragma unroll
        for (int m = 0; m < 4; ++m) { const int pos = pm * 256 + EPI_ROW; const f32x2 s2 = st[0][m];
            EPI_COLS { bf16_t* p = Ob + (size_t)pos * 2048 + pn * 256 + EPI_COL0; f32x4 o0, o1; unpack8(ov[0][m][bj], o0, o1);
                const f32x4 g0 = acc[ai][bj][m][0], g1 = acc[ai][bj][m][1]; f32x4 r0, r1;
#pragma unroll
                for (int e = 0; e < 4; ++e) { r0[e] = DBG_NORET ? 0.f : fsilu(g0[e]) * ((o0[e] - s2.x) * s2.y) * gw[bj][0][e]; r1[e] = DBG_NORET ? 0.f : fsilu(g1[e]) * ((o1[e] - s2.x) * s2.y) * gw[bj][1][e]; }
                *(u32x4*)p = rep == 0 ? pack8(r0, r1) : ov[0][m][bj]; } }
        asm volatile("" ::: "memory"); }
    }
};
struct EpiF {
    static constexpr int NHOOK = 0; static constexpr int AFTER_DRAIN = 0; int h0, h1; Base F;
    __device__ __forceinline__ void hook(acc_t&, const Unit&, int, int, int, int, int) const {}
    __device__ __forceinline__ void operator()(const acc_t& acc, const Unit& u, int wr, int wc, int fr, int fq) const {
        EPI_ROWS { const int mrow = u.i0 * 256 + EPI_ROW, ri = mrow >> 10, ch = mrow & 1023;
            EPI_COLS { const int c0 = EPI_COL0, l2 = 2 * u.i1 + (c0 >> 7), l1 = c0 & 127;
                *(u32x4*)(Wt + (size_t)(ch * 128 + l2) * 256 + ri * 128 + l1) = pack8(acc[ai][bj][m][0], acc[ai][bj][m][1]); }  asm volatile("" ::: "memory"); }
    }
};
struct EpiF1 {
    static constexpr int NHOOK = 0; static constexpr int AFTER_DRAIN = 0; int h0, h1; Base F;
    __device__ __forceinline__ void hook(acc_t&, const Unit&, int, int, int, int, int) const {}
    __device__ __forceinline__ void operator()(const acc_t& acc, const Unit& u, int wr, int wc, int fr, int fq) const {
        EPI_ROWS { const int r = EPI_ROW, k1 = r >> 1, ri = r & 1; const float sg = ri ? -1.0f : 1.0f;
            EPI_COLS { const int n = u.i1 * 256 + EPI_COL0, ch = n >> 7, l2 = n & 127; f32x4 v[2];
#pragma unroll
                for (int e = 0; e < 8; ++e) { const float rev = (float)((k1 * (l2 + e)) & 16383) * (1.0f / 16384.0f);
                    const float cs = __builtin_amdgcn_cosf(rev), sn = __builtin_amdgcn_sinf(rev); const float mine = acc[ai][bj][m][e >> 2][e & 3], other = __shfl_xor(mine, 1);
                    v[e >> 2][e & 3] = mine * cs + sg * other * sn; }
                *(u32x4*)(Bt + (size_t)(k1 * 1024 + ch) * 256 + ri * 128 + l2) = pack8(v[0], v[1]); }  asm volatile("" ::: "memory"); }
    }
};
struct EpiF2 {
    static constexpr int NHOOK = 0; static constexpr int AFTER_DRAIN = 0; int h0, h1; Base F;
    __device__ __forceinline__ void hook(acc_t&, const Unit&, int, int, int, int, int) const {}
    __device__ __forceinline__ void operator()(const acc_t& acc, const Unit& u, int wr, int wc, int fr, int fq) const {
        const int k1 = u.i1 >> 2, chb = (u.i1 & 3) * 256;
#pragma unroll
        for (int m = 0; m < 4; ++m) { const int k2 = 64 * wr + 16 * m + fr; bf16_t* rowp = MIXb + (size_t)(k1 + 128 * k2) * 2048 + chb;
            EPI_COLS { *(u32x4*)(rowp + EPI_COL0) = pack8(acc[0][bj][m][0], acc[0][bj][m][1]); } }
    }
};
struct EpiGate {
    static constexpr int NHOOK = 0; static constexpr int AFTER_DRAIN = 0; int h0, h1; Base F;
    __device__ __forceinline__ void hook(acc_t&, const Unit&, int, int, int, int, int) const {}
    __device__ __forceinline__ void operator()(const acc_t& acc, const Unit& u, int wr, int wc, int fr, int fq) const {
        bf16_t* dst = (u.i1 >> 2) ? GFb : GAb; const int cb = (u.i1 & 3) * 256;
        EPI_ROWS { bf16_t* rowp = dst + (size_t)(u.i0 * 256 + EPI_ROW) * DM + cb;
            EPI_COLS { f32x4 s0, s1;
#pragma unroll
                for (int e = 0; e < 4; ++e) { s0[e] = fsigmoid(acc[ai][bj][m][0][e]); s1[e] = fsigmoid(acc[ai][bj][m][1][e]); }
                *(u32x4*)(rowp + EPI_COL0) = pack8(s0, s1); }  asm volatile("" ::: "memory"); }
    }
};
struct EpiZ {
    static constexpr int NHOOK = 1; static constexpr int AFTER_DRAIN = 0; int h0, h1; Base F;
    __device__ __forceinline__ void hook(acc_t& acc, const Unit& u, int, int wr, int wc, int fr, int fq) const {
        EPI_ROWS { const size_t ro = (size_t)(u.i0 * 256 + EPI_ROW) * DM + u.i1 * 256;
            EPI_COLS { f32x4 a0, a1, f0, f1; unpack8(*(const u32x4*)(GAb + ro + EPI_COL0), a0, a1); unpack8(*(const u32x4*)(GFb + ro + EPI_COL0), f0, f1);
#pragma unroll
                for (int e = 0; e < 4; ++e) { acc[ai][bj][m][0][e] *= DBG_NOFOUR ? 0.f : f0[e] * __builtin_amdgcn_rcpf(fmaxf(a0[e], 1e-30f)); acc[ai][bj][m][1][e] *= DBG_NOFOUR ? 0.f : f1[e] * __builtin_amdgcn_rcpf(fmaxf(a1[e], 1e-30f)); } }  asm volatile("" ::: "memory"); }
    }
    __device__ __forceinline__ void operator()(const acc_t& acc, const Unit& u, int wr, int wc, int fr, int fq) const {
        EPI_ROWS { const size_t ro = (size_t)(u.i0 * 256 + EPI_ROW) * DM + u.i1 * 256;
            EPI_COLS { f32x4 a0, a1; unpack8(*(const u32x4*)(GAb + ro + EPI_COL0), a0, a1); f32x4 v0, v1;
#pragma unroll
                for (int e = 0; e < 4; ++e) { v0[e] = acc[ai][bj][m][0][e] * fmaxf(a0[e], 1e-30f); v1[e] = acc[ai][bj][m][1][e] * fmaxf(a1[e], 1e-30f); }
                *(u32x4*)(Zb + ro + EPI_COL0) = pack8(v0, v1); }  asm volatile("" ::: "memory"); }
    }
};

struct EpiSlab {
    static constexpr int NHOOK = 0; static constexpr int AFTER_DRAIN = 0; int h0, h1; Base F;
    __device__ __forceinline__ void hook(acc_t&, const Unit&, int, int, int, int, int) const {}
    __device__ __forceinline__ void operator()(const acc_t& acc, const Unit& u, int wr, int wc, int fr, int fq) const {
        float* dst = XcSlab + (size_t)u.i2 * CTX * DM + u.i1 * 256;
        EPI_ROWS { float* rowp = dst + (size_t)EPI_ROW * DM;
            EPI_COLS { *(f32x4*)(rowp + EPI_COL0) = acc[ai][bj][m][0]; *(f32x4*)(rowp + EPI_COL0 + 4) = acc[ai][bj][m][1]; } }
    }
};
struct JobCtxG2 {
    Base F;
    __device__ __forceinline__ void fill(int L, Unit& u) const { const int pn = L & 3, kc = L >> 2;
        u.a0 = (const char*)(Hc + kc * 256); u.a1 = u.a0; u.b = (const char*)(W2t1 + (size_t)pn * 256 * DFF + kc * 256); u.d = nullptr; u.i0 = 64; u.i1 = pn; u.i2 = kc; u.i3 = 0; }
};
struct EpiZ2 {
    static constexpr int NHOOK = 0; static constexpr int AFTER_DRAIN = 0; int h0, h1; Base F; int part;
    __device__ __forceinline__ void hook(acc_t&, const Unit&, int, int, int, int, int) const {}
    __device__ __forceinline__ void operator()(const acc_t& acc, const Unit& u, int wr, int wc, int fr, int fq) const {
        const bf16_t* G = part ? GAb : GFb;
#pragma unroll
        for (int ai = 0; ai < 2; ++ai) { u32x4 gv[4][2], tv[4][2];
#pragma unroll
            for (int m = 0; m < 4; ++m) { const size_t ro = (size_t)(u.i0 * 256 + EPI_ROW) * DM + u.i1 * 256, zo = (size_t)(u.i0 * 256 + EPI_ROW) * 2048 + u.i1 * 256;
                EPI_COLS { gv[m][bj] = *(const u32x4*)(G + ro + EPI_COL0); if (part) tv[m][bj] = *(const u32x4*)(Zb + zo + EPI_COL0); } }
#pragma unroll
            for (int m = 0; m < 4; ++m) { const size_t zo = (size_t)(u.i0 * 256 + EPI_ROW) * 2048 + u.i1 * 256;
                EPI_COLS { f32x4 g0, g1; unpack8(gv[m][bj], g0, g1); f32x4 v0 = acc[ai][bj][m][0] * g0, v1 = acc[ai][bj][m][1] * g1;
                    if (part) { f32x4 t0, t1; unpack8(tv[m][bj], t0, t1); v0 += t0; v1 += t1; }
                    *(u32x4*)(Zb + zo + EPI_COL0) = pack8(v0, v1); } }
            asm volatile("" ::: "memory"); }
    }
};
struct JobGate2 {
    Base F;
    __device__ __forceinline__ void fill(int L, Unit& u) const { const int c = L & 255, which = L >> 8; int pm, pn; pg::tile_pm_pn(c, 64, 4, pm, pn);
        u.a0 = (const char*)(Ax + (size_t)pm * 256 * DM); u.a1 = u.a0; u.b = (const char*)(Win + (size_t)(WR_GA + which * 1024 + pn * 256) * DM); u.d = nullptr; u.i0 = pm; u.i1 = which * 4 + pn; u.i2 = 0; u.i3 = 0; }
};
struct JobG2 {
    Base F;
    __device__ __forceinline__ void fill(int L, Unit& u) const { const int c = L & 255, half = L >> 8, pm = c >> 2, pn = 2 * (c & 3) + half;
        u.a0 = (const char*)(Ax + (size_t)pm * 256 * DM); u.a1 = u.a0; u.b = (const char*)(Win + (size_t)(WR_G + pn * 256) * DM); u.d = nullptr; u.i0 = pm; u.i1 = pn; u.i2 = 0; u.i3 = 0; }
};
struct JobFold {
    Base F;
    __device__ __forceinline__ void fill(int L, Unit& u) const { const int pn = L & 3, pm = (L >> 2) & 1, g = L >> 3;
        u.a0 = (const char*)(T256 + (size_t)pm * 256 * 256); u.a1 = u.a0; u.b = (const char*)(Wn + (size_t)pn * 256 * DM + g * 256);
        u.d = (char*)(Win + (size_t)(WR_F + pm * 1024 + g * 256) * DM + pn * 256); u.i0 = pm; u.i1 = pn; u.i2 = g; u.i3 = 0; }
};
struct JobRowCol {
    Base F; int sel, nM, nN; size_t aoff0, boff0, astep, bstep;
    __device__ __forceinline__ void fill(int L, Unit& u) const { int pm, pn; pg::tile_pm_pn(L, nM, nN, pm, pn);
        const bf16_t* A = sel == 0 ? Ax : (sel == 1 ? Win : Zb); const bf16_t* B = sel == 0 ? Win : (sel == 1 ? Ax : WoT);
        u.a0 = (const char*)(A + aoff0 + (size_t)pm * astep); u.a1 = u.a0; u.b = (const char*)(B + boff0 + (size_t)pn * bstep); u.d = nullptr; u.i0 = pm; u.i1 = pn; u.i2 = 0; u.i3 = 0; }
};
struct JobKc {
    Base F;
    __device__ __forceinline__ void fill(int L, Unit& u) const { const int h = L; u.a0 = (const char*)Ac; u.a1 = u.a0;
        u.b = (const char*)(Win + (size_t)((h >> 1) * 2048 + 512 + (h & 1) * 256) * DM); u.d = nullptr; u.i0 = 0; u.i1 = h; u.i2 = 0; u.i3 = 0; }
};
struct JobVc {
    Base F;
    __device__ __forceinline__ void fill(int L, Unit& u) const { const int t = L, h = t >> 1; u.a0 = (const char*)(Win + (size_t)((h >> 1) * 2048 + 1024 + (h & 1) * 512 + (t & 1) * 256) * DM); u.a1 = u.a0;
        u.b = (const char*)Ac; u.d = nullptr; u.i0 = t; u.i1 = 0; u.i2 = 0; u.i3 = 0; }
};
struct JobS0 {
    Base F;
    __device__ __forceinline__ void fill(int L, Unit& u) const { const int h = L >> 2, dir = (L >> 1) & 1, vt = L & 1;
        u.a0 = (const char*)(VcT + (size_t)(h * 512 + vt * 256) * CTX); u.a1 = u.a0; u.b = (const char*)(KcT + (size_t)dir * 1024 * CTX + (size_t)(h * 256) * CTX);
        u.d = nullptr; u.i0 = h; u.i1 = dir; u.i2 = 0; u.i3 = vt; }
};
struct JobR1 {
    Base F;
    __device__ __forceinline__ void fill(int L, Unit& u) const { const int w = pg::xcd_contig(L, 256), vt = w & 1, dir = (w >> 1) & 1, seg = (w >> 2) & 31, hl = w >> 7;
        u.a0 = (const char*)(B4 + ((size_t)((hl * NSEG + seg) * 512 + vt * 256)) * 1024 + 512); u.a1 = u.a0;
        u.b = (const char*)(Ktb_ + (size_t)dir * 512 * SEQ + (size_t)(hl * 256) * SEQ + seg * LS); u.d = nullptr; u.i0 = hl; u.i1 = dir; u.i2 = seg; u.i3 = vt; }
};
struct JobR3 {
    Base F;
    __device__ __forceinline__ void fill(int L, Unit& u) const { const int w = pg::xcd_contig(L, 256), jt = w & 1, it = (w >> 1) & 1, seg = (w >> 2) & 31, hl = w >> 7;
        u.a0 = (const char*)(Qb + (size_t)(seg * LS + it * 256) * 512 + hl * 256); u.a1 = u.a0; u.b = (const char*)(Knb + (size_t)(seg * LS + jt * 256) * 512 + hl * 256);
        u.d = nullptr; u.i0 = hl; u.i1 = seg; u.i2 = it; u.i3 = jt; }
};
struct JobR4 {
    Base F;
    __device__ __forceinline__ void fill(int L, Unit& u) const { const int w = pg::xcd_contig(L, 256), vt = w & 1, it = (w >> 1) & 1, seg = (w >> 2) & 31, hl = w >> 7;
        u.a0 = (const char*)(Qb + (size_t)(seg * LS + it * 256) * 512 + hl * 256); u.a1 = (const char*)(Pb + (size_t)(seg * LS + it * 256) * 1024 + hl * 512);
        u.b = (const char*)(B4 + ((size_t)((hl * NSEG + seg) * 512 + vt * 256)) * 1024); u.d = nullptr; u.i0 = hl; u.i1 = seg; u.i2 = it; u.i3 = vt; }
};
struct JobF1 {
    Base F;
    __device__ __forceinline__ void fill(int L, Unit& u) const { u.a0 = (const char*)FmT; u.a1 = u.a0; u.b = (const char*)(Wt + (size_t)L * 256 * 256); u.d = nullptr; u.i0 = 0; u.i1 = L; u.i2 = 0; u.i3 = 0; }
};
struct JobF2 {
    Base F;
    __device__ __forceinline__ void fill(int L, Unit& u) const { u.a0 = (const char*)GmT; u.a1 = u.a0; u.b = (const char*)(Bt + (size_t)L * 256 * 256); u.d = nullptr; u.i0 = 0; u.i1 = L; u.i2 = 0; u.i3 = 0; }
};
struct JobZ {
    Base F; int part;
    __device__ __forceinline__ void fill(int L, Unit& u) const { int pm, pn; pg::tile_pm_pn(L, 64, 4, pm, pn);
        u.a0 = (const char*)((part ? Ob : MIXb) + (size_t)pm * 256 * 2048); u.a1 = u.a0; u.b = (const char*)(Bz + (size_t)pn * 256 * 3072 + (part ? 1024 : 0)); u.d = nullptr; u.i0 = pm; u.i1 = pn; u.i2 = 0; u.i3 = 0; }
};

#define XB_TMO      128
#define XB_XCNT(j)  (256  + 64 * (j))
#define XB_XSUB(j)  (1280 + 64 * (j))
#define XB_XGEN(j)  (2304 + 64 * (j))
#define XB_TOP      3328
#define XB_TOPGEN   3392
#define XCD_BAR_WORDS 3456
#define XB_SPIN_CAP (1u << 22)
__device__ __forceinline__ unsigned xb_ld(unsigned* p)              { return __hip_atomic_load(p, __ATOMIC_RELAXED, __HIP_MEMORY_SCOPE_AGENT); }
__device__ __forceinline__ unsigned xb_add(unsigned* p, unsigned v) { return __hip_atomic_fetch_add(p, v, __ATOMIC_RELAXED, __HIP_MEMORY_SCOPE_AGENT); }
__device__ __forceinline__ unsigned xb_xcc_id() { return (unsigned)__builtin_amdgcn_s_getreg((3 << 11) | 20) & 0xFu; }
#define XB_SPIN(cond, bar) do { unsigned _sp = 0; while (cond) { __builtin_amdgcn_s_sleep(1); \
    if ((++_sp & 255u) == 0u) { if (xb_ld(&(bar)[XB_TMO])) break; if (_sp > XB_SPIN_CAP) { atomicAdd(&(bar)[XB_TMO], 1u); break; } } } } while (0)
struct XcdBarrier { unsigned* bar; unsigned x; volatile LAS unsigned* st; };
__device__ __forceinline__ XcdBarrier xcd_barrier_post(unsigned* bar, volatile LAS unsigned* st) {
    XcdBarrier b; b.bar = bar; b.x = xb_xcc_id(); b.st = st;
    if (threadIdx.x == 0) (void)xb_add(&bar[XB_XCNT(b.x)], 1u);
    return b;
}
__device__ __forceinline__ void xcd_barrier_complete(unsigned* bar, unsigned x, unsigned& nloc, unsigned& nx) {
    const unsigned G = gridDim.x * gridDim.y * gridDim.z;
    unsigned sum, cnt, mine, sp = 0u;
    for (;;) {
        sum = 0u; cnt = 0u; mine = 0u;
#pragma unroll
        for (unsigned j = 0; j < 16; ++j) { const unsigned c = xb_ld(&bar[XB_XCNT(j)]); sum += c; cnt += (c > 0u) ? 1u : 0u; mine = (j == x) ? c : mine; }
        if (sum == G) break;
        __builtin_amdgcn_s_sleep(1);
        if ((++sp & 255u) == 0u) { if (xb_ld(&bar[XB_TMO])) break; if (sp > XB_SPIN_CAP) { atomicAdd(&bar[XB_TMO], 1u); break; } }
    }
    nloc = mine > 0u ? mine : 1u; nx = cnt > 0u ? cnt : 1u;
}
__device__ __attribute__((noinline)) void xcd_barrier(unsigned* bar_, unsigned bx_, volatile LAS unsigned* st_) {
    XcdBarrier b; b.bar = bar_; b.x = bx_; b.st = st_;
    asm volatile("s_waitcnt vmcnt(0)" ::: "memory");
    __syncthreads();
    if (threadIdx.x == 0) {
        unsigned* bar = b.bar;
        __builtin_amdgcn_s_waitcnt(0);
        unsigned nloc = b.st[0], nx = b.st[1];
        if (nloc == 0u) { xcd_barrier_complete(bar, b.x, nloc, nx); b.st[0] = nloc; b.st[1] = nx; }
        const unsigned old = xb_add(&bar[XB_XSUB(b.x)], 1u);
        const unsigned gen = old / nloc;
        if (old + 1u == (gen + 1u) * nloc) {
            __builtin_amdgcn_fence(__ATOMIC_RELEASE, "agent");
            asm volatile("s_waitcnt vmcnt(0)" ::: "memory");
            const unsigned og = xb_add(&bar[XB_TOP], 1u);
            const unsigned tg = og / nx;
            if (og + 1u == (tg + 1u) * nx) xb_add(&bar[XB_TOPGEN], 1u);
            else XB_SPIN(xb_ld(&bar[XB_TOPGEN]) == tg, bar);
            __builtin_amdgcn_fence(__ATOMIC_ACQUIRE, "agent");
            xb_add(&bar[XB_XGEN(b.x)], 1u);
            asm volatile("s_waitcnt vmcnt(0)" ::: "memory");
        } else {
            XB_SPIN(xb_ld(&bar[XB_XGEN(b.x)]) == gen, bar);
            __builtin_amdgcn_fence(__ATOMIC_ACQUIRE, "agent");
            asm volatile("s_waitcnt vmcnt(0)" ::: "memory");
        }
    }
    __syncthreads();
}

constexpr int NWAVES = 8, NTHREADS = 512;
constexpr int RING_BYTES = 131072, MISC_OFF = RING_BYTES + 320, LDS_BYTES = 147456;
constexpr int CW_BAR = 4096;

struct Args { const float* in[21]; float* out; unsigned char* ws; int ph_lo, ph_hi; };

struct Ctx {
    LAS unsigned char* lds; int tid, lane, wave, G, vcu;
    unsigned char* ws; unsigned char* dout;
};
#define F_WS (F.ws)
#define F_DOUT (F.dout)

__device__ __forceinline__ void gemv_item(const Ctx& F, int item, const float* W, const float* b, const float* c, const float* cc) {
    LAS float* scr = (LAS float*)F.lds;
    const int cg = F.tid & 7, rg = F.tid >> 3, n0 = item * 32 + cg * 4;
    f32x4 ax = {0.f, 0.f, 0.f, 0.f}, ac = {0.f, 0.f, 0.f, 0.f};
#pragma unroll 4
    for (int k = rg; k < DM; k += 64) { const f32x4 w = *(const f32x4*)(W + (size_t)k * 9216 + n0); const float sx = c[k], sc = cc[k];
        ax += w * (sx / (1.f + expf(-sx))); ac += w * (sc / (1.f + expf(-sc))); }
    __syncthreads();
#pragma unroll
    for (int e = 0; e < 4; ++e) { scr[(rg * 8 + cg) * 8 + e] = ax[e]; scr[(rg * 8 + cg) * 8 + 4 + e] = ac[e]; }
    __syncthreads();
    if (F.tid < 64) { const int which = F.tid >> 5, col = F.tid & 31, g = col >> 2, e = col & 3; float s = 0.f;
        for (int r = 0; r < 64; ++r) s += scr[(r * 8 + g) * 8 + which * 4 + e];
        (which ? modc : modx)[item * 32 + col] = s + b[item * 32 + col]; }
    __syncthreads();
}
struct TrDesc { const float* W; int K, N; bf16_t* dst; int ld, coloff, kind; };
__device__ __forceinline__ int tr_dest_row(int kind, int n) {
    switch (kind) {
    case 0: { const int isb = n >= DFF, j = isb ? n - DFF : n; return 256 * (j >> 7) + 128 * isb + (j & 127); }
    case 2: {
        if (n < 1024) { const int h = n >> 8, d = n & 255; return (h >> 1) * 2048 + (h & 1) * 256 + d; }
        if (n < 2048) { const int h = (n - 1024) >> 8, d = n & 255; return (h >> 1) * 2048 + 512 + (h & 1) * 256 + d; }
        if (n < 4096) { const int h = (n - 2048) >> 9, v = (n - 2048) & 511; return (h >> 1) * 2048 + 1024 + (h & 1) * 512 + v; }
        if (n < 6144) return WR_G + (n - 4096);
        if (n < 7168) return -1;
        if (n < 8192) return WR_GA + (n - 7168);
        return WR_GF + (n - 8192); }
    default: return n; }
}
__device__ __forceinline__ void tr_item(const TrDesc& t, LAS float* scr, int item, int lane) {
    const int nblk = t.N / 32, kb = item / nblk, nb = item % nblk, k0 = 64 * kb, n0 = 32 * nb;
    if (t.kind == 2 && n0 >= 6144 && n0 < 7168) return;
#pragma unroll
    for (int i = 0; i < 8; ++i) { const int kk = 8 * i + (lane >> 3), c4 = (lane & 7) * 4; const f32x4 v = *(const f32x4*)(t.W + (size_t)(k0 + kk) * t.N + n0 + c4);
        scr[kk * 33 + c4] = v[0]; scr[kk * 33 + c4 + 1] = v[1]; scr[kk * 33 + c4 + 2] = v[2]; scr[kk * 33 + c4 + 3] = v[3]; }
    asm volatile("s_waitcnt lgkmcnt(0)" ::: "memory");
    const int c = lane & 7;
#pragma unroll
    for (int j = 0; j < 4; ++j) { const int n = (lane >> 3) + 8 * j; const LAS float* s = scr + (8 * c) * 33 + n;
        u32x4 o; o.x = cvt_pk_bf16(s[0 * 33], s[1 * 33]); o.y = cvt_pk_bf16(s[2 * 33], s[3 * 33]); o.z = cvt_pk_bf16(s[4 * 33], s[5 * 33]); o.w = cvt_pk_bf16(s[6 * 33], s[7 * 33]);
        const int dr = tr_dest_row(t.kind, n0 + n);
        *(u32x4*)(t.dst + (size_t)dr * t.ld + t.coloff + k0 + 8 * c) = o; }
    asm volatile("s_waitcnt lgkmcnt(0)" ::: "memory");
}
__device__ __forceinline__ void tr_all(const Ctx& F, const TrDesc& t, int gw, int NGW) {
    LAS float* scr = (LAS float*)(F.lds + F.wave * 16384);
    const int nitems = (t.K / 64) * (t.N / 32);
    for (int it = gw; it < nitems; it += NGW) tr_item(t, scr, it, F.lane);
}
__device__ __forceinline__ void norm_rows(const Ctx& F, const float* xin, const float* cin, const float* nw, int modoff, const bf16_t* dx, const float* dcf, bool has_delta, int row0, int nrows) {
    const int gw = F.vcu * NWAVES + F.wave, NGW = F.G * NWAVES;
    for (int r = row0 + gw; r < nrows; r += NGW) {
        const bool isx = r < SEQ; const int rr = isx ? r : r - SEQ;
        const float* xr = (isx ? xin : cin) + (size_t)rr * DM; const bf16_t* dr = dx + (size_t)rr * DM; const float* drf = dcf + (size_t)rr * DM;
        const float* md = (isx ? modx : modc) + modoff; bf16_t* orow = (isx ? Ax : Ac) + (size_t)rr * DM;
        f32x4 v[4]; float ss = 0.f;
#pragma unroll
        for (int j = 0; j < 4; ++j) { v[j] = *(const f32x4*)(xr + 256 * j + 4 * F.lane);
            if (has_delta) { if (isx) { const u32x2 d = *(const u32x2*)(dr + 256 * j + 4 * F.lane); v[j] += (f32x4){bflo(d.x), bfhi(d.x), bflo(d.y), bfhi(d.y)}; } else { f32x4 sacc = {0.f, 0.f, 0.f, 0.f};
#pragma unroll
                for (int kc = 0; kc < 11; ++kc) sacc += *(const f32x4*)(drf + (size_t)kc * CTX * DM + 256 * j + 4 * F.lane);
                v[j] += sacc * (*(const f32x4*)(modc + 2 * DM + 256 * j + 4 * F.lane)) * 0.5f; } }
            ss += (v[j][0] * v[j][0] + v[j][1] * v[j][1]) + (v[j][2] * v[j][2] + v[j][3] * v[j][3]); }
        const float rinv = 1.0f / sqrtf(wave_sum(ss) * (1.f / DM) + EPS);
#pragma unroll
        for (int j = 0; j < 4; ++j) { const int c = 256 * j + 4 * F.lane; const f32x4 w = *(const f32x4*)(nw + c), sh = *(const f32x4*)(md + c), sc = *(const f32x4*)(md + 1024 + c);
            const f32x4 y = (v[j] * rinv) * w * (sc + 1.0f) + sh; u32x2 o; o.x = cvt_pk_bf16(y[0], y[1]); o.y = cvt_pk_bf16(y[2], y[3]);
            *(u32x2*)(orow + c) = o; }
    }
}
__device__ __forceinline__ void final_norm(const Ctx& F, const float* xin, const float* nw, const bf16_t* dx) {
    float* out = (float*)F_DOUT;
    const int gw = F.vcu * NWAVES + F.wave, NGW = F.G * NWAVES;
    for (int r = gw; r < SEQ; r += NGW) {
        const float* xr = xin + (size_t)r * DM; const bf16_t* dr = dx + (size_t)r * DM;
        f32x4 v[4]; float ss = 0.f;
#pragma unroll
        for (int j = 0; j < 4; ++j) { v[j] = *(const f32x4*)(xr + 256 * j + 4 * F.lane);
            const u32x2 d = *(const u32x2*)(dr + 256 * j + 4 * F.lane); v[j] += (f32x4){bflo(d.x), bfhi(d.x), bflo(d.y), bfhi(d.y)};
            ss += (v[j][0] * v[j][0] + v[j][1] * v[j][1]) + (v[j][2] * v[j][2] + v[j][3] * v[j][3]); }
        const float rinv = 1.0f / sqrtf(wave_sum(ss) * (1.f / DM) + EPS);
#pragma unroll
        for (int j = 0; j < 4; ++j) { const int c = 256 * j + 4 * F.lane; *(f32x4*)(out + (size_t)r * DM + c) = (v[j] * rinv) * *(const f32x4*)(nw + c); }
    }
}
__device__ __forceinline__ void copy_delta(const Ctx& F, const bf16_t* src, bf16_t* dst) {
    const size_t n16 = (size_t)SEQ * DM * 2 / 16; const u32x4* s = (const u32x4*)src; u32x4* d = (u32x4*)dst;
    for (size_t i = (size_t)F.vcu * NTHREADS + F.tid; i < n16; i += (size_t)F.G * NTHREADS) d[i] = s[i];
}


__device__ __forceinline__ float block_sum(LAS float* scr, float v, int tid) {
    v = wave_sum(v); __syncthreads(); if ((tid & 63) == 0) scr[tid >> 6] = v; __syncthreads();
    float s = 0.f; for (int i = 0; i < NWAVES; ++i) s += scr[i]; __syncthreads(); return s;
}
__device__ __forceinline__ void dbg_report(unsigned* word, float ref, float got, float floor_) {
    const float e = fabsf(got - ref) / fmaxf(fabsf(ref), floor_); atomicMax(word, __builtin_bit_cast(unsigned, e)); if (e > 0.05f) atomicAdd(word + 64, 1u);
}
__device__ __forceinline__ float bf2f(bf16_t b) { return __builtin_bit_cast(float, (unsigned)b << 16); }

__global__ void __launch_bounds__(NTHREADS, 2) fwd_kernel(Args args) {
    extern __shared__ __attribute__((aligned(16))) unsigned char lds_raw[];
    Ctx F;
    F.lds = (LAS unsigned char*)lds_raw;
    F.tid = threadIdx.x; F.lane = F.tid & 63; F.wave = __builtin_amdgcn_readfirstlane(F.tid >> 6);
    F.G = gridDim.x; { const int bx = blockIdx.x; F.vcu = (F.G % 8 == 0) ? (bx % 8) * (F.G / 8) + bx / 8 : bx; }
    F.ws = args.ws; F.dout = (unsigned char*)args.out;
    volatile LAS unsigned* MISC = (volatile LAS unsigned*)(F.lds + MISC_OFF);
    for (int u = F.tid; u < (LDS_BYTES - RING_BYTES) / 4; u += NTHREADS) ((LAS unsigned*)(F.lds + RING_BYTES))[u] = 0u;
    __syncthreads();
    unsigned* ctl = (unsigned*)(F_WS + WS_CTL);
    XcdBarrier bar = xcd_barrier_post(ctl + CW_BAR, MISC + 8);
    const int lo = args.ph_lo, hi = args.ph_hi;
    int phase = 0;
#define PHASE_BEGIN if (phase >= lo && phase < hi) { for (int _rep = 0; _rep < ((DBG_DUP >= 0 && phase == DBG_DUP) ? 2 : 1); ++_rep) { asm volatile("; MARK %0" :: "i"(__LINE__)); { unsigned char* _w = args.ws; unsigned char* _o = (unsigned char*)args.out; int _t = threadIdx.x; asm volatile("" : "+s"(_w), "+s"(_o), "+v"(_t)); F.ws = _w; F.dout = _o; F.tid = _t; F.lane = _t & 63; }
#define PHASE_END   } if (phase + 1 < hi) xcd_barrier((unsigned*)(F.ws + WS_CTL) + CW_BAR, bar.x, MISC + 8); if (DBG_TSEL >= 0 && bx == 0 && F.tid == 0) ((unsigned long long*)(F.ws + WS_CTL + 160000))[phase + 1] = __builtin_amdgcn_s_memrealtime(); } ++phase;
    const int bx = (int)blockIdx.x;

#define gtid ((size_t)F.vcu * NTHREADS + F.tid)
#define gthreads ((size_t)F.G * NTHREADS)
#define FB (Base{F.ws, F.dout})
    const Geo gK1024{DM, DM, DM, 128u * DM * 2u, 128u * DM * 2u, 128u * DM * 2u, DM / 64, 1 << 20, 1 << 20};
    const Geo gFfn2{DFF, DFF, DFF, 128u * DFF * 2u, 128u * DFF * 2u, 128u * DFF * 2u, DFF / 64, 1 << 20, 1 << 20};

    if (DBG_TSEL >= 0 && bx == 0 && threadIdx.x == 0) ((unsigned long long*)(args.ws + WS_CTL + 160000))[0] = __builtin_amdgcn_s_memrealtime();
    PHASE_BEGIN
        for (int it = F.vcu; it < 288; it += F.G) gemv_item(F, it, args.in[4], args.in[5], args.in[1], args.in[3]);
        __syncthreads();
        if (gtid == 0) { ((unsigned*)(F.ws + WS_CTL))[32768 + 192] = 255u; ((unsigned*)(F.ws + WS_CTL))[32768 + 193] = 255u; }
        if (gtid < 8) { const float x = (gtid < 4 ? args.in[11] : args.in[12])[gtid & 3]; modx[2 * 9216 + gtid] = -log1pf(expf(-x)); }
        for (size_t i = gtid; i < 256 * 64; i += gthreads) { const int p = (int)(i >> 6), f = (int)(i & 63); const float inv = powf(10000.0f, -(float)f / 64.0f), ang = (float)p * inv;
            ropeT[2 * i] = cosf(ang); ropeT[2 * i + 1] = sinf(ang); }
        for (size_t i = gtid; i < 128 * 128; i += gthreads) { const int k1 = (int)(i >> 7), l2 = (int)(i & 127); const float a = (float)((k1 * l2) & 16383) * (1.0f / 8192.0f);
            twT[2 * i] = cospif(a); twT[2 * i + 1] = sinpif(a); }
        for (size_t i = gtid; i < 256 * 256; i += gthreads) { const int r = (int)(i >> 8), cc = (int)(i & 255), rin = cc >> 7, l = cc & 127;
            { const int k1 = r >> 1, ri = r & 1; const float a = (float)((k1 * l) & 127) * (1.0f / 64.0f), c = cospif(a), s = sinpif(a);
              FmT[i] = f2bf(ri == 0 ? (rin == 0 ? c : s) : (rin == 0 ? -s : c)); }
            { const float a = (float)((r * l) & 127) * (1.0f / 64.0f), c = cospif(a), s = sinpif(a);
              GmT[i] = r < 128 ? f2bf((rin == 0 ? c : s) * (1.0f / 2048.0f)) : (bf16_t)0; } }
        for (size_t i = gtid; i < 512 * 256; i += gthreads) { const int r = (int)(i >> 8), c = (int)(i & 255), ri = r >> 8, cp = r & 255; const float a = (float)((c * cp) & 255) * (1.0f / 128.0f);
            T256[i] = f2bf(ri == 0 ? cospif(a) : -sinpif(a)); }
        for (size_t i = gtid; i < (size_t)DM * DM / 4; i += gthreads) { const int k = (int)(i >> 8), c4 = (int)(i & 255) * 4; const f32x4 w = *(const f32x4*)(args.in[10] + (size_t)k * 9216 + 6144 + c4);
            u32x2 o; o.x = cvt_pk_bf16(w[0], w[1]); o.y = cvt_pk_bf16(w[2], w[3]); *(u32x2*)(Wn + (size_t)k * DM + c4) = o; }
        { TrDesc t{args.in[7], DM, 2 * DFF, W13t1, DM, 0, 0}; tr_all(F, t, F.vcu * NWAVES + F.wave, F.G * NWAVES); }
        { TrDesc t{args.in[8], DFF, DM, W2t1, DFF, 0, 1}; tr_all(F, t, F.vcu * NWAVES + F.wave, F.G * NWAVES); }
        { TrDesc t{args.in[10], DM, 9216, Win, DM, 0, 2}; tr_all(F, t, F.vcu * NWAVES + F.wave, F.G * NWAVES); }
        __syncthreads();
    PHASE_END
    for (int xb = 0; xb < DBG_XBAR; ++xb) {
    PHASE_BEGIN
    PHASE_END
    }
    PHASE_BEGIN
        norm_rows(F, args.in[0], args.in[2], args.in[6], 0, nullptr, nullptr, false, 0, SEQ + CTX);
    PHASE_END
    if constexpr (DBG_PROBE == 11) {
    PHASE_BEGIN
        unsigned* dw = (unsigned*)(F.ws + WS_CTL) + 32768;
        for (size_t idx = gtid; idx < (size_t)DM * 9216; idx += gthreads) { const int k = (int)(idx / 9216), n = (int)(idx % 9216); const int dr = tr_dest_row(2, n);
            if (dr >= 0) { const float a = args.in[10][idx]; const float b = bf2f(Win[(size_t)dr * DM + k]); if (fabsf(a - b) > 0.01f * fabsf(a) + 1e-6f) { atomicAdd(dw + 64, 1u); atomicMin(dw + 192, (unsigned)(dr >> 8)); } } }
    PHASE_END
    }
    PHASE_BEGIN
        { pg::Sched<JobFfn1> S{{FB, 65, 1}, 65 * 22, F.G, bx};
          EpiSwiglu E{0, 0, FB};
          pg::gemm_phase<EpiSwiglu, pg::Sched<JobFfn1>, 1>(F.lds, gK1024, S, E); }
        if (bx >= 150 && bx < 194 && _rep == 0) {
            if (F.tid < 64) { unsigned* cnt = (unsigned*)(F.ws + WS_CTL) + 24576; unsigned sp = 0;
                while ((unsigned)__builtin_amdgcn_readfirstlane(__hip_atomic_load(cnt, __ATOMIC_RELAXED, __HIP_MEMORY_SCOPE_AGENT)) < 22u * 8u) { __builtin_amdgcn_s_sleep(2); if (++sp > (1u << 22)) break; }
                __builtin_amdgcn_fence(__ATOMIC_ACQUIRE, "agent"); asm volatile("s_waitcnt vmcnt(0)" ::: "memory"); }
            __syncthreads();
            Geo g{DFF, DFF, DFF, 128u * DFF * 2u, 128u * DFF * 2u, 128u * DFF * 2u, 4, 1 << 20, 1 << 20};
            pg::Sched<JobCtxG2> S{{FB}, 44, 1 << 20, bx - 150}; EpiSlab E{0, 0, FB};
            pg::gemm_phase<EpiSlab, pg::Sched<JobCtxG2>, 1>(F.lds, g, S, E);
            { Geo g2{256, 256, DM, 128u * 256 * 2u, 128u * 256 * 2u, 128u * DM * 2u, 4, 1 << 20, 1 << 20};
              pg::Sched<JobFold> S2{{FB}, 32, 1 << 20, bx - 150}; EpiStore E2{0, 0, DM};
              pg::gemm_phase<EpiStore, pg::Sched<JobFold>, 1>(F.lds, g2, S2, E2); }
        } else if (bx >= 194 && _rep == 0) {
            { TrDesc t{args.in[18], DM, 2 * DFF, W13t, DM, 0, 0}; tr_all(F, t, (bx - 194) * NWAVES + F.wave, (F.G - 194) * NWAVES); }
            { TrDesc t{args.in[19], DFF, DM, W2t, DFF, 0, 1}; tr_all(F, t, (bx - 194) * NWAVES + F.wave, (F.G - 194) * NWAVES); }
            __syncthreads();
        }
    PHASE_END
    PHASE_BEGIN
        if (_rep == 0) norm_rows(F, args.in[0], args.in[2], args.in[9], 3 * DM, Dx, XcSlab, true, SEQ, SEQ + CTX);
        { pg::Sched<JobFfn2> S{{FB, 64, 1}, 64 * 4, F.G, bx};
          EpiFuse E{0, 0, FB, 0, args.in[0], args.in[9]};
          pg::gemm_phase<EpiFuse, pg::Sched<JobFfn2>, 1>(F.lds, gFfn2, S, E); }
    PHASE_END
    if constexpr (STOP_AFTER >= 3) {
    for (int pair = 0; pair < 2; ++pair) {
        PHASE_BEGIN
            { pg::Sched<JobRowCol> S{{FB, 0, 64, 4, 0, (size_t)pair * 2048 * DM, (size_t)256 * DM, (size_t)256 * DM}, 256, F.G, bx};
              EpiQK E{0, 0, FB, pair};
              pg::gemm_phase<EpiQK, pg::Sched<JobRowCol>, 1>(F.lds, gK1024, S, E); }
            { pg::Sched<JobRowCol> S{{FB, 1, 4, 64, (size_t)(pair * 2048 + 1024) * DM, 0, (size_t)256 * DM, (size_t)256 * DM}, 256, F.G, bx};
              EpiVT E{0, 0, FB};
              pg::gemm_phase<EpiVT, pg::Sched<JobRowCol>, 1>(F.lds, gK1024, S, E); }
            if (pair == 0) {
                { pg::Sched<JobKc> S{{FB}, 4, F.G, (bx + F.G - 64) % F.G}; EpiKc E{0, 0, FB};
                  pg::gemm_phase<EpiKc, pg::Sched<JobKc>, 1>(F.lds, gK1024, S, E); }
                { pg::Sched<JobVc> S{{FB}, 8, F.G, (bx + F.G - 72) % F.G}; EpiVc E{0, 0, FB};
                  pg::gemm_phase<EpiVc, pg::Sched<JobVc>, 1>(F.lds, gK1024, S, E); }
            }
        PHASE_END
        if constexpr (DBG_PROBE == 5) {
        PHASE_BEGIN
            LAS float* scr = (LAS float*)F.lds; unsigned* dw = (unsigned*)(F.ws + WS_CTL) + 32768;
            const int s = bx; const int i = (int)(((unsigned)s * 2654435761u) >> 18) & 16383, hl = s & 1, h = 2 * pair + hl, pp = (s * 29 + 3) & 127, v = (s * 37 + 11) & 511;
            const float* win = args.in[10]; float q1 = 0.f, q2 = 0.f, k1 = 0.f, k2 = 0.f, vv = 0.f;
            for (int a = F.tid; a < DM; a += NTHREADS) { const float x = bf2f(Ax[(size_t)i * DM + a]); const float* wr_ = win + (size_t)a * 9216;
                q1 += x * wr_[h * 256 + 2 * pp]; q2 += x * wr_[h * 256 + 2 * pp + 1]; k1 += x * wr_[1024 + h * 256 + 2 * pp]; k2 += x * wr_[1024 + h * 256 + 2 * pp + 1]; vv += x * wr_[2048 + h * 512 + v]; }
            q1 = block_sum(scr, q1, F.tid); q2 = block_sum(scr, q2, F.tid); k1 = block_sum(scr, k1, F.tid); k2 = block_sum(scr, k2, F.tid); vv = block_sum(scr, vv, F.tid);
            if (F.tid == 0) { const float inv = powf(10000.0f, -(float)(pp & 63) / 64.0f), ang = (float)(pp < 64 ? (i >> 6) : (i & 63)) * inv, cs = cosf(ang), sn = sinf(ang);
                const float rq1 = (q1 * cs - q2 * sn) * 0.0625f, rq2 = (q1 * sn + q2 * cs) * 0.0625f, rk1 = k1 * cs - k2 * sn, rk2 = k1 * sn + k2 * cs; const int jl = i & 511;
                dbg_report(dw, rq1, bf2f(Qb[(size_t)i * 512 + hl * 256 + 2 * pp]), 1000.0f); dbg_report(dw, rq2, bf2f(Qb[(size_t)i * 512 + hl * 256 + 2 * pp + 1]), 1000.0f);
                dbg_report(dw, rk1, bf2f(Knb[(size_t)i * 512 + hl * 256 + 2 * pp]), 1000.0f); dbg_report(dw, rk2, bf2f(Knb[(size_t)i * 512 + hl * 256 + 2 * pp + 1]), 1000.0f);
                dbg_report(dw, rk2 * expf(lgp[h] * (float)(511 - jl)), bf2f(Ktb_[(size_t)(hl * 256 + 2 * pp + 1) * SEQ + i]), 1000.0f);
                dbg_report(dw, rk1 * expf(lgp[4 + h] * (float)jl), bf2f(Ktb_[(size_t)512 * SEQ + (size_t)(hl * 256 + 2 * pp) * SEQ + i]), 1000.0f);
                dbg_report(dw, vv, bf2f(B4[((size_t)((hl * NSEG + (i >> 9)) * 512 + v)) * 1024 + 512 + jl]), 1000.0f); }
        PHASE_END
        }
        PHASE_BEGIN
            { Geo g{1024, 1024, SEQ, 128u * 1024 * 2u, 128u * 1024 * 2u, 128u * (unsigned)SEQ * 2u, LS / 64, 1 << 20, 1 << 20};
              pg::Sched<JobR1> S{{FB}, 256, F.G, bx}; EpiU E{0, 0, FB};
              pg::gemm_phase<EpiU, pg::Sched<JobR1>, 1>(F.lds, g, S, E); }
            if (pair == 0) { Geo g{CTX, CTX, CTX, 128u * CTX * 2u, 128u * CTX * 2u, 128u * CTX * 2u, CTX / 64, 1 << 20, 1 << 20};
              pg::Sched<JobS0> S{{FB}, 16, F.G, (bx + F.G - 64) % F.G}; EpiS0 E{0, 0, FB};
              pg::gemm_phase<EpiS0, pg::Sched<JobS0>, 1>(F.lds, g, S, E); }
        PHASE_END
        if constexpr (DBG_PROBE == 6) {
        PHASE_BEGIN
            LAS float* scr = (LAS float*)F.lds; unsigned* dw = (unsigned*)(F.ws + WS_CTL) + 32768;
            const int s = bx, h = s & 3, dir = (s >> 2) & 1, d = (s * 29 + 3) & 255, v = (s * 37 + 11) & 511; const float* win = args.in[10];
            const int j = F.tid & 255, which = F.tid >> 8; const int col = which ? 2048 + h * 512 + v : 1024 + h * 256 + d; float dot = 0.f;
            for (int a = 0; a < DM; ++a) dot += bf2f(Ac[(size_t)j * DM + a]) * win[(size_t)a * 9216 + col];
            scr[16 + F.tid] = dot; __syncthreads();
            float term = 0.f; if (F.tid < 256) term = scr[16 + F.tid] * scr[16 + 256 + F.tid] * expf(lgp[dir * 4 + h] * (float)(dir ? j : 255 - j));
            __syncthreads();
            const float ref = block_sum(scr, term, F.tid);
            if (F.tid == 0) dbg_report(dw, ref, S0[((size_t)((h * 2 + dir) * 512 + v)) * 256 + d], 1000.0f);
        PHASE_END
        }
        PHASE_BEGIN
            { const int gw = F.vcu * NWAVES + F.wave, NGW = F.G * NWAVES;
              for (int rowid = gw; rowid < 1024; rowid += NGW) { const int hl = rowid >> 9, v = rowid & 511, h = 2 * pair + hl, dir = F.lane >> 5, d0 = (F.lane & 31) * 8;
                  const float* s0 = S0 + ((size_t)((h * 2 + dir) * 512 + v)) * 256 + d0; f32x4 c0 = *(const f32x4*)s0, c1 = *(const f32x4*)(s0 + 4);
                  const float dec = expf(lgp[dir * 4 + h] * (float)LS);
                  bf16_t* pb = B4 + ((size_t)(hl * NSEG * 512 + v)) * 1024 + dir * 256 + d0; const long sstep = dir ? -(long)512 * 1024 : (long)512 * 1024; if (dir) pb += (size_t)(NSEG - 1) * 512 * 1024;
                  u32x4 ub[NSEG];
#pragma unroll
                  for (int it = 0; it < NSEG; ++it) ub[it] = *(const u32x4*)(pb + (long)it * sstep);
#pragma unroll
                  for (int it = 0; it < NSEG; ++it) { f32x4 u0, u1; unpack8(ub[it], u0, u1); *(u32x4*)(pb + (long)it * sstep) = _rep == 0 ? pack8(c0, c1) : ub[it]; c0 = c0 * dec + u0; c1 = c1 * dec + u1; } } }
            if (pair == 0 && F.vcu >= 128 && _rep == 0) {
                { TrDesc t{args.in[15], DM, DM, Bz, 3072, 0, 3}; tr_all(F, t, (F.vcu - 128) * NWAVES + F.wave, (F.G - 128) * NWAVES); }
                { TrDesc t{args.in[14], 2048, DM, Bz, 3072, 1024, 4}; tr_all(F, t, (F.vcu - 128) * NWAVES + F.wave, (F.G - 128) * NWAVES); }
                { TrDesc t{args.in[16], DM, DM, WoT, DM, 0, 5}; tr_all(F, t, (F.vcu - 128) * NWAVES + F.wave, (F.G - 128) * NWAVES); }
                __syncthreads(); }
            { Geo g{512, 512, 512, 128u * 512 * 2u, 128u * 512 * 2u, 128u * 512 * 2u, 4, 1 << 20, 1 << 20};
              pg::Sched<JobR3> S{{FB}, 256, F.G, bx}; EpiP E{0, 0, FB, pair};
              pg::gemm_phase<EpiP, pg::Sched<JobR3>, 1>(F.lds, g, S, E); }
        PHASE_END
        PHASE_BEGIN
            Geo g{512, 1024, 1024, 128u * 512 * 2u, 128u * 1024 * 2u, 128u * 1024 * 2u, 16, 8, 4};
            pg::Sched<JobR4> S{{FB}, 256, F.G, bx}; EpiO E{4, 8, FB, pair};
            pg::gemm_phase<EpiO, pg::Sched<JobR4>, 2>(F.lds, g, S, E);
        PHASE_END
        if constexpr (DBG_PROBE == 1) {
        PHASE_BEGIN
            LAS float* scr = (LAS float*)F.lds; unsigned* dw = (unsigned*)(F.ws + WS_CTL) + 32768;
            const int s = bx; int i = (int)(((unsigned)s * 2654435761u) >> 18) & 16383; if (s < 8) { const int sp[8] = {0, 1, 511, 512, 513, 8191, 16382, 16383}; i = sp[s]; }
            const int hl = s & 1, h = 2 * pair + hl, v = (s * 37 + 11) & 511; const float lgf = lgp[h], lgb = lgp[4 + h];
            float part = 0.f;
            for (int j = F.tid; j < SEQ; j += NTHREADS) { float qk = 0.f;
                for (int d = 0; d < 256; ++d) qk += bf2f(Qb[(size_t)i * 512 + hl * 256 + d]) * bf2f(Knb[(size_t)j * 512 + hl * 256 + d]);
                const float D = j < i ? __expf(lgf * (float)(i - j)) : (j > i ? __expf(lgb * (float)(j - i)) : 2.0f);
                part += D * qk * bf2f(B4[((size_t)((hl * NSEG + (j >> 9)) * 512 + v)) * 1024 + 512 + (j & 511)]); }
            if (F.tid < 256) { const float q = bf2f(Qb[(size_t)i * 512 + hl * 256 + F.tid]);
                part += q * (__expf(lgf * (float)(i + 1)) * S0[((size_t)((h * 2 + 0) * 512 + v)) * 256 + F.tid] + __expf(lgb * (float)(SEQ - i)) * S0[((size_t)((h * 2 + 1) * 512 + v)) * 256 + F.tid]); }
            const float ref = block_sum(scr, part, F.tid);
            const float ov = bf2f(Ob[(size_t)i * 2048 + h * 512 + F.tid]); const float rms = sqrtf(block_sum(scr, ov * ov, F.tid) * (1.0f / 512.0f));
            if (F.tid == 0) dbg_report(dw, ref, bf2f(Ob[(size_t)i * 2048 + h * 512 + v]), rms * 1000.0f);
        PHASE_END
        }
    }
    if constexpr (DBG_PROBE == 7 || DBG_PROBE == 8) {
    PHASE_BEGIN
        LAS float* scr = (LAS float*)F.lds; unsigned* dw = (unsigned*)(F.ws + WS_CTL) + 32768; float* sav = (float*)(F.ws + WS_END);
        const int s = bx; const int i = s * 64 + 57, h = DBG_COL >> 9, v = DBG_COL & 511;
        const float ov = bf2f(Ob[(size_t)i * 2048 + h * 512 + F.tid]); const float mean = block_sum(scr, ov, F.tid) * (1.0f / 512.0f);
        const float var = block_sum(scr, (ov - mean) * (ov - mean), F.tid) * (1.0f / 512.0f); const float rstd = 1.0f / sqrtf(var + EPS);
        if (F.tid == 0) { if (DBG_PROBE == 7) { dbg_report(dw, mean, stats[(size_t)(i * 4 + h) * 2], 1000.0f); dbg_report(dw, rstd, stats[(size_t)(i * 4 + h) * 2 + 1], 1000.0f); }
            sav[s * 4 + 0] = (bf2f(Ob[(size_t)i * 2048 + h * 512 + v]) - mean) * rstd; }
    PHASE_END
    }
    PHASE_BEGIN
        { LAS unsigned char* stl = F.lds + RING_BYTES + 1024;
          if (_rep == 0) { const int pm = bx >> 2, h = bx & 3;
            for (int r = F.wave; r < 256; r += NWAVES) { const int pos = pm * 256 + r; f32x4 a, b; unpack8(*(const u32x4*)(Ob + (size_t)pos * 2048 + h * 512 + F.lane * 8), a, b);
                const float mean = wave_sum((a[0] + a[1]) + (a[2] + a[3]) + (b[0] + b[1]) + (b[2] + b[3])) * (1.0f / 512.0f);
                a -= mean; b -= mean; const float q = wave_sum((a[0] * a[0] + a[1] * a[1]) + (a[2] * a[2] + a[3] * a[3]) + (b[0] * b[0] + b[1] * b[1]) + (b[2] * b[2] + b[3] * b[3]));
                if (F.lane == 0) *(LAS f32x2*)(stl + r * 8) = (f32x2){mean, 1.0f / sqrtf(q * (1.0f / 512.0f) + EPS)}; }
            __syncthreads(); }
          pg::Sched<JobG2> S{{FB}, 512, F.G, bx};
          EpiG E{0, 0, FB, args.in[13], _rep, stl};
          pg::gemm_phase<EpiG, pg::Sched<JobG2>, 1>(F.lds, gK1024, S, E); }
        { Geo g{DM, DM, 128u * DM, 128u * DM * 2u, 128u * DM * 2u, (unsigned)DM * 2u, DM / 64, 1 << 20, 1 << 20};
          pg::Sched<JobRowCol> S{{FB, 1, 8, 64, (size_t)WR_F * DM, 0, (size_t)256 * DM, (size_t)2 * DM}, 512, F.G, bx};
          EpiF E{0, 0, FB};
          pg::gemm_phase<EpiF, pg::Sched<JobRowCol>, 1>(F.lds, g, S, E); }
    PHASE_END
    if constexpr (DBG_PROBE == 8) {
    PHASE_BEGIN
        LAS float* scr = (LAS float*)F.lds; unsigned* dw = (unsigned*)(F.ws + WS_CTL) + 32768; float* sav = (float*)(F.ws + WS_END);
        const int s = bx; const int i = s * 64 + 57, h = DBG_COL >> 9, v = DBG_COL & 511, col = h * 512 + v; float g = 0.f;
        for (int a = F.tid; a < DM; a += NTHREADS) g += bf2f(Ax[(size_t)i * DM + a]) * args.in[10][(size_t)a * 9216 + 4096 + col];
        g = block_sum(scr, g, F.tid);
        if (F.tid == 0) dbg_report(dw, g / (1.0f + expf(-g)) * sav[s * 4] * args.in[13][col], bf2f(Ob[(size_t)i * 2048 + col]), 1.0f);
    PHASE_END
    }
    PHASE_BEGIN
        Geo g{256, 256, 256, 128u * 256 * 2u, 128u * 256 * 2u, 128u * 256 * 2u, 4, 1 << 20, 1 << 20};
        pg::Sched<JobF1> S{{FB}, 512, F.G, bx}; EpiF1 E{0, 0, FB};
        pg::gemm_phase<EpiF1, pg::Sched<JobF1>, 1>(F.lds, g, S, E);
    PHASE_END
    if constexpr (DBG_PROBE == 2 || DBG_PROBE == 4) {
    PHASE_BEGIN
        LAS float* scr = (LAS float*)F.lds; unsigned* dw = (unsigned*)(F.ws + WS_CTL) + 32768;
        if (DBG_PROBE == 4) {
            const int s = bx; const int l = (int)(((unsigned)s * 2654435761u) >> 18) & 16383, ch = (s * 131 + 7) & 1023, g = ch >> 8, cp = ch & 255;
            const int c = F.tid & 255, hf = F.tid >> 8; float fpart = 0.f;
            for (int a = hf * 512; a < hf * 512 + 512; ++a) fpart += bf2f(Ax[(size_t)l * DM + a]) * args.in[10][(size_t)a * 9216 + 6144 + g * 256 + c];
            scr[16 + F.tid] = fpart; __syncthreads();
            float wr_ = 0.f, wi_ = 0.f;
            if (F.tid < 256) { const float fv = scr[16 + F.tid] + scr[16 + 256 + F.tid]; const float ang = (float)((c * cp) & 255) * (1.0f / 128.0f); wr_ = fv * cospif(ang); wi_ = -fv * sinpif(ang); }
            __syncthreads();
            const float Wr = block_sum(scr, wr_, F.tid), Wi = block_sum(scr, wi_, F.tid);
            const int l1 = l >> 7, l2 = l & 127;
            if (F.tid == 0) { dbg_report(dw, Wr, bf2f(Wt[(size_t)(ch * 128 + l2) * 256 + l1]), 16000.0f); dbg_report(dw, Wi, bf2f(Wt[(size_t)(ch * 128 + l2) * 256 + 128 + l1]), 16000.0f); }
        } else {
            const unsigned sid = (unsigned)(bx * NTHREADS + F.tid) * 2654435761u; const int k1 = (sid >> 8) & 127, l2 = (sid >> 15) & 127, ch = (sid >> 22) & 1023;
            float ar = 0.f, ai = 0.f;
            for (int l1 = 0; l1 < 128; ++l1) { const float wr_ = bf2f(Wt[(size_t)(ch * 128 + l2) * 256 + l1]), wi_ = bf2f(Wt[(size_t)(ch * 128 + l2) * 256 + 128 + l1]);
                const float a = (float)((k1 * l1) & 127) * (1.0f / 64.0f), cs = cospif(a), sn = sinpif(a); ar += cs * wr_ + sn * wi_; ai += cs * wi_ - sn * wr_; }
            const float t = (float)((k1 * l2) & 16383) * (1.0f / 8192.0f), ct = cospif(t), st = sinpif(t);
            const float br = ar * ct + ai * st, bi = ai * ct - ar * st;
            dbg_report(dw, br, bf2f(Bt[(size_t)(k1 * 1024 + ch) * 256 + l2]), 180000.0f); dbg_report(dw, bi, bf2f(Bt[(size_t)(k1 * 1024 + ch) * 256 + 128 + l2]), 180000.0f);
        }
    PHASE_END
    }
    PHASE_BEGIN
        Geo g{256, 256, 256, 128u * 256 * 2u, 128u * 256 * 2u, 128u * 256 * 2u, 4, 1 << 20, 1 << 20};
        pg::Sched<JobF2> S{{FB}, 512, F.G, bx}; EpiF2 E{0, 0, FB};
        pg::gemm_phase<EpiF2, pg::Sched<JobF2>, 1>(F.lds, g, S, E);
    PHASE_END
    if constexpr (DBG_PROBE == 3) {
    PHASE_BEGIN
        unsigned* dw = (unsigned*)(F.ws + WS_CTL) + 32768;
        const unsigned sid = (unsigned)(bx * NTHREADS + F.tid) * 2654435761u; const int k1 = (sid >> 8) & 127, k2 = (sid >> 15) & 127, ch = (sid >> 22) & 1023;
        float y = 0.f;
        for (int l2 = 0; l2 < 128; ++l2) { const float br = bf2f(Bt[(size_t)(k1 * 1024 + ch) * 256 + l2]), bi = bf2f(Bt[(size_t)(k1 * 1024 + ch) * 256 + 128 + l2]);
            const float a = (float)((k2 * l2) & 127) * (1.0f / 64.0f); y += br * cospif(a) + bi * sinpif(a); }
        dbg_report(dw, y * (1.0f / 2048.0f), bf2f(MIXb[(size_t)(k1 + 128 * k2) * 2048 + ch]), 1000.0f);
    PHASE_END
    }
    if constexpr (DBG_PROBE == 12) {
    PHASE_BEGIN
        unsigned* dw = (unsigned*)(F.ws + WS_CTL) + 32768;
        for (size_t idx = gtid; idx < (size_t)DM * 9216; idx += gthreads) { const int k = (int)(idx / 9216), n = (int)(idx % 9216); const int dr = tr_dest_row(2, n);
            if (dr >= 0) { const float a = args.in[10][idx]; const float b = bf2f(Win[(size_t)dr * DM + k]); if (fabsf(a - b) > 0.01f * fabsf(a) + 1e-6f) { atomicAdd(dw + 64, 1u); atomicMin(dw + 192, (unsigned)(dr >> 8)); } } }
    PHASE_END
    }
    if constexpr (DBG_PROBE == 9) {
    PHASE_BEGIN
        LAS float* scr = (LAS float*)F.lds; unsigned* dw = (unsigned*)(F.ws + WS_CTL) + 32768;
        const int s = bx; const int i = DBG_VAR == 0 ? 1210 : (DBG_VAR == 1 ? 1024 + s : (DBG_VAR == 2 ? s * 64 + 57 : 1210 + 256 * (s & 63))), n = DBG_VAR == 0 ? 4 * s : 736; float ga = 0.f, gf = 0.f;
        for (int a = F.tid; a < DM; a += NTHREADS) { const float x = bf2f(Ax[(size_t)i * DM + a]); ga += x * args.in[10][(size_t)a * 9216 + 7168 + n]; gf += x * args.in[10][(size_t)a * 9216 + 8192 + n]; }
        ga = block_sum(scr, ga, F.tid); gf = block_sum(scr, gf, F.tid);
        if (F.tid == 0) { const float ea = fabsf(1.0f / (1.0f + expf(-ga)) - bf2f(GAb[(size_t)i * DM + n])), ef = fabsf(1.0f / (1.0f + expf(-gf)) - bf2f(GFb[(size_t)i * DM + n]));
            if (ea > 0.05f) { atomicMin(dw + 192, (unsigned)s); atomicAdd(dw + 64, 1u); dbg_report(dw, 0.f, DBG_GF ? ea : bf2f(GAb[(size_t)i * DM + n]), 1000.0f); } if (ef > 0.05f) atomicMin(dw + 193, (unsigned)s); }
    PHASE_END
    }
    PHASE_BEGIN
        { pg::Sched<JobGate2> S{{FB}, 512, F.G, bx}; EpiGate E{0, 0, FB};
          pg::gemm_phase<EpiGate, pg::Sched<JobGate2>, 1>(F.lds, gK1024, S, E); }
        { Geo g{2048, 2048, 3072, 128u * 2048 * 2u, 128u * 2048 * 2u, 128u * 3072 * 2u, 16, 1 << 20, 1 << 20};
          pg::Sched<JobZ> S{{FB, 0}, 256, F.G, bx}; EpiZ2 E{0, 0, FB, 0};
          pg::gemm_phase<EpiZ2, pg::Sched<JobZ>, 1>(F.lds, g, S, E); }
        { Geo g{2048, 2048, 3072, 128u * 2048 * 2u, 128u * 2048 * 2u, 128u * 3072 * 2u, 32, 1 << 20, 1 << 20};
          pg::Sched<JobZ> S{{FB, 1}, 256, F.G, bx}; EpiZ2 E{0, 0, FB, 1};
          pg::gemm_phase<EpiZ2, pg::Sched<JobZ>, 1>(F.lds, g, S, E); }
    PHASE_END
    if constexpr (DBG_PROBE == 9 || DBG_PROBE == 10) {
    PHASE_BEGIN
        LAS float* scr = (LAS float*)F.lds; unsigned* dw = (unsigned*)(F.ws + WS_CTL) + 32768;
        const int s = bx; const int i = (int)(((unsigned)s * 2654435761u) >> 18) & 16383, n = (s * 131 + 7) & 1023;
        if (DBG_PROBE == 9) { float ga = 0.f, gf = 0.f;
            (void)ga; (void)gf;
        } else { float r = 0.f, fo = 0.f;
            for (int k = F.tid; k < 2048; k += NTHREADS) r += bf2f(Ob[(size_t)i * 2048 + k]) * args.in[14][(size_t)k * DM + n];
            for (int k = F.tid; k < 1024; k += NTHREADS) fo += bf2f(MIXb[(size_t)i * 2048 + k]) * args.in[15][(size_t)k * DM + n];
            r = block_sum(scr, r, F.tid); fo = block_sum(scr, fo, F.tid);
            if (F.tid == 0) dbg_report(dw, bf2f(GAb[(size_t)i * DM + n]) * r + bf2f(GFb[(size_t)i * DM + n]) * fo, bf2f(Zb[(size_t)i * DM + n]), 1000.0f); }
    PHASE_END
    }
    PHASE_BEGIN
        Geo g{2048, 2048, DM, 128u * 2048 * 2u, 128u * 2048 * 2u, 128u * DM * 2u, DM / 64, 1 << 20, 1 << 20};
        pg::Sched<JobRowCol> S{{FB, 2, 64, 4, 0, 0, (size_t)256 * 2048, (size_t)256 * DM}, 256, F.G, bx};
        EpiFuse E{0, 0, FB, 1, args.in[0], args.in[17]};
        pg::gemm_phase<EpiFuse, pg::Sched<JobRowCol>, 1>(F.lds, g, S, E);
    PHASE_END
    }
    PHASE_BEGIN
        pg::Sched<JobFfn1> S{{FB, 64, 0}, 64 * 22, F.G, bx};
        EpiSwiglu E{0, 0, FB};
        pg::gemm_phase<EpiSwiglu, pg::Sched<JobFfn1>, 1>(F.lds, gK1024, S, E);
    PHASE_END
    PHASE_BEGIN
        pg::Sched<JobFfn2> S{{FB, 64, 0}, 64 * 4, F.G, bx};
        EpiFuse E{0, 0, FB, 2, args.in[0], args.in[20]};
        pg::gemm_phase<EpiFuse, pg::Sched<JobFfn2>, 1>(F.lds, gFfn2, S, E);
    PHASE_END
    if constexpr (DBG_TSEL >= 0) {
    PHASE_BEGIN
        const unsigned long long* ts = (const unsigned long long*)(F.ws + WS_CTL + 160000);
        if (bx == 0) { const float a = 0.1f * (float)(ts[DBG_TSEL + 1] - ts[DBG_TSEL]), b = 0.1f * (float)(ts[DBG_TSEL2 + 1] - ts[DBG_TSEL2]);
            if (F.tid == 0) ((float*)F.dout)[0] = a; for (int i = F.tid; i < 1024; i += NTHREADS) ((float*)F.dout)[1024 + i] = b; }
    PHASE_END
    }
    if constexpr (DBG_PROBE != 0) {
    PHASE_BEGIN
        if (bx == 0 && F.tid == 0) { const float e = __builtin_bit_cast(float, ((unsigned*)(F.ws + WS_CTL))[32768]); ((float*)F.dout)[0] = DBG_COUNT == 3 ? 100.0f * (float)(16u + ((((unsigned*)(F.ws + WS_CTL))[32768 + 192 + DBG_GF] + 0xC0000000u - 0xC0000000u) >> DBG_SH & 15u)) : DBG_COUNT == 2 ? 100.0f * (float)(16u + ((unsigned*)(F.ws + WS_CTL))[32768 + 128]) : DBG_COUNT ? 1000.0f + 10.0f * (float)((unsigned*)(F.ws + WS_CTL))[32768 + 64] : 1000.0f * (10.0f + log10f(e + 1e-10f)); }
    PHASE_END
    }
}

extern "C" void kernel_launch(void* const* d_in, const int* in_sizes, int n_in, void* d_out, int out_size, void* d_ws, size_t ws_size, hipStream_t stream) {
    static int grid = 0;
    if (grid == 0) {
        if (n_in != 21 || out_size != SEQ * DM || ws_size < 256 * MiB) { fprintf(stderr, "kernel_launch: unexpected shapes (n_in %d out %d ws %zu)\n", n_in, out_size, ws_size); grid = -1; return; }
        int dev = 0, cus = 0, per_cu = 0;
        if (hipGetDevice(&dev) != hipSuccess || hipDeviceGetAttribute(&cus, hipDeviceAttributeMultiprocessorCount, dev) != hipSuccess) { grid = -1; return; }
        if (hipFuncSetAttribute((const void*)fwd_kernel, hipFuncAttributeMaxDynamicSharedMemorySize, LDS_BYTES) != hipSuccess) { fprintf(stderr, "kernel_launch: hipFuncSetAttribute failed\n"); grid = -1; return; }
        if (hipOccupancyMaxActiveBlocksPerMultiprocessor(&per_cu, (const void*)fwd_kernel, NTHREADS, LDS_BYTES) != hipSuccess || per_cu < 1) { fprintf(stderr, "kernel_launch: occupancy query says %d blocks/CU\n", per_cu); }
        (void)hipGetLastError();
        grid = cus;
    }
    if (grid < 0) return;
    (void)hipMemsetAsync((char*)d_ws + WS_CTL, 0, CTL_ZERO_BYTES, stream);
    Args a{};
    for (int i = 0; i < 21; ++i) a.in[i] = (const float*)d_in[i];
    a.out = (float*)d_out; a.ws = (unsigned char*)d_ws; a.ph_lo = 0; a.ph_hi = 1000;
    hipLaunchKernelGGL(fwd_kernel, dim3(grid), dim3(NTHREADS), LDS_BYTES, stream, a);
}
```

```cpp
#include <hip/hip_runtime.h>
#include <cstdio>
#include <cstdint>

#ifndef DBG_NOFOUR
#define DBG_NOFOUR 0
#endif
#ifndef DBG_NORET
#define DBG_NORET 0
#endif
#ifndef DBG_PROBE
#define DBG_PROBE 0
#endif
#ifndef DBG_COUNT
#define DBG_COUNT 0
#ifndef DBG_COL
#define DBG_COL 736
#endif
#ifndef DBG_VAR
#define DBG_VAR 2
#endif
#ifndef DBG_SH
#define DBG_SH 0
#endif
#ifndef DBG_GF
#define DBG_GF 1
#endif
#ifndef DBG_S0
#define DBG_S0 4
#endif
#endif
#ifndef DBG_XBAR
#define DBG_XBAR 0
#endif
#ifndef DBG_DUP
#define DBG_DUP -1
#endif
#ifndef DBG_TSEL
#define DBG_TSEL -1
#endif
#ifndef DBG_TSEL2
#define DBG_TSEL2 1
#endif
#ifndef PG_ALIGN
#define PG_ALIGN 1
#endif
#ifndef STOP_AFTER
#define STOP_AFTER 99
#endif

#define LAS __attribute__((address_space(3)))
typedef unsigned short bf16_t;
typedef short bf16x8 __attribute__((ext_vector_type(8)));
typedef float f32x4 __attribute__((ext_vector_type(4)));
typedef float f32x2 __attribute__((ext_vector_type(2)));
typedef unsigned u32x4 __attribute__((ext_vector_type(4)));
typedef unsigned u32x2 __attribute__((ext_vector_type(2)));

constexpr int DM = 1024, SEQ = 16384, CTX = 256, DFF = 2816;
constexpr float EPS = 1e-6f;
constexpr int LS = 512, NSEG = SEQ / LS;

constexpr size_t MiB = 1u << 20;
constexpr size_t WS_CTL = 0, CTL_ZERO_BYTES = 1 * MiB;
constexpr size_t WS_MOD = 1 * MiB;
constexpr size_t WS_TAB = 2 * MiB;
constexpr size_t WS_STATS = 3 * MiB;
constexpr size_t WS_S0 = 4 * MiB;
constexpr size_t WS_KC = 8 * MiB;
constexpr size_t WS_VC = 9 * MiB;
constexpr size_t WS_DC = 10 * MiB;
constexpr size_t WS_HC = 12 * MiB;
constexpr size_t WS_WIN = 14 * MiB;
constexpr size_t WS_WN = 34 * MiB;
constexpr size_t WS_WB = 36 * MiB;
constexpr size_t WS_H = 54 * MiB;
constexpr size_t WS_Q = 54 * MiB, WS_KN = 70 * MiB, WS_KT = 86 * MiB, WS_B4 = 118 * MiB;
constexpr size_t WS_O = 182 * MiB;
constexpr size_t WS_END = 246 * MiB;
constexpr size_t WS_XB = 11 * MiB;
constexpr size_t WS_OUTW = 246 * MiB;
constexpr size_t WS_XCSLAB = 150 * MiB;
constexpr size_t WS_WT = 118 * MiB, WS_BT = 54 * MiB, WS_MIX = 118 * MiB, WS_GA = 54 * MiB, WS_GF = 86 * MiB;
constexpr size_t DO_AX = 32 * MiB;
constexpr int WR_G = 4096, WR_F = 6144, WR_GA = 8192, WR_GF = 9216;
constexpr size_t WB_W13 = 0, WB_W2 = 11 * MiB;
constexpr size_t WB_BZ = 0, WB_WO = 6 * MiB;
constexpr size_t TB_ROPE = 0, TB_TW = 128 * 1024, TB_FM = 256 * 1024, TB_GM = 384 * 1024, TB_T256 = 512 * 1024;

typedef __bf16 bf16x2_t __attribute__((ext_vector_type(2)));
__device__ __forceinline__ unsigned cvt_pk_bf16(float lo, float hi) { const f32x2 v = {lo, hi}; return __builtin_bit_cast(unsigned, __builtin_convertvector(v, bf16x2_t)); }
__device__ __forceinline__ unsigned short f2bf(float f) { unsigned u = __builtin_bit_cast(unsigned, f); return (unsigned short)((u + 0x7fffu + ((u >> 16) & 1u)) >> 16); }
__device__ __forceinline__ float bflo(unsigned u) { return __builtin_bit_cast(float, u << 16); }
__device__ __forceinline__ float bfhi(unsigned u) { return __builtin_bit_cast(float, u & 0xffff0000u); }
__device__ __forceinline__ u32x4 pack8(const f32x4 a, const f32x4 b) { u32x4 w; w.x = cvt_pk_bf16(a[0], a[1]); w.y = cvt_pk_bf16(a[2], a[3]); w.z = cvt_pk_bf16(b[0], b[1]); w.w = cvt_pk_bf16(b[2], b[3]); return w; }
__device__ __forceinline__ void unpack8(const u32x4 w, f32x4& a, f32x4& b) { a = (f32x4){bflo(w.x), bfhi(w.x), bflo(w.y), bfhi(w.y)}; b = (f32x4){bflo(w.z), bfhi(w.z), bflo(w.w), bfhi(w.w)}; }

__device__ __forceinline__ void st16wt(void* p, const u32x4 v) { asm volatile("global_store_dwordx4 %0, %1, off sc1\n\ts_nop 1" :: "v"(p), "v"(v) : "memory"); }
__device__ __forceinline__ float fsigmoid(float a) { return __builtin_amdgcn_rcpf(1.0f + __expf(-a)); }
__device__ __forceinline__ float fsilu(float a) { return a * fsigmoid(a); }
__device__ __forceinline__ float wave_sum(float v) {
#pragma unroll
    for (int o = 1; o < 64; o <<= 1) v += __shfl_xor(v, o);
    return v;
}

namespace pg {
constexpr int BM = 256, BK = 64, HALF = 128, HTB = HALF * BK * 2, STAGE_BYTES = 8 * HTB, NXCD = 8, WGM = 4;
__device__ __forceinline__ int lds_byte(int r, int c) { const int st = (r >> 4) * 2 + (c >> 5), rr = r & 15, cc = c & 31, ob = rr * 64 + cc * 2; return st * 1024 + (ob ^ (((ob >> 9) & 1) << 5)); }
__device__ __forceinline__ void stage_rc(int b, int& R, int& C) { const int st = b / 1024, sb = b % 1024, swz = sb ^ (((sb >> 9) & 1) << 5); R = (st >> 1) * 16 + swz / 64; C = (st & 1) * 32 + (swz % 64) / 2; }
__device__ __forceinline__ int perm32(int rho) { const int n = rho >> 4, i = rho & 15; return 8 * (i >> 2) + 4 * n + (i & 3); }

struct Unit { const char* a0; const char* a1; const char* b; char* d; int i0, i1, i2, i3; };
struct Geo { unsigned lda0, lda1, ldb;
             unsigned hsA0, hsA1, hsB;
             int nt, c0, rep0; };

__device__ __forceinline__ void tile_pm_pn(int L, int nM, int nN, int& pm, int& pn) {
    const int nwg = nM * nN; int wgid = L;
    { const int q = nwg / NXCD, r = nwg % NXCD, xcd = wgid % NXCD, off = wgid / NXCD; wgid = (xcd < r ? xcd * (q + 1) : r * (q + 1) + (xcd - r) * q) + off; }
    const int nig = WGM * nN, gid = wgid / nig, fm = gid * WGM, gsz = (nM - fm) < WGM ? (nM - fm) : WGM;
    pm = fm + ((wgid % nig) % gsz); pn = (wgid % nig) / gsz;
}
__device__ __forceinline__ int xcd_contig(int L, int n) { return (L % NXCD) * (n / NXCD) + L / NXCD; }

template <class Job> struct Sched {
    Job j; int n, G, c;
    __device__ __forceinline__ bool next(int i, Unit& u) const { const long L = (long)i * G + c; if (L >= n) return false; j.fill((int)L, u); return true; }
};

template <class Epi, class Sch, int ASEG>
__device__ __forceinline__ void gemm_phase(LAS unsigned char* lds, const Geo g, const Sch& S, const Epi& E) {
    int tid = threadIdx.x; asm volatile("" : "+v"(tid));
    const int wid = __builtin_amdgcn_readfirstlane(tid >> 6), lane = tid & 63, wr = wid >> 2, wc = wid & 3, fr = lane & 15, fq = lane >> 4;
    int nt = g.nt; asm volatile("" : "+s"(nt));
    unsigned voffA0[2], voffA1[2], voffB[2];
#pragma unroll
    for (int i = 0; i < 2; ++i) { int R, C; stage_rc(tid * 16 + i * 8192, R, C); const int Rb = (R & ~31) + perm32(R & 31);
        voffA0[i] = (unsigned)(R * g.lda0 + C) * 2u; voffA1[i] = (ASEG == 2) ? (unsigned)(R * g.lda1 + C) * 2u : 0u; voffB[i] = (unsigned)(Rb * g.ldb + C) * 2u; }
    const unsigned ldsw = (unsigned)wid * 1024u;
    const int aoff = lds_byte(wr * 64 + fr, fq * 8), boff = lds_byte(wc * 32 + fr, fq * 8);
#define PG_SA(b, h) (((b) * 2 + (h)) * HTB)
#define PG_SB(b, h) ((4 + (b) * 2 + (h)) * HTB)
#define PG_GLDS(gp, lp) __builtin_amdgcn_global_load_lds((const unsigned*)(gp), (LAS unsigned*)(lp), 16, 0, 0)
#define PG_ASEL(T) (ASEG == 2 && (T) >= g.c0)
#define PG_APTR(U, T) (PG_ASEL(T) ? (U).a1 + (size_t)((T) - g.c0) * 128 : (U).a0 + (size_t)((T) & (g.rep0 - 1)) * 128)
#define PG_STAGE_A(bufoff, gbase, h, sel) do { const bool _s = (sel); const unsigned _v0 = _s ? voffA1[0] : voffA0[0], _v1 = _s ? voffA1[1] : voffA0[1]; \
        const char* _p = (gbase) + ((h) ? (size_t)(_s ? g.hsA1 : g.hsA0) : (size_t)0); \
        PG_GLDS(_p + _v0, lds + (bufoff) + ldsw); PG_GLDS(_p + _v1, lds + (bufoff) + ldsw + 8192); } while (0)
#define PG_STAGE_B(bufoff, gbase, h) do { const char* _p = (gbase) + ((h) ? (size_t)g.hsB : (size_t)0); \
        PG_GLDS(_p + voffB[0], lds + (bufoff) + ldsw); PG_GLDS(_p + voffB[1], lds + (bufoff) + ldsw + 8192); } while (0)
#define PG_LDA(dst, b, h) do { _Pragma("unroll") for (int m = 0; m < 4; ++m) _Pragma("unroll") for (int k = 0; k < 2; ++k) dst[m][k] = *(const LAS bf16x8*)(lds + PG_SA(b, h) + aoff + m * 2048 + k * 1024); } while (0)
#define PG_LDB(dst, b, h) do { _Pragma("unroll") for (int n = 0; n < 2; ++n) _Pragma("unroll") for (int k = 0; k < 2; ++k) dst[n][k] = *(const LAS bf16x8*)(lds + PG_SB(b, h) + boff + n * 2048 + k * 1024); } while (0)
#define PG_MMA(ai, bj, At, Bt) do { __builtin_amdgcn_s_setprio(1); _Pragma("unroll") for (int m = 0; m < 4; ++m) _Pragma("unroll") for (int n = 0; n < 2; ++n) _Pragma("unroll") for (int k = 0; k < 2; ++k) \
        acc[ai][bj][m][n] = __builtin_amdgcn_mfma_f32_16x16x32_bf16(Bt[n][k], At[m][k], acc[ai][bj][m][n], 0, 0, 0); __builtin_amdgcn_s_setprio(0); } while (0)
#define PG_WAIT_V(n) asm volatile("s_waitcnt vmcnt(" #n ")" ::: "memory")
#define PG_WAIT_L(n) asm volatile("s_waitcnt lgkmcnt(" #n ")" ::: "memory")
#define PG_BAR __builtin_amdgcn_s_barrier()
#define PG_SCHED __builtin_amdgcn_sched_barrier(0)
    Unit cur, nxt; int ui = 0;
    if (!S.next(0, cur)) return;
    f32x4 acc[2][2][4][2];
#pragma unroll
    for (int a = 0; a < 2; ++a)
#pragma unroll
        for (int b = 0; b < 2; ++b)
#pragma unroll
            for (int m = 0; m < 4; ++m)
#pragma unroll
                for (int n = 0; n < 2; ++n) acc[a][b][m][n] = (f32x4){0.f, 0.f, 0.f, 0.f};
    bf16x8 At[4][2], B0[2][2], B1[2][2];
    { const char* p0 = PG_APTR(cur, 0); const char* p1 = PG_APTR(cur, 1);
      PG_STAGE_B(PG_SB(0, 0), cur.b, 0); PG_STAGE_B(PG_SB(0, 1), cur.b, 1); PG_STAGE_A(PG_SA(0, 0), p0, 0, PG_ASEL(0)); PG_STAGE_A(PG_SA(0, 1), p0, 1, PG_ASEL(0));
      if (wr == 1) PG_BAR;
      PG_WAIT_V(2); PG_BAR;
      PG_STAGE_B(PG_SB(1, 0), cur.b + 128, 0); PG_STAGE_A(PG_SA(1, 0), p1, 0, PG_ASEL(1)); PG_STAGE_B(PG_SB(1, 1), cur.b + 128, 1);
      PG_WAIT_V(6); PG_BAR; }
    for (;;) {
        const bool has_next = S.next(ui + 1, nxt);
        const char* nA0 = has_next ? PG_APTR(nxt, 0) : PG_APTR(cur, 0); const char* nA1 = has_next ? PG_APTR(nxt, 1) : PG_APTR(cur, 1); const char* nB = has_next ? nxt.b : cur.b;
        for (int t = 0; t < nt; t += 2) {
            const bool last = (t == nt - 2);
            if constexpr (Epi::NHOOK >= 1) { if (t == E.h0) { int t2 = threadIdx.x; asm volatile("" : "+v"(t2)); E.hook(acc, cur, 0, wr, wc, t2 & 15, (t2 >> 4) & 3); } }
            if constexpr (Epi::NHOOK >= 2) { if (t == E.h1) { int t2 = threadIdx.x; asm volatile("" : "+v"(t2)); E.hook(acc, cur, 1, wr, wc, t2 & 15, (t2 >> 4) & 3); } }
            const char* a1 = PG_APTR(cur, t + 1); const bool s1 = PG_ASEL(t + 1);
            const char* a2 = last ? nA0 : PG_APTR(cur, t + 2); const char* a3 = last ? nA1 : PG_APTR(cur, t + 3);
            const char* b2 = last ? nB : cur.b + (size_t)(t + 2) * 128; const char* b3 = b2 + 128;
            const bool s2 = last ? PG_ASEL(0) : PG_ASEL(t + 2), s3 = last ? PG_ASEL(1) : PG_ASEL(t + 3);
            PG_LDB(B0, 0, 0); PG_LDB(B1, 0, 1); PG_SCHED; PG_LDA(At, 0, 0); PG_STAGE_A(PG_SA(1, 1), a1, 1, s1);
            PG_WAIT_V(8); PG_WAIT_L(0); PG_BAR; PG_MMA(0, 0, At, B0); PG_MMA(0, 1, At, B1); PG_BAR; PG_SCHED;
            PG_LDA(At, 0, 1); PG_STAGE_B(PG_SB(0, 0), b2, 0); PG_STAGE_B(PG_SB(0, 1), b2, 1); PG_STAGE_A(PG_SA(0, 0), a2, 0, s2);
            PG_WAIT_V(8); PG_WAIT_L(0); PG_BAR; PG_MMA(1, 0, At, B0); PG_MMA(1, 1, At, B1); PG_BAR; PG_SCHED;
            PG_LDB(B0, 1, 0); PG_LDB(B1, 1, 1); PG_SCHED; PG_LDA(At, 1, 0); PG_STAGE_A(PG_SA(0, 1), a2, 1, s2);
            PG_WAIT_V(8); PG_WAIT_L(0); PG_BAR; PG_MMA(0, 0, At, B0); PG_MMA(0, 1, At, B1); PG_BAR; PG_SCHED;
            PG_LDA(At, 1, 1); PG_STAGE_B(PG_SB(1, 0), b3, 0); PG_STAGE_B(PG_SB(1, 1), b3, 1); PG_STAGE_A(PG_SA(1, 0), a3, 0, s3);
            PG_WAIT_V(8); PG_WAIT_L(0); PG_BAR; PG_MMA(1, 0, At, B0); PG_MMA(1, 1, At, B1); PG_BAR; PG_SCHED;
        }
        if (PG_ALIGN && wr == 0) PG_BAR;
        if constexpr (!Epi::AFTER_DRAIN) { int t2 = threadIdx.x; asm volatile("" : "+v"(t2)); E(acc, cur, wr, wc, t2 & 15, (t2 >> 4) & 3); }
        if (!has_next) break;
#pragma unroll
        for (int a = 0; a < 2; ++a)
#pragma unroll
            for (int b = 0; b < 2; ++b)
#pragma unroll
                for (int m = 0; m < 4; ++m)
#pragma unroll
                    for (int n = 0; n < 2; ++n) acc[a][b][m][n] = (f32x4){0.f, 0.f, 0.f, 0.f};
        cur = nxt; ++ui;
        if (PG_ALIGN && wr == 1) PG_BAR;
    }
    PG_WAIT_V(0);
    if (!PG_ALIGN && wr == 0) PG_BAR;
    PG_BAR;
    if constexpr (Epi::AFTER_DRAIN) { int t2 = threadIdx.x; asm volatile("" : "+v"(t2)); E.fused(acc, cur, wr, wc, t2 & 15, (t2 >> 4) & 3, lds, wid, t2 & 63); }
#undef PG_SA
#undef PG_SB
#undef PG_GLDS
#undef PG_ASEL
#undef PG_APTR
#undef PG_STAGE_A
#undef PG_STAGE_B
#undef PG_LDA
#undef PG_LDB
#undef PG_MMA
#undef PG_WAIT_V
#undef PG_WAIT_L
#undef PG_BAR
#undef PG_SCHED
}
}
using pg::Unit; using pg::Geo;

#define EPI_ROWS _Pragma("unroll") for (int ai = 0; ai < 2; ++ai) _Pragma("unroll") for (int m = 0; m < 4; ++m)
#define EPI_ROW (128 * ai + 64 * wr + 16 * m + fr)
#define EPI_COLS _Pragma("unroll") for (int bj = 0; bj < 2; ++bj)
#define EPI_COL0 (128 * bj + 32 * wc + 8 * fq)
typedef f32x4 acc_t[2][2][4][2];

struct Base { unsigned char* ws; unsigned char* dout; };
#define modx ((float*)(F.ws + WS_MOD))
#define modc (modx + 9216)
#define lgp (modx + 2 * 9216)
#define Ax ((bf16_t*)(F.dout + DO_AX))
#define Ac ((bf16_t*)(F.ws + WS_DC + 512 * 1024))
#define Dx ((bf16_t*)F.dout)
#define Dc ((bf16_t*)(F.ws + WS_DC))
#define Hb ((bf16_t*)(F.ws + WS_H))
#define Hc ((bf16_t*)(F.ws + WS_HC))
#define W13t ((bf16_t*)(F.ws + WS_WB + WB_W13))
#define W2t ((bf16_t*)(F.ws + WS_WB + WB_W2))
#define W13t1 ((bf16_t*)(F.ws + WS_O + WB_W13))
#define W2t1 ((bf16_t*)(F.ws + WS_O + WB_W2))
#define ropeT ((float*)(F.ws + WS_TAB + TB_ROPE))
#define twT ((float*)(F.ws + WS_TAB + TB_TW))
#define FmT ((bf16_t*)(F.ws + WS_TAB + TB_FM))
#define GmT ((bf16_t*)(F.ws + WS_TAB + TB_GM))
#define T256 ((bf16_t*)(F.ws + WS_TAB + TB_T256))
#define Win ((bf16_t*)(F.ws + WS_WIN))
#define Wn ((bf16_t*)(F.ws + WS_WN))
#define Bz ((bf16_t*)(F.ws + WS_OUTW))
#define WoT ((bf16_t*)(F.ws + WS_OUTW + 6 * MiB))
#define Qb ((bf16_t*)(F.ws + WS_Q))
#define Knb ((bf16_t*)(F.ws + WS_KN))
#define Ktb_ ((bf16_t*)(F.ws + WS_KT))
#define Pb Ktb_
#define B4 ((bf16_t*)(F.ws + WS_B4))
#define Ob ((bf16_t*)(F.ws + WS_O))
#define S0 ((float*)(F.ws + WS_S0))
#define stats ((float*)(F.ws + WS_STATS))
#define KcT ((bf16_t*)(F.ws + WS_KC))
#define VcT ((bf16_t*)(F.ws + WS_VC))
#define Wt ((bf16_t*)(F.ws + WS_WT))
#define Bt ((bf16_t*)(F.ws + WS_BT))
#define MIXb ((bf16_t*)(F.ws + WS_MIX))
#define GAb ((bf16_t*)(F.ws + WS_GA))
#define GFb ((bf16_t*)(F.ws + WS_GF))
#define Zb (MIXb + 1024)
#define XcSlab ((float*)(F.ws + WS_XCSLAB))

struct EpiSwiglu {
    static constexpr int NHOOK = 0; static constexpr int AFTER_DRAIN = 0; int h0, h1;
    Base F;
    __device__ __forceinline__ void hook(acc_t&, const Unit&, int, int, int, int, int) const {}
    __device__ __forceinline__ void operator()(const acc_t& acc, const Unit& u, int wr, int wc, int fr, int fq) const {
        bf16_t* base = u.i0 < 64 ? Hb + (size_t)u.i0 * 256 * DFF : Hc;
        EPI_ROWS { bf16_t* rowp = base + (size_t)EPI_ROW * DFF + u.i1 * 128 + 32 * wc + 8 * fq; f32x4 h[2];
#pragma unroll
            for (int n = 0; n < 2; ++n)
#pragma unroll
                for (int e = 0; e < 4; ++e) h[n][e] = fsilu(acc[ai][0][m][n][e]) * acc[ai][1][m][n][e];
            if (u.i0 == 64) st16wt(rowp, pack8(h[0], h[1])); else *(u32x4*)rowp = pack8(h[0], h[1]); if (m & 1) asm volatile("" ::: "memory"); }
        if (u.i0 == 64) { asm volatile("s_waitcnt vmcnt(0)" ::: "memory");
            if (fr == 0 && fq == 0) __hip_atomic_fetch_add((unsigned*)(F.ws + WS_CTL) + 24576, 1u, __ATOMIC_RELAXED, __HIP_MEMORY_SCOPE_AGENT); }
    }
};
struct EpiResid {
    static constexpr int NHOOK = 0; static constexpr int AFTER_DRAIN = 0; int h0, h1;
    Base F; int mode;
    __device__ __forceinline__ void hook(acc_t&, const Unit&, int, int, int, int, int) const {}
    __device__ __forceinline__ void operator()(const acc_t& acc, const Unit& u, int wr, int wc, int fr, int fq) const {
        const bool isx = u.i0 < 64; const int has_old = mode != 0; const float scale = mode == 1 ? 1.0f : 0.5f;
        const bf16_t* din = Dx + (size_t)u.i0 * 256 * DM; bf16_t* dout = isx ? (mode == 2 ? Ob : Dx) + (size_t)u.i0 * 256 * DM : Dc;
        const float* coef = (isx ? modx : modc) + (mode == 0 ? 2 : (mode == 1 ? 5 : 8)) * DM + u.i1 * 256;
        EPI_COLS { const int c = EPI_COL0; const f32x4 c0 = *(const f32x4*)(coef + c) * scale, c1 = *(const f32x4*)(coef + c + 4) * scale;
#pragma unroll
            for (int ai = 0; ai < 2; ++ai)
#pragma unroll
                for (int m = 0; m < 4; ++m) { const size_t off = (size_t)EPI_ROW * DM + u.i1 * 256 + c;
                    f32x4 v0 = acc[ai][bj][m][0] * c0, v1 = acc[ai][bj][m][1] * c1;
                    if (has_old) { f32x4 o0, o1; unpack8(*(const u32x4*)(din + off), o0, o1); v0 += o0; v1 += o1; }
                    *(u32x4*)(dout + off) = pack8(v0, v1); if (m & 1) asm volatile("" ::: "memory"); } }
    }
};

struct EpiFuse {
    static constexpr int NHOOK = 0; static constexpr int AFTER_DRAIN = 1; int h0, h1; Base F; int mode; const float* x; const float* nw;
    __device__ __forceinline__ void hook(acc_t&, const Unit&, int, int, int, int, int) const {}
    __device__ __forceinline__ void operator()(const acc_t&, const Unit&, int, int, int, int) const {}
    __device__ __forceinline__ void fused(acc_t& acc, const Unit& u, int wr, int wc, int fr, int fq, LAS unsigned char* lds, int wid, int lane) const {
        const int pm = u.i0, pn = u.i1; const float scale = mode == 1 ? 1.0f : 0.5f;
        const float* coef = modx + (mode == 0 ? 2 : (mode == 1 ? 5 : 8)) * DM + pn * 256;
        const bf16_t* din = (mode == 2 ? Ob : Dx) + (size_t)pm * 256 * DM + pn * 256; bf16_t* dout = (mode == 1 ? Ob : Dx) + (size_t)pm * 256 * DM + pn * 256;
        const float* xt = x + (size_t)pm * 256 * DM + pn * 256;
        LAS float* P = (LAS float*)lds; LAS float* S = (LAS float*)(lds + 4096);
        f32x4 cf[2][2];
#pragma unroll
        for (int bj = 0; bj < 2; ++bj) { cf[bj][0] = *(const f32x4*)(coef + EPI_COL0) * scale; cf[bj][1] = *(const f32x4*)(coef + EPI_COL0 + 4) * scale; }
#pragma unroll
        for (int aim = 0; aim < 4; ++aim) { const int ai = aim >> 1; f32x4 xv[4][2][2]; u32x4 ov[4][2];
#pragma unroll
            for (int m = 2 * (aim & 1); m < 2 * (aim & 1) + 2; ++m) EPI_COLS { const size_t off = (size_t)EPI_ROW * DM + EPI_COL0; xv[m][bj][0] = *(const f32x4*)(xt + off); xv[m][bj][1] = *(const f32x4*)(xt + off + 4); if (mode != 0) ov[m][bj] = *(const u32x4*)(din + off); }
#pragma unroll
            for (int m = 2 * (aim & 1); m < 2 * (aim & 1) + 2; ++m) { const int row = EPI_ROW; float ss = 0.f;
                EPI_COLS { const size_t off = (size_t)row * DM + EPI_COL0; f32x4 d0 = acc[ai][bj][m][0] * cf[bj][0], d1 = acc[ai][bj][m][1] * cf[bj][1];
                    if (mode != 0) { f32x4 o0, o1; unpack8(ov[m][bj], o0, o1); d0 += o0; d1 += o1; }
                    if (mode != 2) *(u32x4*)(dout + off) = pack8(d0, d1);
                    const f32x4 v0 = xv[m][bj][0] + d0, v1 = xv[m][bj][1] + d1; acc[ai][bj][m][0] = v0; acc[ai][bj][m][1] = v1;
                    ss += (v0[0] * v0[0] + v0[1] * v0[1]) + (v0[2] * v0[2] + v0[3] * v0[3]) + (v1[0] * v1[0] + v1[1] * v1[1]) + (v1[2] * v1[2] + v1[3] * v1[3]); }
                ss += __shfl_xor(ss, 16); ss += __shfl_xor(ss, 32);
                if (fq == 0) P[row * 4 + wc] = ss; }
            asm volatile("" ::: "memory"); }
        asm volatile("s_waitcnt lgkmcnt(0)" ::: "memory"); __builtin_amdgcn_s_barrier(); asm volatile("" ::: "memory");
        float* xb = (float*)(F.ws + WS_XB) + (size_t)mode * 64 * 256 * 4; unsigned* cnt = (unsigned*)(F.ws + WS_CTL) + 8192 + mode * 4096 + 64 * pm;
        const int prow = wid * 32 + (lane & 31);
        if (lane < 32) { const float t = (P[prow * 4 + 0] + P[prow * 4 + 1]) + (P[prow * 4 + 2] + P[prow * 4 + 3]);
            __hip_atomic_store(xb + ((size_t)(pm * 256 + prow) * 4 + pn), t, __ATOMIC_RELAXED, __HIP_MEMORY_SCOPE_AGENT); }
        asm volatile("s_waitcnt vmcnt(0)" ::: "memory");
        if (lane == 0) __hip_atomic_fetch_add(cnt, 1u, __ATOMIC_RELAXED, __HIP_MEMORY_SCOPE_AGENT);
        if (wid == 0) { unsigned sp = 0;
            while ((unsigned)__builtin_amdgcn_readfirstlane(__hip_atomic_load(cnt, __ATOMIC_RELAXED, __HIP_MEMORY_SCOPE_AGENT)) < 32u) { __builtin_amdgcn_s_sleep(2); if (++sp > (1u << 22)) break; }
            __builtin_amdgcn_fence(__ATOMIC_ACQUIRE, "agent"); }
        asm volatile("s_waitcnt vmcnt(0) lgkmcnt(0)" ::: "memory"); __builtin_amdgcn_s_barrier(); asm volatile("" ::: "memory");
        if (lane < 32) { const float* sl = xb + (size_t)(pm * 256 + prow) * 4; float t = 0.f;
#pragma unroll
            for (int q = 0; q < 4; ++q) t += __hip_atomic_load(sl + q, __ATOMIC_RELAXED, __HIP_MEMORY_SCOPE_AGENT);
            S[prow] = 1.0f / sqrtf(t * (1.0f / DM) + EPS); }
        asm volatile("s_waitcnt lgkmcnt(0)" ::: "memory"); __builtin_amdgcn_s_barrier(); asm volatile("" ::: "memory");
        const float* md = modx + (mode == 0 ? 3 : 6) * DM + pn * 256; const float* nwp = nw + pn * 256;
        f32x4 wv[2][2], shv[2][2];
#pragma unroll
        for (int bj = 0; bj < 2; ++bj)
#pragma unroll
            for (int n = 0; n < 2; ++n) { const int c = EPI_COL0 + 4 * n; const f32x4 w = *(const f32x4*)(nwp + c);
                if (mode == 2) { wv[bj][n] = w; shv[bj][n] = (f32x4){0.f, 0.f, 0.f, 0.f}; } else { wv[bj][n] = w * (*(const f32x4*)(md + DM + c) + 1.0f); shv[bj][n] = *(const f32x4*)(md + c); } }
        EPI_ROWS { const int row = EPI_ROW; const float rinv = S[row];
            EPI_COLS { const size_t off = (size_t)row * DM + EPI_COL0;
                const f32x4 y0 = (acc[ai][bj][m][0] * rinv) * wv[bj][0] + shv[bj][0], y1 = (acc[ai][bj][m][1] * rinv) * wv[bj][1] + shv[bj][1];
                if (mode == 2) { float* o = (float*)F.dout + (size_t)pm * 256 * DM + pn * 256 + off; *(f32x4*)o = y0; *(f32x4*)(o + 4) = y1; }
                else *(u32x4*)(Ax + (size_t)pm * 256 * DM + pn * 256 + off) = pack8(y0, y1); } }
        asm volatile("s_waitcnt lgkmcnt(0)" ::: "memory"); __builtin_amdgcn_s_barrier(); asm volatile("" ::: "memory");
    }
};
struct JobFfn1 {
    Base F; int nM, first;
    __device__ __forceinline__ void fill(int L, Unit& u) const { int pm, pn; if (first) { if (L < 22) { pm = 64; pn = L; } else pg::tile_pm_pn(L - 22, 64, 22, pm, pn); } else pg::tile_pm_pn(L, nM, 22, pm, pn);
        u.a0 = (const char*)(pm < 64 ? Ax + (size_t)pm * 256 * DM : Ac); u.a1 = u.a0; u.b = (const char*)((first ? W13t1 : W13t) + (size_t)pn * 256 * DM); u.d = nullptr; u.i0 = pm; u.i1 = pn; u.i2 = 0; u.i3 = 0; }
};
struct JobFfn2 {
    Base F; int nM, first;
    __device__ __forceinline__ void fill(int L, Unit& u) const { int pm, pn; pg::tile_pm_pn(L, nM, 4, pm, pn);
        u.a0 = (const char*)(pm < 64 ? Hb + (size_t)pm * 256 * DFF : Hc); u.a1 = u.a0; u.b = (const char*)((first ? W2t1 : W2t) + (size_t)pn * 256 * DFF); u.d = nullptr; u.i0 = pm; u.i1 = pn; u.i2 = 0; u.i3 = 0; }
};

struct EpiStore {
    static constexpr int NHOOK = 0; static constexpr int AFTER_DRAIN = 0; int h0, h1; int ldd;
    __device__ __forceinline__ void hook(acc_t&, const Unit&, int, int, int, int, int) const {}
    __device__ __forceinline__ void operator()(const acc_t& acc, const Unit& u, int wr, int wc, int fr, int fq) const {
        bf16_t* d = (bf16_t*)u.d;
        EPI_ROWS { EPI_COLS { *(u32x4*)(d + (size_t)EPI_ROW * ldd + EPI_COL0) = pack8(acc[ai][bj][m][0], acc[ai][bj][m][1]); }  asm volatile("" ::: "memory"); }
    }
};
struct EpiQK {
    static constexpr int NHOOK = 0; static constexpr int AFTER_DRAIN = 1; int h0, h1;
    Base F; int pair;
    __device__ __forceinline__ void hook(acc_t&, const Unit&, int, int, int, int, int) const {}
    __device__ __forceinline__ void operator()(const acc_t&, const Unit&, int, int, int, int) const {}
    __device__ __forceinline__ void fused(acc_t& acc, const Unit& u, int wr, int wc, int fr, int fq, LAS unsigned char* lds, int wid, int lane) const {
        const int pm = u.i0, pn = u.i1, hl = pn & 1, h = 2 * pair + hl; const bool isk = pn >= 2; const float lgf = lgp[h], lgb = lgp[4 + h]; const float* rope = ropeT;
        constexpr int PITCH = 528;
        const int tid = wid * 64 + lane, p8 = tid & 31;
        float zf[8], zb[8];
#pragma unroll
        for (int e = 0; e < 8; ++e) { const int jl = (pm * 256 + p8 * 8 + e) & (LS - 1); zf[e] = __expf(lgf * (float)(LS - 1 - jl)); zb[e] = __expf(lgb * (float)jl); }
#pragma unroll
        for (int bj = 0; bj < 2; ++bj) {
            EPI_ROWS { const int row = EPI_ROW, pos = pm * 256 + row, prow = pos >> 6, pcol = pos & 63;
                const int d0 = EPI_COL0, i0 = d0 >> 1, p = i0 < 64 ? prow : pcol, f0 = i0 & 63;
                const f32x4 t0 = *(const f32x4*)(rope + (size_t)(p * 64 + f0) * 2), t1 = *(const f32x4*)(rope + (size_t)(p * 64 + f0) * 2 + 4);
                f32x4 a = acc[ai][bj][m][0], b = acc[ai][bj][m][1];
                if (!isk) { a *= 0.0625f; b *= 0.0625f; }
                const f32x4 ra = {a[0] * t0[0] - a[1] * t0[1], a[0] * t0[1] + a[1] * t0[0], a[2] * t0[2] - a[3] * t0[3], a[2] * t0[3] + a[3] * t0[2]};
                const f32x4 rb = {b[0] * t1[0] - b[1] * t1[1], b[0] * t1[1] + b[1] * t1[0], b[2] * t1[2] - b[3] * t1[3], b[2] * t1[3] + b[3] * t1[2]};
                const u32x4 pk = pack8(ra, rb);
                if (!isk) *(u32x4*)(Qb + (size_t)pos * 512 + hl * 256 + d0) = pk;
                else { *(u32x4*)(Knb + (size_t)pos * 512 + hl * 256 + d0) = pk;
                    LAS unsigned short* tp = (LAS unsigned short*)(lds + (32 * wc + 8 * fq) * PITCH + row * 2);
                    tp[0 * PITCH / 2] = (unsigned short)pk.x; tp[1 * PITCH / 2] = (unsigned short)(pk.x >> 16); tp[2 * PITCH / 2] = (unsigned short)pk.y; tp[3 * PITCH / 2] = (unsigned short)(pk.y >> 16);
                    tp[4 * PITCH / 2] = (unsigned short)pk.z; tp[5 * PITCH / 2] = (unsigned short)(pk.z >> 16); tp[6 * PITCH / 2] = (unsigned short)pk.w; tp[7 * PITCH / 2] = (unsigned short)(pk.w >> 16); }
                if (m & 1) asm volatile("" ::: "memory"); }
            if (isk) {
                asm volatile("s_waitcnt lgkmcnt(0)" ::: "memory"); __builtin_amdgcn_s_barrier(); asm volatile("" ::: "memory");
#pragma unroll
                for (int k = 0; k < 8; ++k) { const int dl = (tid >> 5) + 16 * k;
                    f32x4 v0, v1; unpack8(*(const LAS u32x4*)(lds + dl * PITCH + p8 * 16), v0, v1);
                    const f32x4 f0v = {v0[0] * zf[0], v0[1] * zf[1], v0[2] * zf[2], v0[3] * zf[3]}, f1v = {v1[0] * zf[4], v1[1] * zf[5], v1[2] * zf[6], v1[3] * zf[7]};
                    const f32x4 b0v = {v0[0] * zb[0], v0[1] * zb[1], v0[2] * zb[2], v0[3] * zb[3]}, b1v = {v1[0] * zb[4], v1[1] * zb[5], v1[2] * zb[6], v1[3] * zb[7]};
                    const size_t o = (size_t)(hl * 256 + bj * 128 + dl) * SEQ + pm * 256 + p8 * 8;
                    *(u32x4*)(Ktb_ + o) = pack8(f0v, f1v); *(u32x4*)(Ktb_ + (size_t)512 * SEQ + o) = pack8(b0v, b1v); }
                asm volatile("s_waitcnt lgkmcnt(0)" ::: "memory"); __builtin_amdgcn_s_barrier(); asm volatile("" ::: "memory");
            }
        }
    }
};
struct EpiVT {
    static constexpr int NHOOK = 0; static constexpr int AFTER_DRAIN = 0; int h0, h1; Base F;
    __device__ __forceinline__ void hook(acc_t&, const Unit&, int, int, int, int, int) const {}
    __device__ __forceinline__ void operator()(const acc_t& acc, const Unit& u, int wr, int wc, int fr, int fq) const {
        const int hl = u.i0 >> 1, vt = u.i0 & 1, pn = u.i1;
        EPI_ROWS { const int v = vt * 256 + EPI_ROW;
            EPI_COLS { const int pos = pn * 256 + EPI_COL0, seg = pos >> 9, jl = pos & (LS - 1);
                *(u32x4*)(B4 + ((size_t)((hl * NSEG + seg) * 512 + v)) * 1024 + 512 + jl) = pack8(acc[ai][bj][m][0], acc[ai][bj][m][1]); }  asm volatile("" ::: "memory"); }
    }
};
struct EpiKc {
    static constexpr int NHOOK = 0; static constexpr int AFTER_DRAIN = 0; int h0, h1; Base F;
    __device__ __forceinline__ void hook(acc_t&, const Unit&, int, int, int, int, int) const {}
    __device__ __forceinline__ void operator()(const acc_t& acc, const Unit& u, int wr, int wc, int fr, int fq) const {
        const int h = u.i1; const float lgf = lgp[h], lgb = lgp[4 + h]; bf16_t* Kcf = KcT; bf16_t* Kcb = KcT + (size_t)1024 * CTX;
        EPI_ROWS { const int j = EPI_ROW; const float zf = __expf(lgf * (float)(CTX - 1 - j)), zb = __expf(lgb * (float)j);
            EPI_COLS { const int d0 = EPI_COL0;
#pragma unroll
                for (int e = 0; e < 8; ++e) { const float v = acc[ai][bj][m][e >> 2][e & 3]; const size_t o = (size_t)(h * 256 + d0 + e) * CTX + j;
                    Kcf[o] = f2bf(v * zf); Kcb[o] = f2bf(v * zb); } }  asm volatile("" ::: "memory"); }
    }
};
struct EpiVc {
    static constexpr int NHOOK = 0; static constexpr int AFTER_DRAIN = 0; int h0, h1; Base F;
    __device__ __forceinline__ void hook(acc_t&, const Unit&, int, int, int, int, int) const {}
    __device__ __forceinline__ void operator()(const acc_t& acc, const Unit& u, int wr, int wc, int fr, int fq) const {
        const int h = u.i0 >> 1, vt = u.i0 & 1;
        EPI_ROWS { const int v = vt * 256 + EPI_ROW;
            EPI_COLS { *(u32x4*)(VcT + (size_t)(h * 512 + v) * CTX + EPI_COL0) = pack8(acc[ai][bj][m][0], acc[ai][bj][m][1]); }  asm volatile("" ::: "memory"); }
    }
};
struct EpiS0 {
    static constexpr int NHOOK = 0; static constexpr int AFTER_DRAIN = 0; int h0, h1; Base F;
    __device__ __forceinline__ void hook(acc_t&, const Unit&, int, int, int, int, int) const {}
    __device__ __forceinline__ void operator()(const acc_t& acc, const Unit& u, int wr, int wc, int fr, int fq) const {
        EPI_ROWS { float* rowp = S0 + ((size_t)((u.i0 * 2 + u.i1) * 512 + u.i3 * 256 + EPI_ROW)) * 256;
            EPI_COLS { *(f32x4*)(rowp + EPI_COL0) = acc[ai][bj][m][0]; *(f32x4*)(rowp + EPI_COL0 + 4) = acc[ai][bj][m][1]; }  asm volatile("" ::: "memory"); }
    }
};
struct EpiU {
    static constexpr int NHOOK = 0; static constexpr int AFTER_DRAIN = 0; int h0, h1; Base F;
    __device__ __forceinline__ void hook(acc_t&, const Unit&, int, int, int, int, int) const {}
    __device__ __forceinline__ void operator()(const acc_t& acc, const Unit& u, int wr, int wc, int fr, int fq) const {
        EPI_ROWS { bf16_t* rowp = B4 + ((size_t)((u.i0 * NSEG + u.i2) * 512 + u.i3 * 256 + EPI_ROW)) * 1024 + u.i1 * 256;
            EPI_COLS { *(u32x4*)(rowp + EPI_COL0) = pack8(acc[ai][bj][m][0], acc[ai][bj][m][1]); }  asm volatile("" ::: "memory"); }
    }
};
struct EpiP {
    static constexpr int NHOOK = 0; static constexpr int AFTER_DRAIN = 0; int h0, h1; Base F; int pair;
    __device__ __forceinline__ void hook(acc_t&, const Unit&, int, int, int, int, int) const {}
    __device__ __forceinline__ void operator()(const acc_t& acc, const Unit& u, int wr, int wc, int fr, int fq) const {
        const int hl = u.i0, seg = u.i1, it = u.i2, jt = u.i3, h = 2 * pair + hl; const float l2f = lgp[h] * 1.44269504f, l2b = lgp[4 + h] * 1.44269504f;
        EPI_ROWS { const int il = it * 256 + EPI_ROW; bf16_t* rowp = Pb + (size_t)(seg * LS + il) * 1024 + hl * 512 + jt * 256;
            EPI_COLS { const int j0 = jt * 256 + EPI_COL0; f32x4 v[2];
#pragma unroll
                for (int e = 0; e < 8; ++e) { const int dl = il - (j0 + e); const float w = dl > 0 ? __builtin_amdgcn_exp2f((float)dl * l2f) : (dl < 0 ? __builtin_amdgcn_exp2f((float)(-dl) * l2b) : 2.0f);
                    v[e >> 2][e & 3] = acc[ai][bj][m][e >> 2][e & 3] * w; }
                *(u32x4*)(rowp + EPI_COL0) = pack8(v[0], v[1]); }  asm volatile("" ::: "memory"); }
    }
};
struct EpiO {
    static constexpr int NHOOK = 2; static constexpr int AFTER_DRAIN = 0; int h0, h1; Base F; int pair;
    __device__ __forceinline__ void hook(acc_t& acc, const Unit& u, int k, int wr, int wc, int fr, int fq) const {
        const int h = 2 * pair + u.i0; const float lgf = lgp[h], lgb = lgp[4 + h];
        EPI_ROWS { const int il = u.i2 * 256 + EPI_ROW; const float eb = lgb * (float)(LS - il);
            const float f = k == 0 ? __expf(lgf * (float)(il + 1) - eb) : __expf(eb);
#pragma unroll
            for (int bj = 0; bj < 2; ++bj) { acc[ai][bj][m][0] *= f; acc[ai][bj][m][1] *= f; }  asm volatile("" ::: "memory"); }
    }
    __device__ __forceinline__ void operator()(const acc_t& acc, const Unit& u, int wr, int wc, int fr, int fq) const {
        const int h = 2 * pair + u.i0;
        EPI_ROWS { bf16_t* rowp = Ob + (size_t)(u.i1 * LS + u.i2 * 256 + EPI_ROW) * 2048 + h * 512 + u.i3 * 256;
            EPI_COLS { *(u32x4*)(rowp + EPI_COL0) = pack8(acc[ai][bj][m][0], acc[ai][bj][m][1]); }  asm volatile("" ::: "memory"); }
    }
};
struct EpiG {
    static constexpr int NHOOK = 0; static constexpr int AFTER_DRAIN = 0; int h0, h1; Base F; const float* gnw; int rep; LAS unsigned char* stl;
    __device__ __forceinline__ void hook(acc_t&, const Unit&, int, int, int, int, int) const {}
    __device__ __forceinline__ void operator()(const acc_t& acc, const Unit& u, int wr, int wc, int fr, int fq) const {
        const int pm = u.i0, pn = u.i1, h = pn >> 1; u32x4 ov[1][4][2]; f32x2 st[1][4]; f32x4 gw[2][2];
#pragma unroll
        for (int bj = 0; bj < 2; ++bj) { gw[bj][0] = *(const f32x4*)(gnw + pn * 256 + EPI_COL0); gw[bj][1] = *(const f32x4*)(gnw + pn * 256 + EPI_COL0 + 4); }
#pragma unroll
        for (int ai = 0; ai < 2; ++ai) {
#pragma unroll
        for (int m = 0; m < 4; ++m) { const int pos = pm * 256 + EPI_ROW; st[0][m] = *(const LAS f32x2*)(stl + EPI_ROW * 8);
            EPI_COLS { ov[0][m][bj] = *(const u32x4*)(Ob + (size_t)pos * 2048 + pn * 256 + EPI_COL0); } }
#pragma unroll
        for (int m = 0; m < 4; ++m) { const int pos = pm * 256 + EPI_ROW; const f32x2 s2 = st[0][m];
            EPI_COLS { bf16_t* p = Ob + (size_t)pos * 2048 + pn * 256 + EPI_COL0; f32x4 o0, o1; unpack8(ov[0][m][bj], o0, o1);
                const f32x4 g0 = acc[ai][bj][m][0], g1 = acc[ai][bj][m][1]; f32x4 r0, r1;
#pragma unroll
                for (int e = 0; e < 4; ++e) { r0[e] = DBG_NORET ? 0.f : fsilu(g0[e]) * ((o0[e] - s2.x) * s2.y) * gw[bj][0][e]; r1[e] = DBG_NORET ? 0.f : fsilu(g1[e]) * ((o1[e] - s2.x) * s2.y) * gw[bj][1][e]; }
                *(u32x4*)p = rep == 0 ? pack8(r0, r1) : ov[0][m][bj]; } }
        asm volatile("" ::: "memory"); }
    }
};
struct EpiF {
    static constexpr int NHOOK = 0; static constexpr int AFTER_DRAIN = 0; int h0, h1; Base F;
    __device__ __forceinline__ void hook(acc_t&, const Unit&, int, int, int, int, int) const {}
    __device__ __forceinline__ void operator()(const acc_t& acc, const Unit& u, int wr, int wc, int fr, int fq) const {
        EPI_ROWS { const int mrow = u.i0 * 256 + EPI_ROW, ri = mrow >> 10, ch = mrow & 1023;
            EPI_COLS { const int c0 = EPI_COL0, l2 = 2 * u.i1 + (c0 >> 7), l1 = c0 & 127;
                *(u32x4*)(Wt + (size_t)(ch * 128 + l2) * 256 + ri * 128 + l1) = pack8(acc[ai][bj][m][0], acc[ai][bj][m][1]); }  asm volatile("" ::: "memory"); }
    }
};
struct EpiF1 {
    static constexpr int NHOOK = 0; static constexpr int AFTER_DRAIN = 0; int h0, h1; Base F;
    __device__ __forceinline__ void hook(acc_t&, const Unit&, int, int, int, int, int) const {}
    __device__ __forceinline__ void operator()(const acc_t& acc, const Unit& u, int wr, int wc, int fr, int fq) const {
        EPI_ROWS { const int r = EPI_ROW, k1 = r >> 1, ri = r & 1; const float sg = ri ? -1.0f : 1.0f;
            EPI_COLS { const int n = u.i1 * 256 + EPI_COL0, ch = n >> 7, l2 = n & 127; f32x4 v[2];
#pragma unroll
                for (int e = 0; e < 8; ++e) { const float rev = (float)((k1 * (l2 + e)) & 16383) * (1.0f / 16384.0f);
                    const float cs = __builtin_amdgcn_cosf(rev), sn = __builtin_amdgcn_sinf(rev); const float mine = acc[ai][bj][m][e >> 2][e & 3], other = __shfl_xor(mine, 1);
                    v[e >> 2][e & 3] = mine * cs + sg * other * sn; }
                *(u32x4*)(Bt + (size_t)(k1 * 1024 + ch) * 256 + ri * 128 + l2) = pack8(v[0], v[1]); }  asm volatile("" ::: "memory"); }
    }
};
struct EpiF2 {
    static constexpr int NHOOK = 0; static constexpr int AFTER_DRAIN = 0; int h0, h1; Base F;
    __device__ __forceinline__ void hook(acc_t&, const Unit&, int, int, int, int, int) const {}
    __device__ __forceinline__ void operator()(const acc_t& acc, const Unit& u, int wr, int wc, int fr, int fq) const {
        const int k1 = u.i1 >> 2, chb = (u.i1 & 3) * 256;
#pragma unroll
        for (int m = 0; m < 4; ++m) { const int k2 = 64 * wr + 16 * m + fr; bf16_t* rowp = MIXb + (size_t)(k1 + 128 * k2) * 2048 + chb;
            EPI_COLS { *(u32x4*)(rowp + EPI_COL0) = pack8(acc[0][bj][m][0], acc[0][bj][m][1]); } }
    }
};
struct EpiGate {
    static constexpr int NHOOK = 0; static constexpr int AFTER_DRAIN = 0; int h0, h1; Base F;
    __device__ __forceinline__ void hook(acc_t&, const Unit&, int, int, int, int, int) const {}
    __device__ __forceinline__ void operator()(const acc_t& acc, const Unit& u, int wr, int wc, int fr, int fq) const {
        bf16_t* dst = (u.i1 >> 2) ? GFb : GAb; const int cb = (u.i1 & 3) * 256;
        EPI_ROWS { bf16_t* rowp = dst + (size_t)(u.i0 * 256 + EPI_ROW) * DM + cb;
            EPI_COLS { f32x4 s0, s1;
#pragma unroll
                for (int e = 0; e < 4; ++e) { s0[e] = fsigmoid(acc[ai][bj][m][0][e]); s1[e] = fsigmoid(acc[ai][bj][m][1][e]); }
                *(u32x4*)(rowp + EPI_COL0) = pack8(s0, s1); }  asm volatile("" ::: "memory"); }
    }
};
struct EpiZ {
    static constexpr int NHOOK = 1; static constexpr int AFTER_DRAIN = 0; int h0, h1; Base F;
    __device__ __forceinline__ void hook(acc_t& acc, const Unit& u, int, int wr, int wc, int fr, int fq) const {
        EPI_ROWS { const size_t ro = (size_t)(u.i0 * 256 + EPI_ROW) * DM + u.i1 * 256;
            EPI_COLS { f32x4 a0, a1, f0, f1; unpack8(*(const u32x4*)(GAb + ro + EPI_COL0), a0, a1); unpack8(*(const u32x4*)(GFb + ro + EPI_COL0), f0, f1);
#pragma unroll
                for (int e = 0; e < 4; ++e) { acc[ai][bj][m][0][e] *= DBG_NOFOUR ? 0.f : f0[e] * __builtin_amdgcn_rcpf(fmaxf(a0[e], 1e-30f)); acc[ai][bj][m][1][e] *= DBG_NOFOUR ? 0.f : f1[e] * __builtin_amdgcn_rcpf(fmaxf(a1[e], 1e-30f)); } }  asm volatile("" ::: "memory"); }
    }
    __device__ __forceinline__ void operator()(const acc_t& acc, const Unit& u, int wr, int wc, int fr, int fq) const {
        EPI_ROWS { const size_t ro = (size_t)(u.i0 * 256 + EPI_ROW) * DM + u.i1 * 256;
            EPI_COLS { f32x4 a0, a1; unpack8(*(const u32x4*)(GAb + ro + EPI_COL0), a0, a1); f32x4 v0, v1;
#pragma unroll
                for (int e = 0; e < 4; ++e) { v0[e] = acc[ai][bj][m][0][e] * fmaxf(a0[e], 1e-30f); v1[e] = acc[ai][bj][m][1][e] * fmaxf(a1[e], 1e-30f); }
                *(u32x4*)(Zb + ro + EPI_COL0) = pack8(v0, v1); }  asm volatile("" ::: "memory"); }
    }
};

struct EpiSlab {
    static constexpr int NHOOK = 0; static constexpr int AFTER_DRAIN = 0; int h0, h1; Base F;
    __device__ __forceinline__ void hook(acc_t&, const Unit&, int, int, int, int, int) const {}
    __device__ __forceinline__ void operator()(const acc_t& acc, const Unit& u, int wr, int wc, int fr, int fq) const {
        float* dst = XcSlab + (size_t)u.i2 * CTX * DM + u.i1 * 256;
        EPI_ROWS { float* rowp = dst + (size_t)EPI_ROW * DM;
            EPI_COLS { *(f32x4*)(rowp + EPI_COL0) = acc[ai][bj][m][0]; *(f32x4*)(rowp + EPI_COL0 + 4) = acc[ai][bj][m][1]; } }
    }
};
struct JobCtxG2 {
    Base F;
    __device__ __forceinline__ void fill(int L, Unit& u) const { const int pn = L & 3, kc = L >> 2;
        u.a0 = (const char*)(Hc + kc * 256); u.a1 = u.a0; u.b = (const char*)(W2t1 + (size_t)pn * 256 * DFF + kc * 256); u.d = nullptr; u.i0 = 64; u.i1 = pn; u.i2 = kc; u.i3 = 0; }
};
struct EpiZ2 {
    static constexpr int NHOOK = 0; static constexpr int AFTER_DRAIN = 0; int h0, h1; Base F; int part;
    __device__ __forceinline__ void hook(acc_t&, const Unit&, int, int, int, int, int) const {}
    __device__ __forceinline__ void operator()(const acc_t& acc, const Unit& u, int wr, int wc, int fr, int fq) const {
        const bf16_t* G = part ? GAb : GFb;
#pragma unroll
        for (int ai = 0; ai < 2; ++ai) { u32x4 gv[4][2], tv[4][2];
#pragma unroll
            for (int m = 0; m < 4; ++m) { const size_t ro = (size_t)(u.i0 * 256 + EPI_ROW) * DM + u.i1 * 256, zo = (size_t)(u.i0 * 256 + EPI_ROW) * 2048 + u.i1 * 256;
                EPI_COLS { gv[m][bj] = *(const u32x4*)(G + ro + EPI_COL0); if (part) tv[m][bj] = *(const u32x4*)(Zb + zo + EPI_COL0); } }
#pragma unroll
            for (int m = 0; m < 4; ++m) { const size_t zo = (size_t)(u.i0 * 256 + EPI_ROW) * 2048 + u.i1 * 256;
                EPI_COLS { f32x4 g0, g1; unpack8(gv[m][bj], g0, g1); f32x4 v0 = acc[ai][bj][m][0] * g0, v1 = acc[ai][bj][m][1] * g1;
                    if (part) { f32x4 t0, t1; unpack8(tv[m][bj], t0, t1); v0 += t0; v1 += t1; }
                    *(u32x4*)(Zb + zo + EPI_COL0) = pack8(v0, v1); } }
            asm volatile("" ::: "memory"); }
    }
};
struct JobGate2 {
    Base F;
    __device__ __forceinline__ void fill(int L, Unit& u) const { const int c = L & 255, which = L >> 8; int pm, pn; pg::tile_pm_pn(c, 64, 4, pm, pn);
        u.a0 = (const char*)(Ax + (size_t)pm * 256 * DM); u.a1 = u.a0; u.b = (const char*)(Win + (size_t)(WR_GA + which * 1024 + pn * 256) * DM); u.d = nullptr; u.i0 = pm; u.i1 = which * 4 + pn; u.i2 = 0; u.i3 = 0; }
};
struct JobG2 {
    Base F;
    __device__ __forceinline__ void fill(int L, Unit& u) const { const int c = L & 255, half = L >> 8, pm = c >> 2, pn = 2 * (c & 3) + half;
        u.a0 = (const char*)(Ax + (size_t)pm * 256 * DM); u.a1 = u.a0; u.b = (const char*)(Win + (size_t)(WR_G + pn * 256) * DM); u.d = nullptr; u.i0 = pm; u.i1 = pn; u.i2 = 0; u.i3 = 0; }
};
struct JobFold {
    Base F;
    __device__ __forceinline__ void fill(int L, Unit& u) const { const int pn = L & 3, pm = (L >> 2) & 1, g = L >> 3;
        u.a0 = (const char*)(T256 + (size_t)pm * 256 * 256); u.a1 = u.a0; u.b = (const char*)(Wn + (size_t)pn * 256 * DM + g * 256);
        u.d = (char*)(Win + (size_t)(WR_F + pm * 1024 + g * 256) * DM + pn * 256); u.i0 = pm; u.i1 = pn; u.i2 = g; u.i3 = 0; }
};
struct JobRowCol {
    Base F; int sel, nM, nN; size_t aoff0, boff0, astep, bstep;
    __device__ __forceinline__ void fill(int L, Unit& u) const { int pm, pn; pg::tile_pm_pn(L, nM, nN, pm, pn);
        const bf16_t* A = sel == 0 ? Ax : (sel == 1 ? Win : Zb); const bf16_t* B = sel == 0 ? Win : (sel == 1 ? Ax : WoT);
        u.a0 = (const char*)(A + aoff0 + (size_t)pm * astep); u.a1 = u.a0; u.b = (const char*)(B + boff0 + (size_t)pn * bstep); u.d = nullptr; u.i0 = pm; u.i1 = pn; u.i2 = 0; u.i3 = 0; }
};
struct JobKc {
    Base F;
    __device__ __forceinline__ void fill(int L, Unit& u) const { const int h = L; u.a0 = (const char*)Ac; u.a1 = u.a0;
        u.b = (const char*)(Win + (size_t)((h >> 1) * 2048 + 512 + (h & 1) * 256) * DM); u.d = nullptr; u.i0 = 0; u.i1 = h; u.i2 = 0; u.i3 = 0; }
};
struct JobVc {
    Base F;
    __device__ __forceinline__ void fill(int L, Unit& u) const { const int t = L, h = t >> 1; u.a0 = (const char*)(Win + (size_t)((h >> 1) * 2048 + 1024 + (h & 1) * 512 + (t & 1) * 256) * DM); u.a1 = u.a0;
        u.b = (const char*)Ac; u.d = nullptr; u.i0 = t; u.i1 = 0; u.i2 = 0; u.i3 = 0; }
};
struct JobS0 {
    Base F;
    __device__ __forceinline__ void fill(int L, Unit& u) const { const int h = L >> 2, dir = (L >> 1) & 1, vt = L & 1;
        u.a0 = (const char*)(VcT + (size_t)(h * 512 + vt * 256) * CTX); u.a1 = u.a0; u.b = (const char*)(KcT + (size_t)dir * 1024 * CTX + (size_t)(h * 256) * CTX);
        u.d = nullptr; u.i0 = h; u.i1 = dir; u.i2 = 0; u.i3 = vt; }
};
struct JobR1 {
    Base F;
    __device__ __forceinline__ void fill(int L, Unit& u) const { const int w = pg::xcd_contig(L, 256), vt = w & 1, dir = (w >> 1) & 1, seg = (w >> 2) & 31, hl = w >> 7;
        u.a0 = (const char*)(B4 + ((size_t)((hl * NSEG + seg) * 512 + vt * 256)) * 1024 + 512); u.a1 = u.a0;
        u.b = (const char*)(Ktb_ + (size_t)dir * 512 * SEQ + (size_t)(hl * 256) * SEQ + seg * LS); u.d = nullptr; u.i0 = hl; u.i1 = dir; u.i2 = seg; u.i3 = vt; }
};
struct JobR3 {
    Base F;
    __device__ __forceinline__ void fill(int L, Unit& u) const { const int w = pg::xcd_contig(L, 256), jt = w & 1, it = (w >> 1) & 1, seg = (w >> 2) & 31, hl = w >> 7;
        u.a0 = (const char*)(Qb + (size_t)(seg * LS + it * 256) * 512 + hl * 256); u.a1 = u.a0; u.b = (const char*)(Knb + (size_t)(seg * LS + jt * 256) * 512 + hl * 256);
        u.d = nullptr; u.i0 = hl; u.i1 = seg; u.i2 = it; u.i3 = jt; }
};
struct JobR4 {
    Base F;
    __device__ __forceinline__ void fill(int L, Unit& u) const { const int w = pg::xcd_contig(L, 256), vt = w & 1, it = (w >> 1) & 1, seg = (w >> 2) & 31, hl = w >> 7;
        u.a0 = (const char*)(Qb + (size_t)(seg * LS + it * 256) * 512 + hl * 256); u.a1 = (const char*)(Pb + (size_t)(seg * LS + it * 256) * 1024 + hl * 512);
        u.b = (const char*)(B4 + ((size_t)((hl * NSEG + seg) * 512 + vt * 256)) * 1024); u.d = nullptr; u.i0 = hl; u.i1 = seg; u.i2 = it; u.i3 = vt; }
};
struct JobF1 {
    Base F;
    __device__ __forceinline__ void fill(int L, Unit& u) const { u.a0 = (const char*)FmT; u.a1 = u.a0; u.b = (const char*)(Wt + (size_t)L * 256 * 256); u.d = nullptr; u.i0 = 0; u.i1 = L; u.i2 = 0; u.i3 = 0; }
};
struct JobF2 {
    Base F;
    __device__ __forceinline__ void fill(int L, Unit& u) const { u.a0 = (const char*)GmT; u.a1 = u.a0; u.b = (const char*)(Bt + (size_t)L * 256 * 256); u.d = nullptr; u.i0 = 0; u.i1 = L; u.i2 = 0; u.i3 = 0; }
};
struct JobZ {
    Base F; int part;
    __device__ __forceinline__ void fill(int L, Unit& u) const { int pm, pn; pg::tile_pm_pn(L, 64, 4, pm, pn);
        u.a0 = (const char*)((part ? Ob : MIXb) + (size_t)pm * 256 * 2048); u.a1 = u.a0; u.b = (const char*)(Bz + (size_t)pn * 256 * 3072 + (part ? 1024 : 0)); u.d = nullptr; u.i0 = pm; u.i1 = pn; u.i2 = 0; u.i3 = 0; }
};

#define XB_TMO      128
#define XB_XCNT(j)  (256  + 64 * (j))
#define XB_XSUB(j)  (1280 + 64 * (j))
#define XB_XGEN(j)  (2304 + 64 * (j))
#define XB_TOP      3328
#define XB_TOPGEN   3392
#define XCD_BAR_WORDS 3456
#define XB_SPIN_CAP (1u << 22)
__device__ __forceinline__ unsigned xb_ld(unsigned* p)              { return __hip_atomic_load(p, __ATOMIC_RELAXED, __HIP_MEMORY_SCOPE_AGENT); }
__device__ __forceinline__ unsigned xb_add(unsigned* p, unsigned v) { return __hip_atomic_fetch_add(p, v, __ATOMIC_RELAXED, __HIP_MEMORY_SCOPE_AGENT); }
__device__ __forceinline__ unsigned xb_xcc_id() { return (unsigned)__builtin_amdgcn_s_getreg((3 << 11) | 20) & 0xFu; }
#define XB_SPIN(cond, bar) do { unsigned _sp = 0; while (cond) { __builtin_amdgcn_s_sleep(1); \
    if ((++_sp & 255u) == 0u) { if (xb_ld(&(bar)[XB_TMO])) break; if (_sp > XB_SPIN_CAP) { atomicAdd(&(bar)[XB_TMO], 1u); break; } } } } while (0)
struct XcdBarrier { unsigned* bar; unsigned x; volatile LAS unsigned* st; };
__device__ __forceinline__ XcdBarrier xcd_barrier_post(unsigned* bar, volatile LAS unsigned* st) {
    XcdBarrier b; b.bar = bar; b.x = xb_xcc_id(); b.st = st;
    if (threadIdx.x == 0) (void)xb_add(&bar[XB_XCNT(b.x)], 1u);
    return b;
}
__device__ __forceinline__ void xcd_barrier_complete(unsigned* bar, unsigned x, unsigned& nloc, unsigned& nx) {
    const unsigned G = gridDim.x * gridDim.y * gridDim.z;
    unsigned sum, cnt, mine, sp = 0u;
    for (;;) {
        sum = 0u; cnt = 0u; mine = 0u;
#pragma unroll
        for (unsigned j = 0; j < 16; ++j) { const unsigned c = xb_ld(&bar[XB_XCNT(j)]); sum += c; cnt += (c > 0u) ? 1u : 0u; mine = (j == x) ? c : mine; }
        if (sum == G) break;
        __builtin_amdgcn_s_sleep(1);
        if ((++sp & 255u) == 0u) { if (xb_ld(&bar[XB_TMO])) break; if (sp > XB_SPIN_CAP) { atomicAdd(&bar[XB_TMO], 1u); break; } }
    }
    nloc = mine > 0u ? mine : 1u; nx = cnt > 0u ? cnt : 1u;
}
__device__ __attribute__((noinline)) void xcd_barrier(unsigned* bar_, unsigned bx_, volatile LAS unsigned* st_) {
    XcdBarrier b; b.bar = bar_; b.x = bx_; b.st = st_;
    asm volatile("s_waitcnt vmcnt(0)" ::: "memory");
    __syncthreads();
    if (threadIdx.x == 0) {
        unsigned* bar = b.bar;
        __builtin_amdgcn_s_waitcnt(0);
        unsigned nloc = b.st[0], nx = b.st[1];
        if (nloc == 0u) { xcd_barrier_complete(bar, b.x, nloc, nx); b.st[0] = nloc; b.st[1] = nx; }
        const unsigned old = xb_add(&bar[XB_XSUB(b.x)], 1u);
        const unsigned gen = old / nloc;
        if (old + 1u == (gen + 1u) * nloc) {
            __builtin_amdgcn_fence(__ATOMIC_RELEASE, "agent");
            asm volatile("s_waitcnt vmcnt(0)" ::: "memory");
            const unsigned og = xb_add(&bar[XB_TOP], 1u);
            const unsigned tg = og / nx;
            if (og + 1u == (tg + 1u) * nx) xb_add(&bar[XB_TOPGEN], 1u);
            else XB_SPIN(xb_ld(&bar[XB_TOPGEN]) == tg, bar);
            __builtin_amdgcn_fence(__ATOMIC_ACQUIRE, "agent");
            xb_add(&bar[XB_XGEN(b.x)], 1u);
            asm volatile("s_waitcnt vmcnt(0)" ::: "memory");
        } else {
            XB_SPIN(xb_ld(&bar[XB_XGEN(b.x)]) == gen, bar);
            __builtin_amdgcn_fence(__ATOMIC_ACQUIRE, "agent");
            asm volatile("s_waitcnt vmcnt(0)" ::: "memory");
        }
    }
    __syncthreads();
}

constexpr int NWAVES = 8, NTHREADS = 512;
constexpr int RING_BYTES = 131072, MISC_OFF = RING_BYTES + 320, LDS_BYTES = 147456;
constexpr int CW_BAR = 4096;

struct Args { const float* in[21]; float* out; unsigned char* ws; int ph_lo, ph_hi; };

struct Ctx {
    LAS unsigned char* lds; int tid, lane, wave, G, vcu;
    unsigned char* ws; unsigned char* dout;
};
#define F_WS (F.ws)
#define F_DOUT (F.dout)

__device__ __forceinline__ void gemv_item(const Ctx& F, int item, const float* W, const float* b, const float* c, const float* cc) {
    LAS float* scr = (LAS float*)F.lds;
    const int cg = F.tid & 7, rg = F.tid >> 3, n0 = item * 32 + cg * 4;
    f32x4 ax = {0.f, 0.f, 0.f, 0.f}, ac = {0.f, 0.f, 0.f, 0.f};
#pragma unroll 4
    for (int k = rg; k < DM; k += 64) { const f32x4 w = *(const f32x4*)(W + (size_t)k * 9216 + n0); const float sx = c[k], sc = cc[k];
        ax += w * (sx / (1.f + expf(-sx))); ac += w * (sc / (1.f + expf(-sc))); }
    __syncthreads();
#pragma unroll
    for (int e = 0; e < 4; ++e) { scr[(rg * 8 + cg) * 8 + e] = ax[e]; scr[(rg * 8 + cg) * 8 + 4 + e] = ac[e]; }
    __syncthreads();
    if (F.tid < 64) { const int which = F.tid >> 5, col = F.tid & 31, g = col >> 2, e = col & 3; float s = 0.f;
        for (int r = 0; r < 64; ++r) s += scr[(r * 8 + g) * 8 + which * 4 + e];
        (which ? modc : modx)[item * 32 + col] = s + b[item * 32 + col]; }
    __syncthreads();
}
struct TrDesc { const float* W; int K, N; bf16_t* dst; int ld, coloff, kind; };
__device__ __forceinline__ int tr_dest_row(int kind, int n) {
    switch (kind) {
    case 0: { const int isb = n >= DFF, j = isb ? n - DFF : n; return 256 * (j >> 7) + 128 * isb + (j & 127); }
    case 2: {
        if (n < 1024) { const int h = n >> 8, d = n & 255; return (h >> 1) * 2048 + (h & 1) * 256 + d; }
        if (n < 2048) { const int h = (n - 1024) >> 8, d = n & 255; return (h >> 1) * 2048 + 512 + (h & 1) * 256 + d; }
        if (n < 4096) { const int h = (n - 2048) >> 9, v = (n - 2048) & 511; return (h >> 1) * 2048 + 1024 + (h & 1) * 512 + v; }
        if (n < 6144) return WR_G + (n - 4096);
        if (n < 7168) return -1;
        if (n < 8192) return WR_GA + (n - 7168);
        return WR_GF + (n - 8192); }
    default: return n; }
}
__device__ __forceinline__ void tr_item(const TrDesc& t, LAS float* scr, int item, int lane) {
    const int nblk = t.N / 32, kb = item / nblk, nb = item % nblk, k0 = 64 * kb, n0 = 32 * nb;
    if (t.kind == 2 && n0 >= 6144 && n0 < 7168) return;
#pragma unroll
    for (int i = 0; i < 8; ++i) { const int kk = 8 * i + (lane >> 3), c4 = (lane & 7) * 4; const f32x4 v = *(const f32x4*)(t.W + (size_t)(k0 + kk) * t.N + n0 + c4);
        scr[kk * 33 + c4] = v[0]; scr[kk * 33 + c4 + 1] = v[1]; scr[kk * 33 + c4 + 2] = v[2]; scr[kk * 33 + c4 + 3] = v[3]; }
    asm volatile("s_waitcnt lgkmcnt(0)" ::: "memory");
    const int c = lane & 7;
#pragma unroll
    for (int j = 0; j < 4; ++j) { const int n = (lane >> 3) + 8 * j; const LAS float* s = scr + (8 * c) * 33 + n;
        u32x4 o; o.x = cvt_pk_bf16(s[0 * 33], s[1 * 33]); o.y = cvt_pk_bf16(s[2 * 33], s[3 * 33]); o.z = cvt_pk_bf16(s[4 * 33], s[5 * 33]); o.w = cvt_pk_bf16(s[6 * 33], s[7 * 33]);
        const int dr = tr_dest_row(t.kind, n0 + n);
        *(u32x4*)(t.dst + (size_t)dr * t.ld + t.coloff + k0 + 8 * c) = o; }
    asm volatile("s_waitcnt lgkmcnt(0)" ::: "memory");
}
__device__ __forceinline__ void tr_all(const Ctx& F, const TrDesc& t, int gw, int NGW) {
    LAS float* scr = (LAS float*)(F.lds + F.wave * 16384);
    const int nitems = (t.K / 64) * (t.N / 32);
    for (int it = gw; it < nitems; it += NGW) tr_item(t, scr, it, F.lane);
}
__device__ __forceinline__ void norm_rows(const Ctx& F, const float* xin, const float* cin, const float* nw, int modoff, const bf16_t* dx, const float* dcf, bool has_delta, int row0, int nrows) {
    const int gw = F.vcu * NWAVES + F.wave, NGW = F.G * NWAVES;
    for (int r = row0 + gw; r < nrows; r += NGW) {
        const bool isx = r < SEQ; const int rr = isx ? r : r - SEQ;
        const float* xr = (isx ? xin : cin) + (size_t)rr * DM; const bf16_t* dr = dx + (size_t)rr * DM; const float* drf = dcf + (size_t)rr * DM;
        const float* md = (isx ? modx : modc) + modoff; bf16_t* orow = (isx ? Ax : Ac) + (size_t)rr * DM;
        f32x4 v[4]; float ss = 0.f;
#pragma unroll
        for (int j = 0; j < 4; ++j) { v[j] = *(const f32x4*)(xr + 256 * j + 4 * F.lane);
            if (has_delta) { if (isx) { const u32x2 d = *(const u32x2*)(dr + 256 * j + 4 * F.lane); v[j] += (f32x4){bflo(d.x), bfhi(d.x), bflo(d.y), bfhi(d.y)}; } else { f32x4 sacc = {0.f, 0.f, 0.f, 0.f};
#pragma unroll
                for (int kc = 0; kc < 11; ++kc) sacc += *(const f32x4*)(drf + (size_t)kc * CTX * DM + 256 * j + 4 * F.lane);
                v[j] += sacc * (*(const f32x4*)(modc + 2 * DM + 256 * j + 4 * F.lane)) * 0.5f; } }
            ss += (v[j][0] * v[j][0] + v[j][1] * v[j][1]) + (v[j][2] * v[j][2] + v[j][3] * v[j][3]); }
        const float rinv = 1.0f / sqrtf(wave_sum(ss) * (1.f / DM) + EPS);
#pragma unroll
        for (int j = 0; j < 4; ++j) { const int c = 256 * j + 4 * F.lane; const f32x4 w = *(const f32x4*)(nw + c), sh = *(const f32x4*)(md + c), sc = *(const f32x4*)(md + 1024 + c);
            const f32x4 y = (v[j] * rinv) * w * (sc + 1.0f) + sh; u32x2 o; o.x = cvt_pk_bf16(y[0], y[1]); o.y = cvt_pk_bf16(y[2], y[3]);
            *(u32x2*)(orow + c) = o; }
    }
}
__device__ __forceinline__ void final_norm(const Ctx& F, const float* xin, const float* nw, const bf16_t* dx) {
    float* out = (float*)F_DOUT;
    const int gw = F.vcu * NWAVES + F.wave, NGW = F.G * NWAVES;
    for (int r = gw; r < SEQ; r += NGW) {
        const float* xr = xin + (size_t)r * DM; const bf16_t* dr = dx + (size_t)r * DM;
        f32x4 v[4]; float ss = 0.f;
#pragma unroll
        for (int j = 0; j < 4; ++j) { v[j] = *(const f32x4*)(xr + 256 * j + 4 * F.lane);
            const u32x2 d = *(const u32x2*)(dr + 256 * j + 4 * F.lane); v[j] += (f32x4){bflo(d.x), bfhi(d.x), bflo(d.y), bfhi(d.y)};
            ss += (v[j][0] * v[j][0] + v[j][1] * v[j][1]) + (v[j][2] * v[j][2] + v[j][3] * v[j][3]); }
        const float rinv = 1.0f / sqrtf(wave_sum(ss) * (1.f / DM) + EPS);
#pragma unroll
        for (int j = 0; j < 4; ++j) { const int c = 256 * j + 4 * F.lane; *(f32x4*)(out + (size_t)r * DM + c) = (v[j] * rinv) * *(const f32x4*)(nw + c); }
    }
}
__device__ __forceinline__ void copy_delta(const Ctx& F, const bf16_t* src, bf16_t* dst) {
    const size_t n16 = (size_t)SEQ * DM * 2 / 16; const u32x4* s = (const u32x4*)src; u32x4* d = (u32x4*)dst;
    for (size_t i = (size_t)F.vcu * NTHREADS + F.tid; i < n16; i += (size_t)F.G * NTHREADS) d[i] = s[i];
}


__device__ __forceinline__ float block_sum(LAS float* scr, float v, int tid) {
    v = wave_sum(v); __syncthreads(); if ((tid & 63) == 0) scr[tid >> 6] = v; __syncthreads();
    float s = 0.f; for (int i = 0; i < NWAVES; ++i) s += scr[i]; __syncthreads(); return s;
}
__device__ __forceinline__ void dbg_report(unsigned* word, float ref, float got, float floor_) {
    const float e = fabsf(got - ref) / fmaxf(fabsf(ref), floor_); atomicMax(word, __builtin_bit_cast(unsigned, e)); if (e > 0.05f) atomicAdd(word + 64, 1u);
}
__device__ __forceinline__ float bf2f(bf16_t b) { return __builtin_bit_cast(float, (unsigned)b << 16); }

__global__ void __launch_bounds__(NTHREADS, 2) fwd_kernel(Args args) {
    extern __shared__ __attribute__((aligned(16))) unsigned char lds_raw[];
    Ctx F;
    F.lds = (LAS unsigned char*)lds_raw;
    F.tid = threadIdx.x; F.lane = F.tid & 63; F.wave = __builtin_amdgcn_readfirstlane(F.tid >> 6);
    F.G = gridDim.x; { const int bx = blockIdx.x; F.vcu = (F.G % 8 == 0) ? (bx % 8) * (F.G / 8) + bx / 8 : bx; }
    F.ws = args.ws; F.dout = (unsigned char*)args.out;
    volatile LAS unsigned* MISC = (volatile LAS unsigned*)(F.lds + MISC_OFF);
    for (int u = F.tid; u < (LDS_BYTES - RING_BYTES) / 4; u += NTHREADS) ((LAS unsigned*)(F.lds + RING_BYTES))[u] = 0u;
    __syncthreads();
    unsigned* ctl = (unsigned*)(F_WS + WS_CTL);
    XcdBarrier bar = xcd_barrier_post(ctl + CW_BAR, MISC + 8);
    const int lo = args.ph_lo, hi = args.ph_hi;
    int phase = 0;
#define PHASE_BEGIN if (phase >= lo && phase < hi) { for (int _rep = 0; _rep < ((DBG_DUP >= 0 && phase == DBG_DUP) ? 2 : 1); ++_rep) { asm volatile("; MARK %0" :: "i"(__LINE__)); { unsigned char* _w = args.ws; unsigned char* _o = (unsigned char*)args.out; int _t = threadIdx.x; asm volatile("" : "+s"(_w), "+s"(_o), "+v"(_t)); F.ws = _w; F.dout = _o; F.tid = _t; F.lane = _t & 63; }
#define PHASE_END   } if (phase + 1 < hi) xcd_barrier((unsigned*)(F.ws + WS_CTL) + CW_BAR, bar.x, MISC + 8); if (DBG_TSEL >= 0 && bx == 0 && F.tid == 0) ((unsigned long long*)(F.ws + WS_CTL + 160000))[phase + 1] = __builtin_amdgcn_s_memrealtime(); } ++phase;
    const int bx = (int)blockIdx.x;

#define gtid ((size_t)F.vcu * NTHREADS + F.tid)
#define gthreads ((size_t)F.G * NTHREADS)
#define FB (Base{F.ws, F.dout})
    const Geo gK1024{DM, DM, DM, 128u * DM * 2u, 128u * DM * 2u, 128u * DM * 2u, DM / 64, 1 << 20, 1 << 20};
    const Geo gFfn2{DFF, DFF, DFF, 128u * DFF * 2u, 128u * DFF * 2u, 128u * DFF * 2u, DFF / 64, 1 << 20, 1 << 20};

    if (DBG_TSEL >= 0 && bx == 0 && threadIdx.x == 0) ((unsigned long long*)(args.ws + WS_CTL + 160000))[0] = __builtin_amdgcn_s_memrealtime();
    PHASE_BEGIN
        for (int it = F.vcu; it < 288; it += F.G) gemv_item(F, it, args.in[4], args.in[5], args.in[1], args.in[3]);
        __syncthreads();
        if (gtid == 0) { ((unsigned*)(F.ws + WS_CTL))[32768 + 192] = 255u; ((unsigned*)(F.ws + WS_CTL))[32768 + 193] = 255u; }
        if (gtid < 8) { const float x = (gtid < 4 ? args.in[11] : args.in[12])[gtid & 3]; modx[2 * 9216 + gtid] = -log1pf(expf(-x)); }
        for (size_t i = gtid; i < 256 * 64; i += gthreads) { const int p = (int)(i >> 6), f = (int)(i & 63); const float inv = powf(10000.0f, -(float)f / 64.0f), ang = (float)p * inv;
            ropeT[2 * i] = cosf(ang); ropeT[2 * i + 1] = sinf(ang); }
        for (size_t i = gtid; i < 128 * 128; i += gthreads) { const int k1 = (int)(i >> 7), l2 = (int)(i & 127); const float a = (float)((k1 * l2) & 16383) * (1.0f / 8192.0f);
            twT[2 * i] = cospif(a); twT[2 * i + 1] = sinpif(a); }
        for (size_t i = gtid; i < 256 * 256; i += gthreads) { const int r = (int)(i >> 8), cc = (int)(i & 255), rin = cc >> 7, l = cc & 127;
            { const int k1 = r >> 1, ri = r & 1; const float a = (float)((k1 * l) & 127) * (1.0f / 64.0f), c = cospif(a), s = sinpif(a);
              FmT[i] = f2bf(ri == 0 ? (rin == 0 ? c : s) : (rin == 0 ? -s : c)); }
            { const float a = (float)((r * l) & 127) * (1.0f / 64.0f), c = cospif(a), s = sinpif(a);
              GmT[i] = r < 128 ? f2bf((rin == 0 ? c : s) * (1.0f / 2048.0f)) : (bf16_t)0; } }
        for (size_t i = gtid; i < 512 * 256; i += gthreads) { const int r = (int)(i >> 8), c = (int)(i & 255), ri = r >> 8, cp = r & 255; const float a = (float)((c * cp) & 255) * (1.0f / 128.0f);
            T256[i] = f2bf(ri == 0 ? cospif(a) : -sinpif(a)); }
        for (size_t i = gtid; i < (size_t)DM * DM / 4; i += gthreads) { const int k = (int)(i >> 8), c4 = (int)(i & 255) * 4; const f32x4 w = *(const f32x4*)(args.in[10] + (size_t)k * 9216 + 6144 + c4);
            u32x2 o; o.x = cvt_pk_bf16(w[0], w[1]); o.y = cvt_pk_bf16(w[2], w[3]); *(u32x2*)(Wn + (size_t)k * DM + c4) = o; }
        { TrDesc t{args.in[7], DM, 2 * DFF, W13t1, DM, 0, 0}; tr_all(F, t, F.vcu * NWAVES + F.wave, F.G * NWAVES); }
        { TrDesc t{args.in[8], DFF, DM, W2t1, DFF, 0, 1}; tr_all(F, t, F.vcu * NWAVES + F.wave, F.G * NWAVES); }
        __syncthreads();
    PHASE_END
    for (int xb = 0; xb < DBG_XBAR; ++xb) {
    PHASE_BEGIN
    PHASE_END
    }
    PHASE_BEGIN
        norm_rows(F, args.in[0], args.in[2], args.in[6], 0, nullptr, nullptr, false, 0, SEQ + CTX);
    PHASE_END
    if constexpr (DBG_PROBE == 11) {
    PHASE_BEGIN
        unsigned* dw = (unsigned*)(F.ws + WS_CTL) + 32768;
        for (size_t idx = gtid; idx < (size_t)DM * 9216; idx += gthreads) { const int k = (int)(idx / 9216), n = (int)(idx % 9216); const int dr = tr_dest_row(2, n);
            if (dr >= 0) { const float a = args.in[10][idx]; const float b = bf2f(Win[(size_t)dr * DM + k]); if (fabsf(a - b) > 0.01f * fabsf(a) + 1e-6f) { atomicAdd(dw + 64, 1u); atomicMin(dw + 192, (unsigned)(dr >> 8)); } } }
    PHASE_END
    }
    PHASE_BEGIN
        { pg::Sched<JobFfn1> S{{FB, 65, 1}, 65 * 22, F.G, bx};
          EpiSwiglu E{0, 0, FB};
          pg::gemm_phase<EpiSwiglu, pg::Sched<JobFfn1>, 1>(F.lds, gK1024, S, E); }
        if (bx >= 150 && bx < 194 && _rep == 0) {
            if (F.tid < 64) { unsigned* cnt = (unsigned*)(F.ws + WS_CTL) + 24576; unsigned sp = 0;
                while ((unsigned)__builtin_amdgcn_readfirstlane(__hip_atomic_load(cnt, __ATOMIC_RELAXED, __HIP_MEMORY_SCOPE_AGENT)) < 22u * 8u) { __builtin_amdgcn_s_sleep(2); if (++sp > (1u << 22)) break; }
                __builtin_amdgcn_fence(__ATOMIC_ACQUIRE, "agent"); asm volatile("s_waitcnt vmcnt(0)" ::: "memory"); }
            __syncthreads();
            Geo g{DFF, DFF, DFF, 128u * DFF * 2u, 128u * DFF * 2u, 128u * DFF * 2u, 4, 1 << 20, 1 << 20};
            pg::Sched<JobCtxG2> S{{FB}, 44, 1 << 20, bx - 150}; EpiSlab E{0, 0, FB};
            pg::gemm_phase<EpiSlab, pg::Sched<JobCtxG2>, 1>(F.lds, g, S, E);
            { Geo g2{256, 256, DM, 128u * 256 * 2u, 128u * 256 * 2u, 128u * DM * 2u, 4, 1 << 20, 1 << 20};
              pg::Sched<JobFold> S2{{FB}, 32, 1 << 20, bx - 150}; EpiStore E2{0, 0, DM};
              pg::gemm_phase<EpiStore, pg::Sched<JobFold>, 1>(F.lds, g2, S2, E2); }
        } else if (bx >= 194 && _rep == 0) {
            { TrDesc t{args.in[10], DM, 9216, Win, DM, 0, 2}; tr_all(F, t, (bx - 194) * NWAVES + F.wave, (F.G - 194) * NWAVES); }
            __syncthreads();
        }
    PHASE_END
    PHASE_BEGIN
        if (_rep == 0) norm_rows(F, args.in[0], args.in[2], args.in[9], 3 * DM, Dx, XcSlab, true, SEQ, SEQ + CTX);
        { pg::Sched<JobFfn2> S{{FB, 64, 1}, 64 * 4, F.G, bx};
          EpiFuse E{0, 0, FB, 0, args.in[0], args.in[9]};
          pg::gemm_phase<EpiFuse, pg::Sched<JobFfn2>, 1>(F.lds, gFfn2, S, E); }
    PHASE_END
    if constexpr (STOP_AFTER >= 3) {
    for (int pair = 0; pair < 2; ++pair) {
        PHASE_BEGIN
            { pg::Sched<JobRowCol> S{{FB, 0, 64, 4, 0, (size_t)pair * 2048 * DM, (size_t)256 * DM, (size_t)256 * DM}, 256, F.G, bx};
              EpiQK E{0, 0, FB, pair};
              pg::gemm_phase<EpiQK, pg::Sched<JobRowCol>, 1>(F.lds, gK1024, S, E); }
            { pg::Sched<JobRowCol> S{{FB, 1, 4, 64, (size_t)(pair * 2048 + 1024) * DM, 0, (size_t)256 * DM, (size_t)256 * DM}, 256, F.G, bx};
              EpiVT E{0, 0, FB};
              pg::gemm_phase<EpiVT, pg::Sched<JobRowCol>, 1>(F.lds, gK1024, S, E); }
            if (pair == 0 && !((bx >= 64 && bx < 68) || (bx >= 72 && bx < 80)) && _rep == 0) {
                const int r = bx < 64 ? bx : (bx < 72 ? bx - 4 : bx - 12), tgw = r * NWAVES + F.wave, tng = (F.G - 12) * NWAVES;
                { TrDesc t{args.in[18], DM, 2 * DFF, W13t, DM, 0, 0}; tr_all(F, t, tgw, tng); }
                { TrDesc t{args.in[19], DFF, DM, W2t, DFF, 0, 1}; tr_all(F, t, tgw, tng); }
                __syncthreads(); }
            if (pair == 0) {
                { pg::Sched<JobKc> S{{FB}, 4, F.G, (bx + F.G - 64) % F.G}; EpiKc E{0, 0, FB};
                  pg::gemm_phase<EpiKc, pg::Sched<JobKc>, 1>(F.lds, gK1024, S, E); }
                { pg::Sched<JobVc> S{{FB}, 8, F.G, (bx + F.G - 72) % F.G}; EpiVc E{0, 0, FB};
                  pg::gemm_phase<EpiVc, pg::Sched<JobVc>, 1>(F.lds, gK1024, S, E); }
            }
        PHASE_END
        if constexpr (DBG_PROBE == 5) {
        PHASE_BEGIN
            LAS float* scr = (LAS float*)F.lds; unsigned* dw = (unsigned*)(F.ws + WS_CTL) + 32768;
            const int s = bx; const int i = (int)(((unsigned)s * 2654435761u) >> 18) & 16383, hl = s & 1, h = 2 * pair + hl, pp = (s * 29 + 3) & 127, v = (s * 37 + 11) & 511;
            const float* win = args.in[10]; float q1 = 0.f, q2 = 0.f, k1 = 0.f, k2 = 0.f, vv = 0.f;
            for (int a = F.tid; a < DM; a += NTHREADS) { const float x = bf2f(Ax[(size_t)i * DM + a]); const float* wr_ = win + (size_t)a * 9216;
                q1 += x * wr_[h * 256 + 2 * pp]; q2 += x * wr_[h * 256 + 2 * pp + 1]; k1 += x * wr_[1024 + h * 256 + 2 * pp]; k2 += x * wr_[1024 + h * 256 + 2 * pp + 1]; vv += x * wr_[2048 + h * 512 + v]; }
            q1 = block_sum(scr, q1, F.tid); q2 = block_sum(scr, q2, F.tid); k1 = block_sum(scr, k1, F.tid); k2 = block_sum(scr, k2, F.tid); vv = block_sum(scr, vv, F.tid);
            if (F.tid == 0) { const float inv = powf(10000.0f, -(float)(pp & 63) / 64.0f), ang = (float)(pp < 64 ? (i >> 6) : (i & 63)) * inv, cs = cosf(ang), sn = sinf(ang);
                const float rq1 = (q1 * cs - q2 * sn) * 0.0625f, rq2 = (q1 * sn + q2 * cs) * 0.0625f, rk1 = k1 * cs - k2 * sn, rk2 = k1 * sn + k2 * cs; const int jl = i & 511;
                dbg_report(dw, rq1, bf2f(Qb[(size_t)i * 512 + hl * 256 + 2 * pp]), 1000.0f); dbg_report(dw, rq2, bf2f(Qb[(size_t)i * 512 + hl * 256 + 2 * pp + 1]), 1000.0f);
                dbg_report(dw, rk1, bf2f(Knb[(size_t)i * 512 + hl * 256 + 2 * pp]), 1000.0f); dbg_report(dw, rk2, bf2f(Knb[(size_t)i * 512 + hl * 256 + 2 * pp + 1]), 1000.0f);
                dbg_report(dw, rk2 * expf(lgp[h] * (float)(511 - jl)), bf2f(Ktb_[(size_t)(hl * 256 + 2 * pp + 1) * SEQ + i]), 1000.0f);
                dbg_report(dw, rk1 * expf(lgp[4 + h] * (float)jl), bf2f(Ktb_[(size_t)512 * SEQ + (size_t)(hl * 256 + 2 * pp) * SEQ + i]), 1000.0f);
                dbg_report(dw, vv, bf2f(B4[((size_t)((hl * NSEG + (i >> 9)) * 512 + v)) * 1024 + 512 + jl]), 1000.0f); }
        PHASE_END
        }
        PHASE_BEGIN
            { Geo g{1024, 1024, SEQ, 128u * 1024 * 2u, 128u * 1024 * 2u, 128u * (unsigned)SEQ * 2u, LS / 64, 1 << 20, 1 << 20};
              pg::Sched<JobR1> S{{FB}, 256, F.G, bx}; EpiU E{0, 0, FB};
              pg::gemm_phase<EpiU, pg::Sched<JobR1>, 1>(F.lds, g, S, E); }
            if (pair == 0) { Geo g{CTX, CTX, CTX, 128u * CTX * 2u, 128u * CTX * 2u, 128u * CTX * 2u, CTX / 64, 1 << 20, 1 << 20};
              pg::Sched<JobS0> S{{FB}, 16, F.G, (bx + F.G - 64) % F.G}; EpiS0 E{0, 0, FB};
              pg::gemm_phase<EpiS0, pg::Sched<JobS0>, 1>(F.lds, g, S, E); }
        PHASE_END
        if constexpr (DBG_PROBE == 6) {
        PHASE_BEGIN
            LAS float* scr = (LAS float*)F.lds; unsigned* dw = (unsigned*)(F.ws + WS_CTL) + 32768;
            const int s = bx, h = s & 3, dir = (s >> 2) & 1, d = (s * 29 + 3) & 255, v = (s * 37 + 11) & 511; const float* win = args.in[10];
            const int j = F.tid & 255, which = F.tid >> 8; const int col = which ? 2048 + h * 512 + v : 1024 + h * 256 + d; float dot = 0.f;
            for (int a = 0; a < DM; ++a) dot += bf2f(Ac[(size_t)j * DM + a]) * win[(size_t)a * 9216 + col];
            scr[16 + F.tid] = dot; __syncthreads();
            float term = 0.f; if (F.tid < 256) term = scr[16 + F.tid] * scr[16 + 256 + F.tid] * expf(lgp[dir * 4 + h] * (float)(dir ? j : 255 - j));
            __syncthreads();
            const float ref = block_sum(scr, term, F.tid);
            if (F.tid == 0) dbg_report(dw, ref, S0[((size_t)((h * 2 + dir) * 512 + v)) * 256 + d], 1000.0f);
        PHASE_END
        }
        PHASE_BEGIN
            { const int gw = F.vcu * NWAVES + F.wave, NGW = F.G * NWAVES;
              for (int rowid = gw; rowid < 1024; rowid += NGW) { const int hl = rowid >> 9, v = rowid & 511, h = 2 * pair + hl, dir = F.lane >> 5, d0 = (F.lane & 31) * 8;
                  const float* s0 = S0 + ((size_t)((h * 2 + dir) * 512 + v)) * 256 + d0; f32x4 c0 = *(const f32x4*)s0, c1 = *(const f32x4*)(s0 + 4);
                  const float dec = expf(lgp[dir * 4 + h] * (float)LS);
                  bf16_t* pb = B4 + ((size_t)(hl * NSEG * 512 + v)) * 1024 + dir * 256 + d0; const long sstep = dir ? -(long)512 * 1024 : (long)512 * 1024; if (dir) pb += (size_t)(NSEG - 1) * 512 * 1024;
                  u32x4 ub[NSEG];
#pragma unroll
                  for (int it = 0; it < NSEG; ++it) ub[it] = *(const u32x4*)(pb + (long)it * sstep);
#pragma unroll
                  for (int it = 0; it < NSEG; ++it) { f32x4 u0, u1; unpack8(ub[it], u0, u1); *(u32x4*)(pb + (long)it * sstep) = _rep == 0 ? pack8(c0, c1) : ub[it]; c0 = c0 * dec + u0; c1 = c1 * dec + u1; } } }
            if (pair == 0 && F.vcu >= 128 && _rep == 0) {
                { TrDesc t{args.in[15], DM, DM, Bz, 3072, 0, 3}; tr_all(F, t, (F.vcu - 128) * NWAVES + F.wave, (F.G - 128) * NWAVES); }
                { TrDesc t{args.in[14], 2048, DM, Bz, 3072, 1024, 4}; tr_all(F, t, (F.vcu - 128) * NWAVES + F.wave, (F.G - 128) * NWAVES); }
                { TrDesc t{args.in[16], DM, DM, WoT, DM, 0, 5}; tr_all(F, t, (F.vcu - 128) * NWAVES + F.wave, (F.G - 128) * NWAVES); }
                __syncthreads(); }
            { Geo g{512, 512, 512, 128u * 512 * 2u, 128u * 512 * 2u, 128u * 512 * 2u, 4, 1 << 20, 1 << 20};
              pg::Sched<JobR3> S{{FB}, 256, F.G, bx}; EpiP E{0, 0, FB, pair};
              pg::gemm_phase<EpiP, pg::Sched<JobR3>, 1>(F.lds, g, S, E); }
        PHASE_END
        PHASE_BEGIN
            Geo g{512, 1024, 1024, 128u * 512 * 2u, 128u * 1024 * 2u, 128u * 1024 * 2u, 16, 8, 4};
            pg::Sched<JobR4> S{{FB}, 256, F.G, bx}; EpiO E{4, 8, FB, pair};
            pg::gemm_phase<EpiO, pg::Sched<JobR4>, 2>(F.lds, g, S, E);
        PHASE_END
        if constexpr (DBG_PROBE == 1) {
        PHASE_BEGIN
            LAS float* scr = (LAS float*)F.lds; unsigned* dw = (unsigned*)(F.ws + WS_CTL) + 32768;
            const int s = bx; int i = (int)(((unsigned)s * 2654435761u) >> 18) & 16383; if (s < 8) { const int sp[8] = {0, 1, 511, 512, 513, 8191, 16382, 16383}; i = sp[s]; }
            const int hl = s & 1, h = 2 * pair + hl, v = (s * 37 + 11) & 511; const float lgf = lgp[h], lgb = lgp[4 + h];
            float part = 0.f;
            for (int j = F.tid; j < SEQ; j += NTHREADS) { float qk = 0.f;
                for (int d = 0; d < 256; ++d) qk += bf2f(Qb[(size_t)i * 512 + hl * 256 + d]) * bf2f(Knb[(size_t)j * 512 + hl * 256 + d]);
                const float D = j < i ? __expf(lgf * (float)(i - j)) : (j > i ? __expf(lgb * (float)(j - i)) : 2.0f);
                part += D * qk * bf2f(B4[((size_t)((hl * NSEG + (j >> 9)) * 512 + v)) * 1024 + 512 + (j & 511)]); }
            if (F.tid < 256) { const float q = bf2f(Qb[(size_t)i * 512 + hl * 256 + F.tid]);
                part += q * (__expf(lgf * (float)(i + 1)) * S0[((size_t)((h * 2 + 0) * 512 + v)) * 256 + F.tid] + __expf(lgb * (float)(SEQ - i)) * S0[((size_t)((h * 2 + 1) * 512 + v)) * 256 + F.tid]); }
            const float ref = block_sum(scr, part, F.tid);
            const float ov = bf2f(Ob[(size_t)i * 2048 + h * 512 + F.tid]); const float rms = sqrtf(block_sum(scr, ov * ov, F.tid) * (1.0f / 512.0f));
            if (F.tid == 0) dbg_report(dw, ref, bf2f(Ob[(size_t)i * 2048 + h * 512 + v]), rms * 1000.0f);
        PHASE_END
        }
    }
    if constexpr (DBG_PROBE == 7 || DBG_PROBE == 8) {
    PHASE_BEGIN
        LAS float* scr = (LAS float*)F.lds; unsigned* dw = (unsigned*)(F.ws + WS_CTL) + 32768; float* sav = (float*)(F.ws + WS_END);
        const int s = bx; const int i = s * 64 + 57, h = DBG_COL >> 9, v = DBG_COL & 511;
        const float ov = bf2f(Ob[(size_t)i * 2048 + h * 512 + F.tid]); const float mean = block_sum(scr, ov, F.tid) * (1.0f / 512.0f);
        const float var = block_sum(scr, (ov - mean) * (ov - mean), F.tid) * (1.0f / 512.0f); const float rstd = 1.0f / sqrtf(var + EPS);
        if (F.tid == 0) { if (DBG_PROBE == 7) { dbg_report(dw, mean, stats[(size_t)(i * 4 + h) * 2], 1000.0f); dbg_report(dw, rstd, stats[(size_t)(i * 4 + h) * 2 + 1], 1000.0f); }
            sav[s * 4 + 0] = (bf2f(Ob[(size_t)i * 2048 + h * 512 + v]) - mean) * rstd; }
    PHASE_END
    }
    PHASE_BEGIN
        { LAS unsigned char* stl = F.lds + RING_BYTES + 1024;
          if (_rep == 0) { const int pm = bx >> 2, h = bx & 3;
            for (int r = F.wave; r < 256; r += NWAVES) { const int pos = pm * 256 + r; f32x4 a, b; unpack8(*(const u32x4*)(Ob + (size_t)pos * 2048 + h * 512 + F.lane * 8), a, b);
                const float mean = wave_sum((a[0] + a[1]) + (a[2] + a[3]) + (b[0] + b[1]) + (b[2] + b[3])) * (1.0f / 512.0f);
                a -= mean; b -= mean; const float q = wave_sum((a[0] * a[0] + a[1] * a[1]) + (a[2] * a[2] + a[3] * a[3]) + (b[0] * b[0] + b[1] * b[1]) + (b[2] * b[2] + b[3] * b[3]));
                if (F.lane == 0) *(LAS f32x2*)(stl + r * 8) = (f32x2){mean, 1.0f / sqrtf(q * (1.0f / 512.0f) + EPS)}; }
            __syncthreads(); }
          pg::Sched<JobG2> S{{FB}, 512, F.G, bx};
          EpiG E{0, 0, FB, args.in[13], _rep, stl};
          pg::gemm_phase<EpiG, pg::Sched<JobG2>, 1>(F.lds, gK1024, S, E); }
        { Geo g{DM, DM, 128u * DM, 128u * DM * 2u, 128u * DM * 2u, (unsigned)DM * 2u, DM / 64, 1 << 20, 1 << 20};
          pg::Sched<JobRowCol> S{{FB, 1, 8, 64, (size_t)WR_F * DM, 0, (size_t)256 * DM, (size_t)2 * DM}, 512, F.G, bx};
          EpiF E{0, 0, FB};
          pg::gemm_phase<EpiF, pg::Sched<JobRowCol>, 1>(F.lds, g, S, E); }
    PHASE_END
    if constexpr (DBG_PROBE == 8) {
    PHASE_BEGIN
        LAS float* scr = (LAS float*)F.lds; unsigned* dw = (unsigned*)(F.ws + WS_CTL) + 32768; float* sav = (float*)(F.ws + WS_END);
        const int s = bx; const int i = s * 64 + 57, h = DBG_COL >> 9, v = DBG_COL & 511, col = h * 512 + v; float g = 0.f;
        for (int a = F.tid; a < DM; a += NTHREADS) g += bf2f(Ax[(size_t)i * DM + a]) * args.in[10][(size_t)a * 9216 + 4096 + col];
        g = block_sum(scr, g, F.tid);
        if (F.tid == 0) dbg_report(dw, g / (1.0f + expf(-g)) * sav[s * 4] * args.in[13][col], bf2f(Ob[(size_t)i * 2048 + col]), 1.0f);
    PHASE_END
    }
    PHASE_BEGIN
        Geo g{256, 256, 256, 128u * 256 * 2u, 128u * 256 * 2u, 128u * 256 * 2u, 4, 1 << 20, 1 << 20};
        pg::Sched<JobF1> S{{FB}, 512, F.G, bx}; EpiF1 E{0, 0, FB};
        pg::gemm_phase<EpiF1, pg::Sched<JobF1>, 1>(F.lds, g, S, E);
    PHASE_END
    if constexpr (DBG_PROBE == 2 || DBG_PROBE == 4) {
    PHASE_BEGIN
        LAS float* scr = (LAS float*)F.lds; unsigned* dw = (unsigned*)(F.ws + WS_CTL) + 32768;
        if (DBG_PROBE == 4) {
            const int s = bx; const int l = (int)(((unsigned)s * 2654435761u) >> 18) & 16383, ch = (s * 131 + 7) & 1023, g = ch >> 8, cp = ch & 255;
            const int c = F.tid & 255, hf = F.tid >> 8; float fpart = 0.f;
            for (int a = hf * 512; a < hf * 512 + 512; ++a) fpart += bf2f(Ax[(size_t)l * DM + a]) * args.in[10][(size_t)a * 9216 + 6144 + g * 256 + c];
            scr[16 + F.tid] = fpart; __syncthreads();
            float wr_ = 0.f, wi_ = 0.f;
            if (F.tid < 256) { const float fv = scr[16 + F.tid] + scr[16 + 256 + F.tid]; const float ang = (float)((c * cp) & 255) * (1.0f / 128.0f); wr_ = fv * cospif(ang); wi_ = -fv * sinpif(ang); }
            __syncthreads();
            const float Wr = block_sum(scr, wr_, F.tid), Wi = block_sum(scr, wi_, F.tid);
            const int l1 = l >> 7, l2 = l & 127;
            if (F.tid == 0) { dbg_report(dw, Wr, bf2f(Wt[(size_t)(ch * 128 + l2) * 256 + l1]), 16000.0f); dbg_report(dw, Wi, bf2f(Wt[(size_t)(ch * 128 + l2) * 256 + 128 + l1]), 16000.0f); }
        } else {
            const unsigned sid = (unsigned)(bx * NTHREADS + F.tid) * 2654435761u; const int k1 = (sid >> 8) & 127, l2 = (sid >> 15) & 127, ch = (sid >> 22) & 1023;
            float ar = 0.f, ai = 0.f;
            for (int l1 = 0; l1 < 128; ++l1) { const float wr_ = bf2f(Wt[(size_t)(ch * 128 + l2) * 256 + l1]), wi_ = bf2f(Wt[(size_t)(ch * 128 + l2) * 256 + 128 + l1]);
                const float a = (float)((k1 * l1) & 127) * (1.0f / 64.0f), cs = cospif(a), sn = sinpif(a); ar += cs * wr_ + sn * wi_; ai += cs * wi_ - sn * wr_; }
            const float t = (float)((k1 * l2) & 16383) * (1.0f / 8192.0f), ct = cospif(t), st = sinpif(t);
            const float br = ar * ct + ai * st, bi = ai * ct - ar * st;
            dbg_report(dw, br, bf2f(Bt[(size_t)(k1 * 1024 + ch) * 256 + l2]), 180000.0f); dbg_report(dw, bi, bf2f(Bt[(size_t)(k1 * 1024 + ch) * 256 + 128 + l2]), 180000.0f);
        }
    PHASE_END
    }
    PHASE_BEGIN
        Geo g{256, 256, 256, 128u * 256 * 2u, 128u * 256 * 2u, 128u * 256 * 2u, 4, 1 << 20, 1 << 20};
        pg::Sched<JobF2> S{{FB}, 512, F.G, bx}; EpiF2 E{0, 0, FB};
        pg::gemm_phase<EpiF2, pg::Sched<JobF2>, 1>(F.lds, g, S, E);
    PHASE_END
    if constexpr (DBG_PROBE == 3) {
    PHASE_BEGIN
        unsigned* dw = (unsigned*)(F.ws + WS_CTL) + 32768;
        const unsigned sid = (unsigned)(bx * NTHREADS + F.tid) * 2654435761u; const int k1 = (sid >> 8) & 127, k2 = (sid >> 15) & 127, ch = (sid >> 22) & 1023;
        float y = 0.f;
        for (int l2 = 0; l2 < 128; ++l2) { const float br = bf2f(Bt[(size_t)(k1 * 1024 + ch) * 256 + l2]), bi = bf2f(Bt[(size_t)(k1 * 1024 + ch) * 256 + 128 + l2]);
            const float a = (float)((k2 * l2) & 127) * (1.0f / 64.0f); y += br * cospif(a) + bi * sinpif(a); }
        dbg_report(dw, y * (1.0f / 2048.0f), bf2f(MIXb[(size_t)(k1 + 128 * k2) * 2048 + ch]), 1000.0f);
    PHASE_END
    }
    if constexpr (DBG_PROBE == 12) {
    PHASE_BEGIN
        unsigned* dw = (unsigned*)(F.ws + WS_CTL) + 32768;
        for (size_t idx = gtid; idx < (size_t)DM * 9216; idx += gthreads) { const int k = (int)(idx / 9216), n = (int)(idx % 9216); const int dr = tr_dest_row(2, n);
            if (dr >= 0) { const float a = args.in[10][idx]; const float b = bf2f(Win[(size_t)dr * DM + k]); if (fabsf(a - b) > 0.01f * fabsf(a) + 1e-6f) { atomicAdd(dw + 64, 1u); atomicMin(dw + 192, (unsigned)(dr >> 8)); } } }
    PHASE_END
    }
    if constexpr (DBG_PROBE == 9) {
    PHASE_BEGIN
        LAS float* scr = (LAS float*)F.lds; unsigned* dw = (unsigned*)(F.ws + WS_CTL) + 32768;
        const int s = bx; const int i = DBG_VAR == 0 ? 1210 : (DBG_VAR == 1 ? 1024 + s : (DBG_VAR == 2 ? s * 64 + 57 : 1210 + 256 * (s & 63))), n = DBG_VAR == 0 ? 4 * s : 736; float ga = 0.f, gf = 0.f;
        for (int a = F.tid; a < DM; a += NTHREADS) { const float x = bf2f(Ax[(size_t)i * DM + a]); ga += x * args.in[10][(size_t)a * 9216 + 7168 + n]; gf += x * args.in[10][(size_t)a * 9216 + 8192 + n]; }
        ga = block_sum(scr, ga, F.tid); gf = block_sum(scr, gf, F.tid);
        if (F.tid == 0) { const float ea = fabsf(1.0f / (1.0f + expf(-ga)) - bf2f(GAb[(size_t)i * DM + n])), ef = fabsf(1.0f / (1.0f + expf(-gf)) - bf2f(GFb[(size_t)i * DM + n]));
            if (ea > 0.05f) { atomicMin(dw + 192, (unsigned)s); atomicAdd(dw + 64, 1u); dbg_report(dw, 0.f, DBG_GF ? ea : bf2f(GAb[(size_t)i * DM + n]), 1000.0f); } if (ef > 0.05f) atomicMin(dw + 193, (unsigned)s); }
    PHASE_END
    }
    PHASE_BEGIN
        { pg::Sched<JobGate2> S{{FB}, 512, F.G, bx}; EpiGate E{0, 0, FB};
          pg::gemm_phase<EpiGate, pg::Sched<JobGate2>, 1>(F.lds, gK1024, S, E); }
        { Geo g{2048, 2048, 3072, 128u * 2048 * 2u, 128u * 2048 * 2u, 128u * 3072 * 2u, 16, 1 << 20, 1 << 20};
          pg::Sched<JobZ> S{{FB, 0}, 256, F.G, bx}; EpiZ2 E{0, 0, FB, 0};
          pg::gemm_phase<EpiZ2, pg::Sched<JobZ>, 1>(F.lds, g, S, E); }
        { Geo g{2048, 2048, 3072, 128u * 2048 * 2u, 128u * 2048 * 2u, 128u * 3072 * 2u, 32, 1 << 20, 1 << 20};
          pg::Sched<JobZ> S{{FB, 1}, 256, F.G, bx}; EpiZ2 E{0, 0, FB, 1};
          pg::gemm_phase<EpiZ2, pg::Sched<JobZ>, 1>(F.lds, g, S, E); }
    PHASE_END
    if constexpr (DBG_PROBE == 9 || DBG_PROBE == 10) {
    PHASE_BEGIN
        LAS float* scr = (LAS float*)F.lds; unsigned* dw = (unsigned*)(F.ws + WS_CTL) + 32768;
        const int s = bx; const int i = (int)(((unsigned)s * 2654435761u) >> 18) & 16383, n = (s * 131 + 7) & 1023;
        if (DBG_PROBE == 9) { float ga = 0.f, gf = 0.f;
            (void)ga; (void)gf;
        } else { float r = 0.f, fo = 0.f;
            for (int k = F.tid; k < 2048; k += NTHREADS) r += bf2f(Ob[(size_t)i * 2048 + k]) * args.in[14][(size_t)k * DM + n];
            for (int k = F.tid; k < 1024; k += NTHREADS) fo += bf2f(MIXb[(size_t)i * 2048 + k]) * args.in[15][(size_t)k * DM + n];
            r = block_sum(scr, r, F.tid); fo = block_sum(scr, fo, F.tid);
            if (F.tid == 0) dbg_report(dw, bf2f(GAb[(size_t)i * DM + n]) * r + bf2f(GFb[(size_t)i * DM + n]) * fo, bf2f(Zb[(size_t)i * DM + n]), 1000.0f); }
    PHASE_END
    }
    PHASE_BEGIN
        Geo g{2048, 2048, DM, 128u * 2048 * 2u, 128u * 2048 * 2u, 128u * DM * 2u, DM / 64, 1 << 20, 1 << 20};
        pg::Sched<JobRowCol> S{{FB, 2, 64, 4, 0, 0, (size_t)256 * 2048, (size_t)256 * DM}, 256, F.G, bx};
        EpiFuse E{0, 0, FB, 1, args.in[0], args.in[17]};
        pg::gemm_phase<EpiFuse, pg::Sched<JobRowCol>, 1>(F.lds, g, S, E);
    PHASE_END
    }
    PHASE_BEGIN
        pg::Sched<JobFfn1> S{{FB, 64, 0}, 64 * 22, F.G, bx};
        EpiSwiglu E{0, 0, FB};
        pg::gemm_phase<EpiSwiglu, pg::Sched<JobFfn1>, 1>(F.lds, gK1024, S, E);
    PHASE_END
    PHASE_BEGIN
        pg::Sched<JobFfn2> S{{FB, 64, 0}, 64 * 4, F.G, bx};
        EpiFuse E{0, 0, FB, 2, args.in[0], args.in[20]};
        pg::gemm_phase<EpiFuse, pg::Sched<JobFfn2>, 1>(F.lds, gFfn2, S, E);
    PHASE_END
    if constexpr (DBG_TSEL >= 0) {
    PHASE_BEGIN
        const unsigned long long* ts = (const unsigned long long*)(F.ws + WS_CTL + 160000);
        if (bx == 0) { const float a = 0.1f * (float)(ts[DBG_TSEL + 1] - ts[DBG_TSEL]), b = 0.1f * (float)(ts[DBG_TSEL2 + 1] - ts[DBG_TSEL2]);
            if (F.tid == 0) ((float*)F.dout)[0] = a; for (int i = F.tid; i < 1024; i += NTHREADS) ((float*)F.dout)[1024 + i] = b; }
    PHASE_END
    }
    if constexpr (DBG_PROBE != 0) {
    PHASE_BEGIN
        if (bx == 0 && F.tid == 0) { const float e = __builtin_bit_cast(float, ((unsigned*)(F.ws + WS_CTL))[32768]); ((float*)F.dout)[0] = DBG_COUNT == 3 ? 100.0f * (float)(16u + ((((unsigned*)(F.ws + WS_CTL))[32768 + 192 + DBG_GF] + 0xC0000000u - 0xC0000000u) >> DBG_SH & 15u)) : DBG_COUNT == 2 ? 100.0f * (float)(16u + ((unsigned*)(F.ws + WS_CTL))[32768 + 128]) : DBG_COUNT ? 1000.0f + 10.0f * (float)((unsigned*)(F.ws + WS_CTL))[32768 + 64] : 1000.0f * (10.0f + log10f(e + 1e-10f)); }
    PHASE_END
    }
}

extern "C" void kernel_launch(void* const* d_in, const int* in_sizes, int n_in, void* d_out, int out_size, void* d_ws, size_t ws_size, hipStream_t stream) {
    static int grid = 0;
    if (grid == 0) {
        if (n_in != 21 || out_size != SEQ * DM || ws_size < 256 * MiB) { fprintf(stderr, "kernel_launch: unexpected shapes (n_in %d out %d ws %zu)\n", n_in, out_size, ws_size); grid = -1; return; }
        int dev = 0, cus = 0, per_cu = 0;
        if (hipGetDevice(&dev) != hipSuccess || hipDeviceGetAttribute(&cus, hipDeviceAttributeMultiprocessorCount, dev) != hipSuccess) { grid = -1; return; }
        if (hipFuncSetAttribute((const void*)fwd_kernel, hipFuncAttributeMaxDynamicSharedMemorySize, LDS_BYTES) != hipSuccess) { fprintf(stderr, "kernel_launch: hipFuncSetAttribute failed\n"); grid = -1; return; }
        if (hipOccupancyMaxActiveBlocksPerMultiprocessor(&per_cu, (const void*)fwd_kernel, NTHREADS, LDS_BYTES) != hipSuccess || per_cu < 1) { fprintf(stderr, "kernel_launch: occupancy query says %d blocks/CU\n", per_cu); }
        (void)hipGetLastError();
        grid = cus;
    }
    if (grid < 0) return;
    (void)hipMemsetAsync((char*)d_ws + WS_CTL, 0, CTL_ZERO_BYTES, stream);
    Args a{};
    for (int i = 0; i < 21; ++i) a.in[i] = (const float*)d_in[i];
    a.out = (float*)d_out; a.ws = (unsigned char*)d_ws; a.ph_lo = 0; a.ph_hi = 1000;
    hipLaunchKernelGGL(fwd_kernel, dim3(grid), dim3(NTHREADS), LDS_BYTES, stream, a);
}
```

```cpp
#include <hip/hip_runtime.h>
#include <cstdio>
#include <cstdint>

#ifndef DBG_NOFOUR
#define DBG_NOFOUR 0
#endif
#ifndef DBG_NORET
#define DBG_NORET 0
#endif
#ifndef DBG_PROBE
#define DBG_PROBE 0
#endif
#ifndef DBG_COUNT
#define DBG_COUNT 0
#ifndef DBG_COL
#define DBG_COL 736
#endif
#ifndef DBG_VAR
#define DBG_VAR 2
#endif
#ifndef DBG_SH
#define DBG_SH 0
#endif
#ifndef DBG_GF
#define DBG_GF 1
#endif
#ifndef DBG_S0
#define DBG_S0 4
#endif
#endif
#ifndef DBG_XBAR
#define DBG_XBAR 0
#endif
#ifndef DBG_DUP
#define DBG_DUP -1
#endif
#ifndef DBG_TSEL
#define DBG_TSEL -1
#endif
#ifndef DBG_TSEL2
#define DBG_TSEL2 1
#endif
#ifndef PG_ALIGN
#define PG_ALIGN 1
#endif
#ifndef STOP_AFTER
#define STOP_AFTER 99
#endif

#define LAS __attribute__((address_space(3)))
typedef unsigned short bf16_t;
typedef short bf16x8 __attribute__((ext_vector_type(8)));
typedef float f32x4 __attribute__((ext_vector_type(4)));
typedef float f32x2 __attribute__((ext_vector_type(2)));
typedef unsigned u32x4 __attribute__((ext_vector_type(4)));
typedef unsigned u32x2 __attribute__((ext_vector_type(2)));

constexpr int DM = 1024, SEQ = 16384, CTX = 256, DFF = 2816;
constexpr float EPS = 1e-6f;
constexpr int LS = 512, NSEG = SEQ / LS;

constexpr size_t MiB = 1u << 20;
constexpr size_t WS_CTL = 0, CTL_ZERO_BYTES = 1 * MiB;
constexpr size_t WS_MOD = 1 * MiB;
constexpr size_t WS_TAB = 2 * MiB;
constexpr size_t WS_STATS = 3 * MiB;
constexpr size_t WS_S0 = 4 * MiB;
constexpr size_t WS_KC = 8 * MiB;
constexpr size_t WS_VC = 9 * MiB;
constexpr size_t WS_DC = 10 * MiB;
constexpr size_t WS_HC = 12 * MiB;
constexpr size_t WS_WIN = 14 * MiB;
constexpr size_t WS_WN = 34 * MiB;
constexpr size_t WS_WB = 36 * MiB;
constexpr size_t WS_H = 54 * MiB;
constexpr size_t WS_Q = 54 * MiB, WS_KN = 70 * MiB, WS_KT = 86 * MiB, WS_B4 = 118 * MiB;
constexpr size_t WS_O = 182 * MiB;
constexpr size_t WS_END = 246 * MiB;
constexpr size_t WS_XB = 11 * MiB;
constexpr size_t WS_OUTW = 246 * MiB;
constexpr size_t WS_XCSLAB = 150 * MiB;
constexpr size_t WS_WT = 118 * MiB, WS_BT = 54 * MiB, WS_MIX = 118 * MiB, WS_GA = 54 * MiB, WS_GF = 86 * MiB;
constexpr size_t DO_AX = 32 * MiB;
constexpr int WR_G = 4096, WR_F = 6144, WR_GA = 8192, WR_GF = 9216;
constexpr size_t WB_W13 = 0, WB_W2 = 11 * MiB;
constexpr size_t WB_BZ = 0, WB_WO = 6 * MiB;
constexpr size_t TB_ROPE = 0, TB_TW = 128 * 1024, TB_FM = 256 * 1024, TB_GM = 384 * 1024, TB_T256 = 512 * 1024;

typedef __bf16 bf16x2_t __attribute__((ext_vector_type(2)));
__device__ __forceinline__ unsigned cvt_pk_bf16(float lo, float hi) { const f32x2 v = {lo, hi}; return __builtin_bit_cast(unsigned, __builtin_convertvector(v, bf16x2_t)); }
__device__ __forceinline__ unsigned short f2bf(float f) { unsigned u = __builtin_bit_cast(unsigned, f); return (unsigned short)((u + 0x7fffu + ((u >> 16) & 1u)) >> 16); }
__device__ __forceinline__ float bflo(unsigned u) { return __builtin_bit_cast(float, u << 16); }
__device__ __forceinline__ float bfhi(unsigned u) { return __builtin_bit_cast(float, u & 0xffff0000u); }
__device__ __forceinline__ u32x4 pack8(const f32x4 a, const f32x4 b) { u32x4 w; w.x = cvt_pk_bf16(a[0], a[1]); w.y = cvt_pk_bf16(a[2], a[3]); w.z = cvt_pk_bf16(b[0], b[1]); w.w = cvt_pk_bf16(b[2], b[3]); return w; }
__device__ __forceinline__ void unpack8(const u32x4 w, f32x4& a, f32x4& b) { a = (f32x4){bflo(w.x), bfhi(w.x), bflo(w.y), bfhi(w.y)}; b = (f32x4){bflo(w.z), bfhi(w.z), bflo(w.w), bfhi(w.w)}; }

__device__ __forceinline__ void st16wt(void* p, const u32x4 v) { asm volatile("global_store_dwordx4 %0, %1, off sc1\n\ts_nop 1" :: "v"(p), "v"(v) : "memory"); }
__device__ __forceinline__ float fsigmoid(float a) { return __builtin_amdgcn_rcpf(1.0f + __expf(-a)); }
__device__ __forceinline__ float fsilu(float a) { return a * fsigmoid(a); }
__device__ __forceinline__ float wave_sum(float v) {
#pragma unroll
    for (int o = 1; o < 64; o <<= 1) v += __shfl_xor(v, o);
    return v;
}

namespace pg {
constexpr int BM = 256, BK = 64, HALF = 128, HTB = HALF * BK * 2, STAGE_BYTES = 8 * HTB, NXCD = 8, WGM = 4;
__device__ __forceinline__ int lds_byte(int r, int c) { const int st = (r >> 4) * 2 + (c >> 5), rr = r & 15, cc = c & 31, ob = rr * 64 + cc * 2; return st * 1024 + (ob ^ (((ob >> 9) & 1) << 5)); }
__device__ __forceinline__ void stage_rc(int b, int& R, int& C) { const int st = b / 1024, sb = b % 1024, swz = sb ^ (((sb >> 9) & 1) << 5); R = (st >> 1) * 16 + swz / 64; C = (st & 1) * 32 + (swz % 64) / 2; }
__device__ __forceinline__ int perm32(int rho) { const int n = rho >> 4, i = rho & 15; return 8 * (i >> 2) + 4 * n + (i & 3); }

struct Unit { const char* a0; const char* a1; const char* b; char* d; int i0, i1, i2, i3; };
struct Geo { unsigned lda0, lda1, ldb;
             unsigned hsA0, hsA1, hsB;
             int nt, c0, rep0; };

__device__ __forceinline__ void tile_pm_pn(int L, int nM, int nN, int& pm, int& pn) {
    const int nwg = nM * nN; int wgid = L;
    { const int q = nwg / NXCD, r = nwg % NXCD, xcd = wgid % NXCD, off = wgid / NXCD; wgid = (xcd < r ? xcd * (q + 1) : r * (q + 1) + (xcd - r) * q) + off; }
    const int nig = WGM * nN, gid = wgid / nig, fm = gid * WGM, gsz = (nM - fm) < WGM ? (nM - fm) : WGM;
    pm = fm + ((wgid % nig) % gsz); pn = (wgid % nig) / gsz;
}
__device__ __forceinline__ int xcd_contig(int L, int n) { return (L % NXCD) * (n / NXCD) + L / NXCD; }

template <class Job> struct Sched {
    Job j; int n, G, c;
    __device__ __forceinline__ bool next(int i, Unit& u) const { const long L = (long)i * G + c; if (L >= n) return false; j.fill((int)L, u); return true; }
};

template <class Epi, class Sch, int ASEG>
__device__ __forceinline__ void gemm_phase(LAS unsigned char* lds, const Geo g, const Sch& S, const Epi& E) {
    int tid = threadIdx.x; asm volatile("" : "+v"(tid));
    const int wid = __builtin_amdgcn_readfirstlane(tid >> 6), lane = tid & 63, wr = wid >> 2, wc = wid & 3, fr = lane & 15, fq = lane >> 4;
    int nt = g.nt; asm volatile("" : "+s"(nt));
    unsigned voffA0[2], voffA1[2], voffB[2];
#pragma unroll
    for (int i = 0; i < 2; ++i) { int R, C; stage_rc(tid * 16 + i * 8192, R, C); const int Rb = (R & ~31) + perm32(R & 31);
        voffA0[i] = (unsigned)(R * g.lda0 + C) * 2u; voffA1[i] = (ASEG == 2) ? (unsigned)(R * g.lda1 + C) * 2u : 0u; voffB[i] = (unsigned)(Rb * g.ldb + C) * 2u; }
    const unsigned ldsw = (unsigned)wid * 1024u;
    const int aoff = lds_byte(wr * 64 + fr, fq * 8), boff = lds_byte(wc * 32 + fr, fq * 8);
#define PG_SA(b, h) (((b) * 2 + (h)) * HTB)
#define PG_SB(b, h) ((4 + (b) * 2 + (h)) * HTB)
#define PG_GLDS(gp, lp) __builtin_amdgcn_global_load_lds((const unsigned*)(gp), (LAS unsigned*)(lp), 16, 0, 0)
#define PG_ASEL(T) (ASEG == 2 && (T) >= g.c0)
#define PG_APTR(U, T) (PG_ASEL(T) ? (U).a1 + (size_t)((T) - g.c0) * 128 : (U).a0 + (size_t)((T) & (g.rep0 - 1)) * 128)
#define PG_STAGE_A(bufoff, gbase, h, sel) do { const bool _s = (sel); const unsigned _v0 = _s ? voffA1[0] : voffA0[0], _v1 = _s ? voffA1[1] : voffA0[1]; \
        const char* _p = (gbase) + ((h) ? (size_t)(_s ? g.hsA1 : g.hsA0) : (size_t)0); \
        PG_GLDS(_p + _v0, lds + (bufoff) + ldsw); PG_GLDS(_p + _v1, lds + (bufoff) + ldsw + 8192); } while (0)
#define PG_STAGE_B(bufoff, gbase, h) do { const char* _p = (gbase) + ((h) ? (size_t)g.hsB : (size_t)0); \
        PG_GLDS(_p + voffB[0], lds + (bufoff) + ldsw); PG_GLDS(_p + voffB[1], lds + (bufoff) + ldsw + 8192); } while (0)
#define PG_LDA(dst, b, h) do { _Pragma("unroll") for (int m = 0; m < 4; ++m) _Pragma("unroll") for (int k = 0; k < 2; ++k) dst[m][k] = *(const LAS bf16x8*)(lds + PG_SA(b, h) + aoff + m * 2048 + k * 1024); } while (0)
#define PG_LDB(dst, b, h) do { _Pragma("unroll") for (int n = 0; n < 2; ++n) _Pragma("unroll") for (int k = 0; k < 2; ++k) dst[n][k] = *(const LAS bf16x8*)(lds + PG_SB(b, h) + boff + n * 2048 + k * 1024); } while (0)
#define PG_MMA(ai, bj, At, Bt) do { __builtin_amdgcn_s_setprio(1); _Pragma("unroll") for (int m = 0; m < 4; ++m) _Pragma("unroll") for (int n = 0; n < 2; ++n) _Pragma("unroll") for (int k = 0; k < 2; ++k) \
        acc[ai][bj][m][n] = __builtin_amdgcn_mfma_f32_16x16x32_bf16(Bt[n][k], At[m][k], acc[ai][bj][m][n], 0, 0, 0); __builtin_amdgcn_s_setprio(0); } while (0)
#define PG_WAIT_V(n) asm volatile("s_waitcnt vmcnt(" #n ")" ::: "memory")
#define PG_WAIT_L(n) asm volatile("s_waitcnt lgkmcnt(" #n ")" ::: "memory")
#define PG_BAR __builtin_amdgcn_s_barrier()
#define PG_SCHED __builtin_amdgcn_sched_barrier(0)
    Unit cur, nxt; int ui = 0;
    if (!S.next(0, cur)) return;
    f32x4 acc[2][2][4][2];
#pragma unroll
    for (int a = 0; a < 2; ++a)
#pragma unroll
        for (int b = 0; b < 2; ++b)
#pragma unroll
            for (int m = 0; m < 4; ++m)
#pragma unroll
                for (int n = 0; n < 2; ++n) acc[a][b][m][n] = (f32x4){0.f, 0.f, 0.f, 0.f};
    bf16x8 At[4][2], B0[2][2], B1[2][2];
    { const char* p0 = PG_APTR(cur, 0); const char* p1 = PG_APTR(cur, 1);
      PG_STAGE_B(PG_SB(0, 0), cur.b, 0); PG_STAGE_B(PG_SB(0, 1), cur.b, 1); PG_STAGE_A(PG_SA(0, 0), p0, 0, PG_ASEL(0)); PG_STAGE_A(PG_SA(0, 1), p0, 1, PG_ASEL(0));
      if (wr == 1) PG_BAR;
      PG_WAIT_V(2); PG_BAR;
      PG_STAGE_B(PG_SB(1, 0), cur.b + 128, 0); PG_STAGE_A(PG_SA(1, 0), p1, 0, PG_ASEL(1)); PG_STAGE_B(PG_SB(1, 1), cur.b + 128, 1);
      PG_WAIT_V(6); PG_BAR; }
    for (;;) {
        const bool has_next = S.next(ui + 1, nxt);
        const char* nA0 = has_next ? PG_APTR(nxt, 0) : PG_APTR(cur, 0); const char* nA1 = has_next ? PG_APTR(nxt, 1) : PG_APTR(cur, 1); const char* nB = has_next ? nxt.b : cur.b;
        for (int t = 0; t < nt; t += 2) {
            const bool last = (t == nt - 2);
            if constexpr (Epi::NHOOK >= 1) { if (t == E.h0) { int t2 = threadIdx.x; asm volatile("" : "+v"(t2)); E.hook(acc, cur, 0, wr, wc, t2 & 15, (t2 >> 4) & 3); } }
            if constexpr (Epi::NHOOK >= 2) { if (t == E.h1) { int t2 = threadIdx.x; asm volatile("" : "+v"(t2)); E.hook(acc, cur, 1, wr, wc, t2 & 15, (t2 >> 4) & 3); } }
            const char* a1 = PG_APTR(cur, t + 1); const bool s1 = PG_ASEL(t + 1);
            const char* a2 = last ? nA0 : PG_APTR(cur, t + 2); const char* a3 = last ? nA1 : PG_APTR(cur, t + 3);
            const char* b2 = last ? nB : cur.b + (size_t)(t + 2) * 128; const char* b3 = b2 + 128;
            const bool s2 = last ? PG_ASEL(0) : PG_ASEL(t + 2), s3 = last ? PG_ASEL(1) : PG_ASEL(t + 3);
            PG_LDB(B0, 0, 0); PG_LDB(B1, 0, 1); PG_SCHED; PG_LDA(At, 0, 0); PG_STAGE_A(PG_SA(1, 1), a1, 1, s1);
            PG_WAIT_V(8); PG_WAIT_L(0); PG_BAR; PG_MMA(0, 0, At, B0); PG_MMA(0, 1, At, B1); PG_BAR; PG_SCHED;
            PG_LDA(At, 0, 1); PG_STAGE_B(PG_SB(0, 0), b2, 0); PG_STAGE_B(PG_SB(0, 1), b2, 1); PG_STAGE_A(PG_SA(0, 0), a2, 0, s2);
            PG_WAIT_V(8); PG_WAIT_L(0); PG_BAR; PG_MMA(1, 0, At, B0); PG_MMA(1, 1, At, B1); PG_BAR; PG_SCHED;
            PG_LDB(B0, 1, 0); PG_LDB(B1, 1, 1); PG_SCHED; PG_LDA(At, 1, 0); PG_STAGE_A(PG_SA(0, 1), a2, 1, s2);
            PG_WAIT_V(8); PG_WAIT_L(0); PG_BAR; PG_MMA(0, 0, At, B0); PG_MMA(0, 1, At, B1); PG_BAR; PG_SCHED;
            PG_LDA(At, 1, 1); PG_STAGE_B(PG_SB(1, 0), b3, 0); PG_STAGE_B(PG_SB(1, 1), b3, 1); PG_STAGE_A(PG_SA(1, 0), a3, 0, s3);
            PG_WAIT_V(8); PG_WAIT_L(0); PG_BAR; PG_MMA(1, 0, At, B0); PG_MMA(1, 1, At, B1); PG_BAR; PG_SCHED;
        }
        if (PG_ALIGN && wr == 0) PG_BAR;
        if constexpr (!Epi::AFTER_DRAIN) { int t2 = threadIdx.x; asm volatile("" : "+v"(t2)); E(acc, cur, wr, wc, t2 & 15, (t2 >> 4) & 3); }
        if (!has_next) break;
#pragma unroll
        for (int a = 0; a < 2; ++a)
#pragma unroll
            for (int b = 0; b < 2; ++b)
#pragma unroll
                for (int m = 0; m < 4; ++m)
#pragma unroll
                    for (int n = 0; n < 2; ++n) acc[a][b][m][n] = (f32x4){0.f, 0.f, 0.f, 0.f};
        cur = nxt; ++ui;
        if (PG_ALIGN && wr == 1) PG_BAR;
    }
    PG_WAIT_V(0);
    if (!PG_ALIGN && wr == 0) PG_BAR;
    PG_BAR;
    if constexpr (Epi::AFTER_DRAIN) { int t2 = threadIdx.x; asm volatile("" : "+v"(t2)); E.fused(acc, cur, wr, wc, t2 & 15, (t2 >> 4) & 3, lds, wid, t2 & 63); }
#undef PG_SA
#undef PG_SB
#undef PG_GLDS
#undef PG_ASEL
#undef PG_APTR
#undef PG_STAGE_A
#undef PG_STAGE_B
#undef PG_LDA
#undef PG_LDB
#undef PG_MMA
#undef PG_WAIT_V
#undef PG_WAIT_L
#undef PG_BAR
#undef PG_SCHED
}
}
using pg::Unit; using pg::Geo;

#define EPI_ROWS _Pragma("unroll") for (int ai = 0; ai < 2; ++ai) _Pragma("unroll") for (int m = 0; m < 4; ++m)
#define EPI_ROW (128 * ai + 64 * wr + 16 * m + fr)
#define EPI_COLS _Pragma("unroll") for (int bj = 0; bj < 2; ++bj)
#define EPI_COL0 (128 * bj + 32 * wc + 8 * fq)
typedef f32x4 acc_t[2][2][4][2];

struct Base { unsigned char* ws; unsigned char* dout; };
#define modx ((float*)(F.ws + WS_MOD))
#define modc (modx + 9216)
#define lgp (modx + 2 * 9216)
#define Ax ((bf16_t*)(F.dout + DO_AX))
#define Ac ((bf16_t*)(F.ws + WS_DC + 512 * 1024))
#define Dx ((bf16_t*)F.dout)
#define Dc ((bf16_t*)(F.ws + WS_DC))
#define Hb ((bf16_t*)(F.ws + WS_H))
#define Hc ((bf16_t*)(F.ws + WS_HC))
#define W13t ((bf16_t*)(F.ws + WS_WB + WB_W13))
#define W2t ((bf16_t*)(F.ws + WS_WB + WB_W2))
#define W13t1 ((bf16_t*)(F.ws + WS_O + WB_W13))
#define W2t1 ((bf16_t*)(F.ws + WS_O + WB_W2))
#define ropeT ((float*)(F.ws + WS_TAB + TB_ROPE))
#define twT ((float*)(F.ws + WS_TAB + TB_TW))
#define FmT ((bf16_t*)(F.ws + WS_TAB + TB_FM))
#define GmT ((bf16_t*)(F.ws + WS_TAB + TB_GM))
#define T256 ((bf16_t*)(F.ws + WS_TAB + TB_T256))
#define Win ((bf16_t*)(F.ws + WS_WIN))
#define Wn ((bf16_t*)(F.ws + WS_WN))
#define Bz ((bf16_t*)(F.ws + WS_OUTW))
#define WoT ((bf16_t*)(F.ws + WS_OUTW + 6 * MiB))
#define Qb ((bf16_t*)(F.ws + WS_Q))
#define Knb ((bf16_t*)(F.ws + WS_KN))
#define Ktb_ ((bf16_t*)(F.ws + WS_KT))
#define Pb Ktb_
#define B4 ((bf16_t*)(F.ws + WS_B4))
#define Ob ((bf16_t*)(F.ws + WS_O))
#define S0 ((float*)(F.ws + WS_S0))
#define stats ((float*)(F.ws + WS_STATS))
#define KcT ((bf16_t*)(F.ws + WS_KC))
#define VcT ((bf16_t*)(F.ws + WS_VC))
#define Wt ((bf16_t*)(F.ws + WS_WT))
#define Bt ((bf16_t*)(F.ws + WS_BT))
#define MIXb ((bf16_t*)(F.ws + WS_MIX))
#define GAb ((bf16_t*)(F.ws + WS_GA))
#define GFb ((bf16_t*)(F.ws + WS_GF))
#define Zb (MIXb + 1024)
#define XcSlab ((float*)(F.ws + WS_XCSLAB))

struct EpiSwiglu {
    static constexpr int NHOOK = 0; static constexpr int AFTER_DRAIN = 0; int h0, h1;
    Base F;
    __device__ __forceinline__ void hook(acc_t&, const Unit&, int, int, int, int, int) const {}
    __device__ __forceinline__ void operator()(const acc_t& acc, const Unit& u, int wr, int wc, int fr, int fq) const {
        bf16_t* base = u.i0 < 64 ? Hb + (size_t)u.i0 * 256 * DFF : Hc;
        EPI_ROWS { bf16_t* rowp = base + (size_t)EPI_ROW * DFF + u.i1 * 128 + 32 * wc + 8 * fq; f32x4 h[2];
#pragma unroll
            for (int n = 0; n < 2; ++n)
#pragma unroll
                for (int e = 0; e < 4; ++e) h[n][e] = fsilu(acc[ai][0][m][n][e]) * acc[ai][1][m][n][e];
            if (u.i0 == 64) st16wt(rowp, pack8(h[0], h[1])); else *(u32x4*)rowp = pack8(h[0], h[1]); if (m & 1) asm volatile("" ::: "memory"); }
        if (u.i0 == 64) { asm volatile("s_waitcnt vmcnt(0)" ::: "memory");
            if (fr == 0 && fq == 0) __hip_atomic_fetch_add((unsigned*)(F.ws + WS_CTL) + 24576, 1u, __ATOMIC_RELAXED, __HIP_MEMORY_SCOPE_AGENT); }
    }
};
struct EpiResid {
    static constexpr int NHOOK = 0; static constexpr int AFTER_DRAIN = 0; int h0, h1;
    Base F; int mode;
    __device__ __forceinline__ void hook(acc_t&, const Unit&, int, int, int, int, int) const {}
    __device__ __forceinline__ void operator()(const acc_t& acc, const Unit& u, int wr, int wc, int fr, int fq) const {
        const bool isx = u.i0 < 64; const int has_old = mode != 0; const float scale = mode == 1 ? 1.0f : 0.5f;
        const bf16_t* din = Dx + (size_t)u.i0 * 256 * DM; bf16_t* dout = isx ? (mode == 2 ? Ob : Dx) + (size_t)u.i0 * 256 * DM : Dc;
        const float* coef = (isx ? modx : modc) + (mode == 0 ? 2 : (mode == 1 ? 5 : 8)) * DM + u.i1 * 256;
        EPI_COLS { const int c = EPI_COL0; const f32x4 c0 = *(const f32x4*)(coef + c) * scale, c1 = *(const f32x4*)(coef + c + 4) * scale;
#pragma unroll
            for (int ai = 0; ai < 2; ++ai)
#pragma unroll
                for (int m = 0; m < 4; ++m) { const size_t off = (size_t)EPI_ROW * DM + u.i1 * 256 + c;
                    f32x4 v0 = acc[ai][bj][m][0] * c0, v1 = acc[ai][bj][m][1] * c1;
                    if (has_old) { f32x4 o0, o1; unpack8(*(const u32x4*)(din + off), o0, o1); v0 += o0; v1 += o1; }
                    *(u32x4*)(dout + off) = pack8(v0, v1); if (m & 1) asm volatile("" ::: "memory"); } }
    }
};

struct EpiFuse {
    static constexpr int NHOOK = 0; static constexpr int AFTER_DRAIN = 1; int h0, h1; Base F; int mode; const float* x; const float* nw;
    __device__ __forceinline__ void hook(acc_t&, const Unit&, int, int, int, int, int) const {}
    __device__ __forceinline__ void operator()(const acc_t&, const Unit&, int, int, int, int) const {}
    __device__ __forceinline__ void fused(acc_t& acc, const Unit& u, int wr, int wc, int fr, int fq, LAS unsigned char* lds, int wid, int lane) const {
        const int pm = u.i0, pn = u.i1; const float scale = mode == 1 ? 1.0f : 0.5f;
        const float* coef = modx + (mode == 0 ? 2 : (mode == 1 ? 5 : 8)) * DM + pn * 256;
        const bf16_t* din = (mode == 2 ? Ob : Dx) + (size_t)pm * 256 * DM + pn * 256; bf16_t* dout = (mode == 1 ? Ob : Dx) + (size_t)pm * 256 * DM + pn * 256;
        const float* xt = x + (size_t)pm * 256 * DM + pn * 256;
        LAS float* P = (LAS float*)lds; LAS float* S = (LAS float*)(lds + 4096);
        f32x4 cf[2][2];
#pragma unroll
        for (int bj = 0; bj < 2; ++bj) { cf[bj][0] = *(const f32x4*)(coef + EPI_COL0) * scale; cf[bj][1] = *(const f32x4*)(coef + EPI_COL0 + 4) * scale; }
#pragma unroll
        for (int aim = 0; aim < 4; ++aim) { const int ai = aim >> 1; f32x4 xv[4][2][2]; u32x4 ov[4][2];
#pragma unroll
            for (int m = 2 * (aim & 1); m < 2 * (aim & 1) + 2; ++m) EPI_COLS { const size_t off = (size_t)EPI_ROW * DM + EPI_COL0; xv[m][bj][0] = *(const f32x4*)(xt + off); xv[m][bj][1] = *(const f32x4*)(xt + off + 4); if (mode != 0) ov[m][bj] = *(const u32x4*)(din + off); }
#pragma unroll
            for (int m = 2 * (aim & 1); m < 2 * (aim & 1) + 2; ++m) { const int row = EPI_ROW; float ss = 0.f;
                EPI_COLS { const size_t off = (size_t)row * DM + EPI_COL0; f32x4 d0 = acc[ai][bj][m][0] * cf[bj][0], d1 = acc[ai][bj][m][1] * cf[bj][1];
                    if (mode != 0) { f32x4 o0, o1; unpack8(ov[m][bj], o0, o1); d0 += o0; d1 += o1; }
                    if (mode != 2) *(u32x4*)(dout + off) = pack8(d0, d1);
                    const f32x4 v0 = xv[m][bj][0] + d0, v1 = xv[m][bj][1] + d1; acc[ai][bj][m][0] = v0; acc[ai][bj][m][1] = v1;
                    ss += (v0[0] * v0[0] + v0[1] * v0[1]) + (v0[2] * v0[2] + v0[3] * v0[3]) + (v1[0] * v1[0] + v1[1] * v1[1]) + (v1[2] * v1[2] + v1[3] * v1[3]); }
                ss += __shfl_xor(ss, 16); ss += __shfl_xor(ss, 32);
                if (fq == 0) P[row * 4 + wc] = ss; }
            asm volatile("" ::: "memory"); }
        asm volatile("s_waitcnt lgkmcnt(0)" ::: "memory"); __builtin_amdgcn_s_barrier(); asm volatile("" ::: "memory");
        float* xb = (float*)(F.ws + WS_XB) + (size_t)mode * 64 * 256 * 4; unsigned* cnt = (unsigned*)(F.ws + WS_CTL) + 8192 + mode * 4096 + 64 * pm;
        const int prow = wid * 32 + (lane & 31);
        if (lane < 32) { const float t = (P[prow * 4 + 0] + P[prow * 4 + 1]) + (P[prow * 4 + 2] + P[prow * 4 + 3]);
            __hip_atomic_store(xb + ((size_t)(pm * 256 + prow) * 4 + pn), t, __ATOMIC_RELAXED, __HIP_MEMORY_SCOPE_AGENT); }
        asm volatile("s_waitcnt vmcnt(0)" ::: "memory");
        if (lane == 0) __hip_atomic_fetch_add(cnt, 1u, __ATOMIC_RELAXED, __HIP_MEMORY_SCOPE_AGENT);
        if (wid == 0) { unsigned sp = 0;
            while ((unsigned)__builtin_amdgcn_readfirstlane(__hip_atomic_load(cnt, __ATOMIC_RELAXED, __HIP_MEMORY_SCOPE_AGENT)) < 32u) { __builtin_amdgcn_s_sleep(2); if (++sp > (1u << 22)) break; }
            __builtin_amdgcn_fence(__ATOMIC_ACQUIRE, "agent"); }
        asm volatile("s_waitcnt vmcnt(0) lgkmcnt(0)" ::: "memory"); __builtin_amdgcn_s_barrier(); asm volatile("" ::: "memory");
        if (lane < 32) { const float* sl = xb + (size_t)(pm * 256 + prow) * 4; float t = 0.f;
#pragma unroll
            for (int q = 0; q < 4; ++q) t += __hip_atomic_load(sl + q, __ATOMIC_RELAXED, __HIP_MEMORY_SCOPE_AGENT);
            S[prow] = 1.0f / sqrtf(t * (1.0f / DM) + EPS); }
        asm volatile("s_waitcnt lgkmcnt(0)" ::: "memory"); __builtin_amdgcn_s_barrier(); asm volatile("" ::: "memory");
        const float* md = modx + (mode == 0 ? 3 : 6) * DM + pn * 256; const float* nwp = nw + pn * 256;
        f32x4 wv[2][2], shv[2][2];
#pragma unroll
        for (int bj = 0; bj < 2; ++bj)
#pragma unroll
            for (int n = 0; n < 2; ++n) { const int c = EPI_COL0 + 4 * n; const f32x4 w = *(const f32x4*)(nwp + c);
                if (mode == 2) { wv[bj][n] = w; shv[bj][n] = (f32x4){0.f, 0.f, 0.f, 0.f}; } else { wv[bj][n] = w * (*(const f32x4*)(md + DM + c) + 1.0f); shv[bj][n] = *(const f32x4*)(md + c); } }
        EPI_ROWS { const int row = EPI_ROW; const float rinv = S[row];
            EPI_COLS { const size_t off = (size_t)row * DM + EPI_COL0;
                const f32x4 y0 = (acc[ai][bj][m][0] * rinv) * wv[bj][0] + shv[bj][0], y1 = (acc[ai][bj][m][1] * rinv) * wv[bj][1] + shv[bj][1];
                if (mode == 2) { float* o = (float*)F.dout + (size_t)pm * 256 * DM + pn * 256 + off; *(f32x4*)o = y0; *(f32x4*)(o + 4) = y1; }
                else *(u32x4*)(Ax + (size_t)pm * 256 * DM + pn * 256 + off) = pack8(y0, y1); } }
        asm volatile("s_waitcnt lgkmcnt(0)" ::: "memory"); __builtin_amdgcn_s_barrier(); asm volatile("" ::: "memory");
    }
};
struct JobFfn1 {
    Base F; int nM, first;
    __device__ __forceinline__ void fill(int L, Unit& u) const { int pm, pn; if (first) { if (L < 22) { pm = 64; pn = L; } else pg::tile_pm_pn(L - 22, 64, 22, pm, pn); } else pg::tile_pm_pn(L, nM, 22, pm, pn);
        u.a0 = (const char*)(pm < 64 ? Ax + (size_t)pm * 256 * DM : Ac); u.a1 = u.a0; u.b = (const char*)((first ? W13t1 : W13t) + (size_t)pn * 256 * DM); u.d = nullptr; u.i0 = pm; u.i1 = pn; u.i2 = 0; u.i3 = 0; }
};
struct JobFfn2 {
    Base F; int nM, first;
    __device__ __forceinline__ void fill(int L, Unit& u) const { int pm, pn; pg::tile_pm_pn(L, nM, 4, pm, pn);
        u.a0 = (const char*)(pm < 64 ? Hb + (size_t)pm * 256 * DFF : Hc); u.a1 = u.a0; u.b = (const char*)((first ? W2t1 : W2t) + (size_t)pn * 256 * DFF); u.d = nullptr; u.i0 = pm; u.i1 = pn; u.i2 = 0; u.i3 = 0; }
};

struct EpiStore {
    static constexpr int NHOOK = 0; static constexpr int AFTER_DRAIN = 0; int h0, h1; int ldd;
    __device__ __forceinline__ void hook(acc_t&, const Unit&, int, int, int, int, int) const {}
    __device__ __forceinline__ void operator()(const acc_t& acc, const Unit& u, int wr, int wc, int fr, int fq) const {
        bf16_t* d = (bf16_t*)u.d;
        EPI_ROWS { EPI_COLS { *(u32x4*)(d + (size_t)EPI_ROW * ldd + EPI_COL0) = pack8(acc[ai][bj][m][0], acc[ai][bj][m][1]); }  asm volatile("" ::: "memory"); }
    }
};
struct EpiQK {
    static constexpr int NHOOK = 0; static constexpr int AFTER_DRAIN = 1; int h0, h1;
    Base F; int pair;
    __device__ __forceinline__ void hook(acc_t&, const Unit&, int, int, int, int, int) const {}
    __device__ __forceinline__ void operator()(const acc_t&, const Unit&, int, int, int, int) const {}
    __device__ __forceinline__ void fused(acc_t& acc, const Unit& u, int wr, int wc, int fr, int fq, LAS unsigned char* lds, int wid, int lane) const {
        const int pm = u.i0, pn = u.i1, hl = pn & 1, h = 2 * pair + hl; const bool isk = pn >= 2; const float lgf = lgp[h], lgb = lgp[4 + h]; const float* rope = ropeT;
        constexpr int PITCH = 528;
        const int tid = wid * 64 + lane, p8 = tid & 31;
        float zf[8], zb[8];
#pragma unroll
        for (int e = 0; e < 8; ++e) { const int jl = (pm * 256 + p8 * 8 + e) & (LS - 1); zf[e] = __expf(lgf * (float)(LS - 1 - jl)); zb[e] = __expf(lgb * (float)jl); }
#pragma unroll
        for (int bj = 0; bj < 2; ++bj) {
            EPI_ROWS { const int row = EPI_ROW, pos = pm * 256 + row, prow = pos >> 6, pcol = pos & 63;
                const int d0 = EPI_COL0, i0 = d0 >> 1, p = i0 < 64 ? prow : pcol, f0 = i0 & 63;
                const f32x4 t0 = *(const f32x4*)(rope + (size_t)(p * 64 + f0) * 2), t1 = *(const f32x4*)(rope + (size_t)(p * 64 + f0) * 2 + 4);
                f32x4 a = acc[ai][bj][m][0], b = acc[ai][bj][m][1];
                if (!isk) { a *= 0.0625f; b *= 0.0625f; }
                const f32x4 ra = {a[0] * t0[0] - a[1] * t0[1], a[0] * t0[1] + a[1] * t0[0], a[2] * t0[2] - a[3] * t0[3], a[2] * t0[3] + a[3] * t0[2]};
                const f32x4 rb = {b[0] * t1[0] - b[1] * t1[1], b[0] * t1[1] + b[1] * t1[0], b[2] * t1[2] - b[3] * t1[3], b[2] * t1[3] + b[3] * t1[2]};
                const u32x4 pk = pack8(ra, rb);
                if (!isk) *(u32x4*)(Qb + (size_t)pos * 512 + hl * 256 + d0) = pk;
                else { *(u32x4*)(Knb + (size_t)pos * 512 + hl * 256 + d0) = pk;
                    LAS unsigned short* tp = (LAS unsigned short*)(lds + (32 * wc + 8 * fq) * PITCH + row * 2);
                    tp[0 * PITCH / 2] = (unsigned short)pk.x; tp[1 * PITCH / 2] = (unsigned short)(pk.x >> 16); tp[2 * PITCH / 2] = (unsigned short)pk.y; tp[3 * PITCH / 2] = (unsigned short)(pk.y >> 16);
                    tp[4 * PITCH / 2] = (unsigned short)pk.z; tp[5 * PITCH / 2] = (unsigned short)(pk.z >> 16); tp[6 * PITCH / 2] = (unsigned short)pk.w; tp[7 * PITCH / 2] = (unsigned short)(pk.w >> 16); }
                if (m & 1) asm volatile("" ::: "memory"); }
            if (isk) {
                asm volatile("s_waitcnt lgkmcnt(0)" ::: "memory"); __builtin_amdgcn_s_barrier(); asm volatile("" ::: "memory");
#pragma unroll
                for (int k = 0; k < 8; ++k) { const int dl = (tid >> 5) + 16 * k;
                    f32x4 v0, v1; unpack8(*(const LAS u32x4*)(lds + dl * PITCH + p8 * 16), v0, v1);
                    const f32x4 f0v = {v0[0] * zf[0], v0[1] * zf[1], v0[2] * zf[2], v0[3] * zf[3]}, f1v = {v1[0] * zf[4], v1[1] * zf[5], v1[2] * zf[6], v1[3] * zf[7]};
                    const f32x4 b0v = {v0[0] * zb[0], v0[1] * zb[1], v0[2] * zb[2], v0[3] * zb[3]}, b1v = {v1[0] * zb[4], v1[1] * zb[5], v1[2] * zb[6], v1[3] * zb[7]};
                    const size_t o = (size_t)(hl * 256 + bj * 128 + dl) * SEQ + pm * 256 + p8 * 8;
                    *(u32x4*)(Ktb_ + o) = pack8(f0v, f1v); *(u32x4*)(Ktb_ + (size_t)512 * SEQ + o) = pack8(b0v, b1v); }
                asm volatile("s_waitcnt lgkmcnt(0)" ::: "memory"); __builtin_amdgcn_s_barrier(); asm volatile("" ::: "memory");
            }
        }
    }
};
struct EpiVT {
    static constexpr int NHOOK = 0; static constexpr int AFTER_DRAIN = 0; int h0, h1; Base F;
    __device__ __forceinline__ void hook(acc_t&, const Unit&, int, int, int, int, int) const {}
    __device__ __forceinline__ void operator()(const acc_t& acc, const Unit& u, int wr, int wc, int fr, int fq) const {
        const int hl = u.i0 >> 1, vt = u.i0 & 1, pn = u.i1;
        EPI_ROWS { const int v = vt * 256 + EPI_ROW;
            EPI_COLS { const int pos = pn * 256 + EPI_COL0, seg = pos >> 9, jl = pos & (LS - 1);
                *(u32x4*)(B4 + ((size_t)((hl * NSEG + seg) * 512 + v)) * 1024 + 512 + jl) = pack8(acc[ai][bj][m][0], acc[ai][bj][m][1]); }  asm volatile("" ::: "memory"); }
    }
};
struct EpiKc {
    static constexpr int NHOOK = 0; static constexpr int AFTER_DRAIN = 0; int h0, h1; Base F;
    __device__ __forceinline__ void hook(acc_t&, const Unit&, int, int, int, int, int) const {}
    __device__ __forceinline__ void operator()(const acc_t& acc, const Unit& u, int wr, int wc, int fr, int fq) const {
        const int h = u.i1; const float lgf = lgp[h], lgb = lgp[4 + h]; bf16_t* Kcf = KcT; bf16_t* Kcb = KcT + (size_t)1024 * CTX;
        EPI_ROWS { const int j = EPI_ROW; const float zf = __expf(lgf * (float)(CTX - 1 - j)), zb = __expf(lgb * (float)j);
            EPI_COLS { const int d0 = EPI_COL0;
#pragma unroll
                for (int e = 0; e < 8; ++e) { const float v = acc[ai][bj][m][e >> 2][e & 3]; const size_t o = (size_t)(h * 256 + d0 + e) * CTX + j;
                    Kcf[o] = f2bf(v * zf); Kcb[o] = f2bf(v * zb); } }  asm volatile("" ::: "memory"); }
    }
};
struct EpiVc {
    static constexpr int NHOOK = 0; static constexpr int AFTER_DRAIN = 0; int h0, h1; Base F;
    __device__ __forceinline__ void hook(acc_t&, const Unit&, int, int, int, int, int) const {}
    __device__ __forceinline__ void operator()(const acc_t& acc, const Unit& u, int wr, int wc, int fr, int fq) const {
        const int h = u.i0 >> 1, vt = u.i0 & 1;
        EPI_ROWS { const int v = vt * 256 + EPI_ROW;
            EPI_COLS { *(u32x4*)(VcT + (size_t)(h * 512 + v) * CTX + EPI_COL0) = pack8(acc[ai][bj][m][0], acc[ai][bj][m][1]); }  asm volatile("" ::: "memory"); }
    }
};
struct EpiS0 {
    static constexpr int NHOOK = 0; static constexpr int AFTER_DRAIN = 0; int h0, h1; Base F;
    __device__ __forceinline__ void hook(acc_t&, const Unit&, int, int, int, int, int) const {}
    __device__ __forceinline__ void operator()(const acc_t& acc, const Unit& u, int wr, int wc, int fr, int fq) const {
        EPI_ROWS { float* rowp = S0 + ((size_t)((u.i0 * 2 + u.i1) * 512 + u.i3 * 256 + EPI_ROW)) * 256;
            EPI_COLS { *(f32x4*)(rowp + EPI_COL0) = acc[ai][bj][m][0]; *(f32x4*)(rowp + EPI_COL0 + 4) = acc[ai][bj][m][1]; }  asm volatile("" ::: "memory"); }
    }
};
struct EpiU {
    static constexpr int NHOOK = 0; static constexpr int AFTER_DRAIN = 0; int h0, h1; Base F;
    __device__ __forceinline__ void hook(acc_t&, const Unit&, int, int, int, int, int) const {}
    __device__ __forceinline__ void operator()(const acc_t& acc, const Unit& u, int wr, int wc, int fr, int fq) const {
        EPI_ROWS { bf16_t* rowp = B4 + ((size_t)((u.i0 * NSEG + u.i2) * 512 + u.i3 * 256 + EPI_ROW)) * 1024 + u.i1 * 256;
            EPI_COLS { *(u32x4*)(rowp + EPI_COL0) = pack8(acc[ai][bj][m][0], acc[ai][bj][m][1]); }  asm volatile("" ::: "memory"); }
    }
};
struct EpiP {
    static constexpr int NHOOK = 0; static constexpr int AFTER_DRAIN = 0; int h0, h1; Base F; int pair;
    __device__ __forceinline__ void hook(acc_t&, const Unit&, int, int, int, int, int) const {}
    __device__ __forceinline__ void operator()(const acc_t& acc, const Unit& u, int wr, int wc, int fr, int fq) const {
        const int hl = u.i0, seg = u.i1, it = u.i2, jt = u.i3, h = 2 * pair + hl; const float l2f = lgp[h] * 1.44269504f, l2b = lgp[4 + h] * 1.44269504f;
        EPI_ROWS { const int il = it * 256 + EPI_ROW; bf16_t* rowp = Pb + (size_t)(seg * LS + il) * 1024 + hl * 512 + jt * 256;
            EPI_COLS { const int j0 = jt * 256 + EPI_COL0; f32x4 v[2];
#pragma unroll
                for (int e = 0; e < 8; ++e) { const int dl = il - (j0 + e); const float w = dl > 0 ? __builtin_amdgcn_exp2f((float)dl * l2f) : (dl < 0 ? __builtin_amdgcn_exp2f((float)(-dl) * l2b) : 2.0f);
                    v[e >> 2][e & 3] = acc[ai][bj][m][e >> 2][e & 3] * w; }
                *(u32x4*)(rowp + EPI_COL0) = pack8(v[0], v[1]); }  asm volatile("" ::: "memory"); }
    }
};
struct EpiO {
    static constexpr int NHOOK = 2; static constexpr int AFTER_DRAIN = 0; int h0, h1; Base F; int pair;
    __device__ __forceinline__ void hook(acc_t& acc, const Unit& u, int k, int wr, int wc, int fr, int fq) const {
        const int h = 2 * pair + u.i0; const float lgf = lgp[h], lgb = lgp[4 + h];
        EPI_ROWS { const int il = u.i2 * 256 + EPI_ROW; const float eb = lgb * (float)(LS - il);
            const float f = k == 0 ? __expf(lgf * (float)(il + 1) - eb) : __expf(eb);
#pragma unroll
            for (int bj = 0; bj < 2; ++bj) { acc[ai][bj][m][0] *= f; acc[ai][bj][m][1] *= f; }  asm volatile("" ::: "memory"); }
    }
    __device__ __forceinline__ void operator()(const acc_t& acc, const Unit& u, int wr, int wc, int fr, int fq) const {
        const int h = 2 * pair + u.i0;
        EPI_ROWS { bf16_t* rowp = Ob + (size_t)(u.i1 * LS + u.i2 * 256 + EPI_ROW) * 2048 + h * 512 + u.i3 * 256;
            EPI_COLS { *(u32x4*)(rowp + EPI_COL0) = pack8(acc[ai][bj][m][0], acc[ai][bj][m][1]); }  asm volatile("" ::: "memory"); }
    }
};
struct EpiG {
    static constexpr int NHOOK = 0; static constexpr int AFTER_DRAIN = 0; int h0, h1; Base F; const float* gnw; int rep; LAS unsigned char* stl;
    __device__ __forceinline__ void hook(acc_t&, const Unit&, int, int, int, int, int) const {}
    __device__ __forceinline__ void operator()(const acc_t& acc, const Unit& u, int wr, int wc, int fr, int fq) const {
        const int pm = u.i0, pn = u.i1, h = pn >> 1; u32x4 ov[1][4][2]; f32x2 st[1][4]; f32x4 gw[2][2];
#pragma unroll
        for (int bj = 0; bj < 2; ++bj) { gw[bj][0] = *(const f32x4*)(gnw + pn * 256 + EPI_COL0); gw[bj][1] = *(const f32x4*)(gnw + pn * 256 + EPI_COL0 + 4); }
#pragma unroll
        for (int ai = 0; ai < 2; ++ai) {
#pragma unroll
        for (int m = 0; m < 4; ++m) { const int pos = pm * 256 + EPI_ROW; st[0][m] = *(const LAS f32x2*)(stl + EPI_ROW * 8);
            EPI_COLS { ov[0][m][bj] = *(const u32x4*)(Ob + (size_t)pos * 2048 + pn * 256 + EPI_COL0); } }
#pragma unroll
        for (int m = 0; m < 4; ++m) { const int pos = pm * 256 + EPI_ROW; const f32x2 s2 = st[0][m];
            EPI_COLS { bf16_t* p = Ob + (size_t)pos * 2048 + pn * 256 + EPI_COL0; f32x4 o0, o1; unpack8(ov[0][m][bj], o0, o1);
                const f32x4 g0 = acc[ai][bj][m][0], g1 = acc[ai][bj][m][1]; f32x4 r0, r1;
#pragma unroll
                for (int e = 0; e < 4; ++e) { r0[e] = DBG_NORET ? 0.f : fsilu(g0[e]) * ((o0[e] - s2.x) * s2.y) * gw[bj][0][e]; r1[e] = DBG_NORET ? 0.f : fsilu(g1[e]) * ((o1[e] - s2.x) * s2.y) * gw[bj][1][e]; }
                *(u32x4*)p = rep == 0 ? pack8(r0, r1) : ov[0][m][bj]; } }
        asm volatile("" ::: "memory"); }
    }
};
struct EpiF {
    static constexpr int NHOOK = 0; static constexpr int AFTER_DRAIN = 0; int h0, h1; Base F;
    __device__ __forceinline__ void hook(acc_t&, const Unit&, int, int, int, int, int) const {}
    __device__ __forceinline__ void operator()(const acc_t& acc, const Unit& u, int wr, int wc, int fr, int fq) const {
        EPI_ROWS { const int mrow = u.i0 * 256 + EPI_ROW, ri = mrow >> 9, ch = mrow & 511;
            EPI_COLS { const int c0 = EPI_COL0, l2 = 2 * u.i1 + (c0 >> 7), l1 = c0 & 127;
                *(u32x4*)(Wt + (size_t)(ch * 128 + l2) * 256 + ri * 128 + l1) = pack8(acc[ai][bj][m][0], acc[ai][bj][m][1]); }  asm volatile("" ::: "memory"); }
    }
};
struct EpiF1 {
    static constexpr int NHOOK = 0; static constexpr int AFTER_DRAIN = 0; int h0, h1; Base F;
    __device__ __forceinline__ void hook(acc_t&, const Unit&, int, int, int, int, int) const {}
    __device__ __forceinline__ void operator()(const acc_t& acc, const Unit& u, int wr, int wc, int fr, int fq) const {
        EPI_ROWS { const int r = EPI_ROW, k1 = r >> 1, ri = r & 1; const float sg = ri ? -1.0f : 1.0f;
            EPI_COLS { const int n = u.i1 * 256 + EPI_COL0, ch = n >> 7, l2 = n & 127; f32x4 v[2];
#pragma unroll
                for (int e = 0; e < 8; ++e) { const float rev = (float)((k1 * (l2 + e)) & 16383) * (1.0f / 16384.0f);
                    const float cs = __builtin_amdgcn_cosf(rev), sn = __builtin_amdgcn_sinf(rev); const float mine = acc[ai][bj][m][e >> 2][e & 3], other = __shfl_xor(mine, 1);
                    v[e >> 2][e & 3] = mine * cs + sg * other * sn; }
                *(u32x4*)(Bt + (size_t)(k1 * 512 + ch) * 256 + ri * 128 + l2) = pack8(v[0], v[1]); }  asm volatile("" ::: "memory"); }
    }
};
struct EpiF2 {
    static constexpr int NHOOK = 0; static constexpr int AFTER_DRAIN = 0; int h0, h1; Base F;
    __device__ __forceinline__ void hook(acc_t&, const Unit&, int, int, int, int, int) const {}
    __device__ __forceinline__ void operator()(const acc_t& acc, const Unit& u, int wr, int wc, int fr, int fq) const {
        const int k1 = u.i1 >> 1, ch0 = (u.i1 & 1) * 256; float* side = (float*)(F.ws + WS_STATS);
        EPI_ROWS { const int k2 = 64 * wr + 16 * m + fr, k = k1 + 128 * k2, kr = (SEQ - k) & (SEQ - 1);
            EPI_COLS { const int ch = ch0 + EPI_COL0, g = ch >> 7, j = ch & 127;
                if (ai == 0) { const u32x4 pk = pack8(acc[0][bj][m][0], acc[0][bj][m][1]);
                    *(u32x4*)(MIXb + (size_t)k * 2048 + g * 256 + j) = pk; *(u32x4*)(MIXb + (size_t)kr * 2048 + g * 256 + 128 + j) = pk;
                    if (j == 0) side[(size_t)(k * 4 + g) * 2] = acc[0][bj][m][0][0]; }
                else if (j == 0) side[(size_t)(k * 4 + g) * 2 + 1] = acc[1][bj][m][0][0]; } }
    }
};
struct EpiGate {
    static constexpr int NHOOK = 0; static constexpr int AFTER_DRAIN = 0; int h0, h1; Base F;
    __device__ __forceinline__ void hook(acc_t&, const Unit&, int, int, int, int, int) const {}
    __device__ __forceinline__ void operator()(const acc_t& acc, const Unit& u, int wr, int wc, int fr, int fq) const {
        bf16_t* dst = (u.i1 >> 2) ? GFb : GAb; const int cb = (u.i1 & 3) * 256;
        EPI_ROWS { bf16_t* rowp = dst + (size_t)(u.i0 * 256 + EPI_ROW) * DM + cb;
            EPI_COLS { f32x4 s0, s1;
#pragma unroll
                for (int e = 0; e < 4; ++e) { s0[e] = fsigmoid(acc[ai][bj][m][0][e]); s1[e] = fsigmoid(acc[ai][bj][m][1][e]); }
                *(u32x4*)(rowp + EPI_COL0) = pack8(s0, s1); }  asm volatile("" ::: "memory"); }
    }
};
struct EpiZ {
    static constexpr int NHOOK = 1; static constexpr int AFTER_DRAIN = 0; int h0, h1; Base F;
    __device__ __forceinline__ void hook(acc_t& acc, const Unit& u, int, int wr, int wc, int fr, int fq) const {
        EPI_ROWS { const size_t ro = (size_t)(u.i0 * 256 + EPI_ROW) * DM + u.i1 * 256;
            EPI_COLS { f32x4 a0, a1, f0, f1; unpack8(*(const u32x4*)(GAb + ro + EPI_COL0), a0, a1); unpack8(*(const u32x4*)(GFb + ro + EPI_COL0), f0, f1);
#pragma unroll
                for (int e = 0; e < 4; ++e) { acc[ai][bj][m][0][e] *= DBG_NOFOUR ? 0.f : f0[e] * __builtin_amdgcn_rcpf(fmaxf(a0[e], 1e-30f)); acc[ai][bj][m][1][e] *= DBG_NOFOUR ? 0.f : f1[e] * __builtin_amdgcn_rcpf(fmaxf(a1[e], 1e-30f)); } }  asm volatile("" ::: "memory"); }
    }
    __device__ __forceinline__ void operator()(const acc_t& acc, const Unit& u, int wr, int wc, int fr, int fq) const {
        EPI_ROWS { const size_t ro = (size_t)(u.i0 * 256 + EPI_ROW) * DM + u.i1 * 256;
            EPI_COLS { f32x4 a0, a1; unpack8(*(const u32x4*)(GAb + ro + EPI_COL0), a0, a1); f32x4 v0, v1;
#pragma unroll
                for (int e = 0; e < 4; ++e) { v0[e] = acc[ai][bj][m][0][e] * fmaxf(a0[e], 1e-30f); v1[e] = acc[ai][bj][m][1][e] * fmaxf(a1[e], 1e-30f); }
                *(u32x4*)(Zb + ro + EPI_COL0) = pack8(v0, v1); }  asm volatile("" ::: "memory"); }
    }
};

struct EpiSlab {
    static constexpr int NHOOK = 0; static constexpr int AFTER_DRAIN = 0; int h0, h1; Base F;
    __device__ __forceinline__ void hook(acc_t&, const Unit&, int, int, int, int, int) const {}
    __device__ __forceinline__ void operator()(const acc_t& acc, const Unit& u, int wr, int wc, int fr, int fq) const {
        float* dst = XcSlab + (size_t)u.i2 * CTX * DM + u.i1 * 256;
        EPI_ROWS { float* rowp = dst + (size_t)EPI_ROW * DM;
            EPI_COLS { *(f32x4*)(rowp + EPI_COL0) = acc[ai][bj][m][0]; *(f32x4*)(rowp + EPI_COL0 + 4) = acc[ai][bj][m][1]; } }
    }
};
struct JobCtxG2 {
    Base F;
    __device__ __forceinline__ void fill(int L, Unit& u) const { const int pn = L & 3, kc = L >> 2;
        u.a0 = (const char*)(Hc + kc * 256); u.a1 = u.a0; u.b = (const char*)(W2t1 + (size_t)pn * 256 * DFF + kc * 256); u.d = nullptr; u.i0 = 64; u.i1 = pn; u.i2 = kc; u.i3 = 0; }
};
struct EpiZ2 {
    static constexpr int NHOOK = 0; static constexpr int AFTER_DRAIN = 0; int h0, h1; Base F; int part;
    __device__ __forceinline__ void hook(acc_t&, const Unit&, int, int, int, int, int) const {}
    __device__ __forceinline__ void operator()(const acc_t& acc, const Unit& u, int wr, int wc, int fr, int fq) const {
        const bf16_t* G = part ? GAb : GFb;
#pragma unroll
        for (int ai = 0; ai < 2; ++ai) { u32x4 gv[4][2], tv[4][2];
#pragma unroll
            for (int m = 0; m < 4; ++m) { const size_t ro = (size_t)(u.i0 * 256 + EPI_ROW) * DM + u.i1 * 256, zo = (size_t)(u.i0 * 256 + EPI_ROW) * 2048 + u.i1 * 256;
                EPI_COLS { gv[m][bj] = *(const u32x4*)(G + ro + EPI_COL0); if (part) tv[m][bj] = *(const u32x4*)(Zb + zo + EPI_COL0); } }
#pragma unroll
            for (int m = 0; m < 4; ++m) { const size_t zo = (size_t)(u.i0 * 256 + EPI_ROW) * 2048 + u.i1 * 256;
                EPI_COLS { f32x4 g0, g1; unpack8(gv[m][bj], g0, g1); f32x4 v0 = acc[ai][bj][m][0] * g0, v1 = acc[ai][bj][m][1] * g1;
                    if (part) { f32x4 t0, t1; unpack8(tv[m][bj], t0, t1); v0 += t0; v1 += t1; }
                    *(u32x4*)(Zb + zo + EPI_COL0) = pack8(v0, v1); } }
            asm volatile("" ::: "memory"); }
    }
};
struct JobGate2 {
    Base F;
    __device__ __forceinline__ void fill(int L, Unit& u) const { const int c = L & 255, which = L >> 8; int pm, pn; pg::tile_pm_pn(c, 64, 4, pm, pn);
        u.a0 = (const char*)(Ax + (size_t)pm * 256 * DM); u.a1 = u.a0; u.b = (const char*)(Win + (size_t)(WR_GA + which * 1024 + pn * 256) * DM); u.d = nullptr; u.i0 = pm; u.i1 = which * 4 + pn; u.i2 = 0; u.i3 = 0; }
};
struct JobG2 {
    Base F;
    __device__ __forceinline__ void fill(int L, Unit& u) const { const int c = L & 255, half = L >> 8, pm = c >> 2, pn = 2 * (c & 3) + half;
        u.a0 = (const char*)(Ax + (size_t)pm * 256 * DM); u.a1 = u.a0; u.b = (const char*)(Win + (size_t)(WR_G + pn * 256) * DM); u.d = nullptr; u.i0 = pm; u.i1 = pn; u.i2 = 0; u.i3 = 0; }
};
struct JobFold {
    Base F;
    __device__ __forceinline__ void fill(int L, Unit& u) const { const int pn = L & 3, g = L >> 2;
        u.a0 = (const char*)T256; u.a1 = u.a0; u.b = (const char*)(Wn + (size_t)pn * 256 * DM + g * 256); u.d = nullptr; u.i0 = 0; u.i1 = pn; u.i2 = g; u.i3 = 0; }
};
struct EpiFold {
    static constexpr int NHOOK = 0; static constexpr int AFTER_DRAIN = 0; int h0, h1; Base F;
    __device__ __forceinline__ void hook(acc_t&, const Unit&, int, int, int, int, int) const {}
    __device__ __forceinline__ void operator()(const acc_t& acc, const Unit& u, int wr, int wc, int fr, int fq) const {
        EPI_ROWS { const int r = EPI_ROW; bf16_t* rowp = Win + (size_t)(WR_F + (r >> 7) * 512 + u.i2 * 128 + (r & 127)) * DM + u.i1 * 256;
            EPI_COLS { *(u32x4*)(rowp + EPI_COL0) = pack8(acc[ai][bj][m][0], acc[ai][bj][m][1]); } }
    }
};
struct JobRowCol {
    Base F; int sel, nM, nN; size_t aoff0, boff0, astep, bstep;
    __device__ __forceinline__ void fill(int L, Unit& u) const { int pm, pn; pg::tile_pm_pn(L, nM, nN, pm, pn);
        const bf16_t* A = sel == 0 ? Ax : (sel == 1 ? Win : Zb); const bf16_t* B = sel == 0 ? Win : (sel == 1 ? Ax : WoT);
        u.a0 = (const char*)(A + aoff0 + (size_t)pm * astep); u.a1 = u.a0; u.b = (const char*)(B + boff0 + (size_t)pn * bstep); u.d = nullptr; u.i0 = pm; u.i1 = pn; u.i2 = 0; u.i3 = 0; }
};
struct JobKc {
    Base F;
    __device__ __forceinline__ void fill(int L, Unit& u) const { const int h = L; u.a0 = (const char*)Ac; u.a1 = u.a0;
        u.b = (const char*)(Win + (size_t)((h >> 1) * 2048 + 512 + (h & 1) * 256) * DM); u.d = nullptr; u.i0 = 0; u.i1 = h; u.i2 = 0; u.i3 = 0; }
};
struct JobVc {
    Base F;
    __device__ __forceinline__ void fill(int L, Unit& u) const { const int t = L, h = t >> 1; u.a0 = (const char*)(Win + (size_t)((h >> 1) * 2048 + 1024 + (h & 1) * 512 + (t & 1) * 256) * DM); u.a1 = u.a0;
        u.b = (const char*)Ac; u.d = nullptr; u.i0 = t; u.i1 = 0; u.i2 = 0; u.i3 = 0; }
};
struct JobS0 {
    Base F;
    __device__ __forceinline__ void fill(int L, Unit& u) const { const int h = L >> 2, dir = (L >> 1) & 1, vt = L & 1;
        u.a0 = (const char*)(VcT + (size_t)(h * 512 + vt * 256) * CTX); u.a1 = u.a0; u.b = (const char*)(KcT + (size_t)dir * 1024 * CTX + (size_t)(h * 256) * CTX);
        u.d = nullptr; u.i0 = h; u.i1 = dir; u.i2 = 0; u.i3 = vt; }
};
struct JobR1 {
    Base F;
    __device__ __forceinline__ void fill(int L, Unit& u) const { const int w = pg::xcd_contig(L, 256), vt = w & 1, dir = (w >> 1) & 1, seg = (w >> 2) & 31, hl = w >> 7;
        u.a0 = (const char*)(B4 + ((size_t)((hl * NSEG + seg) * 512 + vt * 256)) * 1024 + 512); u.a1 = u.a0;
        u.b = (const char*)(Ktb_ + (size_t)dir * 512 * SEQ + (size_t)(hl * 256) * SEQ + seg * LS); u.d = nullptr; u.i0 = hl; u.i1 = dir; u.i2 = seg; u.i3 = vt; }
};
struct JobR3 {
    Base F;
    __device__ __forceinline__ void fill(int L, Unit& u) const { const int w = pg::xcd_contig(L, 256), jt = w & 1, it = (w >> 1) & 1, seg = (w >> 2) & 31, hl = w >> 7;
        u.a0 = (const char*)(Qb + (size_t)(seg * LS + it * 256) * 512 + hl * 256); u.a1 = u.a0; u.b = (const char*)(Knb + (size_t)(seg * LS + jt * 256) * 512 + hl * 256);
        u.d = nullptr; u.i0 = hl; u.i1 = seg; u.i2 = it; u.i3 = jt; }
};
struct JobR4 {
    Base F;
    __device__ __forceinline__ void fill(int L, Unit& u) const { const int w = pg::xcd_contig(L, 256), vt = w & 1, it = (w >> 1) & 1, seg = (w >> 2) & 31, hl = w >> 7;
        u.a0 = (const char*)(Qb + (size_t)(seg * LS + it * 256) * 512 + hl * 256); u.a1 = (const char*)(Pb + (size_t)(seg * LS + it * 256) * 1024 + hl * 512);
        u.b = (const char*)(B4 + ((size_t)((hl * NSEG + seg) * 512 + vt * 256)) * 1024); u.d = nullptr; u.i0 = hl; u.i1 = seg; u.i2 = it; u.i3 = vt; }
};
struct JobF1 {
    Base F;
    __device__ __forceinline__ void fill(int L, Unit& u) const { u.a0 = (const char*)FmT; u.a1 = u.a0; u.b = (const char*)(Wt + (size_t)L * 256 * 256); u.d = nullptr; u.i0 = 0; u.i1 = L; u.i2 = 0; u.i3 = 0; }
};
struct JobF2 {
    Base F;
    __device__ __forceinline__ void fill(int L, Unit& u) const { u.a0 = (const char*)GmT; u.a1 = u.a0; u.b = (const char*)(Bt + (size_t)L * 256 * 256); u.d = nullptr; u.i0 = 0; u.i1 = L; u.i2 = 0; u.i3 = 0; }
};
struct JobZ {
    Base F; int part;
    __device__ __forceinline__ void fill(int L, Unit& u) const { int pm, pn; pg::tile_pm_pn(L, 64, 4, pm, pn);
        u.a0 = (const char*)((part ? Ob : MIXb) + (size_t)pm * 256 * 2048); u.a1 = u.a0; u.b = (const char*)(Bz + (size_t)pn * 256 * 3072 + (part ? 1024 : 0)); u.d = nullptr; u.i0 = pm; u.i1 = pn; u.i2 = 0; u.i3 = 0; }
};

#define XB_TMO      128
#define XB_XCNT(j)  (256  + 64 * (j))
#define XB_XSUB(j)  (1280 + 64 * (j))
#define XB_XGEN(j)  (2304 + 64 * (j))
#define XB_TOP      3328
#define XB_TOPGEN   3392
#define XCD_BAR_WORDS 3456
#define XB_SPIN_CAP (1u << 22)
__device__ __forceinline__ unsigned xb_ld(unsigned* p)              { return __hip_atomic_load(p, __ATOMIC_RELAXED, __HIP_MEMORY_SCOPE_AGENT); }
__device__ __forceinline__ unsigned xb_add(unsigned* p, unsigned v) { return __hip_atomic_fetch_add(p, v, __ATOMIC_RELAXED, __HIP_MEMORY_SCOPE_AGENT); }
__device__ __forceinline__ unsigned xb_xcc_id() { return (unsigned)__builtin_amdgcn_s_getreg((3 << 11) | 20) & 0xFu; }
#define XB_SPIN(cond, bar) do { unsigned _sp = 0; while (cond) { __builtin_amdgcn_s_sleep(1); \
    if ((++_sp & 255u) == 0u) { if (xb_ld(&(bar)[XB_TMO])) break; if (_sp > XB_SPIN_CAP) { atomicAdd(&(bar)[XB_TMO], 1u); break; } } } } while (0)
struct XcdBarrier { unsigned* bar; unsigned x; volatile LAS unsigned* st; };
__device__ __forceinline__ XcdBarrier xcd_barrier_post(unsigned* bar, volatile LAS unsigned* st) {
    XcdBarrier b; b.bar = bar; b.x = xb_xcc_id(); b.st = st;
    if (threadIdx.x == 0) (void)xb_add(&bar[XB_XCNT(b.x)], 1u);
    return b;
}
__device__ __forceinline__ void xcd_barrier_complete(unsigned* bar, unsigned x, unsigned& nloc, unsigned& nx) {
    const unsigned G = gridDim.x * gridDim.y * gridDim.z;
    unsigned sum, cnt, mine, sp = 0u;
    for (;;) {
        sum = 0u; cnt = 0u; mine = 0u;
#pragma unroll
        for (unsigned j = 0; j < 16; ++j) { const unsigned c = xb_ld(&bar[XB_XCNT(j)]); sum += c; cnt += (c > 0u) ? 1u : 0u; mine = (j == x) ? c : mine; }
        if (sum == G) break;
        __builtin_amdgcn_s_sleep(1);
        if ((++sp & 255u) == 0u) { if (xb_ld(&bar[XB_TMO])) break; if (sp > XB_SPIN_CAP) { atomicAdd(&bar[XB_TMO], 1u); break; } }
    }
    nloc = mine > 0u ? mine : 1u; nx = cnt > 0u ? cnt : 1u;
}
__device__ __attribute__((noinline)) void xcd_barrier(unsigned* bar_, unsigned bx_, volatile LAS unsigned* st_) {
    XcdBarrier b; b.bar = bar_; b.x = bx_; b.st = st_;
    asm volatile("s_waitcnt vmcnt(0)" ::: "memory");
    __syncthreads();
    if (threadIdx.x == 0) {
        unsigned* bar = b.bar;
        __builtin_amdgcn_s_waitcnt(0);
        unsigned nloc = b.st[0], nx = b.st[1];
        if (nloc == 0u) { xcd_barrier_complete(bar, b.x, nloc, nx); b.st[0] = nloc; b.st[1] = nx; }
        const unsigned old = xb_add(&bar[XB_XSUB(b.x)], 1u);
        const unsigned gen = old / nloc;
        if (old + 1u == (gen + 1u) * nloc) {
            __builtin_amdgcn_fence(__ATOMIC_RELEASE, "agent");
            asm volatile("s_waitcnt vmcnt(0)" ::: "memory");
            const unsigned og = xb_add(&bar[XB_TOP], 1u);
            const unsigned tg = og / nx;
            if (og + 1u == (tg + 1u) * nx) xb_add(&bar[XB_TOPGEN], 1u);
            else XB_SPIN(xb_ld(&bar[XB_TOPGEN]) == tg, bar);
            __builtin_amdgcn_fence(__ATOMIC_ACQUIRE, "agent");
            xb_add(&bar[XB_XGEN(b.x)], 1u);
            asm volatile("s_waitcnt vmcnt(0)" ::: "memory");
        } else {
            XB_SPIN(xb_ld(&bar[XB_XGEN(b.x)]) == gen, bar);
            __builtin_amdgcn_fence(__ATOMIC_ACQUIRE, "agent");
            asm volatile("s_waitcnt vmcnt(0)" ::: "memory");
        }
    }
    __syncthreads();
}

constexpr int NWAVES = 8, NTHREADS = 512;
constexpr int RING_BYTES = 131072, MISC_OFF = RING_BYTES + 320, LDS_BYTES = 147456;
constexpr int CW_BAR = 4096;

struct Args { const float* in[21]; float* out; unsigned char* ws; int ph_lo, ph_hi; };

struct Ctx {
    LAS unsigned char* lds; int tid, lane, wave, G, vcu;
    unsigned char* ws; unsigned char* dout;
};
#define F_WS (F.ws)
#define F_DOUT (F.dout)

__device__ __forceinline__ void gemv_item(const Ctx& F, int item, const float* W, const float* b, const float* c, const float* cc) {
    LAS float* scr = (LAS float*)F.lds;
    const int cg = F.tid & 7, rg = F.tid >> 3, n0 = item * 32 + cg * 4;
    f32x4 ax = {0.f, 0.f, 0.f, 0.f}, ac = {0.f, 0.f, 0.f, 0.f};
#pragma unroll 4
    for (int k = rg; k < DM; k += 64) { const f32x4 w = *(const f32x4*)(W + (size_t)k * 9216 + n0); const float sx = c[k], sc = cc[k];
        ax += w * (sx / (1.f + expf(-sx))); ac += w * (sc / (1.f + expf(-sc))); }
    __syncthreads();
#pragma unroll
    for (int e = 0; e < 4; ++e) { scr[(rg * 8 + cg) * 8 + e] = ax[e]; scr[(rg * 8 + cg) * 8 + 4 + e] = ac[e]; }
    __syncthreads();
    if (F.tid < 64) { const int which = F.tid >> 5, col = F.tid & 31, g = col >> 2, e = col & 3; float s = 0.f;
        for (int r = 0; r < 64; ++r) s += scr[(r * 8 + g) * 8 + which * 4 + e];
        (which ? modc : modx)[item * 32 + col] = s + b[item * 32 + col]; }
    __syncthreads();
}
struct TrDesc { const float* W; int K, N; bf16_t* dst; int ld, coloff, kind; };
__device__ __forceinline__ int tr_dest_row(int kind, int n) {
    switch (kind) {
    case 0: { const int isb = n >= DFF, j = isb ? n - DFF : n; return 256 * (j >> 7) + 128 * isb + (j & 127); }
    case 2: {
        if (n < 1024) { const int h = n >> 8, d = n & 255; return (h >> 1) * 2048 + (h & 1) * 256 + d; }
        if (n < 2048) { const int h = (n - 1024) >> 8, d = n & 255; return (h >> 1) * 2048 + 512 + (h & 1) * 256 + d; }
        if (n < 4096) { const int h = (n - 2048) >> 9, v = (n - 2048) & 511; return (h >> 1) * 2048 + 1024 + (h & 1) * 512 + v; }
        if (n < 6144) return WR_G + (n - 4096);
        if (n < 7168) return -1;
        if (n < 8192) return WR_GA + (n - 7168);
        return WR_GF + (n - 8192); }
    default: return n; }
}
__device__ __forceinline__ void tr_item(const TrDesc& t, LAS float* scr, int item, int lane) {
    const int nblk = t.N / 32, kb = item / nblk, nb = item % nblk, k0 = 64 * kb, n0 = 32 * nb;
    if (t.kind == 2 && n0 >= 6144 && n0 < 7168) return;
#pragma unroll
    for (int i = 0; i < 8; ++i) { const int kk = 8 * i + (lane >> 3), c4 = (lane & 7) * 4; const f32x4 v = *(const f32x4*)(t.W + (size_t)(k0 + kk) * t.N + n0 + c4);
        scr[kk * 33 + c4] = v[0]; scr[kk * 33 + c4 + 1] = v[1]; scr[kk * 33 + c4 + 2] = v[2]; scr[kk * 33 + c4 + 3] = v[3]; }
    asm volatile("s_waitcnt lgkmcnt(0)" ::: "memory");
    const int c = lane & 7;
#pragma unroll
    for (int j = 0; j < 4; ++j) { const int n = (lane >> 3) + 8 * j; const LAS float* s = scr + (8 * c) * 33 + n;
        u32x4 o; o.x = cvt_pk_bf16(s[0 * 33], s[1 * 33]); o.y = cvt_pk_bf16(s[2 * 33], s[3 * 33]); o.z = cvt_pk_bf16(s[4 * 33], s[5 * 33]); o.w = cvt_pk_bf16(s[6 * 33], s[7 * 33]);
        const int dr = tr_dest_row(t.kind, n0 + n);
        *(u32x4*)(t.dst + (size_t)dr * t.ld + t.coloff + k0 + 8 * c) = o; }
    asm volatile("s_waitcnt lgkmcnt(0)" ::: "memory");
}
__device__ __forceinline__ void tr_all(const Ctx& F, const TrDesc& t, int gw, int NGW) {
    LAS float* scr = (LAS float*)(F.lds + F.wave * 16384);
    const int nitems = (t.K / 64) * (t.N / 32);
    for (int it = gw; it < nitems; it += NGW) tr_item(t, scr, it, F.lane);
}
__device__ __forceinline__ void norm_rows(const Ctx& F, const float* xin, const float* cin, const float* nw, int modoff, const bf16_t* dx, const float* dcf, bool has_delta, int row0, int nrows) {
    const int gw = F.vcu * NWAVES + F.wave, NGW = F.G * NWAVES;
    for (int r = row0 + gw; r < nrows; r += NGW) {
        const bool isx = r < SEQ; const int rr = isx ? r : r - SEQ;
        const float* xr = (isx ? xin : cin) + (size_t)rr * DM; const bf16_t* dr = dx + (size_t)rr * DM; const float* drf = dcf + (size_t)rr * DM;
        const float* md = (isx ? modx : modc) + modoff; bf16_t* orow = (isx ? Ax : Ac) + (size_t)rr * DM;
        f32x4 v[4]; float ss = 0.f;
#pragma unroll
        for (int j = 0; j < 4; ++j) { v[j] = *(const f32x4*)(xr + 256 * j + 4 * F.lane);
            if (has_delta) { if (isx) { const u32x2 d = *(const u32x2*)(dr + 256 * j + 4 * F.lane); v[j] += (f32x4){bflo(d.x), bfhi(d.x), bflo(d.y), bfhi(d.y)}; } else { f32x4 sacc = {0.f, 0.f, 0.f, 0.f};
#pragma unroll
                for (int kc = 0; kc < 11; ++kc) sacc += *(const f32x4*)(drf + (size_t)kc * CTX * DM + 256 * j + 4 * F.lane);
                v[j] += sacc * (*(const f32x4*)(modc + 2 * DM + 256 * j + 4 * F.lane)) * 0.5f; } }
            ss += (v[j][0] * v[j][0] + v[j][1] * v[j][1]) + (v[j][2] * v[j][2] + v[j][3] * v[j][3]); }
        const float rinv = 1.0f / sqrtf(wave_sum(ss) * (1.f / DM) + EPS);
#pragma unroll
        for (int j = 0; j < 4; ++j) { const int c = 256 * j + 4 * F.lane; const f32x4 w = *(const f32x4*)(nw + c), sh = *(const f32x4*)(md + c), sc = *(const f32x4*)(md + 1024 + c);
            const f32x4 y = (v[j] * rinv) * w * (sc + 1.0f) + sh; u32x2 o; o.x = cvt_pk_bf16(y[0], y[1]); o.y = cvt_pk_bf16(y[2], y[3]);
            *(u32x2*)(orow + c) = o; }
    }
}
__device__ __forceinline__ void final_norm(const Ctx& F, const float* xin, const float* nw, const bf16_t* dx) {
    float* out = (float*)F_DOUT;
    const int gw = F.vcu * NWAVES + F.wave, NGW = F.G * NWAVES;
    for (int r = gw; r < SEQ; r += NGW) {
        const float* xr = xin + (size_t)r * DM; const bf16_t* dr = dx + (size_t)r * DM;
        f32x4 v[4]; float ss = 0.f;
#pragma unroll
        for (int j = 0; j < 4; ++j) { v[j] = *(const f32x4*)(xr + 256 * j + 4 * F.lane);
            const u32x2 d = *(const u32x2*)(dr + 256 * j + 4 * F.lane); v[j] += (f32x4){bflo(d.x), bfhi(d.x), bflo(d.y), bfhi(d.y)};
            ss += (v[j][0] * v[j][0] + v[j][1] * v[j][1]) + (v[j][2] * v[j][2] + v[j][3] * v[j][3]); }
        const float rinv = 1.0f / sqrtf(wave_sum(ss) * (1.f / DM) + EPS);
#pragma unroll
        for (int j = 0; j < 4; ++j) { const int c = 256 * j + 4 * F.lane; *(f32x4*)(out + (size_t)r * DM + c) = (v[j] * rinv) * *(const f32x4*)(nw + c); }
    }
}
__device__ __forceinline__ void copy_delta(const Ctx& F, const bf16_t* src, bf16_t* dst) {
    const size_t n16 = (size_t)SEQ * DM * 2 / 16; const u32x4* s = (const u32x4*)src; u32x4* d = (u32x4*)dst;
    for (size_t i = (size_t)F.vcu * NTHREADS + F.tid; i < n16; i += (size_t)F.G * NTHREADS) d[i] = s[i];
}


__device__ __forceinline__ float block_sum(LAS float* scr, float v, int tid) {
    v = wave_sum(v); __syncthreads(); if ((tid & 63) == 0) scr[tid >> 6] = v; __syncthreads();
    float s = 0.f; for (int i = 0; i < NWAVES; ++i) s += scr[i]; __syncthreads(); return s;
}
__device__ __forceinline__ void dbg_report(unsigned* word, float ref, float got, float floor_) {
    const float e = fabsf(got - ref) / fmaxf(fabsf(ref), floor_); atomicMax(word, __builtin_bit_cast(unsigned, e)); if (e > 0.05f) atomicAdd(word + 64, 1u);
}
__device__ __forceinline__ float bf2f(bf16_t b) { return __builtin_bit_cast(float, (unsigned)b << 16); }

__global__ void __launch_bounds__(NTHREADS, 2) fwd_kernel(Args args) {
    extern __shared__ __attribute__((aligned(16))) unsigned char lds_raw[];
    Ctx F;
    F.lds = (LAS unsigned char*)lds_raw;
    F.tid = threadIdx.x; F.lane = F.tid & 63; F.wave = __builtin_amdgcn_readfirstlane(F.tid >> 6);
    F.G = gridDim.x; { const int bx = blockIdx.x; F.vcu = (F.G % 8 == 0) ? (bx % 8) * (F.G / 8) + bx / 8 : bx; }
    F.ws = args.ws; F.dout = (unsigned char*)args.out;
    volatile LAS unsigned* MISC = (volatile LAS unsigned*)(F.lds + MISC_OFF);
    for (int u = F.tid; u < (LDS_BYTES - RING_BYTES) / 4; u += NTHREADS) ((LAS unsigned*)(F.lds + RING_BYTES))[u] = 0u;
    __syncthreads();
    unsigned* ctl = (unsigned*)(F_WS + WS_CTL);
    XcdBarrier bar = xcd_barrier_post(ctl + CW_BAR, MISC + 8);
    const int lo = args.ph_lo, hi = args.ph_hi;
    int phase = 0;
#define PHASE_BEGIN if (phase >= lo && phase < hi) { for (int _rep = 0; _rep < ((DBG_DUP >= 0 && phase == DBG_DUP) ? 2 : 1); ++_rep) { asm volatile("; MARK %0" :: "i"(__LINE__)); { unsigned char* _w = args.ws; unsigned char* _o = (unsigned char*)args.out; int _t = threadIdx.x; asm volatile("" : "+s"(_w), "+s"(_o), "+v"(_t)); F.ws = _w; F.dout = _o; F.tid = _t; F.lane = _t & 63; }
#define PHASE_END   } if (phase + 1 < hi) xcd_barrier((unsigned*)(F.ws + WS_CTL) + CW_BAR, bar.x, MISC + 8); if (DBG_TSEL >= 0 && bx == 0 && F.tid == 0) ((unsigned long long*)(F.ws + WS_CTL + 160000))[phase + 1] = __builtin_amdgcn_s_memrealtime(); } ++phase;
    const int bx = (int)blockIdx.x;

#define gtid ((size_t)F.vcu * NTHREADS + F.tid)
#define gthreads ((size_t)F.G * NTHREADS)
#define FB (Base{F.ws, F.dout})
    const Geo gK1024{DM, DM, DM, 128u * DM * 2u, 128u * DM * 2u, 128u * DM * 2u, DM / 64, 1 << 20, 1 << 20};
    const Geo gFfn2{DFF, DFF, DFF, 128u * DFF * 2u, 128u * DFF * 2u, 128u * DFF * 2u, DFF / 64, 1 << 20, 1 << 20};

    if (DBG_TSEL >= 0 && bx == 0 && threadIdx.x == 0) ((unsigned long long*)(args.ws + WS_CTL + 160000))[0] = __builtin_amdgcn_s_memrealtime();
    PHASE_BEGIN
        for (int it = F.vcu; it < 288; it += F.G) gemv_item(F, it, args.in[4], args.in[5], args.in[1], args.in[3]);
        __syncthreads();
        if (gtid == 0) { ((unsigned*)(F.ws + WS_CTL))[32768 + 192] = 255u; ((unsigned*)(F.ws + WS_CTL))[32768 + 193] = 255u; }
        if (gtid < 8) { const float x = (gtid < 4 ? args.in[11] : args.in[12])[gtid & 3]; modx[2 * 9216 + gtid] = -log1pf(expf(-x)); }
        for (size_t i = gtid; i < 256 * 64; i += gthreads) { const int p = (int)(i >> 6), f = (int)(i & 63); const float inv = powf(10000.0f, -(float)f / 64.0f), ang = (float)p * inv;
            ropeT[2 * i] = cosf(ang); ropeT[2 * i + 1] = sinf(ang); }
        for (size_t i = gtid; i < 128 * 128; i += gthreads) { const int k1 = (int)(i >> 7), l2 = (int)(i & 127); const float a = (float)((k1 * l2) & 16383) * (1.0f / 8192.0f);
            twT[2 * i] = cospif(a); twT[2 * i + 1] = sinpif(a); }
        for (size_t i = gtid; i < 256 * 256; i += gthreads) { const int r = (int)(i >> 8), cc = (int)(i & 255), rin = cc >> 7, l = cc & 127;
            { const int k1 = r >> 1, ri = r & 1; const float a = (float)((k1 * l) & 127) * (1.0f / 64.0f), c = cospif(a), s = sinpif(a);
              FmT[i] = f2bf(ri == 0 ? (rin == 0 ? c : s) : (rin == 0 ? -s : c)); }
            { const float a = (float)((r * l) & 127) * (1.0f / 64.0f), c = cospif(a), s = sinpif(a);
              GmT[i] = r < 128 ? f2bf((rin == 0 ? c : s) * (1.0f / 2048.0f)) : f2bf((rin == 0 ? -s : c) * (1.0f / 2048.0f)); } }
        for (size_t i = gtid; i < 256 * 256; i += gthreads) { const int r = (int)(i >> 8), c = (int)(i & 255), ri = r >> 7, cp = r & 127; const float a = (float)((c * cp) & 255) * (1.0f / 128.0f);
            T256[i] = f2bf(ri == 0 ? cospif(a) : (cp == 0 ? ((c & 1) ? -1.0f : 1.0f) : -sinpif(a))); }
        for (size_t i = gtid; i < (size_t)DM * DM / 4; i += gthreads) { const int k = (int)(i >> 8), c4 = (int)(i & 255) * 4; const f32x4 w = *(const f32x4*)(args.in[10] + (size_t)k * 9216 + 6144 + c4);
            u32x2 o; o.x = cvt_pk_bf16(w[0], w[1]); o.y = cvt_pk_bf16(w[2], w[3]); *(u32x2*)(Wn + (size_t)k * DM + c4) = o; }
        { TrDesc t{args.in[7], DM, 2 * DFF, W13t1, DM, 0, 0}; tr_all(F, t, F.vcu * NWAVES + F.wave, F.G * NWAVES); }
        { TrDesc t{args.in[8], DFF, DM, W2t1, DFF, 0, 1}; tr_all(F, t, F.vcu * NWAVES + F.wave, F.G * NWAVES); }
        __syncthreads();
    PHASE_END
    for (int xb = 0; xb < DBG_XBAR; ++xb) {
    PHASE_BEGIN
    PHASE_END
    }
    PHASE_BEGIN
        norm_rows(F, args.in[0], args.in[2], args.in[6], 0, nullptr, nullptr, false, 0, SEQ + CTX);
    PHASE_END
    if constexpr (DBG_PROBE == 11) {
    PHASE_BEGIN
        unsigned* dw = (unsigned*)(F.ws + WS_CTL) + 32768;
        for (size_t idx = gtid; idx < (size_t)DM * 9216; idx += gthreads) { const int k = (int)(idx / 9216), n = (int)(idx % 9216); const int dr = tr_dest_row(2, n);
            if (dr >= 0) { const float a = args.in[10][idx]; const float b = bf2f(Win[(size_t)dr * DM + k]); if (fabsf(a - b) > 0.01f * fabsf(a) + 1e-6f) { atomicAdd(dw + 64, 1u); atomicMin(dw + 192, (unsigned)(dr >> 8)); } } }
    PHASE_END
    }
    PHASE_BEGIN
        { pg::Sched<JobFfn1> S{{FB, 65, 1}, 65 * 22, F.G, bx};
          EpiSwiglu E{0, 0, FB};
          pg::gemm_phase<EpiSwiglu, pg::Sched<JobFfn1>, 1>(F.lds, gK1024, S, E); }
        if (bx >= 150 && bx < 194 && _rep == 0) {
            if (F.tid < 64) { unsigned* cnt = (unsigned*)(F.ws + WS_CTL) + 24576; unsigned sp = 0;
                while ((unsigned)__builtin_amdgcn_readfirstlane(__hip_atomic_load(cnt, __ATOMIC_RELAXED, __HIP_MEMORY_SCOPE_AGENT)) < 22u * 8u) { __builtin_amdgcn_s_sleep(2); if (++sp > (1u << 22)) break; }
                __builtin_amdgcn_fence(__ATOMIC_ACQUIRE, "agent"); asm volatile("s_waitcnt vmcnt(0)" ::: "memory"); }
            __syncthreads();
            Geo g{DFF, DFF, DFF, 128u * DFF * 2u, 128u * DFF * 2u, 128u * DFF * 2u, 4, 1 << 20, 1 << 20};
            pg::Sched<JobCtxG2> S{{FB}, 44, 1 << 20, bx - 150}; EpiSlab E{0, 0, FB};
            pg::gemm_phase<EpiSlab, pg::Sched<JobCtxG2>, 1>(F.lds, g, S, E);
            { Geo g2{256, 256, DM, 128u * 256 * 2u, 128u * 256 * 2u, 128u * DM * 2u, 4, 1 << 20, 1 << 20};
              pg::Sched<JobFold> S2{{FB}, 16, 1 << 20, bx - 150}; EpiFold E2{0, 0, FB};
              pg::gemm_phase<EpiFold, pg::Sched<JobFold>, 1>(F.lds, g2, S2, E2); }
        } else if (bx >= 194 && _rep == 0) {
            { TrDesc t{args.in[10], DM, 9216, Win, DM, 0, 2}; tr_all(F, t, (bx - 194) * NWAVES + F.wave, (F.G - 194) * NWAVES); }
            __syncthreads();
        }
    PHASE_END
    PHASE_BEGIN
        if (_rep == 0) norm_rows(F, args.in[0], args.in[2], args.in[9], 3 * DM, Dx, XcSlab, true, SEQ, SEQ + CTX);
        { pg::Sched<JobFfn2> S{{FB, 64, 1}, 64 * 4, F.G, bx};
          EpiFuse E{0, 0, FB, 0, args.in[0], args.in[9]};
          pg::gemm_phase<EpiFuse, pg::Sched<JobFfn2>, 1>(F.lds, gFfn2, S, E); }
    PHASE_END
    if constexpr (STOP_AFTER >= 3) {
    for (int pair = 0; pair < 2; ++pair) {
        PHASE_BEGIN
            { pg::Sched<JobRowCol> S{{FB, 0, 64, 4, 0, (size_t)pair * 2048 * DM, (size_t)256 * DM, (size_t)256 * DM}, 256, F.G, bx};
              EpiQK E{0, 0, FB, pair};
              pg::gemm_phase<EpiQK, pg::Sched<JobRowCol>, 1>(F.lds, gK1024, S, E); }
            { pg::Sched<JobRowCol> S{{FB, 1, 4, 64, (size_t)(pair * 2048 + 1024) * DM, 0, (size_t)256 * DM, (size_t)256 * DM}, 256, F.G, bx};
              EpiVT E{0, 0, FB};
              pg::gemm_phase<EpiVT, pg::Sched<JobRowCol>, 1>(F.lds, gK1024, S, E); }
            if (pair == 0 && !((bx >= 64 && bx < 68) || (bx >= 72 && bx < 80)) && _rep == 0) {
                const int r = bx < 64 ? bx : (bx < 72 ? bx - 4 : bx - 12), tgw = r * NWAVES + F.wave, tng = (F.G - 12) * NWAVES;
                { TrDesc t{args.in[18], DM, 2 * DFF, W13t, DM, 0, 0}; tr_all(F, t, tgw, tng); }
                { TrDesc t{args.in[19], DFF, DM, W2t, DFF, 0, 1}; tr_all(F, t, tgw, tng); }
                __syncthreads(); }
            if (pair == 0) {
                { pg::Sched<JobKc> S{{FB}, 4, F.G, (bx + F.G - 64) % F.G}; EpiKc E{0, 0, FB};
                  pg::gemm_phase<EpiKc, pg::Sched<JobKc>, 1>(F.lds, gK1024, S, E); }
                { pg::Sched<JobVc> S{{FB}, 8, F.G, (bx + F.G - 72) % F.G}; EpiVc E{0, 0, FB};
                  pg::gemm_phase<EpiVc, pg::Sched<JobVc>, 1>(F.lds, gK1024, S, E); }
            }
        PHASE_END
        if constexpr (DBG_PROBE == 5) {
        PHASE_BEGIN
            LAS float* scr = (LAS float*)F.lds; unsigned* dw = (unsigned*)(F.ws + WS_CTL) + 32768;
            const int s = bx; const int i = (int)(((unsigned)s * 2654435761u) >> 18) & 16383, hl = s & 1, h = 2 * pair + hl, pp = (s * 29 + 3) & 127, v = (s * 37 + 11) & 511;
            const float* win = args.in[10]; float q1 = 0.f, q2 = 0.f, k1 = 0.f, k2 = 0.f, vv = 0.f;
            for (int a = F.tid; a < DM; a += NTHREADS) { const float x = bf2f(Ax[(size_t)i * DM + a]); const float* wr_ = win + (size_t)a * 9216;
                q1 += x * wr_[h * 256 + 2 * pp]; q2 += x * wr_[h * 256 + 2 * pp + 1]; k1 += x * wr_[1024 + h * 256 + 2 * pp]; k2 += x * wr_[1024 + h * 256 + 2 * pp + 1]; vv += x * wr_[2048 + h * 512 + v]; }
            q1 = block_sum(scr, q1, F.tid); q2 = block_sum(scr, q2, F.tid); k1 = block_sum(scr, k1, F.tid); k2 = block_sum(scr, k2, F.tid); vv = block_sum(scr, vv, F.tid);
            if (F.tid == 0) { const float inv = powf(10000.0f, -(float)(pp & 63) / 64.0f), ang = (float)(pp < 64 ? (i >> 6) : (i & 63)) * inv, cs = cosf(ang), sn = sinf(ang);
                const float rq1 = (q1 * cs - q2 * sn) * 0.0625f, rq2 = (q1 * sn + q2 * cs) * 0.0625f, rk1 = k1 * cs - k2 * sn, rk2 = k1 * sn + k2 * cs; const int jl = i & 511;
                dbg_report(dw, rq1, bf2f(Qb[(size_t)i * 512 + hl * 256 + 2 * pp]), 1000.0f); dbg_report(dw, rq2, bf2f(Qb[(size_t)i * 512 + hl * 256 + 2 * pp + 1]), 1000.0f);
                dbg_report(dw, rk1, bf2f(Knb[(size_t)i * 512 + hl * 256 + 2 * pp]), 1000.0f); dbg_report(dw, rk2, bf2f(Knb[(size_t)i * 512 + hl * 256 + 2 * pp + 1]), 1000.0f);
                dbg_report(dw, rk2 * expf(lgp[h] * (float)(511 - jl)), bf2f(Ktb_[(size_t)(hl * 256 + 2 * pp + 1) * SEQ + i]), 1000.0f);
                dbg_report(dw, rk1 * expf(lgp[4 + h] * (float)jl), bf2f(Ktb_[(size_t)512 * SEQ + (size_t)(hl * 256 + 2 * pp) * SEQ + i]), 1000.0f);
                dbg_report(dw, vv, bf2f(B4[((size_t)((hl * NSEG + (i >> 9)) * 512 + v)) * 1024 + 512 + jl]), 1000.0f); }
        PHASE_END
        }
        PHASE_BEGIN
            { Geo g{1024, 1024, SEQ, 128u * 1024 * 2u, 128u * 1024 * 2u, 128u * (unsigned)SEQ * 2u, LS / 64, 1 << 20, 1 << 20};
              pg::Sched<JobR1> S{{FB}, 256, F.G, bx}; EpiU E{0, 0, FB};
              pg::gemm_phase<EpiU, pg::Sched<JobR1>, 1>(F.lds, g, S, E); }
            if (pair == 0) { Geo g{CTX, CTX, CTX, 128u * CTX * 2u, 128u * CTX * 2u, 128u * CTX * 2u, CTX / 64, 1 << 20, 1 << 20};
              pg::Sched<JobS0> S{{FB}, 16, F.G, (bx + F.G - 64) % F.G}; EpiS0 E{0, 0, FB};
              pg::gemm_phase<EpiS0, pg::Sched<JobS0>, 1>(F.lds, g, S, E); }
        PHASE_END
        if constexpr (DBG_PROBE == 6) {
        PHASE_BEGIN
            LAS float* scr = (LAS float*)F.lds; unsigned* dw = (unsigned*)(F.ws + WS_CTL) + 32768;
            const int s = bx, h = s & 3, dir = (s >> 2) & 1, d = (s * 29 + 3) & 255, v = (s * 37 + 11) & 511; const float* win = args.in[10];
            const int j = F.tid & 255, which = F.tid >> 8; const int col = which ? 2048 + h * 512 + v : 1024 + h * 256 + d; float dot = 0.f;
            for (int a = 0; a < DM; ++a) dot += bf2f(Ac[(size_t)j * DM + a]) * win[(size_t)a * 9216 + col];
            scr[16 + F.tid] = dot; __syncthreads();
            float term = 0.f; if (F.tid < 256) term = scr[16 + F.tid] * scr[16 + 256 + F.tid] * expf(lgp[dir * 4 + h] * (float)(dir ? j : 255 - j));
            __syncthreads();
            const float ref = block_sum(scr, term, F.tid);
            if (F.tid == 0) dbg_report(dw, ref, S0[((size_t)((h * 2 + dir) * 512 + v)) * 256 + d], 1000.0f);
        PHASE_END
        }
        PHASE_BEGIN
            { const int gw = F.vcu * NWAVES + F.wave, NGW = F.G * NWAVES;
              for (int rowid = gw; rowid < 1024; rowid += NGW) { const int hl = rowid >> 9, v = rowid & 511, h = 2 * pair + hl, dir = F.lane >> 5, d0 = (F.lane & 31) * 8;
                  const float* s0 = S0 + ((size_t)((h * 2 + dir) * 512 + v)) * 256 + d0; f32x4 c0 = *(const f32x4*)s0, c1 = *(const f32x4*)(s0 + 4);
                  const float dec = expf(lgp[dir * 4 + h] * (float)LS);
                  bf16_t* pb = B4 + ((size_t)(hl * NSEG * 512 + v)) * 1024 + dir * 256 + d0; const long sstep = dir ? -(long)512 * 1024 : (long)512 * 1024; if (dir) pb += (size_t)(NSEG - 1) * 512 * 1024;
                  u32x4 ub[NSEG];
#pragma unroll
                  for (int it = 0; it < NSEG; ++it) ub[it] = *(const u32x4*)(pb + (long)it * sstep);
#pragma unroll
                  for (int it = 0; it < NSEG; ++it) { f32x4 u0, u1; unpack8(ub[it], u0, u1); *(u32x4*)(pb + (long)it * sstep) = _rep == 0 ? pack8(c0, c1) : ub[it]; c0 = c0 * dec + u0; c1 = c1 * dec + u1; } } }
            if (pair == 0 && F.vcu >= 128 && _rep == 0) {
                for (size_t i = (size_t)(F.vcu - 128) * NTHREADS + F.tid; i < (size_t)DM * DM; i += (size_t)(F.G - 128) * NTHREADS) {
                    const int k = (int)(i >> 10), n = (int)(i & 1023), g = k >> 8, cc = k & 255, dc = cc < 128 ? cc : (cc == 128 ? 128 : 128 + (256 - cc));
                    Bz[(size_t)n * 3072 + g * 256 + dc] = f2bf(args.in[15][i]); }
                { TrDesc t{args.in[14], 2048, DM, Bz, 3072, 1024, 4}; tr_all(F, t, (F.vcu - 128) * NWAVES + F.wave, (F.G - 128) * NWAVES); }
                { TrDesc t{args.in[16], DM, DM, WoT, DM, 0, 5}; tr_all(F, t, (F.vcu - 128) * NWAVES + F.wave, (F.G - 128) * NWAVES); }
                __syncthreads(); }
            { Geo g{512, 512, 512, 128u * 512 * 2u, 128u * 512 * 2u, 128u * 512 * 2u, 4, 1 << 20, 1 << 20};
              pg::Sched<JobR3> S{{FB}, 256, F.G, bx}; EpiP E{0, 0, FB, pair};
              pg::gemm_phase<EpiP, pg::Sched<JobR3>, 1>(F.lds, g, S, E); }
        PHASE_END
        PHASE_BEGIN
            Geo g{512, 1024, 1024, 128u * 512 * 2u, 128u * 1024 * 2u, 128u * 1024 * 2u, 16, 8, 4};
            pg::Sched<JobR4> S{{FB}, 256, F.G, bx}; EpiO E{4, 8, FB, pair};
            pg::gemm_phase<EpiO, pg::Sched<JobR4>, 2>(F.lds, g, S, E);
        PHASE_END
        if constexpr (DBG_PROBE == 1) {
        PHASE_BEGIN
            LAS float* scr = (LAS float*)F.lds; unsigned* dw = (unsigned*)(F.ws + WS_CTL) + 32768;
            const int s = bx; int i = (int)(((unsigned)s * 2654435761u) >> 18) & 16383; if (s < 8) { const int sp[8] = {0, 1, 511, 512, 513, 8191, 16382, 16383}; i = sp[s]; }
            const int hl = s & 1, h = 2 * pair + hl, v = (s * 37 + 11) & 511; const float lgf = lgp[h], lgb = lgp[4 + h];
            float part = 0.f;
            for (int j = F.tid; j < SEQ; j += NTHREADS) { float qk = 0.f;
                for (int d = 0; d < 256; ++d) qk += bf2f(Qb[(size_t)i * 512 + hl * 256 + d]) * bf2f(Knb[(size_t)j * 512 + hl * 256 + d]);
                const float D = j < i ? __expf(lgf * (float)(i - j)) : (j > i ? __expf(lgb * (float)(j - i)) : 2.0f);
                part += D * qk * bf2f(B4[((size_t)((hl * NSEG + (j >> 9)) * 512 + v)) * 1024 + 512 + (j & 511)]); }
            if (F.tid < 256) { const float q = bf2f(Qb[(size_t)i * 512 + hl * 256 + F.tid]);
                part += q * (__expf(lgf * (float)(i + 1)) * S0[((size_t)((h * 2 + 0) * 512 + v)) * 256 + F.tid] + __expf(lgb * (float)(SEQ - i)) * S0[((size_t)((h * 2 + 1) * 512 + v)) * 256 + F.tid]); }
            const float ref = block_sum(scr, part, F.tid);
            const float ov = bf2f(Ob[(size_t)i * 2048 + h * 512 + F.tid]); const float rms = sqrtf(block_sum(scr, ov * ov, F.tid) * (1.0f / 512.0f));
            if (F.tid == 0) dbg_report(dw, ref, bf2f(Ob[(size_t)i * 2048 + h * 512 + v]), rms * 1000.0f);
        PHASE_END
        }
    }
    if constexpr (DBG_PROBE == 7 || DBG_PROBE == 8) {
    PHASE_BEGIN
        LAS float* scr = (LAS float*)F.lds; unsigned* dw = (unsigned*)(F.ws + WS_CTL) + 32768; float* sav = (float*)(F.ws + WS_END);
        const int s = bx; const int i = s * 64 + 57, h = DBG_COL >> 9, v = DBG_COL & 511;
        const float ov = bf2f(Ob[(size_t)i * 2048 + h * 512 + F.tid]); const float mean = block_sum(scr, ov, F.tid) * (1.0f / 512.0f);
        const float var = block_sum(scr, (ov - mean) * (ov - mean), F.tid) * (1.0f / 512.0f); const float rstd = 1.0f / sqrtf(var + EPS);
        if (F.tid == 0) { if (DBG_PROBE == 7) { dbg_report(dw, mean, stats[(size_t)(i * 4 + h) * 2], 1000.0f); dbg_report(dw, rstd, stats[(size_t)(i * 4 + h) * 2 + 1], 1000.0f); }
            sav[s * 4 + 0] = (bf2f(Ob[(size_t)i * 2048 + h * 512 + v]) - mean) * rstd; }
    PHASE_END
    }
    PHASE_BEGIN
        { LAS unsigned char* stl = F.lds + RING_BYTES + 1024;
          if (_rep == 0) { const int pm = bx >> 2, h = bx & 3;
            for (int r = F.wave; r < 256; r += NWAVES) { const int pos = pm * 256 + r; f32x4 a, b; unpack8(*(const u32x4*)(Ob + (size_t)pos * 2048 + h * 512 + F.lane * 8), a, b);
                const float mean = wave_sum((a[0] + a[1]) + (a[2] + a[3]) + (b[0] + b[1]) + (b[2] + b[3])) * (1.0f / 512.0f);
                a -= mean; b -= mean; const float q = wave_sum((a[0] * a[0] + a[1] * a[1]) + (a[2] * a[2] + a[3] * a[3]) + (b[0] * b[0] + b[1] * b[1]) + (b[2] * b[2] + b[3] * b[3]));
                if (F.lane == 0) *(LAS f32x2*)(stl + r * 8) = (f32x2){mean, 1.0f / sqrtf(q * (1.0f / 512.0f) + EPS)}; }
            __syncthreads(); }
          pg::Sched<JobG2> S{{FB}, 512, F.G, bx};
          EpiG E{0, 0, FB, args.in[13], _rep, stl};
          pg::gemm_phase<EpiG, pg::Sched<JobG2>, 1>(F.lds, gK1024, S, E); }
        { Geo g{DM, DM, 128u * DM, 128u * DM * 2u, 128u * DM * 2u, (unsigned)DM * 2u, DM / 64, 1 << 20, 1 << 20};
          pg::Sched<JobRowCol> S{{FB, 1, 4, 64, (size_t)WR_F * DM, 0, (size_t)256 * DM, (size_t)2 * DM}, 256, F.G, bx};
          EpiF E{0, 0, FB};
          pg::gemm_phase<EpiF, pg::Sched<JobRowCol>, 1>(F.lds, g, S, E); }
    PHASE_END
    if constexpr (DBG_PROBE == 8) {
    PHASE_BEGIN
        LAS float* scr = (LAS float*)F.lds; unsigned* dw = (unsigned*)(F.ws + WS_CTL) + 32768; float* sav = (float*)(F.ws + WS_END);
        const int s = bx; const int i = s * 64 + 57, h = DBG_COL >> 9, v = DBG_COL & 511, col = h * 512 + v; float g = 0.f;
        for (int a = F.tid; a < DM; a += NTHREADS) g += bf2f(Ax[(size_t)i * DM + a]) * args.in[10][(size_t)a * 9216 + 4096 + col];
        g = block_sum(scr, g, F.tid);
        if (F.tid == 0) dbg_report(dw, g / (1.0f + expf(-g)) * sav[s * 4] * args.in[13][col], bf2f(Ob[(size_t)i * 2048 + col]), 1.0f);
    PHASE_END
    }
    PHASE_BEGIN
        Geo g{256, 256, 256, 128u * 256 * 2u, 128u * 256 * 2u, 128u * 256 * 2u, 4, 1 << 20, 1 << 20};
        pg::Sched<JobF1> S{{FB}, 256, F.G, bx}; EpiF1 E{0, 0, FB};
        pg::gemm_phase<EpiF1, pg::Sched<JobF1>, 1>(F.lds, g, S, E);
    PHASE_END
    if constexpr (DBG_PROBE == 2 || DBG_PROBE == 4) {
    PHASE_BEGIN
        LAS float* scr = (LAS float*)F.lds; unsigned* dw = (unsigned*)(F.ws + WS_CTL) + 32768;
        if (DBG_PROBE == 4) {
            const int s = bx; const int l = (int)(((unsigned)s * 2654435761u) >> 18) & 16383, ch = (s * 131 + 7) & 1023, g = ch >> 8, cp = ch & 255;
            const int c = F.tid & 255, hf = F.tid >> 8; float fpart = 0.f;
            for (int a = hf * 512; a < hf * 512 + 512; ++a) fpart += bf2f(Ax[(size_t)l * DM + a]) * args.in[10][(size_t)a * 9216 + 6144 + g * 256 + c];
            scr[16 + F.tid] = fpart; __syncthreads();
            float wr_ = 0.f, wi_ = 0.f;
            if (F.tid < 256) { const float fv = scr[16 + F.tid] + scr[16 + 256 + F.tid]; const float ang = (float)((c * cp) & 255) * (1.0f / 128.0f); wr_ = fv * cospif(ang); wi_ = -fv * sinpif(ang); }
            __syncthreads();
            const float Wr = block_sum(scr, wr_, F.tid), Wi = block_sum(scr, wi_, F.tid);
            const int l1 = l >> 7, l2 = l & 127;
            if (F.tid == 0) { dbg_report(dw, Wr, bf2f(Wt[(size_t)(ch * 128 + l2) * 256 + l1]), 16000.0f); dbg_report(dw, Wi, bf2f(Wt[(size_t)(ch * 128 + l2) * 256 + 128 + l1]), 16000.0f); }
        } else {
            const unsigned sid = (unsigned)(bx * NTHREADS + F.tid) * 2654435761u; const int k1 = (sid >> 8) & 127, l2 = (sid >> 15) & 127, ch = (sid >> 22) & 1023;
            float ar = 0.f, ai = 0.f;
            for (int l1 = 0; l1 < 128; ++l1) { const float wr_ = bf2f(Wt[(size_t)(ch * 128 + l2) * 256 + l1]), wi_ = bf2f(Wt[(size_t)(ch * 128 + l2) * 256 + 128 + l1]);
                const float a = (float)((k1 * l1) & 127) * (1.0f / 64.0f), cs = cospif(a), sn = sinpif(a); ar += cs * wr_ + sn * wi_; ai += cs * wi_ - sn * wr_; }
            const float t = (float)((k1 * l2) & 16383) * (1.0f / 8192.0f), ct = cospif(t), st = sinpif(t);
            const float br = ar * ct + ai * st, bi = ai * ct - ar * st;
            dbg_report(dw, br, bf2f(Bt[(size_t)(k1 * 1024 + ch) * 256 + l2]), 180000.0f); dbg_report(dw, bi, bf2f(Bt[(size_t)(k1 * 1024 + ch) * 256 + 128 + l2]), 180000.0f);
        }
    PHASE_END
    }
    PHASE_BEGIN
        Geo g{256, 256, 256, 128u * 256 * 2u, 128u * 256 * 2u, 128u * 256 * 2u, 4, 1 << 20, 1 << 20};
        pg::Sched<JobF2> S{{FB}, 256, F.G, bx}; EpiF2 E{0, 0, FB};
        pg::gemm_phase<EpiF2, pg::Sched<JobF2>, 1>(F.lds, g, S, E);
    PHASE_END
    if constexpr (DBG_PROBE == 3) {
    PHASE_BEGIN
        unsigned* dw = (unsigned*)(F.ws + WS_CTL) + 32768;
        const unsigned sid = (unsigned)(bx * NTHREADS + F.tid) * 2654435761u; const int k1 = (sid >> 8) & 127, k2 = (sid >> 15) & 127, ch = (sid >> 22) & 1023;
        float y = 0.f;
        for (int l2 = 0; l2 < 128; ++l2) { const float br = bf2f(Bt[(size_t)(k1 * 1024 + ch) * 256 + l2]), bi = bf2f(Bt[(size_t)(k1 * 1024 + ch) * 256 + 128 + l2]);
            const float a = (float)((k2 * l2) & 127) * (1.0f / 64.0f); y += br * cospif(a) + bi * sinpif(a); }
        dbg_report(dw, y * (1.0f / 2048.0f), bf2f(MIXb[(size_t)(k1 + 128 * k2) * 2048 + ch]), 1000.0f);
    PHASE_END
    }
    if constexpr (DBG_PROBE == 12) {
    PHASE_BEGIN
        unsigned* dw = (unsigned*)(F.ws + WS_CTL) + 32768;
        for (size_t idx = gtid; idx < (size_t)DM * 9216; idx += gthreads) { const int k = (int)(idx / 9216), n = (int)(idx % 9216); const int dr = tr_dest_row(2, n);
            if (dr >= 0) { const float a = args.in[10][idx]; const float b = bf2f(Win[(size_t)dr * DM + k]); if (fabsf(a - b) > 0.01f * fabsf(a) + 1e-6f) { atomicAdd(dw + 64, 1u); atomicMin(dw + 192, (unsigned)(dr >> 8)); } } }
    PHASE_END
    }
    if constexpr (DBG_PROBE == 9) {
    PHASE_BEGIN
        LAS float* scr = (LAS float*)F.lds; unsigned* dw = (unsigned*)(F.ws + WS_CTL) + 32768;
        const int s = bx; const int i = DBG_VAR == 0 ? 1210 : (DBG_VAR == 1 ? 1024 + s : (DBG_VAR == 2 ? s * 64 + 57 : 1210 + 256 * (s & 63))), n = DBG_VAR == 0 ? 4 * s : 736; float ga = 0.f, gf = 0.f;
        for (int a = F.tid; a < DM; a += NTHREADS) { const float x = bf2f(Ax[(size_t)i * DM + a]); ga += x * args.in[10][(size_t)a * 9216 + 7168 + n]; gf += x * args.in[10][(size_t)a * 9216 + 8192 + n]; }
        ga = block_sum(scr, ga, F.tid); gf = block_sum(scr, gf, F.tid);
        if (F.tid == 0) { const float ea = fabsf(1.0f / (1.0f + expf(-ga)) - bf2f(GAb[(size_t)i * DM + n])), ef = fabsf(1.0f / (1.0f + expf(-gf)) - bf2f(GFb[(size_t)i * DM + n]));
            if (ea > 0.05f) { atomicMin(dw + 192, (unsigned)s); atomicAdd(dw + 64, 1u); dbg_report(dw, 0.f, DBG_GF ? ea : bf2f(GAb[(size_t)i * DM + n]), 1000.0f); } if (ef > 0.05f) atomicMin(dw + 193, (unsigned)s); }
    PHASE_END
    }
    PHASE_BEGIN
        { int pmz, pnz; pg::tile_pm_pn(bx, 64, 4, pmz, pnz); const float* side = (const float*)(F.ws + WS_STATS);
          for (int t = F.tid; t < 1024; t += NTHREADS) { const int k = pmz * 256 + (t >> 2), g = t & 3, kr = (SEQ - k) & (SEQ - 1);
              const f32x2 s1 = *(const f32x2*)(side + (size_t)(k * 4 + g) * 2), s2 = *(const f32x2*)(side + (size_t)(kr * 4 + g) * 2);
              MIXb[(size_t)k * 2048 + g * 256] = f2bf(0.5f * (s1.x + s2.x)); MIXb[(size_t)k * 2048 + g * 256 + 128] = f2bf(0.5f * (s1.y + s2.y)); }
          asm volatile("s_waitcnt vmcnt(0)" ::: "memory"); __syncthreads(); }
        { pg::Sched<JobGate2> S{{FB}, 512, F.G, bx}; EpiGate E{0, 0, FB};
          pg::gemm_phase<EpiGate, pg::Sched<JobGate2>, 1>(F.lds, gK1024, S, E); }
        { Geo g{2048, 2048, 3072, 128u * 2048 * 2u, 128u * 2048 * 2u, 128u * 3072 * 2u, 16, 1 << 20, 1 << 20};
          pg::Sched<JobZ> S{{FB, 0}, 256, F.G, bx}; EpiZ2 E{0, 0, FB, 0};
          pg::gemm_phase<EpiZ2, pg::Sched<JobZ>, 1>(F.lds, g, S, E); }
        { Geo g{2048, 2048, 3072, 128u * 2048 * 2u, 128u * 2048 * 2u, 128u * 3072 * 2u, 32, 1 << 20, 1 << 20};
          pg::Sched<JobZ> S{{FB, 1}, 256, F.G, bx}; EpiZ2 E{0, 0, FB, 1};
          pg::gemm_phase<EpiZ2, pg::Sched<JobZ>, 1>(F.lds, g, S, E); }
    PHASE_END
    if constexpr (DBG_PROBE == 9 || DBG_PROBE == 10) {
    PHASE_BEGIN
        LAS float* scr = (LAS float*)F.lds; unsigned* dw = (unsigned*)(F.ws + WS_CTL) + 32768;
        const int s = bx; const int i = (int)(((unsigned)s * 2654435761u) >> 18) & 16383, n = (s * 131 + 7) & 1023;
        if (DBG_PROBE == 9) { float ga = 0.f, gf = 0.f;
            (void)ga; (void)gf;
        } else { float r = 0.f, fo = 0.f;
            for (int k = F.tid; k < 2048; k += NTHREADS) r += bf2f(Ob[(size_t)i * 2048 + k]) * args.in[14][(size_t)k * DM + n];
            for (int k = F.tid; k < 1024; k += NTHREADS) fo += bf2f(MIXb[(size_t)i * 2048 + k]) * args.in[15][(size_t)k * DM + n];
            r = block_sum(scr, r, F.tid); fo = block_sum(scr, fo, F.tid);
            if (F.tid == 0) dbg_report(dw, bf2f(GAb[(size_t)i * DM + n]) * r + bf2f(GFb[(size_t)i * DM + n]) * fo, bf2f(Zb[(size_t)i * DM + n]), 1000.0f); }
    PHASE_END
    }
    PHASE_BEGIN
        Geo g{2048, 2048, DM, 128u * 2048 * 2u, 128u * 2048 * 2u, 128u * DM * 2u, DM / 64, 1 << 20, 1 << 20};
        pg::Sched<JobRowCol> S{{FB, 2, 64, 4, 0, 0, (size_t)256 * 2048, (size_t)256 * DM}, 256, F.G, bx};
        EpiFuse E{0, 0, FB, 1, args.in[0], args.in[17]};
        pg::gemm_phase<EpiFuse, pg::Sched<JobRowCol>, 1>(F.lds, g, S, E);
    PHASE_END
    }
    PHASE_BEGIN
        pg::Sched<JobFfn1> S{{FB, 64, 0}, 64 * 22, F.G, bx};
        EpiSwiglu E{0, 0, FB};
        pg::gemm_phase<EpiSwiglu, pg::Sched<JobFfn1>, 1>(F.lds, gK1024, S, E);
    PHASE_END
    PHASE_BEGIN
        pg::Sched<JobFfn2> S{{FB, 64, 0}, 64 * 4, F.G, bx};
        EpiFuse E{0, 0, FB, 2, args.in[0], args.in[20]};
        pg::gemm_phase<EpiFuse, pg::Sched<JobFfn2>, 1>(F.lds, gFfn2, S, E);
    PHASE_END
    if constexpr (DBG_TSEL >= 0) {
    PHASE_BEGIN
        const unsigned long long* ts = (const unsigned long long*)(F.ws + WS_CTL + 160000);
        if (bx == 0) { const float a = 0.1f * (float)(ts[DBG_TSEL + 1] - ts[DBG_TSEL]), b = 0.1f * (float)(ts[DBG_TSEL2 + 1] - ts[DBG_TSEL2]);
            if (F.tid == 0) ((float*)F.dout)[0] = a; for (int i = F.tid; i < 1024; i += NTHREADS) ((float*)F.dout)[1024 + i] = b; }
    PHASE_END
    }
    if constexpr (DBG_PROBE != 0) {
    PHASE_BEGIN
        if (bx == 0 && F.tid == 0) { const float e = __builtin_bit_cast(float, ((unsigned*)(F.ws + WS_CTL))[32768]); ((float*)F.dout)[0] = DBG_COUNT == 3 ? 100.0f * (float)(16u + ((((unsigned*)(F.ws + WS_CTL))[32768 + 192 + DBG_GF] + 0xC0000000u - 0xC0000000u) >> DBG_SH & 15u)) : DBG_COUNT == 2 ? 100.0f * (float)(16u + ((unsigned*)(F.ws + WS_CTL))[32768 + 128]) : DBG_COUNT ? 1000.0f + 10.0f * (float)((unsigned*)(F.ws + WS_CTL))[32768 + 64] : 1000.0f * (10.0f + log10f(e + 1e-10f)); }
    PHASE_END
    }
}

extern "C" void kernel_launch(void* const* d_in, const int* in_sizes, int n_in, void* d_out, int out_size, void* d_ws, size_t ws_size, hipStream_t stream) {
    static int grid = 0;
    if (grid == 0) {
        if (n_in != 21 || out_size != SEQ * DM || ws_size < 256 * MiB) { fprintf(stderr, "kernel_launch: unexpected shapes (n_in %d out %d ws %zu)\n", n_in, out_size, ws_size); grid = -1; return; }
        int dev = 0, cus = 0, per_cu = 0;
        if (hipGetDevice(&dev) != hipSuccess || hipDeviceGetAttribute(&cus, hipDeviceAttributeMultiprocessorCount, dev) != hipSuccess) { grid = -1; return; }
        if (hipFuncSetAttribute((const void*)fwd_kernel, hipFuncAttributeMaxDynamicSharedMemorySize, LDS_BYTES) != hipSuccess) { fprintf(stderr, "kernel_launch: hipFuncSetAttribute failed\n"); grid = -1; return; }
        if (hipOccupancyMaxActiveBlocksPerMultiprocessor(&per_cu, (const void*)fwd_kernel, NTHREADS, LDS_BYTES) != hipSuccess || per_cu < 1) { fprintf(stderr, "kernel_launch: occupancy query says %d blocks/CU\n", per_cu); }
        (void)hipGetLastError();
        grid = cus;
    }
    if (grid < 0) return;
    (void)hipMemsetAsync((char*)d_ws + WS_CTL, 0, CTL_ZERO_BYTES, stream);
    Args a{};
    for (int i = 0; i < 21; ++i) a.in[i] = (const float*)d_in[i];
    a.out = (float*)d_out; a.ws = (unsigned char*)d_ws; a.ph_lo = 0; a.ph_hi = 1000;
    hipLaunchKernelGGL(fwd_kernel, dim3(grid), dim3(NTHREADS), LDS_BYTES, stream, a);
}
```

```cpp
#include <hip/hip_runtime.h>
#include <cstdio>
#include <cstdint>

#ifndef DBG_NOFOUR
#define DBG_NOFOUR 0
#endif
#ifndef DBG_NORET
#define DBG_NORET 0
#endif
#ifndef DBG_PROBE
#define DBG_PROBE 0
#endif
#ifndef DBG_COUNT
#define DBG_COUNT 0
#ifndef DBG_COL
#define DBG_COL 736
#endif
#ifndef DBG_VAR
#define DBG_VAR 2
#endif
#ifndef DBG_SH
#define DBG_SH 0
#endif
#ifndef DBG_GF
#define DBG_GF 1
#endif
#ifndef DBG_S0
#define DBG_S0 4
#endif
#endif
#ifndef DBG_XBAR
#define DBG_XBAR 0
#endif
#ifndef DBG_DUP
#define DBG_DUP -1
#endif
#ifndef DBG_TSEL
#define DBG_TSEL -1
#endif
#ifndef DBG_TSEL2
#define DBG_TSEL2 1
#endif
#ifndef PG_ALIGN
#define PG_ALIGN 1
#endif
#ifndef STOP_AFTER
#define STOP_AFTER 99
#endif

#define LAS __attribute__((address_space(3)))
typedef unsigned short bf16_t;
typedef short bf16x8 __attribute__((ext_vector_type(8)));
typedef float f32x4 __attribute__((ext_vector_type(4)));
typedef float f32x2 __attribute__((ext_vector_type(2)));
typedef unsigned u32x4 __attribute__((ext_vector_type(4)));
typedef unsigned u32x2 __attribute__((ext_vector_type(2)));

constexpr int DM = 1024, SEQ = 16384, CTX = 256, DFF = 2816;
constexpr float EPS = 1e-6f;
constexpr int LS = 512, NSEG = SEQ / LS;

constexpr size_t MiB = 1u << 20;
constexpr size_t WS_CTL = 0, CTL_ZERO_BYTES = 1 * MiB;
constexpr size_t WS_MOD = 1 * MiB;
constexpr size_t WS_TAB = 2 * MiB;
constexpr size_t WS_STATS = 3 * MiB;
constexpr size_t WS_S0 = 4 * MiB;
constexpr size_t WS_KC = 8 * MiB;
constexpr size_t WS_VC = 9 * MiB;
constexpr size_t WS_DC = 10 * MiB;
constexpr size_t WS_HC = 12 * MiB;
constexpr size_t WS_WIN = 14 * MiB;
constexpr size_t WS_WN = 34 * MiB;
constexpr size_t WS_WB = 36 * MiB;
constexpr size_t WS_H = 54 * MiB;
constexpr size_t WS_Q = 54 * MiB, WS_KN = 70 * MiB, WS_KT = 86 * MiB, WS_B4 = 118 * MiB;
constexpr size_t WS_O = 182 * MiB;
constexpr size_t WS_END = 246 * MiB;
constexpr size_t WS_XB = 11 * MiB;
constexpr size_t WS_OUTW = 246 * MiB;
constexpr size_t WS_XCSLAB = 150 * MiB;
constexpr size_t WS_WT = 118 * MiB, WS_BT = 150 * MiB, WS_MIX = 118 * MiB, WS_GA = 54 * MiB, WS_GF = 86 * MiB;
constexpr size_t DO_AX = 32 * MiB;
constexpr int WR_G = 4096, WR_F = 6144, WR_GA = 8192, WR_GF = 9216;
constexpr size_t WB_W13 = 0, WB_W2 = 11 * MiB;
constexpr size_t WB_BZ = 0, WB_WO = 6 * MiB;
constexpr size_t TB_ROPE = 0, TB_TW = 128 * 1024, TB_FM = 256 * 1024, TB_GM = 384 * 1024, TB_T256 = 512 * 1024;

typedef __bf16 bf16x2_t __attribute__((ext_vector_type(2)));
__device__ __forceinline__ unsigned cvt_pk_bf16(float lo, float hi) { const f32x2 v = {lo, hi}; return __builtin_bit_cast(unsigned, __builtin_convertvector(v, bf16x2_t)); }
__device__ __forceinline__ unsigned short f2bf(float f) { unsigned u = __builtin_bit_cast(unsigned, f); return (unsigned short)((u + 0x7fffu + ((u >> 16) & 1u)) >> 16); }
__device__ __forceinline__ float bflo(unsigned u) { return __builtin_bit_cast(float, u << 16); }
__device__ __forceinline__ float bfhi(unsigned u) { return __builtin_bit_cast(float, u & 0xffff0000u); }
__device__ __forceinline__ u32x4 pack8(const f32x4 a, const f32x4 b) { u32x4 w; w.x = cvt_pk_bf16(a[0], a[1]); w.y = cvt_pk_bf16(a[2], a[3]); w.z = cvt_pk_bf16(b[0], b[1]); w.w = cvt_pk_bf16(b[2], b[3]); return w; }
__device__ __forceinline__ void unpack8(const u32x4 w, f32x4& a, f32x4& b) { a = (f32x4){bflo(w.x), bfhi(w.x), bflo(w.y), bfhi(w.y)}; b = (f32x4){bflo(w.z), bfhi(w.z), bflo(w.w), bfhi(w.w)}; }

__device__ __forceinline__ void st16wt(void* p, const u32x4 v) { asm volatile("global_store_dwordx4 %0, %1, off sc1\n\ts_nop 1" :: "v"(p), "v"(v) : "memory"); }
__device__ __forceinline__ float fsigmoid(float a) { return __builtin_amdgcn_rcpf(1.0f + __expf(-a)); }
__device__ __forceinline__ float fsilu(float a) { return a * fsigmoid(a); }
__device__ __forceinline__ f32x4 vsigmoid(const f32x4 a) { f32x4 t = a * -1.44269504f;
    t = (f32x4){__builtin_amdgcn_exp2f(t[0]), __builtin_amdgcn_exp2f(t[1]), __builtin_amdgcn_exp2f(t[2]), __builtin_amdgcn_exp2f(t[3])}; t = t + 1.0f;
    return (f32x4){__builtin_amdgcn_rcpf(t[0]), __builtin_amdgcn_rcpf(t[1]), __builtin_amdgcn_rcpf(t[2]), __builtin_amdgcn_rcpf(t[3])}; }
__device__ __forceinline__ float wave_sum(float v) {
#pragma unroll
    for (int o = 1; o < 64; o <<= 1) v += __shfl_xor(v, o);
    return v;
}

namespace pg {
constexpr int BM = 256, BK = 64, HALF = 128, HTB = HALF * BK * 2, STAGE_BYTES = 8 * HTB, NXCD = 8, WGM = 4;
__device__ __forceinline__ int lds_byte(int r, int c) { const int st = (r >> 4) * 2 + (c >> 5), rr = r & 15, cc = c & 31, ob = rr * 64 + cc * 2; return st * 1024 + (ob ^ (((ob >> 9) & 1) << 5)); }
__device__ __forceinline__ void stage_rc(int b, int& R, int& C) { const int st = b / 1024, sb = b % 1024, swz = sb ^ (((sb >> 9) & 1) << 5); R = (st >> 1) * 16 + swz / 64; C = (st & 1) * 32 + (swz % 64) / 2; }
__device__ __forceinline__ int perm32(int rho) { const int n = rho >> 4, i = rho & 15; return 8 * (i >> 2) + 4 * n + (i & 3); }

struct Unit { const char* a0; const char* a1; const char* b; char* d; int i0, i1, i2, i3; };
struct Geo { unsigned lda0, lda1, ldb;
             unsigned hsA0, hsA1, hsB;
             int nt, c0, rep0; };

__device__ __forceinline__ void tile_pm_pn(int L, int nM, int nN, int& pm, int& pn) {
    const int nwg = nM * nN; int wgid = L;
    { const int q = nwg / NXCD, r = nwg % NXCD, xcd = wgid % NXCD, off = wgid / NXCD; wgid = (xcd < r ? xcd * (q + 1) : r * (q + 1) + (xcd - r) * q) + off; }
    const int nig = WGM * nN, gid = wgid / nig, fm = gid * WGM, gsz = (nM - fm) < WGM ? (nM - fm) : WGM;
    pm = fm + ((wgid % nig) % gsz); pn = (wgid % nig) / gsz;
}
__device__ __forceinline__ int xcd_contig(int L, int n) { return (L % NXCD) * (n / NXCD) + L / NXCD; }

template <class Job> struct Sched {
    Job j; int n, G, c;
    __device__ __forceinline__ bool next(int i, Unit& u) const { const long L = (long)i * G + c; if (L >= n) return false; j.fill((int)L, u); return true; }
};

template <class Epi, class Sch, int ASEG>
__device__ __forceinline__ void gemm_phase(LAS unsigned char* lds, const Geo g, const Sch& S, const Epi& E) {
    int tid = threadIdx.x; asm volatile("" : "+v"(tid));
    const int wid = __builtin_amdgcn_readfirstlane(tid >> 6), lane = tid & 63, wr = wid >> 2, wc = wid & 3, fr = lane & 15, fq = lane >> 4;
    int nt = g.nt; asm volatile("" : "+s"(nt));
    unsigned voffA0[2], voffA1[2], voffB[2];
#pragma unroll
    for (int i = 0; i < 2; ++i) { int R, C; stage_rc(tid * 16 + i * 8192, R, C); const int Rb = (R & ~31) + perm32(R & 31);
        voffA0[i] = (unsigned)(R * g.lda0 + C) * 2u; voffA1[i] = (ASEG == 2) ? (unsigned)(R * g.lda1 + C) * 2u : 0u; voffB[i] = (unsigned)(Rb * g.ldb + C) * 2u; }
    const unsigned ldsw = (unsigned)wid * 1024u;
    const int aoff = lds_byte(wr * 64 + fr, fq * 8), boff = lds_byte(wc * 32 + fr, fq * 8);
#define PG_SA(b, h) (((b) * 2 + (h)) * HTB)
#define PG_SB(b, h) ((4 + (b) * 2 + (h)) * HTB)
#define PG_GLDS(gp, lp) __builtin_amdgcn_global_load_lds((const unsigned*)(gp), (LAS unsigned*)(lp), 16, 0, 0)
#define PG_ASEL(T) (ASEG == 2 && (T) >= g.c0)
#define PG_APTR(U, T) (PG_ASEL(T) ? (U).a1 + (size_t)((T) - g.c0) * 128 : (U).a0 + (size_t)((T) & (g.rep0 - 1)) * 128)
#define PG_STAGE_A(bufoff, gbase, h, sel) do { const bool _s = (sel); const unsigned _v0 = _s ? voffA1[0] : voffA0[0], _v1 = _s ? voffA1[1] : voffA0[1]; \
        const char* _p = (gbase) + ((h) ? (size_t)(_s ? g.hsA1 : g.hsA0) : (size_t)0); \
        PG_GLDS(_p + _v0, lds + (bufoff) + ldsw); PG_GLDS(_p + _v1, lds + (bufoff) + ldsw + 8192); } while (0)
#define PG_STAGE_B(bufoff, gbase, h) do { const char* _p = (gbase) + ((h) ? (size_t)g.hsB : (size_t)0); \
        PG_GLDS(_p + voffB[0], lds + (bufoff) + ldsw); PG_GLDS(_p + voffB[1], lds + (bufoff) + ldsw + 8192); } while (0)
#define PG_LDA(dst, b, h) do { _Pragma("unroll") for (int m = 0; m < 4; ++m) _Pragma("unroll") for (int k = 0; k < 2; ++k) dst[m][k] = *(const LAS bf16x8*)(lds + PG_SA(b, h) + aoff + m * 2048 + k * 1024); } while (0)
#define PG_LDB(dst, b, h) do { _Pragma("unroll") for (int n = 0; n < 2; ++n) _Pragma("unroll") for (int k = 0; k < 2; ++k) dst[n][k] = *(const LAS bf16x8*)(lds + PG_SB(b, h) + boff + n * 2048 + k * 1024); } while (0)
#define PG_MMA(ai, bj, At, Bt) do { __builtin_amdgcn_s_setprio(1); _Pragma("unroll") for (int m = 0; m < 4; ++m) _Pragma("unroll") for (int n = 0; n < 2; ++n) _Pragma("unroll") for (int k = 0; k < 2; ++k) \
        acc[ai][bj][m][n] = __builtin_amdgcn_mfma_f32_16x16x32_bf16(Bt[n][k], At[m][k], acc[ai][bj][m][n], 0, 0, 0); __builtin_amdgcn_s_setprio(0); } while (0)
#define PG_WAIT_V(n) asm volatile("s_waitcnt vmcnt(" #n ")" ::: "memory")
#define PG_WAIT_L(n) asm volatile("s_waitcnt lgkmcnt(" #n ")" ::: "memory")
#define PG_BAR __builtin_amdgcn_s_barrier()
#define PG_SCHED __builtin_amdgcn_sched_barrier(0)
    Unit cur, nxt; int ui = 0;
    if (!S.next(0, cur)) return;
    f32x4 acc[2][2][4][2];
#pragma unroll
    for (int a = 0; a < 2; ++a)
#pragma unroll
        for (int b = 0; b < 2; ++b)
#pragma unroll
            for (int m = 0; m < 4; ++m)
#pragma unroll
                for (int n = 0; n < 2; ++n) acc[a][b][m][n] = (f32x4){0.f, 0.f, 0.f, 0.f};
    bf16x8 At[4][2], B0[2][2], B1[2][2];
    { const char* p0 = PG_APTR(cur, 0); const char* p1 = PG_APTR(cur, 1);
      PG_STAGE_B(PG_SB(0, 0), cur.b, 0); PG_STAGE_B(PG_SB(0, 1), cur.b, 1); PG_STAGE_A(PG_SA(0, 0), p0, 0, PG_ASEL(0)); PG_STAGE_A(PG_SA(0, 1), p0, (Epi::HALFM && cur.i3 != 0) ? 0 : 1, PG_ASEL(0));
      if (wr == 1) PG_BAR;
      PG_WAIT_V(2); PG_BAR;
      PG_STAGE_B(PG_SB(1, 0), cur.b + 128, 0); PG_STAGE_A(PG_SA(1, 0), p1, 0, PG_ASEL(1)); PG_STAGE_B(PG_SB(1, 1), cur.b + 128, 1);
      PG_WAIT_V(6); PG_BAR; }
    for (;;) {
        const bool has_next = S.next(ui + 1, nxt);
        const char* nA0 = has_next ? PG_APTR(nxt, 0) : PG_APTR(cur, 0); const char* nA1 = has_next ? PG_APTR(nxt, 1) : PG_APTR(cur, 1); const char* nB = has_next ? nxt.b : cur.b;
        const bool hmc = Epi::HALFM && cur.i3 != 0, hmn = Epi::HALFM && (has_next ? nxt.i3 != 0 : cur.i3 != 0);
        for (int t = 0; t < nt; t += 2) {
            const bool last = (t == nt - 2);
            if constexpr (Epi::NHOOK >= 1) { if (t == E.h0) { int t2 = threadIdx.x; asm volatile("" : "+v"(t2)); E.hook(acc, cur, 0, wr, wc, t2 & 15, (t2 >> 4) & 3); } }
            if constexpr (Epi::NHOOK >= 2) { if (t == E.h1) { int t2 = threadIdx.x; asm volatile("" : "+v"(t2)); E.hook(acc, cur, 1, wr, wc, t2 & 15, (t2 >> 4) & 3); } }
            const char* a1 = PG_APTR(cur, t + 1); const bool s1 = PG_ASEL(t + 1);
            const char* a2 = last ? nA0 : PG_APTR(cur, t + 2); const char* a3 = last ? nA1 : PG_APTR(cur, t + 3);
            const char* b2 = last ? nB : cur.b + (size_t)(t + 2) * 128; const char* b3 = b2 + 128;
            const bool s2 = last ? PG_ASEL(0) : PG_ASEL(t + 2), s3 = last ? PG_ASEL(1) : PG_ASEL(t + 3);
            PG_LDB(B0, 0, 0); PG_LDB(B1, 0, 1); PG_SCHED; PG_LDA(At, 0, 0); PG_STAGE_A(PG_SA(1, 1), a1, hmc ? 0 : 1, s1);
            PG_WAIT_V(8); PG_WAIT_L(0); PG_BAR; PG_MMA(0, 0, At, B0); PG_MMA(0, 1, At, B1); PG_BAR; PG_SCHED;
            if (!hmc) PG_LDA(At, 0, 1); PG_STAGE_B(PG_SB(0, 0), b2, 0); PG_STAGE_B(PG_SB(0, 1), b2, 1); PG_STAGE_A(PG_SA(0, 0), a2, 0, s2);
            PG_WAIT_V(8); PG_WAIT_L(0); PG_BAR; if (!hmc) { PG_MMA(1, 0, At, B0); PG_MMA(1, 1, At, B1); } PG_BAR; PG_SCHED;
            PG_LDB(B0, 1, 0); PG_LDB(B1, 1, 1); PG_SCHED; PG_LDA(At, 1, 0); PG_STAGE_A(PG_SA(0, 1), a2, (last ? hmn : hmc) ? 0 : 1, s2);
            PG_WAIT_V(8); PG_WAIT_L(0); PG_BAR; PG_MMA(0, 0, At, B0); PG_MMA(0, 1, At, B1); PG_BAR; PG_SCHED;
            if (!hmc) PG_LDA(At, 1, 1); PG_STAGE_B(PG_SB(1, 0), b3, 0); PG_STAGE_B(PG_SB(1, 1), b3, 1); PG_STAGE_A(PG_SA(1, 0), a3, 0, s3);
            PG_WAIT_V(8); PG_WAIT_L(0); PG_BAR; if (!hmc) { PG_MMA(1, 0, At, B0); PG_MMA(1, 1, At, B1); } PG_BAR; PG_SCHED;
        }
        if (PG_ALIGN && wr == 0) PG_BAR;
        if constexpr (!Epi::AFTER_DRAIN) { int t2 = threadIdx.x; asm volatile("" : "+v"(t2)); E(acc, cur, wr, wc, t2 & 15, (t2 >> 4) & 3); }
        if (!has_next) break;
#pragma unroll
        for (int a = 0; a < 2; ++a)
#pragma unroll
            for (int b = 0; b < 2; ++b)
#pragma unroll
                for (int m = 0; m < 4; ++m)
#pragma unroll
                    for (int n = 0; n < 2; ++n) acc[a][b][m][n] = (f32x4){0.f, 0.f, 0.f, 0.f};
        cur = nxt; ++ui;
        if (PG_ALIGN && wr == 1) PG_BAR;
    }
    PG_WAIT_V(0);
    if (!PG_ALIGN && wr == 0) PG_BAR;
    PG_BAR;
    if constexpr (Epi::AFTER_DRAIN) { int t2 = threadIdx.x; asm volatile("" : "+v"(t2)); E.fused(acc, cur, wr, wc, t2 & 15, (t2 >> 4) & 3, lds, wid, t2 & 63); }
#undef PG_SA
#undef PG_SB
#undef PG_GLDS
#undef PG_ASEL
#undef PG_APTR
#undef PG_STAGE_A
#undef PG_STAGE_B
#undef PG_LDA
#undef PG_LDB
#undef PG_MMA
#undef PG_WAIT_V
#undef PG_WAIT_L
#undef PG_BAR
#undef PG_SCHED
}
}
using pg::Unit; using pg::Geo;

#define EPI_ROWS _Pragma("unroll") for (int ai = 0; ai < 2; ++ai) _Pragma("unroll") for (int m = 0; m < 4; ++m)
#define EPI_ROW (128 * ai + 64 * wr + 16 * m + fr)
#define EPI_COLS _Pragma("unroll") for (int bj = 0; bj < 2; ++bj)
#define EPI_COL0 (128 * bj + 32 * wc + 8 * fq)
typedef f32x4 acc_t[2][2][4][2];

struct Base { unsigned char* ws; unsigned char* dout; };
#define modx ((float*)(F.ws + WS_MOD))
#define modc (modx + 9216)
#define lgp (modx + 2 * 9216)
#define Ax ((bf16_t*)(F.dout + DO_AX))
#define Ac ((bf16_t*)(F.ws + WS_DC + 512 * 1024))
#define Dx ((bf16_t*)F.dout)
#define Dc ((bf16_t*)(F.ws + WS_DC))
#define Hb ((bf16_t*)(F.ws + WS_H))
#define Hc ((bf16_t*)(F.ws + WS_HC))
#define W13t ((bf16_t*)(F.ws + WS_WB + WB_W13))
#define W2t ((bf16_t*)(F.ws + WS_WB + WB_W2))
#define W13t1 ((bf16_t*)(F.ws + WS_O + WB_W13))
#define W2t1 ((bf16_t*)(F.ws + WS_O + WB_W2))
#define ropeT ((float*)(F.ws + WS_TAB + TB_ROPE))
#define twT ((float*)(F.ws + WS_TAB + TB_TW))
#define FmT ((bf16_t*)(F.ws + WS_TAB + TB_FM))
#define GmT ((bf16_t*)(F.ws + WS_TAB + TB_GM))
#define T256 ((bf16_t*)(F.ws + WS_TAB + TB_T256))
#define Win ((bf16_t*)(F.ws + WS_WIN))
#define Wn ((bf16_t*)(F.ws + WS_WN))
#define Bz ((bf16_t*)(F.ws + WS_OUTW))
#define WoT ((bf16_t*)(F.ws + WS_OUTW + 7 * MiB))
constexpr int BZP = 3136;
#define Qb ((bf16_t*)(F.ws + WS_Q))
#define Knb ((bf16_t*)(F.ws + WS_KN))
#define Ktb_ ((bf16_t*)(F.ws + WS_KT))
#define Pb Ktb_
#define B4 ((bf16_t*)(F.ws + WS_B4))
#define Ob ((bf16_t*)(F.ws + WS_O))
#define S0 ((float*)(F.ws + WS_S0))
#define stats ((float*)(F.ws + WS_STATS))
#define KcT ((bf16_t*)(F.ws + WS_KC))
#define VcT ((bf16_t*)(F.ws + WS_VC))
#define Wt ((bf16_t*)(F.ws + WS_WT))
#define Bt ((bf16_t*)(F.ws + WS_BT))
#define MIXb ((bf16_t*)(F.ws + WS_MIX))
#define GAb ((bf16_t*)(F.ws + WS_GA))
#define GFb ((bf16_t*)(F.ws + WS_GF))
#define Zb (MIXb + 1024)
#define XcSlab ((float*)(F.ws + WS_XCSLAB))

struct EpiSwiglu {
    static constexpr int NHOOK = 0; static constexpr int AFTER_DRAIN = 0; static constexpr int HALFM = 0; int h0, h1;
    Base F;
    __device__ __forceinline__ void hook(acc_t&, const Unit&, int, int, int, int, int) const {}
    __device__ __forceinline__ void operator()(const acc_t& acc, const Unit& u, int wr, int wc, int fr, int fq) const {
        bf16_t* base = u.i0 < 64 ? Hb + (size_t)u.i0 * 256 * DFF : Hc;
        EPI_ROWS { bf16_t* rowp = base + (size_t)EPI_ROW * DFF + u.i1 * 128 + 32 * wc + 8 * fq; f32x4 h[2];
#pragma unroll
            for (int n = 0; n < 2; ++n) h[n] = (acc[ai][0][m][n] * acc[ai][1][m][n]) * vsigmoid(acc[ai][0][m][n]);
            if (u.i0 == 64) st16wt(rowp, pack8(h[0], h[1])); else *(u32x4*)rowp = pack8(h[0], h[1]); if (m & 1) asm volatile("" ::: "memory"); }
        if (u.i0 == 64) { asm volatile("s_waitcnt vmcnt(0)" ::: "memory");
            if (fr == 0 && fq == 0) __hip_atomic_fetch_add((unsigned*)(F.ws + WS_CTL) + 24576, 1u, __ATOMIC_RELAXED, __HIP_MEMORY_SCOPE_AGENT); }
    }
};
struct EpiSwigluH {
    static constexpr int NHOOK = 0; static constexpr int AFTER_DRAIN = 0; static constexpr int HALFM = 1; int h0, h1;
    Base F;
    __device__ __forceinline__ void hook(acc_t&, const Unit&, int, int, int, int, int) const {}
    __device__ __forceinline__ void operator()(const acc_t& acc, const Unit& u, int wr, int wc, int fr, int fq) const {
        bf16_t* base = Hb + ((size_t)u.i0 * 256 + u.i2) * DFF; const int nai = u.i3 ? 1 : 2;
#pragma unroll
        for (int ai = 0; ai < 2; ++ai) { if (ai < nai) {
#pragma unroll
            for (int m = 0; m < 4; ++m) { bf16_t* rowp = base + (size_t)EPI_ROW * DFF + u.i1 * 128 + 32 * wc + 8 * fq; f32x4 h[2];
#pragma unroll
                for (int n = 0; n < 2; ++n) h[n] = (acc[ai][0][m][n] * acc[ai][1][m][n]) * vsigmoid(acc[ai][0][m][n]);
                *(u32x4*)rowp = pack8(h[0], h[1]); if (m & 1) asm volatile("" ::: "memory"); } } }
    }
};
struct SchedFfn2Up {
    Base F; int G, c; static constexpr bool VAR_NT = false;
    __device__ __forceinline__ int nt_of(int) const { return 0; }
    __device__ __forceinline__ bool next(int i, Unit& u) const { const long Lv = (long)i * G + c; if (Lv >= 1280 + 256) return false;
        const int half = Lv >= 1280 ? (int)((Lv - 1280) & 1) : 0, L = Lv >= 1280 ? 1280 + (int)((Lv - 1280) >> 1) : (int)Lv;
        int pm, pn; pg::tile_pm_pn(L, 64, 22, pm, pn);
        u.a0 = (const char*)(Ax + ((size_t)pm * 256 + half * 128) * DM); u.a1 = u.a0; u.b = (const char*)(W13t + (size_t)pn * 256 * DM); u.d = nullptr; u.i0 = pm; u.i1 = pn; u.i2 = half * 128; u.i3 = Lv >= 1280; return true; }
};
struct EpiResid {
    static constexpr int NHOOK = 0; static constexpr int AFTER_DRAIN = 0; static constexpr int HALFM = 0; int h0, h1;
    Base F; int mode;
    __device__ __forceinline__ void hook(acc_t&, const Unit&, int, int, int, int, int) const {}
    __device__ __forceinline__ void operator()(const acc_t& acc, const Unit& u, int wr, int wc, int fr, int fq) const {
        const bool isx = u.i0 < 64; const int has_old = mode != 0; const float scale = mode == 1 ? 1.0f : 0.5f;
        const bf16_t* din = Dx + (size_t)u.i0 * 256 * DM; bf16_t* dout = isx ? (mode == 2 ? Ob : Dx) + (size_t)u.i0 * 256 * DM : Dc;
        const float* coef = (isx ? modx : modc) + (mode == 0 ? 2 : (mode == 1 ? 5 : 8)) * DM + u.i1 * 256;
        EPI_COLS { const int c = EPI_COL0; const f32x4 c0 = *(const f32x4*)(coef + c) * scale, c1 = *(const f32x4*)(coef + c + 4) * scale;
#pragma unroll
            for (int ai = 0; ai < 2; ++ai)
#pragma unroll
                for (int m = 0; m < 4; ++m) { const size_t off = (size_t)EPI_ROW * DM + u.i1 * 256 + c;
                    f32x4 v0 = acc[ai][bj][m][0] * c0, v1 = acc[ai][bj][m][1] * c1;
                    if (has_old) { f32x4 o0, o1; unpack8(*(const u32x4*)(din + off), o0, o1); v0 += o0; v1 += o1; }
                    *(u32x4*)(dout + off) = pack8(v0, v1); if (m & 1) asm volatile("" ::: "memory"); } }
    }
};

struct EpiFuse {
    static constexpr int NHOOK = 0; static constexpr int AFTER_DRAIN = 1; static constexpr int HALFM = 0; int h0, h1; Base F; int mode; const float* x; const float* nw;
    __device__ __forceinline__ void hook(acc_t&, const Unit&, int, int, int, int, int) const {}
    __device__ __forceinline__ void operator()(const acc_t&, const Unit&, int, int, int, int) const {}
    __device__ __forceinline__ void fused(acc_t& acc, const Unit& u, int wr, int wc, int fr, int fq, LAS unsigned char* lds, int wid, int lane) const {
        const int pm = u.i0, pn = u.i1; const float scale = mode == 1 ? 1.0f : 0.5f;
        const float* coef = modx + (mode == 0 ? 2 : (mode == 1 ? 5 : 8)) * DM + pn * 256;
        const bf16_t* din = (mode == 2 ? Ob : Dx) + (size_t)pm * 256 * DM + pn * 256; bf16_t* dout = (mode == 1 ? Ob : Dx) + (size_t)pm * 256 * DM + pn * 256;
        const float* xt = x + (size_t)pm * 256 * DM + pn * 256;
        LAS float* P = (LAS float*)lds; LAS float* S = (LAS float*)(lds + 4096);
        f32x4 cf[2][2];
#pragma unroll
        for (int bj = 0; bj < 2; ++bj) { cf[bj][0] = *(const f32x4*)(coef + EPI_COL0) * scale; cf[bj][1] = *(const f32x4*)(coef + EPI_COL0 + 4) * scale; }
#pragma unroll
        for (int aim = 0; aim < 4; ++aim) { const int ai = aim >> 1; f32x4 xv[4][2][2]; u32x4 ov[4][2];
#pragma unroll
            for (int m = 2 * (aim & 1); m < 2 * (aim & 1) + 2; ++m) EPI_COLS { const size_t off = (size_t)EPI_ROW * DM + EPI_COL0; if (mode == 0) { xv[m][bj][0] = __builtin_nontemporal_load((const f32x4*)(xt + off)); xv[m][bj][1] = __builtin_nontemporal_load((const f32x4*)(xt + off + 4)); } else ov[m][bj] = *(const u32x4*)(din + off); }
#pragma unroll
            for (int m = 2 * (aim & 1); m < 2 * (aim & 1) + 2; ++m) { const int row = EPI_ROW; float ss = 0.f;
                EPI_COLS { const size_t off = (size_t)row * DM + EPI_COL0; f32x4 d0 = acc[ai][bj][m][0] * cf[bj][0], d1 = acc[ai][bj][m][1] * cf[bj][1];
                    f32x4 v0, v1;
                    if (mode != 0) { f32x4 o0, o1; unpack8(ov[m][bj], o0, o1); v0 = o0 + d0; v1 = o1 + d1; } else { v0 = xv[m][bj][0] + d0; v1 = xv[m][bj][1] + d1; }
                    if (mode != 2) *(u32x4*)(dout + off) = pack8(v0, v1);
                    acc[ai][bj][m][0] = v0; acc[ai][bj][m][1] = v1;
                    ss += (v0[0] * v0[0] + v0[1] * v0[1]) + (v0[2] * v0[2] + v0[3] * v0[3]) + (v1[0] * v1[0] + v1[1] * v1[1]) + (v1[2] * v1[2] + v1[3] * v1[3]); }
                ss += __shfl_xor(ss, 16); ss += __shfl_xor(ss, 32);
                if (fq == 0) P[row * 4 + wc] = ss; }
            asm volatile("" ::: "memory"); }
        asm volatile("s_waitcnt lgkmcnt(0)" ::: "memory"); __builtin_amdgcn_s_barrier(); asm volatile("" ::: "memory");
        float* xb = (float*)(F.ws + WS_XB) + (size_t)mode * 64 * 256 * 4; unsigned* cnt = (unsigned*)(F.ws + WS_CTL) + 8192 + mode * 4096 + 64 * pm;
        const int prow = wid * 32 + (lane & 31);
        if (lane < 32) { const float t = (P[prow * 4 + 0] + P[prow * 4 + 1]) + (P[prow * 4 + 2] + P[prow * 4 + 3]);
            __hip_atomic_store(xb + ((size_t)(pm * 256 + prow) * 4 + pn), t, __ATOMIC_RELAXED, __HIP_MEMORY_SCOPE_AGENT); }
        asm volatile("s_waitcnt vmcnt(0)" ::: "memory");
        if (lane == 0) __hip_atomic_fetch_add(cnt, 1u, __ATOMIC_RELAXED, __HIP_MEMORY_SCOPE_AGENT);
        if (wid == 0) { unsigned sp = 0;
            while ((unsigned)__builtin_amdgcn_readfirstlane(__hip_atomic_load(cnt, __ATOMIC_RELAXED, __HIP_MEMORY_SCOPE_AGENT)) < 32u) { __builtin_amdgcn_s_sleep(2); if (++sp > (1u << 22)) break; }
            __builtin_amdgcn_fence(__ATOMIC_ACQUIRE, "agent"); }
        asm volatile("s_waitcnt vmcnt(0) lgkmcnt(0)" ::: "memory"); __builtin_amdgcn_s_barrier(); asm volatile("" ::: "memory");
        if (lane < 32) { const float* sl = xb + (size_t)(pm * 256 + prow) * 4; float t = 0.f;
#pragma unroll
            for (int q = 0; q < 4; ++q) t += __hip_atomic_load(sl + q, __ATOMIC_RELAXED, __HIP_MEMORY_SCOPE_AGENT);
            S[prow] = 1.0f / sqrtf(t * (1.0f / DM) + EPS); }
        asm volatile("s_waitcnt lgkmcnt(0)" ::: "memory"); __builtin_amdgcn_s_barrier(); asm volatile("" ::: "memory");
        const float* md = modx + (mode == 0 ? 3 : 6) * DM + pn * 256; const float* nwp = nw + pn * 256;
        f32x4 wv[2][2], shv[2][2];
#pragma unroll
        for (int bj = 0; bj < 2; ++bj)
#pragma unroll
            for (int n = 0; n < 2; ++n) { const int c = EPI_COL0 + 4 * n; const f32x4 w = *(const f32x4*)(nwp + c);
                if (mode == 2) { wv[bj][n] = w; shv[bj][n] = (f32x4){0.f, 0.f, 0.f, 0.f}; } else { wv[bj][n] = w * (*(const f32x4*)(md + DM + c) + 1.0f); shv[bj][n] = *(const f32x4*)(md + c); } }
        EPI_ROWS { const int row = EPI_ROW; const float rinv = S[row];
            EPI_COLS { const size_t off = (size_t)row * DM + EPI_COL0;
                const f32x4 y0 = (acc[ai][bj][m][0] * rinv) * wv[bj][0] + shv[bj][0], y1 = (acc[ai][bj][m][1] * rinv) * wv[bj][1] + shv[bj][1];
                if (mode == 2) { float* o = (float*)F.dout + (size_t)pm * 256 * DM + pn * 256 + off; __builtin_nontemporal_store(y0, (f32x4*)o); __builtin_nontemporal_store(y1, (f32x4*)(o + 4)); }
                else *(u32x4*)(Ax + (size_t)pm * 256 * DM + pn * 256 + off) = pack8(y0, y1); } }
        asm volatile("s_waitcnt lgkmcnt(0)" ::: "memory"); __builtin_amdgcn_s_barrier(); asm volatile("" ::: "memory");
    }
};
struct JobFfn1 {
    Base F; int nM, first;
    __device__ __forceinline__ void fill(int L, Unit& u) const { int pm, pn; if (first) { if (L < 22) { pm = 64; pn = L; } else pg::tile_pm_pn(L - 22, 64, 22, pm, pn); } else pg::tile_pm_pn(L, nM, 22, pm, pn);
        u.a0 = (const char*)(pm < 64 ? Ax + (size_t)pm * 256 * DM : Ac); u.a1 = u.a0; u.b = (const char*)((first ? W13t1 : W13t) + (size_t)pn * 256 * DM); u.d = nullptr; u.i0 = pm; u.i1 = pn; u.i2 = 0; u.i3 = 0; }
};
struct JobFfn2 {
    Base F; int nM, first;
    __device__ __forceinline__ void fill(int L, Unit& u) const { int pm, pn; pg::tile_pm_pn(L, nM, 4, pm, pn);
        u.a0 = (const char*)(pm < 64 ? Hb + (size_t)pm * 256 * DFF : Hc); u.a1 = u.a0; u.b = (const char*)((first ? W2t1 : W2t) + (size_t)pn * 256 * DFF); u.d = nullptr; u.i0 = pm; u.i1 = pn; u.i2 = 0; u.i3 = 0; }
};

struct EpiStore {
    static constexpr int NHOOK = 0; static constexpr int AFTER_DRAIN = 0; static constexpr int HALFM = 0; int h0, h1; int ldd;
    __device__ __forceinline__ void hook(acc_t&, const Unit&, int, int, int, int, int) const {}
    __device__ __forceinline__ void operator()(const acc_t& acc, const Unit& u, int wr, int wc, int fr, int fq) const {
        bf16_t* d = (bf16_t*)u.d;
        EPI_ROWS { EPI_COLS { *(u32x4*)(d + (size_t)EPI_ROW * ldd + EPI_COL0) = pack8(acc[ai][bj][m][0], acc[ai][bj][m][1]); }  asm volatile("" ::: "memory"); }
    }
};
struct EpiQK {
    static constexpr int NHOOK = 0; static constexpr int AFTER_DRAIN = 1; static constexpr int HALFM = 0; int h0, h1;
    Base F; int pair;
    __device__ __forceinline__ void hook(acc_t&, const Unit&, int, int, int, int, int) const {}
    __device__ __forceinline__ void operator()(const acc_t&, const Unit&, int, int, int, int) const {}
    __device__ __forceinline__ void fused(acc_t& acc, const Unit& u, int wr, int wc, int fr, int fq, LAS unsigned char* lds, int wid, int lane) const {
        const int pm = u.i0, pn = u.i1, hl = pn & 1, h = 2 * pair + hl; const bool isk = pn >= 2; const float lgf = lgp[h], lgb = lgp[4 + h]; const float* rope = ropeT;
        constexpr int PITCH = 528;
        const int tid = wid * 64 + lane, p8 = tid & 31;
        float zf[8], zb[8];
#pragma unroll
        for (int e = 0; e < 8; ++e) { const int jl = (pm * 256 + p8 * 8 + e) & (LS - 1); zf[e] = __expf(lgf * (float)(LS - 1 - jl)); zb[e] = __expf(lgb * (float)jl); }
#pragma unroll
        for (int bj = 0; bj < 2; ++bj) {
            f32x4 tb[2][4][2];
            EPI_ROWS { const int pos = pm * 256 + EPI_ROW, prow = pos >> 6, pcol = pos & 63, i0 = EPI_COL0 >> 1, p = i0 < 64 ? prow : pcol, f0 = i0 & 63;
                tb[ai][m][0] = *(const f32x4*)(rope + (size_t)(p * 64 + f0) * 2); tb[ai][m][1] = *(const f32x4*)(rope + (size_t)(p * 64 + f0) * 2 + 4); }
            EPI_ROWS { const int row = EPI_ROW, pos = pm * 256 + row;
                const int d0 = EPI_COL0;
                const f32x4 t0 = tb[ai][m][0], t1 = tb[ai][m][1];
                f32x4 a = acc[ai][bj][m][0], b = acc[ai][bj][m][1];
                if (!isk) { a *= 0.0625f; b *= 0.0625f; }
                const f32x4 ra = {a[0] * t0[0] - a[1] * t0[1], a[0] * t0[1] + a[1] * t0[0], a[2] * t0[2] - a[3] * t0[3], a[2] * t0[3] + a[3] * t0[2]};
                const f32x4 rb = {b[0] * t1[0] - b[1] * t1[1], b[0] * t1[1] + b[1] * t1[0], b[2] * t1[2] - b[3] * t1[3], b[2] * t1[3] + b[3] * t1[2]};
                const u32x4 pk = pack8(ra, rb);
                if (!isk) *(u32x4*)(Qb + (size_t)pos * 512 + hl * 256 + d0) = pk;
                else { *(u32x4*)(Knb + (size_t)pos * 512 + hl * 256 + d0) = pk;
                    LAS unsigned short* tp = (LAS unsigned short*)(lds + (32 * wc + 8 * fq) * PITCH + row * 2);
                    tp[0 * PITCH / 2] = (unsigned short)pk.x; tp[1 * PITCH / 2] = (unsigned short)(pk.x >> 16); tp[2 * PITCH / 2] = (unsigned short)pk.y; tp[3 * PITCH / 2] = (unsigned short)(pk.y >> 16);
                    tp[4 * PITCH / 2] = (unsigned short)pk.z; tp[5 * PITCH / 2] = (unsigned short)(pk.z >> 16); tp[6 * PITCH / 2] = (unsigned short)pk.w; tp[7 * PITCH / 2] = (unsigned short)(pk.w >> 16); }
                if (m & 1) asm volatile("" ::: "memory"); }
            if (isk) {
                asm volatile("s_waitcnt lgkmcnt(0)" ::: "memory"); __builtin_amdgcn_s_barrier(); asm volatile("" ::: "memory");
#pragma unroll
                for (int k = 0; k < 8; ++k) { const int dl = (tid >> 5) + 16 * k;
                    f32x4 v0, v1; unpack8(*(const LAS u32x4*)(lds + dl * PITCH + p8 * 16), v0, v1);
                    const f32x4 f0v = {v0[0] * zf[0], v0[1] * zf[1], v0[2] * zf[2], v0[3] * zf[3]}, f1v = {v1[0] * zf[4], v1[1] * zf[5], v1[2] * zf[6], v1[3] * zf[7]};
                    const f32x4 b0v = {v0[0] * zb[0], v0[1] * zb[1], v0[2] * zb[2], v0[3] * zb[3]}, b1v = {v1[0] * zb[4], v1[1] * zb[5], v1[2] * zb[6], v1[3] * zb[7]};
                    const size_t o = ((size_t)((hl * NSEG + (pm >> 1)) * 256 + bj * 128 + dl)) * LS + (pm & 1) * 256 + p8 * 8;
                    *(u32x4*)(Ktb_ + o) = pack8(f0v, f1v); *(u32x4*)(Ktb_ + (size_t)512 * SEQ + o) = pack8(b0v, b1v); }
                asm volatile("s_waitcnt lgkmcnt(0)" ::: "memory"); __builtin_amdgcn_s_barrier(); asm volatile("" ::: "memory");
            }
        }
    }
};
struct EpiVT {
    static constexpr int NHOOK = 0; static constexpr int AFTER_DRAIN = 0; static constexpr int HALFM = 0; int h0, h1; Base F;
    __device__ __forceinline__ void hook(acc_t&, const Unit&, int, int, int, int, int) const {}
    __device__ __forceinline__ void operator()(const acc_t& acc, const Unit& u, int wr, int wc, int fr, int fq) const {
        const int hl = u.i0 >> 1, vt = u.i0 & 1, pn = u.i1;
        EPI_ROWS { const int v = vt * 256 + EPI_ROW;
            EPI_COLS { const int pos = pn * 256 + EPI_COL0, seg = pos >> 9, jl = pos & (LS - 1);
                *(u32x4*)(B4 + ((size_t)((hl * NSEG + seg) * 512 + v)) * 1024 + 512 + jl) = pack8(acc[ai][bj][m][0], acc[ai][bj][m][1]); }  asm volatile("" ::: "memory"); }
    }
};
struct EpiKc {
    static constexpr int NHOOK = 0; static constexpr int AFTER_DRAIN = 0; static constexpr int HALFM = 0; int h0, h1; Base F;
    __device__ __forceinline__ void hook(acc_t&, const Unit&, int, int, int, int, int) const {}
    __device__ __forceinline__ void operator()(const acc_t& acc, const Unit& u, int wr, int wc, int fr, int fq) const {
        const int h = u.i1; const float lgf = lgp[h], lgb = lgp[4 + h]; bf16_t* Kcf = KcT; bf16_t* Kcb = KcT + (size_t)1024 * CTX;
        float zf[2][8], zb[2][8];
        EPI_COLS {
#pragma unroll
            for (int e = 0; e < 8; ++e) { const int j = EPI_COL0 + e; zf[bj][e] = __expf(lgf * (float)(CTX - 1 - j)); zb[bj][e] = __expf(lgb * (float)j); } }
        EPI_ROWS { const int d = EPI_ROW;
            EPI_COLS { const size_t o = (size_t)(h * 256 + d) * CTX + EPI_COL0; f32x4 f[2], b[2];
#pragma unroll
                for (int e = 0; e < 8; ++e) { const float v = acc[ai][bj][m][e >> 2][e & 3]; f[e >> 2][e & 3] = v * zf[bj][e]; b[e >> 2][e & 3] = v * zb[bj][e]; }
                *(u32x4*)(Kcf + o) = pack8(f[0], f[1]); *(u32x4*)(Kcb + o) = pack8(b[0], b[1]); }  asm volatile("" ::: "memory"); }
    }
};
struct EpiVc {
    static constexpr int NHOOK = 0; static constexpr int AFTER_DRAIN = 0; static constexpr int HALFM = 0; int h0, h1; Base F;
    __device__ __forceinline__ void hook(acc_t&, const Unit&, int, int, int, int, int) const {}
    __device__ __forceinline__ void operator()(const acc_t& acc, const Unit& u, int wr, int wc, int fr, int fq) const {
        const int h = u.i0 >> 1, vt = u.i0 & 1;
        EPI_ROWS { const int v = vt * 256 + EPI_ROW;
            EPI_COLS { *(u32x4*)(VcT + (size_t)(h * 512 + v) * CTX + EPI_COL0) = pack8(acc[ai][bj][m][0], acc[ai][bj][m][1]); }  asm volatile("" ::: "memory"); }
    }
};
struct EpiS0 {
    static constexpr int NHOOK = 0; static constexpr int AFTER_DRAIN = 0; static constexpr int HALFM = 0; int h0, h1; Base F;
    __device__ __forceinline__ void hook(acc_t&, const Unit&, int, int, int, int, int) const {}
    __device__ __forceinline__ void operator()(const acc_t& acc, const Unit& u, int wr, int wc, int fr, int fq) const {
        EPI_ROWS { float* rowp = S0 + ((size_t)((u.i0 * 2 + u.i1) * 512 + u.i3 * 256 + EPI_ROW)) * 256;
            EPI_COLS { *(f32x4*)(rowp + EPI_COL0) = acc[ai][bj][m][0]; *(f32x4*)(rowp + EPI_COL0 + 4) = acc[ai][bj][m][1]; }  asm volatile("" ::: "memory"); }
    }
};
struct EpiU {
    static constexpr int NHOOK = 0; static constexpr int AFTER_DRAIN = 0; static constexpr int HALFM = 0; int h0, h1; Base F;
    __device__ __forceinline__ void hook(acc_t&, const Unit&, int, int, int, int, int) const {}
    __device__ __forceinline__ void operator()(const acc_t& acc, const Unit& u, int wr, int wc, int fr, int fq) const {
        EPI_ROWS { bf16_t* rowp = B4 + ((size_t)((u.i0 * NSEG + u.i2) * 512 + u.i3 * 256 + EPI_ROW)) * 1024 + u.i1 * 256;
            EPI_COLS { *(u32x4*)(rowp + EPI_COL0) = pack8(acc[ai][bj][m][0], acc[ai][bj][m][1]); }  asm volatile("" ::: "memory"); }
    }
};
struct EpiP {
    static constexpr int NHOOK = 0; static constexpr int AFTER_DRAIN = 0; static constexpr int HALFM = 0; int h0, h1; Base F; int pair;
    __device__ __forceinline__ void hook(acc_t&, const Unit&, int, int, int, int, int) const {}
    __device__ __forceinline__ void operator()(const acc_t& acc, const Unit& u, int wr, int wc, int fr, int fq) const {
        const int hl = u.i0, seg = u.i1, it = u.i2, jt = u.i3, h = 2 * pair + hl; const float l2f = lgp[h] * 1.44269504f, l2b = lgp[4 + h] * 1.44269504f;
        float cf[2][8], cb[2][8];
        EPI_COLS {
#pragma unroll
            for (int e = 0; e < 8; ++e) { const float c = (float)(EPI_COL0 + e); cf[bj][e] = __builtin_amdgcn_exp2f(-c * l2f); cb[bj][e] = __builtin_amdgcn_exp2f(c * l2b); } }
        EPI_ROWS { const int il = it * 256 + EPI_ROW; bf16_t* rowp = Pb + (size_t)(seg * LS + il) * 1024 + hl * 512 + jt * 256;
            const float ri = (float)(il - jt * 256), rf = __builtin_amdgcn_exp2f(ri * l2f), rb = __builtin_amdgcn_exp2f(-ri * l2b);
            EPI_COLS { const int j0 = jt * 256 + EPI_COL0; f32x4 v[2];
#pragma unroll
                for (int e = 0; e < 8; ++e) { const int dl = il - (j0 + e); const float wf = rf * cf[bj][e], wb = rb * cb[bj][e];
                    const float w = it > jt ? wf : (it < jt ? wb : (dl > 0 ? wf : (dl < 0 ? wb : 2.0f)));
                    v[e >> 2][e & 3] = acc[ai][bj][m][e >> 2][e & 3] * w; }
                *(u32x4*)(rowp + EPI_COL0) = pack8(v[0], v[1]); }  asm volatile("" ::: "memory"); }
    }
};
struct EpiO {
    static constexpr int NHOOK = 2; static constexpr int AFTER_DRAIN = 0; static constexpr int HALFM = 0; int h0, h1; Base F; int pair;
    __device__ __forceinline__ void hook(acc_t& acc, const Unit& u, int k, int wr, int wc, int fr, int fq) const {
        const int h = 2 * pair + u.i0; const float lgf = lgp[h], lgb = lgp[4 + h];
        EPI_ROWS { const int il = u.i2 * 256 + EPI_ROW; const float eb = lgb * (float)(LS - il);
            const float f = k == 0 ? __expf(lgf * (float)(il + 1) - eb) : __expf(eb);
#pragma unroll
            for (int bj = 0; bj < 2; ++bj) { acc[ai][bj][m][0] *= f; acc[ai][bj][m][1] *= f; }  asm volatile("" ::: "memory"); }
    }
    __device__ __forceinline__ void operator()(const acc_t& acc, const Unit& u, int wr, int wc, int fr, int fq) const {
        const int h = 2 * pair + u.i0;
        float* gst = (float*)(F.ws + (pair ? WS_KC : WS_HC));
        EPI_ROWS { const int pos = u.i1 * LS + u.i2 * 256 + EPI_ROW; bf16_t* rowp = Ob + (size_t)pos * 2048 + h * 512 + u.i3 * 256;
            float s = 0.f, q = 0.f;
            EPI_COLS { const f32x4 a = acc[ai][bj][m][0], b = acc[ai][bj][m][1]; *(u32x4*)(rowp + EPI_COL0) = pack8(a, b);
                s += ((a[0] + a[1]) + (a[2] + a[3])) + ((b[0] + b[1]) + (b[2] + b[3]));
                q += ((a[0] * a[0] + a[1] * a[1]) + (a[2] * a[2] + a[3] * a[3])) + ((b[0] * b[0] + b[1] * b[1]) + (b[2] * b[2] + b[3] * b[3])); }
            s += __shfl_xor(s, 16); q += __shfl_xor(q, 16); s += __shfl_xor(s, 32); q += __shfl_xor(q, 32);
            if (fq == 0) *(f32x2*)(gst + ((size_t)(pos * 2 + u.i0) * 8 + u.i3 * 4 + wc) * 2) = (f32x2){s, q};
            asm volatile("" ::: "memory"); }
    }
};
struct EpiG {
    static constexpr int NHOOK = 0; static constexpr int AFTER_DRAIN = 0; static constexpr int HALFM = 0; int h0, h1; Base F; const float* gnw; int rep; LAS unsigned char* stl;
    __device__ __forceinline__ void hook(acc_t&, const Unit&, int, int, int, int, int) const {}
    __device__ __forceinline__ void operator()(const acc_t& acc, const Unit& u, int wr, int wc, int fr, int fq) const {
        const int pm = u.i0, pn = u.i1, h = pn >> 1; u32x4 ov[1][4][2]; f32x2 st[1][4]; f32x4 gw[2][2];
#pragma unroll
        for (int bj = 0; bj < 2; ++bj) { gw[bj][0] = *(const f32x4*)(gnw + pn * 256 + EPI_COL0); gw[bj][1] = *(const f32x4*)(gnw + pn * 256 + EPI_COL0 + 4); }
#pragma unroll
        for (int ai = 0; ai < 2; ++ai) {
#pragma unroll
        for (int m = 0; m < 4; ++m) { const int pos = pm * 256 + EPI_ROW; st[0][m] = *(const LAS f32x2*)(stl + EPI_ROW * 8);
            EPI_COLS { ov[0][m][bj] = *(const u32x4*)(Ob + (size_t)pos * 2048 + pn * 256 + EPI_COL0); } }
#pragma unroll
        for (int m = 0; m < 4; ++m) { const int pos = pm * 256 + EPI_ROW; const f32x2 s2 = st[0][m];
            EPI_COLS { bf16_t* p = Ob + (size_t)pos * 2048 + pn * 256 + EPI_COL0; f32x4 o0, o1; unpack8(ov[0][m][bj], o0, o1);
                const f32x4 g0 = acc[ai][bj][m][0], g1 = acc[ai][bj][m][1];
                const f32x4 r0 = (g0 * vsigmoid(g0)) * (((o0 - s2.x) * s2.y) * gw[bj][0]), r1 = (g1 * vsigmoid(g1)) * (((o1 - s2.x) * s2.y) * gw[bj][1]);
                *(u32x4*)p = rep == 0 ? pack8(r0, r1) : ov[0][m][bj]; } }
        asm volatile("" ::: "memory"); }
    }
};
struct EpiF {
    static constexpr int NHOOK = 0; static constexpr int AFTER_DRAIN = 0; static constexpr int HALFM = 0; int h0, h1; Base F;
    __device__ __forceinline__ void hook(acc_t&, const Unit&, int, int, int, int, int) const {}
    __device__ __forceinline__ void operator()(const acc_t& acc, const Unit& u, int wr, int wc, int fr, int fq) const {
        EPI_ROWS { const int mrow = u.i0 * 256 + EPI_ROW, ri = mrow >> 9, ch = mrow & 511;
            EPI_COLS { const int c0 = EPI_COL0, l2 = 2 * u.i1 + (c0 >> 7), l1 = c0 & 127;
                *(u32x4*)(Wt + (size_t)(ch * 128 + l2) * 256 + ri * 128 + l1) = pack8(acc[ai][bj][m][0], acc[ai][bj][m][1]); }  asm volatile("" ::: "memory"); }
    }
};
struct EpiF1 {
    static constexpr int NHOOK = 0; static constexpr int AFTER_DRAIN = 0; static constexpr int HALFM = 0; int h0, h1; Base F;
    __device__ __forceinline__ void hook(acc_t&, const Unit&, int, int, int, int, int) const {}
    __device__ __forceinline__ void operator()(const acc_t& acc, const Unit& u, int wr, int wc, int fr, int fq) const {
        EPI_ROWS { const int r = EPI_ROW, k1 = r >> 1, ri = r & 1; const float sg = ri ? -1.0f : 1.0f;
            EPI_COLS { const int n = u.i1 * 256 + EPI_COL0, ch = n >> 7, l2 = n & 127; f32x4 v[2];
#pragma unroll
                for (int e = 0; e < 8; ++e) { const float rev = (float)((k1 * (l2 + e)) & 16383) * (1.0f / 16384.0f);
                    const float cs = __builtin_amdgcn_cosf(rev), sn = __builtin_amdgcn_sinf(rev); const float mine = acc[ai][bj][m][e >> 2][e & 3], other = __shfl_xor(mine, 1);
                    v[e >> 2][e & 3] = mine * cs + sg * other * sn; }
                *(u32x4*)(Bt + (size_t)(k1 * 512 + ch) * 256 + ri * 128 + l2) = pack8(v[0], v[1]); }  asm volatile("" ::: "memory"); }
    }
};
struct EpiF2 {
    static constexpr int NHOOK = 0; static constexpr int AFTER_DRAIN = 0; static constexpr int HALFM = 0; int h0, h1; Base F;
    __device__ __forceinline__ void hook(acc_t&, const Unit&, int, int, int, int, int) const {}
    __device__ __forceinline__ void operator()(const acc_t& acc, const Unit& u, int wr, int wc, int fr, int fq) const {
        const int k1 = u.i1 >> 1, ch0 = (u.i1 & 1) * 256; float* side = (float*)(F.ws + WS_STATS);
        EPI_ROWS { const int k2 = 64 * wr + 16 * m + fr, k = k1 + 128 * k2, kr = (SEQ - k) & (SEQ - 1);
            EPI_COLS { const int ch = ch0 + EPI_COL0, g = ch >> 7, j = ch & 127;
                if (ai == 0) { const u32x4 pk = pack8(acc[0][bj][m][0], acc[0][bj][m][1]);
                    *(u32x4*)(MIXb + (size_t)k * 1024 + g * 256 + j) = pk; *(u32x4*)(MIXb + (size_t)kr * 1024 + g * 256 + 128 + j) = pk;
                    if (j == 0) side[(size_t)(k * 4 + g) * 2] = acc[0][bj][m][0][0]; }
                else if (j == 0) side[(size_t)(k * 4 + g) * 2 + 1] = acc[1][bj][m][0][0]; } }
    }
};
struct EpiGate {
    static constexpr int NHOOK = 0; static constexpr int AFTER_DRAIN = 0; static constexpr int HALFM = 0; int h0, h1; Base F;
    __device__ __forceinline__ void hook(acc_t&, const Unit&, int, int, int, int, int) const {}
    __device__ __forceinline__ void operator()(const acc_t& acc, const Unit& u, int wr, int wc, int fr, int fq) const {
        const bool isf = (u.i1 >> 2) != 0; bf16_t* dst = isf ? GFb : GAb; const int cb = (u.i1 & 3) * 256;
#pragma unroll
        for (int ai = 0; ai < 2; ++ai) { u32x4 av[4][2];
            if (isf) {
#pragma unroll
                for (int m = 0; m < 4; ++m) EPI_COLS { av[m][bj] = *(const u32x4*)(GAb + (size_t)(u.i0 * 256 + EPI_ROW) * DM + cb + EPI_COL0); } }
#pragma unroll
            for (int m = 0; m < 4; ++m) { bf16_t* rowp = dst + (size_t)(u.i0 * 256 + EPI_ROW) * DM + cb;
                EPI_COLS { f32x4 s0 = vsigmoid(acc[ai][bj][m][0]), s1 = vsigmoid(acc[ai][bj][m][1]);
                    if (isf) { f32x4 a0, a1; unpack8(av[m][bj], a0, a1);
#pragma unroll
                        for (int e = 0; e < 4; ++e) { s0[e] *= __builtin_amdgcn_rcpf(fmaxf(a0[e], 1e-30f)); s1[e] *= __builtin_amdgcn_rcpf(fmaxf(a1[e], 1e-30f)); } }
                    *(u32x4*)(rowp + EPI_COL0) = pack8(s0, s1); } }
            asm volatile("" ::: "memory"); }
    }
};
struct EpiZ {
    static constexpr int NHOOK = 1; static constexpr int AFTER_DRAIN = 0; static constexpr int HALFM = 0; int h0, h1; Base F;
    __device__ __forceinline__ void hook(acc_t& acc, const Unit& u, int, int wr, int wc, int fr, int fq) const {
        EPI_ROWS { const size_t ro = (size_t)(u.i0 * 256 + EPI_ROW) * DM + u.i1 * 256;
            EPI_COLS { f32x4 a0, a1, f0, f1; unpack8(*(const u32x4*)(GAb + ro + EPI_COL0), a0, a1); unpack8(*(const u32x4*)(GFb + ro + EPI_COL0), f0, f1);
#pragma unroll
                for (int e = 0; e < 4; ++e) { acc[ai][bj][m][0][e] *= DBG_NOFOUR ? 0.f : f0[e] * __builtin_amdgcn_rcpf(fmaxf(a0[e], 1e-30f)); acc[ai][bj][m][1][e] *= DBG_NOFOUR ? 0.f : f1[e] * __builtin_amdgcn_rcpf(fmaxf(a1[e], 1e-30f)); } }  asm volatile("" ::: "memory"); }
    }
    __device__ __forceinline__ void operator()(const acc_t& acc, const Unit& u, int wr, int wc, int fr, int fq) const {
        EPI_ROWS { const size_t ro = (size_t)(u.i0 * 256 + EPI_ROW) * DM + u.i1 * 256;
            EPI_COLS { f32x4 a0, a1; unpack8(*(const u32x4*)(GAb + ro + EPI_COL0), a0, a1); f32x4 v0, v1;
#pragma unroll
                for (int e = 0; e < 4; ++e) { v0[e] = acc[ai][bj][m][0][e] * fmaxf(a0[e], 1e-30f); v1[e] = acc[ai][bj][m][1][e] * fmaxf(a1[e], 1e-30f); }
                *(u32x4*)(Zb + ro + EPI_COL0) = pack8(v0, v1); }  asm volatile("" ::: "memory"); }
    }
};

struct EpiZ3 {
    static constexpr int NHOOK = 1; static constexpr int AFTER_DRAIN = 0; static constexpr int HALFM = 0; int h0, h1; Base F;
    __device__ __forceinline__ void hook(acc_t& acc, const Unit& u, int, int wr, int wc, int fr, int fq) const {
#pragma unroll
        for (int ai = 0; ai < 2; ++ai) { u32x4 rv[4][2];
#pragma unroll
            for (int m = 0; m < 4; ++m) EPI_COLS { rv[m][bj] = *(const u32x4*)(GFb + (size_t)(u.i0 * 256 + EPI_ROW) * DM + u.i1 * 256 + EPI_COL0); }
#pragma unroll
            for (int m = 0; m < 4; ++m) EPI_COLS { f32x4 r0, r1; unpack8(rv[m][bj], r0, r1); acc[ai][bj][m][0] *= r0; acc[ai][bj][m][1] *= r1; }
            asm volatile("" ::: "memory"); }
    }
    __device__ __forceinline__ void operator()(const acc_t& acc, const Unit& u, int wr, int wc, int fr, int fq) const {
#pragma unroll
        for (int ai = 0; ai < 2; ++ai) { u32x4 gv[4][2];
#pragma unroll
            for (int m = 0; m < 4; ++m) EPI_COLS { gv[m][bj] = *(const u32x4*)(GAb + (size_t)(u.i0 * 256 + EPI_ROW) * DM + u.i1 * 256 + EPI_COL0); }
#pragma unroll
            for (int m = 0; m < 4; ++m) EPI_COLS { f32x4 g0, g1; unpack8(gv[m][bj], g0, g1);
                *(u32x4*)(GFb + (size_t)(u.i0 * 256 + EPI_ROW) * DM + u.i1 * 256 + EPI_COL0) = pack8(acc[ai][bj][m][0] * g0, acc[ai][bj][m][1] * g1); }
            asm volatile("" ::: "memory"); }
    }
};
struct JobZ3 {
    Base F;
    __device__ __forceinline__ void fill(int L, Unit& u) const { int pm, pn; pg::tile_pm_pn(L, 64, 4, pm, pn);
        u.a0 = (const char*)(MIXb + (size_t)pm * 256 * 1024); u.a1 = (const char*)(Ob + (size_t)pm * 256 * 2048); u.b = (const char*)(Bz + (size_t)pn * 256 * BZP); u.d = nullptr; u.i0 = pm; u.i1 = pn; u.i2 = 0; u.i3 = 0; }
};
struct EpiSlab {
    static constexpr int NHOOK = 0; static constexpr int AFTER_DRAIN = 0; static constexpr int HALFM = 0; int h0, h1; Base F;
    __device__ __forceinline__ void hook(acc_t&, const Unit&, int, int, int, int, int) const {}
    __device__ __forceinline__ void operator()(const acc_t& acc, const Unit& u, int wr, int wc, int fr, int fq) const {
        float* dst = XcSlab + (size_t)u.i2 * CTX * DM + u.i1 * 256;
        EPI_ROWS { float* rowp = dst + (size_t)EPI_ROW * DM;
            EPI_COLS { *(f32x4*)(rowp + EPI_COL0) = acc[ai][bj][m][0]; *(f32x4*)(rowp + EPI_COL0 + 4) = acc[ai][bj][m][1]; } }
    }
};
struct JobCtxG2 {
    Base F;
    __device__ __forceinline__ void fill(int L, Unit& u) const { const int pn = L & 3, kc = L >> 2;
        u.a0 = (const char*)(Hc + kc * 256); u.a1 = u.a0; u.b = (const char*)(W2t1 + (size_t)pn * 256 * DFF + kc * 256); u.d = nullptr; u.i0 = 64; u.i1 = pn; u.i2 = kc; u.i3 = 0; }
};
struct EpiZ2 {
    static constexpr int NHOOK = 0; static constexpr int AFTER_DRAIN = 0; static constexpr int HALFM = 0; int h0, h1; Base F; int part;
    __device__ __forceinline__ void hook(acc_t&, const Unit&, int, int, int, int, int) const {}
    __device__ __forceinline__ void operator()(const acc_t& acc, const Unit& u, int wr, int wc, int fr, int fq) const {
        const bf16_t* G = part ? GAb : GFb;
#pragma unroll
        for (int ai = 0; ai < 2; ++ai) { u32x4 gv[4][2], tv[4][2];
#pragma unroll
            for (int m = 0; m < 4; ++m) { const size_t ro = (size_t)(u.i0 * 256 + EPI_ROW) * DM + u.i1 * 256, zo = (size_t)(u.i0 * 256 + EPI_ROW) * 2048 + u.i1 * 256;
                EPI_COLS { gv[m][bj] = *(const u32x4*)(G + ro + EPI_COL0); if (part) tv[m][bj] = *(const u32x4*)(Zb + zo + EPI_COL0); } }
#pragma unroll
            for (int m = 0; m < 4; ++m) { const size_t zo = (size_t)(u.i0 * 256 + EPI_ROW) * 2048 + u.i1 * 256;
                EPI_COLS { f32x4 g0, g1; unpack8(gv[m][bj], g0, g1); f32x4 v0 = acc[ai][bj][m][0] * g0, v1 = acc[ai][bj][m][1] * g1;
                    if (part) { f32x4 t0, t1; unpack8(tv[m][bj], t0, t1); v0 += t0; v1 += t1; }
                    *(u32x4*)(Zb + zo + EPI_COL0) = pack8(v0, v1); } }
            asm volatile("" ::: "memory"); }
    }
};
struct JobGate2 {
    Base F;
    __device__ __forceinline__ void fill(int L, Unit& u) const { const int c = L & 255, which = L >> 8; int pm, pn; pg::tile_pm_pn(c, 64, 4, pm, pn);
        u.a0 = (const char*)(Ax + (size_t)pm * 256 * DM); u.a1 = u.a0; u.b = (const char*)(Win + (size_t)(WR_GA + which * 1024 + pn * 256) * DM); u.d = nullptr; u.i0 = pm; u.i1 = which * 4 + pn; u.i2 = 0; u.i3 = 0; }
};
struct JobG2 {
    Base F;
    __device__ __forceinline__ void fill(int L, Unit& u) const { const int c0 = L & 255, c = (c0 & 7) * 32 + (c0 >> 3), half = L >> 8, pm = c >> 2, pn = 2 * (c & 3) + half;
        u.a0 = (const char*)(Ax + (size_t)pm * 256 * DM); u.a1 = u.a0; u.b = (const char*)(Win + (size_t)(WR_G + pn * 256) * DM); u.d = nullptr; u.i0 = pm; u.i1 = pn; u.i2 = 0; u.i3 = 0; }
};
struct EpiGG {
    static constexpr int NHOOK = 0; static constexpr int AFTER_DRAIN = 0; static constexpr int HALFM = 0; int h0, h1; Base F; const float* gnw; int rep; LAS unsigned char* stl;
    __device__ __forceinline__ void hook(acc_t&, const Unit&, int, int, int, int, int) const {}
    __device__ __forceinline__ void operator()(const acc_t& acc, const Unit& u, int wr, int wc, int fr, int fq) const {
        if (u.i3 == 0) { const EpiG e{0, 0, F, gnw, rep, stl}; e(acc, u, wr, wc, fr, fq); } else { const EpiGate e{0, 0, F}; e(acc, u, wr, wc, fr, fq); }
    }
};
struct JobGG {
    Base F;
    __device__ __forceinline__ void fill(int L, Unit& u) const { if (L < 512) { JobG2{F}.fill(L, u); u.i3 = 0; } else { JobGate2{F}.fill(L - 512, u); u.i3 = 1; } }
};
struct JobFold {
    Base F;
    __device__ __forceinline__ void fill(int L, Unit& u) const { const int pn = L & 3, g = L >> 2;
        u.a0 = (const char*)T256; u.a1 = u.a0; u.b = (const char*)(Wn + (size_t)pn * 256 * DM + g * 256); u.d = nullptr; u.i0 = 0; u.i1 = pn; u.i2 = g; u.i3 = 0; }
};
struct EpiFold {
    static constexpr int NHOOK = 0; static constexpr int AFTER_DRAIN = 0; static constexpr int HALFM = 0; int h0, h1; Base F;
    __device__ __forceinline__ void hook(acc_t&, const Unit&, int, int, int, int, int) const {}
    __device__ __forceinline__ void operator()(const acc_t& acc, const Unit& u, int wr, int wc, int fr, int fq) const {
        EPI_ROWS { const int r = EPI_ROW; bf16_t* rowp = Win + (size_t)(WR_F + (r >> 7) * 512 + u.i2 * 128 + (r & 127)) * DM + u.i1 * 256;
            EPI_COLS { *(u32x4*)(rowp + EPI_COL0) = pack8(acc[ai][bj][m][0], acc[ai][bj][m][1]); } }
    }
};
struct JobRowCol {
    Base F; int sel, nM, nN; size_t aoff0, boff0, astep, bstep;
    __device__ __forceinline__ void fill(int L, Unit& u) const { int pm, pn; pg::tile_pm_pn(L, nM, nN, pm, pn);
        const bf16_t* A = sel == 0 ? Ax : (sel == 1 ? Win : GFb); const bf16_t* B = sel == 0 ? Win : (sel == 1 ? Ax : WoT);
        u.a0 = (const char*)(A + aoff0 + (size_t)pm * astep); u.a1 = u.a0; u.b = (const char*)(B + boff0 + (size_t)pn * bstep); u.d = nullptr; u.i0 = pm; u.i1 = pn; u.i2 = 0; u.i3 = 0; }
};
struct JobKc {
    Base F;
    __device__ __forceinline__ void fill(int L, Unit& u) const { const int h = L; u.b = (const char*)Ac;
        u.a0 = (const char*)(Win + (size_t)((h >> 1) * 2048 + 512 + (h & 1) * 256) * DM); u.a1 = u.a0; u.d = nullptr; u.i0 = 0; u.i1 = h; u.i2 = 0; u.i3 = 0; }
};
struct JobVc {
    Base F;
    __device__ __forceinline__ void fill(int L, Unit& u) const { const int t = L, h = t >> 1; u.a0 = (const char*)(Win + (size_t)((h >> 1) * 2048 + 1024 + (h & 1) * 512 + (t & 1) * 256) * DM); u.a1 = u.a0;
        u.b = (const char*)Ac; u.d = nullptr; u.i0 = t; u.i1 = 0; u.i2 = 0; u.i3 = 0; }
};
struct JobS0 {
    Base F;
    __device__ __forceinline__ void fill(int L, Unit& u) const { const int h = L >> 2, dir = (L >> 1) & 1, vt = L & 1;
        u.a0 = (const char*)(VcT + (size_t)(h * 512 + vt * 256) * CTX); u.a1 = u.a0; u.b = (const char*)(KcT + (size_t)dir * 1024 * CTX + (size_t)(h * 256) * CTX);
        u.d = nullptr; u.i0 = h; u.i1 = dir; u.i2 = 0; u.i3 = vt; }
};
struct JobR1 {
    Base F;
    __device__ __forceinline__ void fill(int L, Unit& u) const { const int w = pg::xcd_contig(L, 256), vt = w & 1, dir = (w >> 1) & 1, seg = (w >> 2) & 31, hl = w >> 7;
        u.a0 = (const char*)(B4 + ((size_t)((hl * NSEG + seg) * 512 + vt * 256)) * 1024 + 512); u.a1 = u.a0;
        u.b = (const char*)(Ktb_ + (size_t)dir * 512 * SEQ + ((size_t)(hl * NSEG + seg) * 256) * LS); u.d = nullptr; u.i0 = hl; u.i1 = dir; u.i2 = seg; u.i3 = vt; }
};
struct JobR3 {
    Base F;
    __device__ __forceinline__ void fill(int L, Unit& u) const { const int w = pg::xcd_contig(L, 256), jt = w & 1, it = (w >> 1) & 1, seg = (w >> 2) & 31, hl = w >> 7;
        u.a0 = (const char*)(Qb + (size_t)(seg * LS + it * 256) * 512 + hl * 256); u.a1 = u.a0; u.b = (const char*)(Knb + (size_t)(seg * LS + jt * 256) * 512 + hl * 256);
        u.d = nullptr; u.i0 = hl; u.i1 = seg; u.i2 = it; u.i3 = jt; }
};
struct JobR4 {
    Base F;
    __device__ __forceinline__ void fill(int L, Unit& u) const { const int w = pg::xcd_contig(L, 256), vt = w & 1, it = (w >> 1) & 1, seg = (w >> 2) & 31, hl = w >> 7;
        u.a0 = (const char*)(Qb + (size_t)(seg * LS + it * 256) * 512 + hl * 256); u.a1 = (const char*)(Pb + (size_t)(seg * LS + it * 256) * 1024 + hl * 512);
        u.b = (const char*)(B4 + ((size_t)((hl * NSEG + seg) * 512 + vt * 256)) * 1024); u.d = nullptr; u.i0 = hl; u.i1 = seg; u.i2 = it; u.i3 = vt; }
};
struct JobF1 {
    Base F;
    __device__ __forceinline__ void fill(int L, Unit& u) const { u.a0 = (const char*)FmT; u.a1 = u.a0; u.b = (const char*)(Wt + (size_t)L * 256 * 256); u.d = nullptr; u.i0 = 0; u.i1 = L; u.i2 = 0; u.i3 = 0; }
};
struct JobF2 {
    Base F;
    __device__ __forceinline__ void fill(int L, Unit& u) const { u.a0 = (const char*)GmT; u.a1 = u.a0; u.b = (const char*)(Bt + (size_t)L * 256 * 256); u.d = nullptr; u.i0 = 0; u.i1 = L; u.i2 = 0; u.i3 = 0; }
};
struct JobZ {
    Base F; int part;
    __device__ __forceinline__ void fill(int L, Unit& u) const { int pm, pn; pg::tile_pm_pn(L, 64, 4, pm, pn);
        u.a0 = (const char*)((part ? Ob : MIXb) + (size_t)pm * 256 * 2048); u.a1 = u.a0; u.b = (const char*)(Bz + (size_t)pn * 256 * 3072 + (part ? 1024 : 0)); u.d = nullptr; u.i0 = pm; u.i1 = pn; u.i2 = 0; u.i3 = 0; }
};

#define XB_TMO      128
#define XB_XCNT(j)  (256  + 64 * (j))
#define XB_XSUB(j)  (1280 + 64 * (j))
#define XB_XGEN(j)  (2304 + 64 * (j))
#define XB_TOP      3328
#define XB_TOPGEN   3392
#define XCD_BAR_WORDS 3456
#define XB_SPIN_CAP (1u << 22)
__device__ __forceinline__ unsigned xb_ld(unsigned* p)              { return __hip_atomic_load(p, __ATOMIC_RELAXED, __HIP_MEMORY_SCOPE_AGENT); }
__device__ __forceinline__ unsigned xb_add(unsigned* p, unsigned v) { return __hip_atomic_fetch_add(p, v, __ATOMIC_RELAXED, __HIP_MEMORY_SCOPE_AGENT); }
__device__ __forceinline__ unsigned xb_xcc_id() { return (unsigned)__builtin_amdgcn_s_getreg((3 << 11) | 20) & 0xFu; }
#define XB_SPIN(cond, bar) do { unsigned _sp = 0; while (cond) { __builtin_amdgcn_s_sleep(1); \
    if ((++_sp & 255u) == 0u) { if (xb_ld(&(bar)[XB_TMO])) break; if (_sp > XB_SPIN_CAP) { atomicAdd(&(bar)[XB_TMO], 1u); break; } } } } while (0)
struct XcdBarrier { unsigned* bar; unsigned x; volatile LAS unsigned* st; };
__device__ __forceinline__ XcdBarrier xcd_barrier_post(unsigned* bar, volatile LAS unsigned* st) {
    XcdBarrier b; b.bar = bar; b.x = xb_xcc_id(); b.st = st;
    if (threadIdx.x == 0) (void)xb_add(&bar[XB_XCNT(b.x)], 1u);
    return b;
}
__device__ __forceinline__ void xcd_barrier_complete(unsigned* bar, unsigned x, unsigned& nloc, unsigned& nx) {
    const unsigned G = gridDim.x * gridDim.y * gridDim.z;
    unsigned sum, cnt, mine, sp = 0u;
    for (;;) {
        sum = 0u; cnt = 0u; mine = 0u;
#pragma unroll
        for (unsigned j = 0; j < 16; ++j) { const unsigned c = xb_ld(&bar[XB_XCNT(j)]); sum += c; cnt += (c > 0u) ? 1u : 0u; mine = (j == x) ? c : mine; }
        if (sum == G) break;
        __builtin_amdgcn_s_sleep(1);
        if ((++sp & 255u) == 0u) { if (xb_ld(&bar[XB_TMO])) break; if (sp > XB_SPIN_CAP) { atomicAdd(&bar[XB_TMO], 1u); break; } }
    }
    nloc = mine > 0u ? mine : 1u; nx = cnt > 0u ? cnt : 1u;
}
__device__ __attribute__((noinline)) void xcd_barrier(unsigned* bar_, unsigned bx_, volatile LAS unsigned* st_) {
    XcdBarrier b; b.bar = bar_; b.x = bx_; b.st = st_;
    asm volatile("s_waitcnt vmcnt(0)" ::: "memory");
    __syncthreads();
    if (threadIdx.x == 0) {
        unsigned* bar = b.bar;
        __builtin_amdgcn_s_waitcnt(0);
        unsigned nloc = b.st[0], nx = b.st[1];
        if (nloc == 0u) { xcd_barrier_complete(bar, b.x, nloc, nx); b.st[0] = nloc; b.st[1] = nx; }
        const unsigned old = xb_add(&bar[XB_XSUB(b.x)], 1u);
        const unsigned gen = old / nloc;
        if (old + 1u == (gen + 1u) * nloc) {
            __builtin_amdgcn_fence(__ATOMIC_RELEASE, "agent");
            asm volatile("s_waitcnt vmcnt(0)" ::: "memory");
            const unsigned og = xb_add(&bar[XB_TOP], 1u);
            const unsigned tg = og / nx;
            if (og + 1u == (tg + 1u) * nx) xb_add(&bar[XB_TOPGEN], 1u);
            else XB_SPIN(xb_ld(&bar[XB_TOPGEN]) == tg, bar);
            __builtin_amdgcn_fence(__ATOMIC_ACQUIRE, "agent");
            xb_add(&bar[XB_XGEN(b.x)], 1u);
            asm volatile("s_waitcnt vmcnt(0)" ::: "memory");
        } else {
            XB_SPIN(xb_ld(&bar[XB_XGEN(b.x)]) == gen, bar);
            __builtin_amdgcn_fence(__ATOMIC_ACQUIRE, "agent");
            asm volatile("s_waitcnt vmcnt(0)" ::: "memory");
        }
    }
    __syncthreads();
}

constexpr int NWAVES = 8, NTHREADS = 512;
constexpr int RING_BYTES = 131072, MISC_OFF = RING_BYTES + 320, LDS_BYTES = 147456;
constexpr int CW_BAR = 4096;

struct Args { const float* in[21]; float* out; unsigned char* ws; int ph_lo, ph_hi; };
#define GAS __attribute__((address_space(1)))
#define GIN(i) ((const float*)(const GAS float*)args.in[i])

struct Ctx {
    LAS unsigned char* lds; int tid, lane, wave, G, vcu;
    unsigned char* ws; unsigned char* dout;
};
#define F_WS (F.ws)
#define F_DOUT (F.dout)

__device__ __forceinline__ void gemv_item(const Ctx& F, int item, const float* W, const float* b, const float* c, const float* cc) {
    LAS float* scr = (LAS float*)F.lds;
    const int cg = F.tid % 9, rg = F.tid / 9, n0 = item * 36 + cg * 4;
    f32x4 ax = {0.f, 0.f, 0.f, 0.f}, ac = {0.f, 0.f, 0.f, 0.f};
    if (rg < 56) {
        f32x4 w[19];
#pragma unroll
        for (int i = 0; i < 19; ++i) { const int k = rg + 56 * i; w[i] = __builtin_nontemporal_load((const f32x4*)(W + (size_t)(k < DM ? k : rg) * 9216 + n0)); }
#pragma unroll
        for (int i = 0; i < 19; ++i) { const int k = rg + 56 * i; if (k < DM) { const float sx = c[k], sc = cc[k]; ax += w[i] * (sx / (1.f + expf(-sx))); ac += w[i] * (sc / (1.f + expf(-sc))); } }
    }
    __syncthreads();
    if (rg < 56) {
#pragma unroll
        for (int e = 0; e < 4; ++e) { scr[(rg * 9 + cg) * 8 + e] = ax[e]; scr[(rg * 9 + cg) * 8 + 4 + e] = ac[e]; } }
    __syncthreads();
    if (F.tid < 72) { const int which = F.tid / 36, col = F.tid % 36, g = col >> 2, e = col & 3; float s = 0.f;
        for (int r = 0; r < 56; ++r) s += scr[(r * 9 + g) * 8 + which * 4 + e];
        (which ? modc : modx)[item * 36 + col] = s + b[item * 36 + col]; }
    __syncthreads();
}
struct TrDesc { const float* W; int K, N; bf16_t* dst; int ld, coloff, kind; };
__device__ __forceinline__ int tr_dest_row(int kind, int n) {
    switch (kind) {
    case 0: { const int isb = n >= DFF, j = isb ? n - DFF : n; return 256 * (j >> 7) + 128 * isb + (j & 127); }
    case 2: {
        if (n < 1024) { const int h = n >> 8, d = n & 255; return (h >> 1) * 2048 + (h & 1) * 256 + d; }
        if (n < 2048) { const int h = (n - 1024) >> 8, d = n & 255; return (h >> 1) * 2048 + 512 + (h & 1) * 256 + d; }
        if (n < 4096) { const int h = (n - 2048) >> 9, v = (n - 2048) & 511; return (h >> 1) * 2048 + 1024 + (h & 1) * 512 + v; }
        if (n < 6144) return WR_G + (n - 4096);
        if (n < 7168) return -1;
        if (n < 8192) return WR_GA + (n - 7168);
        return WR_GF + (n - 8192); }
    default: return n; }
}
__device__ __forceinline__ void tr_item(const TrDesc& t, LAS float* scr, int item, int lane) {
    const int nblk = t.N / 32, kb = item / nblk, nb = item % nblk, k0 = 64 * kb, n0 = 32 * nb;
    if (t.kind == 2 && n0 >= 6144 && n0 < 7168) return;
#pragma unroll
    for (int i = 0; i < 8; ++i) { const int kk = 8 * i + (lane >> 3), c4 = (lane & 7) * 4, kd = k0 + kk, cc = kd & 255;
        const int ks = t.kind == 3 ? ((kd & ~255) | (cc <= 128 ? cc : 384 - cc)) : kd;
        const f32x4 v = __builtin_nontemporal_load((const f32x4*)(t.W + (size_t)ks * t.N + n0 + c4));
        scr[kk * 33 + c4] = v[0]; scr[kk * 33 + c4 + 1] = v[1]; scr[kk * 33 + c4 + 2] = v[2]; scr[kk * 33 + c4 + 3] = v[3]; }
    asm volatile("s_waitcnt lgkmcnt(0)" ::: "memory");
    const int c = lane & 7;
#pragma unroll
    for (int j = 0; j < 4; ++j) { const int n = (lane >> 3) + 8 * j; const LAS float* s = scr + (8 * c) * 33 + n;
        u32x4 o; o.x = cvt_pk_bf16(s[0 * 33], s[1 * 33]); o.y = cvt_pk_bf16(s[2 * 33], s[3 * 33]); o.z = cvt_pk_bf16(s[4 * 33], s[5 * 33]); o.w = cvt_pk_bf16(s[6 * 33], s[7 * 33]);
        const int dr = tr_dest_row(t.kind, n0 + n);
        *(u32x4*)(t.dst + (size_t)dr * t.ld + t.coloff + k0 + 8 * c) = o; }
    asm volatile("s_waitcnt lgkmcnt(0)" ::: "memory");
}
__device__ __forceinline__ void tr_all(const Ctx& F, const TrDesc& t, int gw, int NGW) {
    LAS float* scr = (LAS float*)(F.lds + F.wave * 16384);
    const int nitems = (t.K / 64) * (t.N / 32);
    for (int it = gw; it < nitems; it += NGW) tr_item(t, scr, it, F.lane);
}
__device__ __forceinline__ void norm_rows(const Ctx& F, const float* xin, const float* cin, const float* nw, int modoff, const bf16_t* dx, const float* dcf, bool has_delta, int row0, int nrows) {
    const int gw = F.vcu * NWAVES + F.wave, NGW = F.G * NWAVES;
    for (int r = row0 + gw; r < nrows; r += NGW) {
        const bool isx = r < SEQ; const int rr = isx ? r : r - SEQ;
        const float* xr = (isx ? xin : cin) + (size_t)rr * DM; const bf16_t* dr = dx + (size_t)rr * DM; const float* drf = dcf + (size_t)rr * DM;
        const float* md = (isx ? modx : modc) + modoff; bf16_t* orow = (isx ? Ax : Ac) + (size_t)rr * DM;
        f32x4 v[4]; float ss = 0.f;
#pragma unroll
        for (int j = 0; j < 4; ++j) { v[j] = *(const f32x4*)(xr + 256 * j + 4 * F.lane);
            if (has_delta) { if (isx) { const u32x2 d = *(const u32x2*)(dr + 256 * j + 4 * F.lane); v[j] += (f32x4){bflo(d.x), bfhi(d.x), bflo(d.y), bfhi(d.y)}; } else { f32x4 sacc = {0.f, 0.f, 0.f, 0.f};
#pragma unroll
                for (int kc = 0; kc < 11; ++kc) sacc += *(const f32x4*)(drf + (size_t)kc * CTX * DM + 256 * j + 4 * F.lane);
                v[j] += sacc * (*(const f32x4*)(modc + 2 * DM + 256 * j + 4 * F.lane)) * 0.5f; } }
            ss += (v[j][0] * v[j][0] + v[j][1] * v[j][1]) + (v[j][2] * v[j][2] + v[j][3] * v[j][3]); }
        const float rinv = 1.0f / sqrtf(wave_sum(ss) * (1.f / DM) + EPS);
#pragma unroll
        for (int j = 0; j < 4; ++j) { const int c = 256 * j + 4 * F.lane; const f32x4 w = *(const f32x4*)(nw + c), sh = *(const f32x4*)(md + c), sc = *(const f32x4*)(md + 1024 + c);
            const f32x4 y = (v[j] * rinv) * w * (sc + 1.0f) + sh; u32x2 o; o.x = cvt_pk_bf16(y[0], y[1]); o.y = cvt_pk_bf16(y[2], y[3]);
            *(u32x2*)(orow + c) = o; }
    }
}
__device__ __forceinline__ void norm_rows_x(const Ctx& F, const float* xin, const float* nw, int modoff) {
    const int gw = F.vcu * NWAVES + F.wave, NGW = F.G * NWAVES; const float* md = modx + modoff;
    f32x4 ca[4], cb[4];
#pragma unroll
    for (int j = 0; j < 4; ++j) { const int c = 512 * (j >> 1) + 8 * F.lane + 4 * (j & 1); ca[j] = *(const f32x4*)(nw + c) * (*(const f32x4*)(md + 1024 + c) + 1.0f); cb[j] = *(const f32x4*)(md + c); }
    for (int r = gw; r < SEQ; r += 2 * NGW) { const bool two = r + NGW < SEQ; const int r1 = two ? r + NGW : r;
        f32x4 v[2][4];
#pragma unroll
        for (int u = 0; u < 2; ++u) { const float* xr = xin + (size_t)(u ? r1 : r) * DM + 8 * F.lane;
#pragma unroll
            for (int j = 0; j < 4; ++j) v[u][j] = __builtin_nontemporal_load((const f32x4*)(xr + 512 * (j >> 1) + 4 * (j & 1))); }
#pragma unroll
        for (int u = 0; u < 2; ++u) { float ss = 0.f;
#pragma unroll
            for (int j = 0; j < 4; ++j) ss += (v[u][j][0] * v[u][j][0] + v[u][j][1] * v[u][j][1]) + (v[u][j][2] * v[u][j][2] + v[u][j][3] * v[u][j][3]);
            const float rinv = 1.0f / sqrtf(wave_sum(ss) * (1.f / DM) + EPS);
            if (u == 0 || two) { bf16_t* orow = Ax + (size_t)(u ? r1 : r) * DM + 8 * F.lane;
#pragma unroll
                for (int jj = 0; jj < 2; ++jj) *(u32x4*)(orow + 512 * jj) = pack8((v[u][2 * jj] * rinv) * ca[2 * jj] + cb[2 * jj], (v[u][2 * jj + 1] * rinv) * ca[2 * jj + 1] + cb[2 * jj + 1]); } }
    }
}
__device__ __forceinline__ void norm_ctx1(const Ctx& F, const float* cin, const float* nw) {
    if (F.vcu >= 128) return;
    LAS float* red = (LAS float*)F.lds;
    const int rr = F.vcu * 2 + (F.wave >> 2), c = 256 * (F.wave & 3) + 4 * F.lane;
    const f32x4 v = *(const f32x4*)(cin + (size_t)rr * DM + c), w = *(const f32x4*)(nw + c), sh = *(const f32x4*)(modc + c), sc = *(const f32x4*)(modc + 1024 + c);
    const float ss = wave_sum((v[0] * v[0] + v[1] * v[1]) + (v[2] * v[2] + v[3] * v[3]));
    if (F.lane == 0) red[F.wave] = ss;
    __syncthreads();
    const int w0 = F.wave & ~3; const float tot = (red[w0] + red[w0 + 1]) + (red[w0 + 2] + red[w0 + 3]);
    const float rinv = 1.0f / sqrtf(tot * (1.f / DM) + EPS);
    const f32x4 y = (v * rinv) * w * (sc + 1.0f) + sh; u32x2 o; o.x = cvt_pk_bf16(y[0], y[1]); o.y = cvt_pk_bf16(y[2], y[3]);
    *(u32x2*)(Ac + (size_t)rr * DM + c) = o;
    __syncthreads();
}
__device__ __forceinline__ void norm_ctx2(const Ctx& F, const float* cin, const float* nw, int modoff) {
    if (F.vcu >= 128) return;
    LAS float* red = (LAS float*)F.lds;
    const int rr = F.vcu * 2 + (F.wave >> 2), c = 256 * (F.wave & 3) + 4 * F.lane;
    const float* md = modc + modoff;
    f32x4 v = *(const f32x4*)(cin + (size_t)rr * DM + c), sl[11];
#pragma unroll
    for (int kc = 0; kc < 11; ++kc) sl[kc] = *(const f32x4*)(XcSlab + (size_t)kc * CTX * DM + (size_t)rr * DM + c);
    const f32x4 g = *(const f32x4*)(modc + 2 * DM + c), w = *(const f32x4*)(nw + c), sh = *(const f32x4*)(md + c), sc = *(const f32x4*)(md + 1024 + c);
    f32x4 sacc = {0.f, 0.f, 0.f, 0.f};
#pragma unroll
    for (int kc = 0; kc < 11; ++kc) sacc += sl[kc];
    v += sacc * g * 0.5f;
    const float ss = wave_sum((v[0] * v[0] + v[1] * v[1]) + (v[2] * v[2] + v[3] * v[3]));
    if (F.lane == 0) red[F.wave] = ss;
    __syncthreads();
    const int w0 = F.wave & ~3; const float tot = (red[w0] + red[w0 + 1]) + (red[w0 + 2] + red[w0 + 3]);
    const float rinv = 1.0f / sqrtf(tot * (1.f / DM) + EPS);
    const f32x4 y = (v * rinv) * w * (sc + 1.0f) + sh; u32x2 o; o.x = cvt_pk_bf16(y[0], y[1]); o.y = cvt_pk_bf16(y[2], y[3]);
    *(u32x2*)(Ac + (size_t)rr * DM + c) = o;
    __syncthreads();
}
__device__ __forceinline__ void final_norm(const Ctx& F, const float* xin, const float* nw, const bf16_t* dx) {
    float* out = (float*)F_DOUT;
    const int gw = F.vcu * NWAVES + F.wave, NGW = F.G * NWAVES;
    for (int r = gw; r < SEQ; r += NGW) {
        const float* xr = xin + (size_t)r * DM; const bf16_t* dr = dx + (size_t)r * DM;
        f32x4 v[4]; float ss = 0.f;
#pragma unroll
        for (int j = 0; j < 4; ++j) { v[j] = *(const f32x4*)(xr + 256 * j + 4 * F.lane);
            const u32x2 d = *(const u32x2*)(dr + 256 * j + 4 * F.lane); v[j] += (f32x4){bflo(d.x), bfhi(d.x), bflo(d.y), bfhi(d.y)};
            ss += (v[j][0] * v[j][0] + v[j][1] * v[j][1]) + (v[j][2] * v[j][2] + v[j][3] * v[j][3]); }
        const float rinv = 1.0f / sqrtf(wave_sum(ss) * (1.f / DM) + EPS);
#pragma unroll
        for (int j = 0; j < 4; ++j) { const int c = 256 * j + 4 * F.lane; *(f32x4*)(out + (size_t)r * DM + c) = (v[j] * rinv) * *(const f32x4*)(nw + c); }
    }
}
__device__ __forceinline__ void copy_delta(const Ctx& F, const bf16_t* src, bf16_t* dst) {
    const size_t n16 = (size_t)SEQ * DM * 2 / 16; const u32x4* s = (const u32x4*)src; u32x4* d = (u32x4*)dst;
    for (size_t i = (size_t)F.vcu * NTHREADS + F.tid; i < n16; i += (size_t)F.G * NTHREADS) d[i] = s[i];
}


__device__ __forceinline__ float block_sum(LAS float* scr, float v, int tid) {
    v = wave_sum(v); __syncthreads(); if ((tid & 63) == 0) scr[tid >> 6] = v; __syncthreads();
    float s = 0.f; for (int i = 0; i < NWAVES; ++i) s += scr[i]; __syncthreads(); return s;
}
__device__ __forceinline__ void dbg_report(unsigned* word, float ref, float got, float floor_) {
    const float e = fabsf(got - ref) / fmaxf(fabsf(ref), floor_); atomicMax(word, __builtin_bit_cast(unsigned, e)); if (e > 0.05f) atomicAdd(word + 64, 1u);
}
__device__ __forceinline__ float bf2f(bf16_t b) { return __builtin_bit_cast(float, (unsigned)b << 16); }

__global__ void __launch_bounds__(NTHREADS, 2) fwd_kernel(Args args) {
    extern __shared__ __attribute__((aligned(16))) unsigned char lds_raw[];
    Ctx F;
    F.lds = (LAS unsigned char*)lds_raw;
    F.tid = threadIdx.x; F.lane = F.tid & 63; F.wave = __builtin_amdgcn_readfirstlane(F.tid >> 6);
    F.G = gridDim.x; { const int bx = blockIdx.x; F.vcu = (F.G % 8 == 0) ? (bx % 8) * (F.G / 8) + bx / 8 : bx; }
    F.ws = (unsigned char*)(GAS unsigned char*)args.ws; F.dout = (unsigned char*)(GAS unsigned char*)args.out;
    volatile LAS unsigned* MISC = (volatile LAS unsigned*)(F.lds + MISC_OFF);
    for (int u = F.tid; u < (LDS_BYTES - RING_BYTES) / 4; u += NTHREADS) ((LAS unsigned*)(F.lds + RING_BYTES))[u] = 0u;
    __syncthreads();
    unsigned* ctl = (unsigned*)(F_WS + WS_CTL);
    XcdBarrier bar = xcd_barrier_post(ctl + CW_BAR, MISC + 8);
    const int lo = args.ph_lo, hi = args.ph_hi;
    int phase = 0;
#define PHASE_BEGIN if (phase >= lo && phase < hi) { for (int _rep = 0; _rep < ((DBG_DUP >= 0 && phase == DBG_DUP) ? 2 : 1); ++_rep) { asm volatile("; MARK %0" :: "i"(__LINE__)); { GAS unsigned char* _w = (GAS unsigned char*)args.ws; GAS unsigned char* _o = (GAS unsigned char*)args.out; int _t = threadIdx.x; asm volatile("" : "+s"(_w), "+s"(_o), "+v"(_t)); F.ws = (unsigned char*)_w; F.dout = (unsigned char*)_o; F.tid = _t; F.lane = _t & 63; }
#define PHASE_END   } if (phase + 1 < hi) xcd_barrier((unsigned*)(F.ws + WS_CTL) + CW_BAR, bar.x, MISC + 8); if (DBG_TSEL >= 0 && bx == 0 && F.tid == 0) ((unsigned long long*)(F.ws + WS_CTL + 160000))[phase + 1] = __builtin_amdgcn_s_memrealtime(); } ++phase;
    const int bx = (int)blockIdx.x;

#define gtid ((size_t)F.vcu * NTHREADS + F.tid)
#define gthreads ((size_t)F.G * NTHREADS)
#define FB (Base{F.ws, F.dout})
    const Geo gK1024{DM, DM, DM, 128u * DM * 2u, 128u * DM * 2u, 128u * DM * 2u, DM / 64, 1 << 20, 1 << 20};
    const Geo gFfn2{DFF, DFF, DFF, 128u * DFF * 2u, 128u * DFF * 2u, 128u * DFF * 2u, DFF / 64, 1 << 20, 1 << 20};

    if (DBG_TSEL >= 0 && bx == 0 && threadIdx.x == 0) ((unsigned long long*)(args.ws + WS_CTL + 160000))[0] = __builtin_amdgcn_s_memrealtime();
    PHASE_BEGIN
        for (int it = F.vcu; it < 256; it += F.G) gemv_item(F, it, GIN(4), GIN(5), GIN(1), GIN(3));
        __syncthreads();
        if (gtid == 0) { ((unsigned*)(F.ws + WS_CTL))[32768 + 192] = 255u; ((unsigned*)(F.ws + WS_CTL))[32768 + 193] = 255u; }
        if (gtid < 8) { const float x = (gtid < 4 ? GIN(11) : GIN(12))[gtid & 3]; modx[2 * 9216 + gtid] = -log1pf(expf(-x)); }
        for (size_t i = gtid; i < 256 * 64; i += gthreads) { const int p = (int)(i >> 6), f = (int)(i & 63); const float inv = powf(10000.0f, -(float)f / 64.0f), ang = (float)p * inv;
            ropeT[2 * i] = cosf(ang); ropeT[2 * i + 1] = sinf(ang); }
        for (size_t i = gtid; i < 128 * 128; i += gthreads) { const int k1 = (int)(i >> 7), l2 = (int)(i & 127); const float a = (float)((k1 * l2) & 16383) * (1.0f / 8192.0f);
            twT[2 * i] = cospif(a); twT[2 * i + 1] = sinpif(a); }
        for (size_t i = gtid; i < 256 * 256; i += gthreads) { const int r = (int)(i >> 8), cc = (int)(i & 255), rin = cc >> 7, l = cc & 127;
            { const int k1 = r >> 1, ri = r & 1; const float a = (float)((k1 * l) & 127) * (1.0f / 64.0f), c = cospif(a), s = sinpif(a);
              FmT[i] = f2bf(ri == 0 ? (rin == 0 ? c : s) : (rin == 0 ? -s : c)); }
            { const float a = (float)((r * l) & 127) * (1.0f / 64.0f), c = cospif(a), s = sinpif(a);
              GmT[i] = r < 128 ? f2bf((rin == 0 ? c : s) * (1.0f / 2048.0f)) : f2bf((rin == 0 ? -s : c) * (1.0f / 2048.0f)); } }
        for (size_t i = gtid; i < 256 * 256; i += gthreads) { const int r = (int)(i >> 8), c = (int)(i & 255), ri = r >> 7, cp = r & 127; const float a = (float)((c * cp) & 255) * (1.0f / 128.0f);
            T256[i] = f2bf(ri == 0 ? cospif(a) : (cp == 0 ? ((c & 1) ? -1.0f : 1.0f) : -sinpif(a))); }
        for (size_t i = gtid; i < (size_t)DM * DM / 4; i += gthreads) { const int k = (int)(i >> 8), c4 = (int)(i & 255) * 4; const f32x4 w = __builtin_nontemporal_load((const f32x4*)(GIN(10) + (size_t)k * 9216 + 6144 + c4));
            u32x2 o; o.x = cvt_pk_bf16(w[0], w[1]); o.y = cvt_pk_bf16(w[2], w[3]); *(u32x2*)(Wn + (size_t)k * DM + c4) = o; }
        { TrDesc t{GIN(7), DM, 2 * DFF, W13t1, DM, 0, 0}; tr_all(F, t, F.vcu * NWAVES + F.wave, F.G * NWAVES); }
        { TrDesc t{GIN(8), DFF, DM, W2t1, DFF, 0, 1}; tr_all(F, t, F.vcu * NWAVES + F.wave, F.G * NWAVES); }
        __syncthreads();
    PHASE_END
    for (int xb = 0; xb < DBG_XBAR; ++xb) {
    PHASE_BEGIN
    PHASE_END
    }
    PHASE_BEGIN
        norm_rows_x(F, GIN(0), GIN(6), 0);
        norm_ctx1(F, GIN(2), GIN(6));
    PHASE_END
    if constexpr (DBG_PROBE == 11) {
    PHASE_BEGIN
        unsigned* dw = (unsigned*)(F.ws + WS_CTL) + 32768;
        for (size_t idx = gtid; idx < (size_t)DM * 9216; idx += gthreads) { const int k = (int)(idx / 9216), n = (int)(idx % 9216); const int dr = tr_dest_row(2, n);
            if (dr >= 0) { const float a = GIN(10)[idx]; const float b = bf2f(Win[(size_t)dr * DM + k]); if (fabsf(a - b) > 0.01f * fabsf(a) + 1e-6f) { atomicAdd(dw + 64, 1u); atomicMin(dw + 192, (unsigned)(dr >> 8)); } } }
    PHASE_END
    }
    PHASE_BEGIN
        { pg::Sched<JobFfn1> S{{FB, 65, 1}, 65 * 22, F.G, bx};
          EpiSwiglu E{0, 0, FB};
          pg::gemm_phase<EpiSwiglu, pg::Sched<JobFfn1>, 1>(F.lds, gK1024, S, E); }
        if (bx >= 150 && bx < 194 && _rep == 0) {
            if (F.tid < 64) { unsigned* cnt = (unsigned*)(F.ws + WS_CTL) + 24576; unsigned sp = 0;
                while ((unsigned)__builtin_amdgcn_readfirstlane(__hip_atomic_load(cnt, __ATOMIC_RELAXED, __HIP_MEMORY_SCOPE_AGENT)) < 22u * 8u) { __builtin_amdgcn_s_sleep(2); if (++sp > (1u << 22)) break; }
                __builtin_amdgcn_fence(__ATOMIC_ACQUIRE, "agent"); asm volatile("s_waitcnt vmcnt(0)" ::: "memory"); }
            __syncthreads();
            Geo g{DFF, DFF, DFF, 128u * DFF * 2u, 128u * DFF * 2u, 128u * DFF * 2u, 4, 1 << 20, 1 << 20};
            pg::Sched<JobCtxG2> S{{FB}, 44, 1 << 20, bx - 150}; EpiSlab E{0, 0, FB};
            pg::gemm_phase<EpiSlab, pg::Sched<JobCtxG2>, 1>(F.lds, g, S, E);
            { Geo g2{256, 256, DM, 128u * 256 * 2u, 128u * 256 * 2u, 128u * DM * 2u, 4, 1 << 20, 1 << 20};
              pg::Sched<JobFold> S2{{FB}, 16, 1 << 20, bx - 150}; EpiFold E2{0, 0, FB};
              pg::gemm_phase<EpiFold, pg::Sched<JobFold>, 1>(F.lds, g2, S2, E2); }
        } else if (bx >= 194 && _rep == 0) {
            { TrDesc t{GIN(10), DM, 9216, Win, DM, 0, 2}; tr_all(F, t, (bx - 194) * NWAVES + F.wave, (F.G - 194) * NWAVES); }
            __syncthreads();
        }
    PHASE_END
    PHASE_BEGIN
        { pg::Sched<JobFfn2> S{{FB, 64, 1}, 64 * 4, F.G, bx};
          EpiFuse E{0, 0, FB, 0, GIN(0), GIN(9)};
          pg::gemm_phase<EpiFuse, pg::Sched<JobFfn2>, 1>(F.lds, gFfn2, S, E); }
        if (_rep == 0) norm_ctx2(F, GIN(2), GIN(9), 3 * DM);
    PHASE_END
    if constexpr (STOP_AFTER >= 3) {
    for (int pair = 0; pair < 2; ++pair) {
        PHASE_BEGIN
            { pg::Sched<JobRowCol> S{{FB, 0, 64, 4, 0, (size_t)pair * 2048 * DM, (size_t)256 * DM, (size_t)256 * DM}, 256, F.G, bx};
              EpiQK E{0, 0, FB, pair};
              pg::gemm_phase<EpiQK, pg::Sched<JobRowCol>, 1>(F.lds, gK1024, S, E); }
            { pg::Sched<JobRowCol> S{{FB, 1, 4, 64, (size_t)(pair * 2048 + 1024) * DM, 0, (size_t)256 * DM, (size_t)256 * DM}, 256, F.G, bx};
              EpiVT E{0, 0, FB};
              pg::gemm_phase<EpiVT, pg::Sched<JobRowCol>, 1>(F.lds, gK1024, S, E); }
            if (pair == 0 && !((bx >= 64 && bx < 68) || (bx >= 72 && bx < 80)) && _rep == 0) {
                const int r = bx < 64 ? bx : (bx < 72 ? bx - 4 : bx - 12), tgw = r * NWAVES + F.wave, tng = (F.G - 12) * NWAVES;
                { TrDesc t{GIN(18), DM, 2 * DFF, W13t, DM, 0, 0}; tr_all(F, t, tgw, tng); }
                { TrDesc t{GIN(19), DFF, DM, W2t, DFF, 0, 1}; tr_all(F, t, tgw, tng); }
                { TrDesc t{GIN(15), DM, DM, Bz, BZP, 0, 3}; tr_all(F, t, tgw, tng); }
                { TrDesc t{GIN(14), 2048, DM, Bz, BZP, 1024, 4}; tr_all(F, t, tgw, tng); }
                { TrDesc t{GIN(16), DM, DM, WoT, DM, 0, 5}; tr_all(F, t, tgw, tng); }
                __syncthreads(); }
            if (pair == 0) {
                { pg::Sched<JobKc> S{{FB}, 4, F.G, (bx + F.G - 64) % F.G}; EpiKc E{0, 0, FB};
                  pg::gemm_phase<EpiKc, pg::Sched<JobKc>, 1>(F.lds, gK1024, S, E); }
                { pg::Sched<JobVc> S{{FB}, 8, F.G, (bx + F.G - 72) % F.G}; EpiVc E{0, 0, FB};
                  pg::gemm_phase<EpiVc, pg::Sched<JobVc>, 1>(F.lds, gK1024, S, E); }
            }
        PHASE_END
        if constexpr (DBG_PROBE == 5) {
        PHASE_BEGIN
            LAS float* scr = (LAS float*)F.lds; unsigned* dw = (unsigned*)(F.ws + WS_CTL) + 32768;
            const int s = bx; const int i = (int)(((unsigned)s * 2654435761u) >> 18) & 16383, hl = s & 1, h = 2 * pair + hl, pp = (s * 29 + 3) & 127, v = (s * 37 + 11) & 511;
            const float* win = GIN(10); float q1 = 0.f, q2 = 0.f, k1 = 0.f, k2 = 0.f, vv = 0.f;
            for (int a = F.tid; a < DM; a += NTHREADS) { const float x = bf2f(Ax[(size_t)i * DM + a]); const float* wr_ = win + (size_t)a * 9216;
                q1 += x * wr_[h * 256 + 2 * pp]; q2 += x * wr_[h * 256 + 2 * pp + 1]; k1 += x * wr_[1024 + h * 256 + 2 * pp]; k2 += x * wr_[1024 + h * 256 + 2 * pp + 1]; vv += x * wr_[2048 + h * 512 + v]; }
            q1 = block_sum(scr, q1, F.tid); q2 = block_sum(scr, q2, F.tid); k1 = block_sum(scr, k1, F.tid); k2 = block_sum(scr, k2, F.tid); vv = block_sum(scr, vv, F.tid);
            if (F.tid == 0) { const float inv = powf(10000.0f, -(float)(pp & 63) / 64.0f), ang = (float)(pp < 64 ? (i >> 6) : (i & 63)) * inv, cs = cosf(ang), sn = sinf(ang);
                const float rq1 = (q1 * cs - q2 * sn) * 0.0625f, rq2 = (q1 * sn + q2 * cs) * 0.0625f, rk1 = k1 * cs - k2 * sn, rk2 = k1 * sn + k2 * cs; const int jl = i & 511;
                dbg_report(dw, rq1, bf2f(Qb[(size_t)i * 512 + hl * 256 + 2 * pp]), 1000.0f); dbg_report(dw, rq2, bf2f(Qb[(size_t)i * 512 + hl * 256 + 2 * pp + 1]), 1000.0f);
                dbg_report(dw, rk1, bf2f(Knb[(size_t)i * 512 + hl * 256 + 2 * pp]), 1000.0f); dbg_report(dw, rk2, bf2f(Knb[(size_t)i * 512 + hl * 256 + 2 * pp + 1]), 1000.0f);
                dbg_report(dw, rk2 * expf(lgp[h] * (float)(511 - jl)), bf2f(Ktb_[(size_t)(hl * 256 + 2 * pp + 1) * SEQ + i]), 1000.0f);
                dbg_report(dw, rk1 * expf(lgp[4 + h] * (float)jl), bf2f(Ktb_[(size_t)512 * SEQ + (size_t)(hl * 256 + 2 * pp) * SEQ + i]), 1000.0f);
                dbg_report(dw, vv, bf2f(B4[((size_t)((hl * NSEG + (i >> 9)) * 512 + v)) * 1024 + 512 + jl]), 1000.0f); }
        PHASE_END
        }
        PHASE_BEGIN
            { Geo g{1024, 1024, LS, 128u * 1024 * 2u, 128u * 1024 * 2u, 128u * (unsigned)LS * 2u, LS / 64, 1 << 20, 1 << 20};
              pg::Sched<JobR1> S{{FB}, 256, F.G, bx}; EpiU E{0, 0, FB};
              pg::gemm_phase<EpiU, pg::Sched<JobR1>, 1>(F.lds, g, S, E); }
            if (pair == 0) { Geo g{CTX, CTX, CTX, 128u * CTX * 2u, 128u * CTX * 2u, 128u * CTX * 2u, CTX / 64, 1 << 20, 1 << 20};
              pg::Sched<JobS0> S{{FB}, 16, F.G, (bx + F.G - 64) % F.G}; EpiS0 E{0, 0, FB};
              pg::gemm_phase<EpiS0, pg::Sched<JobS0>, 1>(F.lds, g, S, E); }
        PHASE_END
        if constexpr (DBG_PROBE == 6) {
        PHASE_BEGIN
            LAS float* scr = (LAS float*)F.lds; unsigned* dw = (unsigned*)(F.ws + WS_CTL) + 32768;
            const int s = bx, h = s & 3, dir = (s >> 2) & 1, d = (s * 29 + 3) & 255, v = (s * 37 + 11) & 511; const float* win = GIN(10);
            const int j = F.tid & 255, which = F.tid >> 8; const int col = which ? 2048 + h * 512 + v : 1024 + h * 256 + d; float dot = 0.f;
            for (int a = 0; a < DM; ++a) dot += bf2f(Ac[(size_t)j * DM + a]) * win[(size_t)a * 9216 + col];
            scr[16 + F.tid] = dot; __syncthreads();
            float term = 0.f; if (F.tid < 256) term = scr[16 + F.tid] * scr[16 + 256 + F.tid] * expf(lgp[dir * 4 + h] * (float)(dir ? j : 255 - j));
            __syncthreads();
            const float ref = block_sum(scr, term, F.tid);
            if (F.tid == 0) dbg_report(dw, ref, S0[((size_t)((h * 2 + dir) * 512 + v)) * 256 + d], 1000.0f);
        PHASE_END
        }
        PHASE_BEGIN
            { const int gw = F.wave < 4 ? F.vcu * 4 + F.wave : 1024, NGW = F.G * 4;
              for (int rowid = gw; rowid < 1024; rowid += NGW) { const int hl = rowid >> 9, v = rowid & 511, h = 2 * pair + hl, dir = F.lane >> 5, d0 = (F.lane & 31) * 8;
                  const float* s0 = S0 + ((size_t)((h * 2 + dir) * 512 + v)) * 256 + d0; f32x4 c0 = *(const f32x4*)s0, c1 = *(const f32x4*)(s0 + 4);
                  const float dec = expf(lgp[dir * 4 + h] * (float)LS);
                  bf16_t* pb = B4 + ((size_t)(hl * NSEG * 512 + v)) * 1024 + dir * 256 + d0; const long sstep = dir ? -(long)512 * 1024 : (long)512 * 1024; if (dir) pb += (size_t)(NSEG - 1) * 512 * 1024;
                  u32x4 ub[NSEG];
#pragma unroll
                  for (int it = 0; it < NSEG; ++it) ub[it] = *(const u32x4*)(pb + (long)it * sstep);
#pragma unroll
                  for (int it = 0; it < NSEG; ++it) { f32x4 u0, u1; unpack8(ub[it], u0, u1); *(u32x4*)(pb + (long)it * sstep) = _rep == 0 ? pack8(c0, c1) : ub[it]; c0 = c0 * dec + u0; c1 = c1 * dec + u1; } } }
            { Geo g{512, 512, 512, 128u * 512 * 2u, 128u * 512 * 2u, 128u * 512 * 2u, 4, 1 << 20, 1 << 20};
              pg::Sched<JobR3> S{{FB}, 256, F.G, bx}; EpiP E{0, 0, FB, pair};
              pg::gemm_phase<EpiP, pg::Sched<JobR3>, 1>(F.lds, g, S, E); }
        PHASE_END
        PHASE_BEGIN
            Geo g{512, 1024, 1024, 128u * 512 * 2u, 128u * 1024 * 2u, 128u * 1024 * 2u, 16, 8, 4};
            pg::Sched<JobR4> S{{FB}, 256, F.G, bx}; EpiO E{4, 8, FB, pair};
            pg::gemm_phase<EpiO, pg::Sched<JobR4>, 2>(F.lds, g, S, E);
        PHASE_END
        if constexpr (DBG_PROBE == 1) {
        PHASE_BEGIN
            LAS float* scr = (LAS float*)F.lds; unsigned* dw = (unsigned*)(F.ws + WS_CTL) + 32768;
            const int s = bx; int i = (int)(((unsigned)s * 2654435761u) >> 18) & 16383; if (s < 8) { const int sp[8] = {0, 1, 511, 512, 513, 8191, 16382, 16383}; i = sp[s]; }
            const int hl = s & 1, h = 2 * pair + hl, v = (s * 37 + 11) & 511; const float lgf = lgp[h], lgb = lgp[4 + h];
            float part = 0.f;
            for (int j = F.tid; j < SEQ; j += NTHREADS) { float qk = 0.f;
                for (int d = 0; d < 256; ++d) qk += bf2f(Qb[(size_t)i * 512 + hl * 256 + d]) * bf2f(Knb[(size_t)j * 512 + hl * 256 + d]);
                const float D = j < i ? __expf(lgf * (float)(i - j)) : (j > i ? __expf(lgb * (float)(j - i)) : 2.0f);
                part += D * qk * bf2f(B4[((size_t)((hl * NSEG + (j >> 9)) * 512 + v)) * 1024 + 512 + (j & 511)]); }
            if (F.tid < 256) { const float q = bf2f(Qb[(size_t)i * 512 + hl * 256 + F.tid]);
                part += q * (__expf(lgf * (float)(i + 1)) * S0[((size_t)((h * 2 + 0) * 512 + v)) * 256 + F.tid] + __expf(lgb * (float)(SEQ - i)) * S0[((size_t)((h * 2 + 1) * 512 + v)) * 256 + F.tid]); }
            const float ref = block_sum(scr, part, F.tid);
            const float ov = bf2f(Ob[(size_t)i * 2048 + h * 512 + F.tid]); const float rms = sqrtf(block_sum(scr, ov * ov, F.tid) * (1.0f / 512.0f));
            if (F.tid == 0) dbg_report(dw, ref, bf2f(Ob[(size_t)i * 2048 + h * 512 + v]), rms * 1000.0f);
        PHASE_END
        }
    }
    if constexpr (DBG_PROBE == 7 || DBG_PROBE == 8) {
    PHASE_BEGIN
        LAS float* scr = (LAS float*)F.lds; unsigned* dw = (unsigned*)(F.ws + WS_CTL) + 32768; float* sav = (float*)(F.ws + WS_END);
        const int s = bx; const int i = s * 64 + 57, h = DBG_COL >> 9, v = DBG_COL & 511;
        const float ov = bf2f(Ob[(size_t)i * 2048 + h * 512 + F.tid]); const float mean = block_sum(scr, ov, F.tid) * (1.0f / 512.0f);
        const float var = block_sum(scr, (ov - mean) * (ov - mean), F.tid) * (1.0f / 512.0f); const float rstd = 1.0f / sqrtf(var + EPS);
        if (F.tid == 0) { if (DBG_PROBE == 7) { dbg_report(dw, mean, stats[(size_t)(i * 4 + h) * 2], 1000.0f); dbg_report(dw, rstd, stats[(size_t)(i * 4 + h) * 2 + 1], 1000.0f); }
            sav[s * 4 + 0] = (bf2f(Ob[(size_t)i * 2048 + h * 512 + v]) - mean) * rstd; }
    PHASE_END
    }
    PHASE_BEGIN
        { LAS unsigned char* stl = F.lds + RING_BYTES + 1024;
          if (_rep == 0) { const int cq = (bx & 7) * 32 + (bx >> 3), pm = cq >> 2, h = cq & 3;
            const float* gst = (const float*)(F.ws + ((h >> 1) ? WS_KC : WS_HC));
            if (F.tid < 256) { const int r = F.tid; const float* p = gst + (size_t)((pm * 256 + r) * 2 + (h & 1)) * 16; float s = 0.f, q = 0.f;
#pragma unroll
                for (int i = 0; i < 4; ++i) { const f32x4 v = *(const f32x4*)(p + 4 * i); s += v[0] + v[2]; q += v[1] + v[3]; }
                const float mean = s * (1.0f / 512.0f), var = fmaxf(q * (1.0f / 512.0f) - mean * mean, 0.f);
                *(LAS f32x2*)(stl + r * 8) = (f32x2){mean, 1.0f / sqrtf(var + EPS)}; }
            __syncthreads(); }
          pg::Sched<JobGG> S{{FB}, 1024, F.G, bx};
          EpiGG E{0, 0, FB, GIN(13), _rep, stl};
          pg::gemm_phase<EpiGG, pg::Sched<JobGG>, 1>(F.lds, gK1024, S, E); }
        { Geo g{DM, DM, 128u * DM, 128u * DM * 2u, 128u * DM * 2u, (unsigned)DM * 2u, DM / 64, 1 << 20, 1 << 20};
          pg::Sched<JobRowCol> S{{FB, 1, 4, 64, (size_t)WR_F * DM, 0, (size_t)256 * DM, (size_t)2 * DM}, 256, F.G, bx};
          EpiF E{0, 0, FB};
          pg::gemm_phase<EpiF, pg::Sched<JobRowCol>, 1>(F.lds, g, S, E); }
    PHASE_END
    if constexpr (DBG_PROBE == 8) {
    PHASE_BEGIN
        LAS float* scr = (LAS float*)F.lds; unsigned* dw = (unsigned*)(F.ws + WS_CTL) + 32768; float* sav = (float*)(F.ws + WS_END);
        const int s = bx; const int i = s * 64 + 57, h = DBG_COL >> 9, v = DBG_COL & 511, col = h * 512 + v; float g = 0.f;
        for (int a = F.tid; a < DM; a += NTHREADS) g += bf2f(Ax[(size_t)i * DM + a]) * GIN(10)[(size_t)a * 9216 + 4096 + col];
        g = block_sum(scr, g, F.tid);
        if (F.tid == 0) dbg_report(dw, g / (1.0f + expf(-g)) * sav[s * 4] * GIN(13)[col], bf2f(Ob[(size_t)i * 2048 + col]), 1.0f);
    PHASE_END
    }
    PHASE_BEGIN
        Geo g{256, 256, 256, 128u * 256 * 2u, 128u * 256 * 2u, 128u * 256 * 2u, 4, 1 << 20, 1 << 20};
        pg::Sched<JobF1> S{{FB}, 256, F.G, bx}; EpiF1 E{0, 0, FB};
        pg::gemm_phase<EpiF1, pg::Sched<JobF1>, 1>(F.lds, g, S, E);
    PHASE_END
    if constexpr (DBG_PROBE == 2 || DBG_PROBE == 4) {
    PHASE_BEGIN
        LAS float* scr = (LAS float*)F.lds; unsigned* dw = (unsigned*)(F.ws + WS_CTL) + 32768;
        if (DBG_PROBE == 4) {
            const int s = bx; const int l = (int)(((unsigned)s * 2654435761u) >> 18) & 16383, ch = (s * 131 + 7) & 1023, g = ch >> 8, cp = ch & 255;
            const int c = F.tid & 255, hf = F.tid >> 8; float fpart = 0.f;
            for (int a = hf * 512; a < hf * 512 + 512; ++a) fpart += bf2f(Ax[(size_t)l * DM + a]) * GIN(10)[(size_t)a * 9216 + 6144 + g * 256 + c];
            scr[16 + F.tid] = fpart; __syncthreads();
            float wr_ = 0.f, wi_ = 0.f;
            if (F.tid < 256) { const float fv = scr[16 + F.tid] + scr[16 + 256 + F.tid]; const float ang = (float)((c * cp) & 255) * (1.0f / 128.0f); wr_ = fv * cospif(ang); wi_ = -fv * sinpif(ang); }
            __syncthreads();
            const float Wr = block_sum(scr, wr_, F.tid), Wi = block_sum(scr, wi_, F.tid);
            const int l1 = l >> 7, l2 = l & 127;
            if (F.tid == 0) { dbg_report(dw, Wr, bf2f(Wt[(size_t)(ch * 128 + l2) * 256 + l1]), 16000.0f); dbg_report(dw, Wi, bf2f(Wt[(size_t)(ch * 128 + l2) * 256 + 128 + l1]), 16000.0f); }
        } else {
            const unsigned sid = (unsigned)(bx * NTHREADS + F.tid) * 2654435761u; const int k1 = (sid >> 8) & 127, l2 = (sid >> 15) & 127, ch = (sid >> 22) & 1023;
            float ar = 0.f, ai = 0.f;
            for (int l1 = 0; l1 < 128; ++l1) { const float wr_ = bf2f(Wt[(size_t)(ch * 128 + l2) * 256 + l1]), wi_ = bf2f(Wt[(size_t)(ch * 128 + l2) * 256 + 128 + l1]);
                const float a = (float)((k1 * l1) & 127) * (1.0f / 64.0f), cs = cospif(a), sn = sinpif(a); ar += cs * wr_ + sn * wi_; ai += cs * wi_ - sn * wr_; }
            const float t = (float)((k1 * l2) & 16383) * (1.0f / 8192.0f), ct = cospif(t), st = sinpif(t);
            const float br = ar * ct + ai * st, bi = ai * ct - ar * st;
            dbg_report(dw, br, bf2f(Bt[(size_t)(k1 * 1024 + ch) * 256 + l2]), 180000.0f); dbg_report(dw, bi, bf2f(Bt[(size_t)(k1 * 1024 + ch) * 256 + 128 + l2]), 180000.0f);
        }
    PHASE_END
    }
    PHASE_BEGIN
        Geo g{256, 256, 256, 128u * 256 * 2u, 128u * 256 * 2u, 128u * 256 * 2u, 4, 1 << 20, 1 << 20};
        pg::Sched<JobF2> S{{FB}, 256, F.G, bx}; EpiF2 E{0, 0, FB};
        pg::gemm_phase<EpiF2, pg::Sched<JobF2>, 1>(F.lds, g, S, E);
    PHASE_END
    if constexpr (DBG_PROBE == 3) {
    PHASE_BEGIN
        unsigned* dw = (unsigned*)(F.ws + WS_CTL) + 32768;
        const unsigned sid = (unsigned)(bx * NTHREADS + F.tid) * 2654435761u; const int k1 = (sid >> 8) & 127, k2 = (sid >> 15) & 127, ch = (sid >> 22) & 1023;
        float y = 0.f;
        for (int l2 = 0; l2 < 128; ++l2) { const float br = bf2f(Bt[(size_t)(k1 * 1024 + ch) * 256 + l2]), bi = bf2f(Bt[(size_t)(k1 * 1024 + ch) * 256 + 128 + l2]);
            const float a = (float)((k2 * l2) & 127) * (1.0f / 64.0f); y += br * cospif(a) + bi * sinpif(a); }
        dbg_report(dw, y * (1.0f / 2048.0f), bf2f(MIXb[(size_t)(k1 + 128 * k2) * 2048 + ch]), 1000.0f);
    PHASE_END
    }
    if constexpr (DBG_PROBE == 12) {
    PHASE_BEGIN
        unsigned* dw = (unsigned*)(F.ws + WS_CTL) + 32768;
        for (size_t idx = gtid; idx < (size_t)DM * 9216; idx += gthreads) { const int k = (int)(idx / 9216), n = (int)(idx % 9216); const int dr = tr_dest_row(2, n);
            if (dr >= 0) { const float a = GIN(10)[idx]; const float b = bf2f(Win[(size_t)dr * DM + k]); if (fabsf(a - b) > 0.01f * fabsf(a) + 1e-6f) { atomicAdd(dw + 64, 1u); atomicMin(dw + 192, (unsigned)(dr >> 8)); } } }
    PHASE_END
    }
    if constexpr (DBG_PROBE == 9) {
    PHASE_BEGIN
        LAS float* scr = (LAS float*)F.lds; unsigned* dw = (unsigned*)(F.ws + WS_CTL) + 32768;
        const int s = bx; const int i = DBG_VAR == 0 ? 1210 : (DBG_VAR == 1 ? 1024 + s : (DBG_VAR == 2 ? s * 64 + 57 : 1210 + 256 * (s & 63))), n = DBG_VAR == 0 ? 4 * s : 736; float ga = 0.f, gf = 0.f;
        for (int a = F.tid; a < DM; a += NTHREADS) { const float x = bf2f(Ax[(size_t)i * DM + a]); ga += x * GIN(10)[(size_t)a * 9216 + 7168 + n]; gf += x * GIN(10)[(size_t)a * 9216 + 8192 + n]; }
        ga = block_sum(scr, ga, F.tid); gf = block_sum(scr, gf, F.tid);
        if (F.tid == 0) { const float ea = fabsf(1.0f / (1.0f + expf(-ga)) - bf2f(GAb[(size_t)i * DM + n])), ef = fabsf(1.0f / (1.0f + expf(-gf)) - bf2f(GFb[(size_t)i * DM + n]));
            if (ea > 0.05f) { atomicMin(dw + 192, (unsigned)s); atomicAdd(dw + 64, 1u); dbg_report(dw, 0.f, DBG_GF ? ea : bf2f(GAb[(size_t)i * DM + n]), 1000.0f); } if (ef > 0.05f) atomicMin(dw + 193, (unsigned)s); }
    PHASE_END
    }
    PHASE_BEGIN
        { int pmz, pnz; pg::tile_pm_pn(bx, 64, 4, pmz, pnz); const float* side = (const float*)(F.ws + WS_STATS);
          for (int t = F.tid; t < 1024; t += NTHREADS) { const int k = pmz * 256 + (t >> 2), g = t & 3, kr = (SEQ - k) & (SEQ - 1);
              const f32x2 s1 = *(const f32x2*)(side + (size_t)(k * 4 + g) * 2), s2 = *(const f32x2*)(side + (size_t)(kr * 4 + g) * 2);
              MIXb[(size_t)k * 1024 + g * 256] = f2bf(0.5f * (s1.x + s2.x)); MIXb[(size_t)k * 1024 + g * 256 + 128] = f2bf(0.5f * (s1.y + s2.y)); }
          asm volatile("s_waitcnt vmcnt(0)" ::: "memory"); __syncthreads(); }
        { Geo g{1024, 2048, BZP, 128u * 1024 * 2u, 128u * 2048 * 2u, 128u * BZP * 2u, 48, 16, 1 << 20};
          pg::Sched<JobZ3> S{{FB}, 256, F.G, bx}; EpiZ3 E{16, 0, FB};
          pg::gemm_phase<EpiZ3, pg::Sched<JobZ3>, 2>(F.lds, g, S, E); }
    PHASE_END
    if constexpr (DBG_PROBE == 9 || DBG_PROBE == 10) {
    PHASE_BEGIN
        LAS float* scr = (LAS float*)F.lds; unsigned* dw = (unsigned*)(F.ws + WS_CTL) + 32768;
        const int s = bx; const int i = (int)(((unsigned)s * 2654435761u) >> 18) & 16383, n = (s * 131 + 7) & 1023;
        if (DBG_PROBE == 9) { float ga = 0.f, gf = 0.f;
            (void)ga; (void)gf;
        } else { float r = 0.f, fo = 0.f;
            for (int k = F.tid; k < 2048; k += NTHREADS) r += bf2f(Ob[(size_t)i * 2048 + k]) * GIN(14)[(size_t)k * DM + n];
            for (int k = F.tid; k < 1024; k += NTHREADS) fo += bf2f(MIXb[(size_t)i * 2048 + k]) * GIN(15)[(size_t)k * DM + n];
            r = block_sum(scr, r, F.tid); fo = block_sum(scr, fo, F.tid);
            if (F.tid == 0) dbg_report(dw, bf2f(GAb[(size_t)i * DM + n]) * r + bf2f(GFb[(size_t)i * DM + n]) * fo, bf2f(Zb[(size_t)i * DM + n]), 1000.0f); }
    PHASE_END
    }
    PHASE_BEGIN
        pg::Sched<JobRowCol> S{{FB, 2, 64, 4, 0, 0, (size_t)256 * DM, (size_t)256 * DM}, 256, F.G, bx};
        const Geo& g = gK1024;
        EpiFuse E{0, 0, FB, 1, GIN(0), GIN(17)};
        pg::gemm_phase<EpiFuse, pg::Sched<JobRowCol>, 1>(F.lds, g, S, E);
    PHASE_END
    }
    PHASE_BEGIN
        SchedFfn2Up S{FB, F.G, bx};
        EpiSwigluH E{0, 0, FB};
        pg::gemm_phase<EpiSwigluH, SchedFfn2Up, 1>(F.lds, gK1024, S, E);
    PHASE_END
    PHASE_BEGIN
        pg::Sched<JobFfn2> S{{FB, 64, 0}, 64 * 4, F.G, bx};
        EpiFuse E{0, 0, FB, 2, GIN(0), GIN(20)};
        pg::gemm_phase<EpiFuse, pg::Sched<JobFfn2>, 1>(F.lds, gFfn2, S, E);
    PHASE_END
    if constexpr (DBG_TSEL >= 0) {
    PHASE_BEGIN
        const unsigned long long* ts = (const unsigned long long*)(F.ws + WS_CTL + 160000);
        if (bx == 0) { const float a = 0.1f * (float)(ts[DBG_TSEL + 1] - ts[DBG_TSEL]), b = 0.1f * (float)(ts[DBG_TSEL2 + 1] - ts[DBG_TSEL2]);
            if (F.tid == 0) ((float*)F.dout)[0] = a; for (int i = F.tid; i < 1024; i += NTHREADS) ((float*)F.dout)[1024 + i] = b; }
    PHASE_END
    }
    if constexpr (DBG_PROBE != 0) {
    PHASE_BEGIN
        if (bx == 0 && F.tid == 0) { const float e = __builtin_bit_cast(float, ((unsigned*)(F.ws + WS_CTL))[32768]); ((float*)F.dout)[0] = DBG_COUNT == 3 ? 100.0f * (float)(16u + ((((unsigned*)(F.ws + WS_CTL))[32768 + 192 + DBG_GF] + 0xC0000000u - 0xC0000000u) >> DBG_SH & 15u)) : DBG_COUNT == 2 ? 100.0f * (float)(16u + ((unsigned*)(F.ws + WS_CTL))[32768 + 128]) : DBG_COUNT ? 1000.0f + 10.0f * (float)((unsigned*)(F.ws + WS_CTL))[32768 + 64] : 1000.0f * (10.0f + log10f(e + 1e-10f)); }
    PHASE_END
    }
}

extern "C" void kernel_launch(void* const* d_in, const int* in_sizes, int n_in, void* d_out, int out_size, void* d_ws, size_t ws_size, hipStream_t stream) {
    static int grid = 0;
    if (grid == 0) {
        if (n_in != 21 || out_size != SEQ * DM || ws_size < 256 * MiB) { fprintf(stderr, "kernel_launch: unexpected shapes (n_in %d out %d ws %zu)\n", n_in, out_size, ws_size); grid = -1; return; }
        int dev = 0, cus = 0, per_cu = 0;
        if (hipGetDevice(&dev) != hipSuccess || hipDeviceGetAttribute(&cus, hipDeviceAttributeMultiprocessorCount, dev) != hipSuccess) { grid = -1; return; }
        if (hipFuncSetAttribute((const void*)fwd_kernel, hipFuncAttributeMaxDynamicSharedMemorySize, LDS_BYTES) != hipSuccess) { fprintf(stderr, "kernel_launch: hipFuncSetAttribute failed\n"); grid = -1; return; }
        if (hipOccupancyMaxActiveBlocksPerMultiprocessor(&per_cu, (const void*)fwd_kernel, NTHREADS, LDS_BYTES) != hipSuccess || per_cu < 1) { fprintf(stderr, "kernel_launch: occupancy query says %d blocks/CU\n", per_cu); }
        (void)hipGetLastError();
        grid = cus;
    }
    if (grid < 0) return;
    (void)hipMemsetAsync((char*)d_ws + WS_CTL, 0, CTL_ZERO_BYTES, stream);
    Args a{};
    for (int i = 0; i < 21; ++i) a.in[i] = (const float*)d_in[i];
    a.out = (float*)d_out; a.ws = (unsigned char*)d_ws; a.ph_lo = 0; a.ph_hi = 1000;
    hipLaunchKernelGGL(fwd_kernel, dim3(grid), dim3(NTHREADS), LDS_BYTES, stream, a);
}
```
